# Optimizing an MI355X kernel written in HIP

```python
import jax
import jax.numpy as jnp
from jax import lax
import numpy as np


D_MODEL = 1024
BATCH = 16
SEQ = 2048
DEPTH = 4

N_MIXERS = 2
RET_HEADS = 4
RET_QK_DIM = D_MODEL // RET_HEADS
RET_V_DIM = 2 * RET_QK_DIM
RET_CHUNK = 128
RET_IN_DIM = 2 * RET_HEADS * RET_QK_DIM + 2 * RET_HEADS * RET_V_DIM
NSA_HEADS = 16
NSA_GROUPS = 4
NSA_HPG = NSA_HEADS // NSA_GROUPS
NSA_HEAD_DIM = D_MODEL // NSA_HEADS
NSA_KV_DIM = NSA_GROUPS * NSA_HEAD_DIM
NSA_IN_DIM = D_MODEL + 6 * NSA_KV_DIM + 3 * NSA_HEADS
CMP_BLOCK = 32
CMP_STRIDE = 16
CMP_HIDDEN = 256
SEL_BLOCK = 64
SEL_TOP = 16
WINDOW = 512
Q_BLOCK = 128
FORCED_SCORE = 1e4
INVALID_SCORE = -1.0
D_FF = 2816
FFN_RES = 0.5
DN_ALPHA = (2 * DEPTH) ** 0.25
DN_BETA = (8 * DEPTH) ** -0.25
LN_EPS = 1e-5
GN_EPS = 1e-6
NEG_INF = -1e30
ADA_GAIN = 0.1
N_RET_LAYERS = (DEPTH + 1) // 2
N_NSA_LAYERS = DEPTH // 2

kernel_name = 'hybrid_retention_nsa_macaron_deepnorm'


def layer_norm(x, g, b):
    xf = x.astype(jnp.float32)
    mu = jnp.mean(xf, -1, keepdims=True)
    var = jnp.mean(jnp.square(xf - mu), -1, keepdims=True)
    return ((xf - mu) * lax.rsqrt(var + LN_EPS) * g + b).astype(x.dtype)


def modulate(x, shift, scale):
    return x * (1.0 + scale[:, None, :]) + shift[:, None, :]


def post_norm_residual(x, y, gate, res_w, g, b):
    return layer_norm(DN_ALPHA * x + res_w * (1.0 + gate[:, None, :]) * y, g, b)


def swiglu(h, w_in, w_out):
    a, u = jnp.split(h @ w_in, 2, axis=-1)
    return (jax.nn.silu(a) * u) @ w_out


def masked_softmax(s, mask, axis):
    p = jax.nn.softmax(jnp.where(mask, s, NEG_INF), axis=axis)
    return p * mask


def retention(h, w_in, w_out):
    B, S, _ = h.shape
    C = RET_CHUNK
    n = S // C
    qk = RET_HEADS * RET_QK_DIM
    q, k, v, g = jnp.split(h @ w_in, [qk, 2 * qk, 2 * qk + RET_HEADS * RET_V_DIM], axis=-1)

    def heads(t, d):
        return t.reshape(B, n, C, RET_HEADS, d).transpose(1, 0, 3, 2, 4).astype(jnp.float32)

    qc = heads(q, RET_QK_DIM)
    kc = heads(k, RET_QK_DIM) * (RET_QK_DIM ** -0.5)
    vc = heads(v, RET_V_DIM)
    log_g = jnp.log(1.0 - jnp.exp2(-5.0 - jnp.arange(RET_HEADS, dtype=jnp.float32)))
    i = jnp.arange(C, dtype=jnp.float32)
    diff = i[:, None] - i[None, :]
    decay_intra = jnp.where(diff >= 0, jnp.exp(log_g[:, None, None] * jnp.maximum(diff, 0.0)), 0.0)
    decay_q = jnp.exp(log_g[:, None] * (i + 1.0))[:, :, None]
    decay_k = jnp.exp(log_g[:, None] * (C - 1.0 - i))[:, :, None]
    decay_state = jnp.exp(log_g * C)[:, None, None]

    def step(state, inp):
        qi, ki, vi = inp
        scores = jnp.einsum('bhcd,bhkd->bhck', qi, ki) * decay_intra
        o = jnp.einsum('bhck,bhke->bhce', scores, vi) + jnp.einsum('bhcd,bhde->bhce', qi * decay_q, state)
        state = decay_state * state + jnp.einsum('bhcd,bhce->bhde', ki * decay_k, vi)
        return state, o

    state0 = jnp.zeros((B, RET_HEADS, RET_QK_DIM, RET_V_DIM), jnp.float32)
    _, o = lax.scan(step, state0, (qc, kc, vc))
    mu = jnp.mean(o, -1, keepdims=True)
    var = jnp.mean(jnp.square(o - mu), -1, keepdims=True)
    o = (o - mu) * lax.rsqrt(var + GN_EPS)
    o = o.transpose(1, 0, 3, 2, 4).reshape(B, S, RET_HEADS * RET_V_DIM)
    return (o * jax.nn.silu(g.astype(jnp.float32))).astype(h.dtype) @ w_out


def alibi_slopes(n):
    return jnp.exp2(-8.0 * jnp.arange(1, n + 1, dtype=jnp.float32) / n)


def cmp_to_sel_overlap(n_cmp, n_sel):
    c0 = np.arange(n_cmp) * CMP_STRIDE
    s0 = np.arange(n_sel) * SEL_BLOCK
    lo = np.maximum(c0[:, None], s0[None, :])
    hi = np.minimum(c0[:, None] + CMP_BLOCK, s0[None, :] + SEL_BLOCK)
    return (np.clip(hi - lo, 0, None) / CMP_BLOCK).astype(np.float32)


def compress(t, pe, w1, w2):
    B, S, G, dh = t.shape
    n_cmp = (S - CMP_BLOCK) // CMP_STRIDE + 1
    idx = jnp.arange(n_cmp)[:, None] * CMP_STRIDE + jnp.arange(CMP_BLOCK)[None, :]
    blocks = t[:, idx] + pe[None, None, :, None, :]
    blocks = blocks.transpose(0, 1, 3, 2, 4).reshape(B, n_cmp, G, CMP_BLOCK * dh)
    return jax.nn.gelu(blocks @ w1) @ w2


def nsa(h, w_in, w_out, pe_k, pe_v, ck_w1, ck_w2, cv_w1, cv_w2):
    B, S, D = h.shape
    G, HPG, dh, kv = NSA_GROUPS, NSA_HPG, NSA_HEAD_DIM, NSA_KV_DIM
    splits = [D + j * kv for j in range(7)]
    q, kc, vc, ks, vs, kw, vw, gates = jnp.split(h @ w_in, splits, axis=-1)
    q = q.reshape(B, S, G, HPG, dh) * (dh ** -0.5)
    kc = compress(kc.reshape(B, S, G, dh), pe_k, ck_w1, ck_w2)
    vc = compress(vc.reshape(B, S, G, dh), pe_v, cv_w1, cv_w2)
    n_cmp = kc.shape[1]
    n_sel = S // SEL_BLOCK
    top = min(SEL_TOP, n_sel)
    ks = ks.reshape(B, n_sel, SEL_BLOCK, G, dh).transpose(0, 3, 1, 2, 4)
    vs = vs.reshape(B, n_sel, SEL_BLOCK, G, dh).transpose(0, 3, 1, 2, 4)
    pad = ((0, 0), (WINDOW, 0), (0, 0), (0, 0))
    kw = jnp.pad(kw.reshape(B, S, G, dh), pad)
    vw = jnp.pad(vw.reshape(B, S, G, dh), pad)
    gates = jax.nn.sigmoid(gates.astype(jnp.float32)).reshape(B, S, G, HPG, 3)
    slopes = alibi_slopes(NSA_HEADS).reshape(G, HPG)
    cmp_end = jnp.arange(n_cmp) * CMP_STRIDE + CMP_BLOCK - 1
    overlap = jnp.asarray(cmp_to_sel_overlap(n_cmp, n_sel))
    blk = jnp.arange(n_sel)
    n_qb = S // Q_BLOCK
    span = WINDOW + Q_BLOCK

    def block_fn(bq):
        b = bq // n_qb
        q0 = (bq % n_qb) * Q_BLOCK
        t = q0 + jnp.arange(Q_BLOCK)
        qi = lax.dynamic_slice(q, (b, q0, 0, 0, 0), (1, Q_BLOCK, G, HPG, dh))[0]
        kcb, vcb = kc[b], vc[b]
        dist_c = t[:, None] - cmp_end[None, :]
        s = jnp.einsum('qghd,ngd->ghqn', qi, kcb).astype(jnp.float32) - slopes[:, :, None, None] * dist_c.astype(jnp.float32)
        p_cmp = masked_softmax(s, dist_c >= 0, -1)
        o_cmp = jnp.einsum('ghqn,ngd->qghd', p_cmp, vcb)
        imp = jnp.einsum('ghqn,nj->gqj', p_cmp, overlap)
        cur = (t // SEL_BLOCK)[:, None]
        forced = (blk == 0) | (blk == cur) | (blk == cur - 1)
        valid = blk[None, :] * SEL_BLOCK <= t[:, None]
        score = jnp.where(valid, jnp.where(forced, FORCED_SCORE, imp), INVALID_SCORE)
        _, sel = lax.top_k(score, top)
        k_g = jax.vmap(lambda kk, ii: kk[ii])(ks[b], sel)
        v_g = jax.vmap(lambda vv, ii: vv[ii])(vs[b], sel)
        pos = sel[..., None] * SEL_BLOCK + jnp.arange(SEL_BLOCK)
        dist_s = t[None, :, None, None] - pos
        s = jnp.einsum('qghd,gqnkd->ghqnk', qi, k_g).astype(jnp.float32) - slopes[:, :, None, None, None] * dist_s[:, None].astype(jnp.float32)
        p = masked_softmax(s, (dist_s >= 0)[:, None], (-2, -1))
        o_sel = jnp.einsum('ghqnk,gqnkd->qghd', p, v_g)
        kwb = lax.dynamic_slice(kw, (b, q0, 0, 0), (1, span, G, dh))[0]
        vwb = lax.dynamic_slice(vw, (b, q0, 0, 0), (1, span, G, dh))[0]
        s_pos = q0 - WINDOW + jnp.arange(span)
        dist_w = t[:, None] - s_pos[None, :]
        mask_w = (dist_w >= 0) & (dist_w < WINDOW) & (s_pos >= 0)[None, :]
        s = jnp.einsum('qghd,kgd->ghqk', qi, kwb).astype(jnp.float32) - slopes[:, :, None, None] * dist_w.astype(jnp.float32)
        p = masked_softmax(s, mask_w, -1)
        o_win = jnp.einsum('ghqk,kgd->qghd', p, vwb)
        gb = lax.dynamic_slice(gates, (b, q0, 0, 0, 0), (1, Q_BLOCK, G, HPG, 3))[0]
        o = gb[..., 0:1] * o_cmp + gb[..., 1:2] * o_sel + gb[..., 2:3] * o_win
        return o.astype(h.dtype)

    o = lax.map(block_fn, jnp.arange(B * n_qb))
    return o.reshape(B, S, D) @ w_out


def setup_inputs(seed: int = 0) -> dict:
    key = jax.random.key(seed)
    ks = jax.random.split(key, 20)

    def w(k, shape, fan_in, gain=1.0):
        return jax.random.normal(k, shape, jnp.float32) * (gain * fan_in ** -0.5)

    D = D_MODEL
    dh = NSA_HEAD_DIM
    return {
        'x': jax.random.normal(ks[0], (BATCH, SEQ, D), jnp.float32),
        'c': jax.random.normal(ks[1], (BATCH, D), jnp.float32),
        'ada_w': w(ks[2], (DEPTH, D, 9 * D), D, ADA_GAIN),
        'ada_b': 0.01 * jax.random.normal(ks[3], (DEPTH, 9 * D), jnp.float32),
        'ln_g': 1.0 + 0.02 * jax.random.normal(ks[4], (DEPTH, 3, D), jnp.float32),
        'ln_b': 0.02 * jax.random.normal(ks[5], (DEPTH, 3, D), jnp.float32),
        'ffn_w_in': w(ks[6], (DEPTH, 2, D, 2 * D_FF), D),
        'ffn_w_out': w(ks[7], (DEPTH, 2, D_FF, D), D_FF, DN_BETA),
        'ret_w_in': w(ks[8], (N_RET_LAYERS, D, RET_IN_DIM), D),
        'ret_w_out': w(ks[9], (N_RET_LAYERS, RET_HEADS * RET_V_DIM, D), RET_HEADS * RET_V_DIM, DN_BETA),
        'nsa_w_in': w(ks[10], (N_NSA_LAYERS, D, NSA_IN_DIM), D),
        'nsa_w_out': w(ks[11], (N_NSA_LAYERS, D, D), D, DN_BETA),
        'nsa_pe_k': 0.1 * jax.random.normal(ks[12], (N_NSA_LAYERS, CMP_BLOCK, dh), jnp.float32),
        'nsa_pe_v': 0.1 * jax.random.normal(ks[13], (N_NSA_LAYERS, CMP_BLOCK, dh), jnp.float32),
        'nsa_ck_w1': w(ks[14], (N_NSA_LAYERS, CMP_BLOCK * dh, CMP_HIDDEN), CMP_BLOCK * dh),
        'nsa_ck_w2': w(ks[15], (N_NSA_LAYERS, CMP_HIDDEN, dh), CMP_HIDDEN),
        'nsa_cv_w1': w(ks[16], (N_NSA_LAYERS, CMP_BLOCK * dh, CMP_HIDDEN), CMP_BLOCK * dh),
        'nsa_cv_w2': w(ks[17], (N_NSA_LAYERS, CMP_HIDDEN, dh), CMP_HIDDEN),
    }


def reference(x, c, ada_w, ada_b, ln_g, ln_b, ffn_w_in, ffn_w_out, ret_w_in, ret_w_out,
              nsa_w_in, nsa_w_out, nsa_pe_k, nsa_pe_v, nsa_ck_w1, nsa_ck_w2, nsa_cv_w1, nsa_cv_w2):
    c_act = jax.nn.silu(c)
    for i in range(DEPTH):
        mod = c_act @ ada_w[i] + ada_b[i]
        sh0, sc0, g0, sh1, sc1, g1, sh2, sc2, g2 = jnp.split(mod, 9, axis=-1)
        y = swiglu(modulate(x, sh0, sc0), ffn_w_in[i, 0], ffn_w_out[i, 0])
        x = post_norm_residual(x, y, g0, FFN_RES, ln_g[i, 0], ln_b[i, 0])
        h = modulate(x, sh1, sc1)
        j = i // N_MIXERS
        if i % N_MIXERS == 0:
            y = retention(h, ret_w_in[j], ret_w_out[j])
        else:
            y = nsa(h, nsa_w_in[j], nsa_w_out[j], nsa_pe_k[j], nsa_pe_v[j],
                    nsa_ck_w1[j], nsa_ck_w2[j], nsa_cv_w1[j], nsa_cv_w2[j])
        x = post_norm_residual(x, y, g1, 1.0, ln_g[i, 1], ln_b[i, 1])
        y = swiglu(modulate(x, sh2, sc2), ffn_w_in[i, 1], ffn_w_out[i, 1])
        x = post_norm_residual(x, y, g2, FFN_RES, ln_g[i, 2], ln_b[i, 2])
    return x
```

```cpp
#include <hip/hip_runtime.h>
#include <hip/hip_cooperative_groups.h>
#include <cstdio>
namespace cg = cooperative_groups;

namespace pg8 {
#define PG8_LAS __attribute__((address_space(3)))
typedef unsigned short bf16_t;
typedef short bf16x8 __attribute__((ext_vector_type(8)));
typedef float f32x4 __attribute__((ext_vector_type(4)));
typedef unsigned u32x4 __attribute__((ext_vector_type(4)));
constexpr int BM = 256, BK = 64, HALF = 128, HTB = HALF * BK * 2  , STAGE_BYTES = 8 * HTB, NXCD = 8, WGM = 8;

__host__ __device__ __forceinline__ int lds_byte(int r, int c) { const int st = (r >> 4) * 2 + (c >> 5), rr = r & 15, cc = c & 31, ob = rr * 64 + cc * 2; return st * 1024 + (ob ^ (((ob >> 9) & 1) << 5)); }
__host__ __device__ __forceinline__ void stage_rc(int b, int& R, int& C) { const int st = b / 1024, sb = b % 1024, swz = sb ^ (((sb >> 9) & 1) << 5); R = (st >> 1) * 16 + swz / 64; C = (st & 1) * 32 + (swz % 64) / 2; }
__host__ __device__ __forceinline__ int perm32(int rho) { const int n = rho >> 4, i = rho & 15; return 8 * (i >> 2) + 4 * n + (i & 3); }

struct Unit { int pm, pn; };
struct Gemm { const bf16_t* A; const bf16_t* Bt; int M, N, K; };

struct StaticOrder {
    int nM, nN, nwg, G, c;
    __host__ __device__ void init(int M, int N, int G_, int c_) { nM = M / BM; nN = N / BM; nwg = nM * nN; G = G_; c = c_; }
    __host__ __device__ bool next(int i, Unit& u) const {
        const long L = (long)i * G + c; if (L >= nwg) return false;
        int wgid = (int)L; { const int q = nwg / NXCD, r = nwg % NXCD, xcd = wgid % NXCD, off = wgid / NXCD; wgid = (xcd < r ? xcd * (q + 1) : r * (q + 1) + (xcd - r) * q) + off; }
        const int nig = WGM * nN, gid = wgid / nig, fm = gid * WGM, gsz = (nM - fm) < WGM ? (nM - fm) : WGM;
        u.pm = fm + ((wgid % nig) % gsz); u.pn = (wgid % nig) / gsz; return true;
    }
    __device__ __forceinline__ void a_ready(const Unit&) const {}
    __device__ __forceinline__ void done(const Unit&) const {}
};

typedef float f32x2_t __attribute__((ext_vector_type(2)));
typedef __bf16 bf16x2_t __attribute__((ext_vector_type(2)));
__device__ __forceinline__ unsigned cvt_pk_bf16(float lo, float hi) { const f32x2_t v = {lo, hi}; return __builtin_bit_cast(unsigned, __builtin_convertvector(v, bf16x2_t)); }
__device__ __forceinline__ float silu_f(float a) { return a / (1.0f + __expf(-a)); }
__device__ __forceinline__ float gelu_tanh_f(float x) { const float u = 0.7978845608028654f * (x + 0.044715f * x * x * x); const float t = 1.0f - 2.0f / (1.0f + __expf(2.0f * u)); return 0.5f * x * (1.0f + t); }

template <int ACT> struct Epi {
    static constexpr bool PERM = true, AFTER_DRAIN = false;
    bf16_t* O; int ldc;
    __device__ __forceinline__ void operator()(const f32x4 (&acc)[2][2][4][2], const Unit& u, int wr, int wc, int fr, int fq) const {
        const int row0 = u.pm * BM + wr * 64 + fr;
        if (ACT == 1) {
            const int col0 = u.pn * HALF + wc * 32 + 8 * fq;
#pragma unroll
            for (int ai = 0; ai < 2; ++ai)
#pragma unroll
                for (int m = 0; m < 4; ++m) { bf16_t* rowp = O + (size_t)(row0 + ai * HALF + m * 16) * ldc + col0;
                    const f32x4 a0 = acc[ai][0][m][0], a1 = acc[ai][0][m][1], u0 = acc[ai][1][m][0], u1 = acc[ai][1][m][1];
                    u32x4 w; w.x = cvt_pk_bf16(silu_f(a0[0]) * u0[0], silu_f(a0[1]) * u0[1]); w.y = cvt_pk_bf16(silu_f(a0[2]) * u0[2], silu_f(a0[3]) * u0[3]);
                    w.z = cvt_pk_bf16(silu_f(a1[0]) * u1[0], silu_f(a1[1]) * u1[1]); w.w = cvt_pk_bf16(silu_f(a1[2]) * u1[2], silu_f(a1[3]) * u1[3]);
                    *(u32x4*)rowp = w; }
        } else {
            const int col0 = u.pn * BM + wc * 32 + 8 * fq;
#pragma unroll
            for (int ai = 0; ai < 2; ++ai)
#pragma unroll
                for (int m = 0; m < 4; ++m) { bf16_t* rowp = O + (size_t)(row0 + ai * HALF + m * 16) * ldc + col0;
#pragma unroll
                    for (int bj = 0; bj < 2; ++bj) { f32x4 v0 = acc[ai][bj][m][0], v1 = acc[ai][bj][m][1];
                        if (ACT == 2) {
#pragma unroll
                            for (int j = 0; j < 4; ++j) { v0[j] = gelu_tanh_f(v0[j]); v1[j] = gelu_tanh_f(v1[j]); } }
                        u32x4 w; w.x = cvt_pk_bf16(v0[0], v0[1]); w.y = cvt_pk_bf16(v0[2], v0[3]); w.z = cvt_pk_bf16(v1[0], v1[1]); w.w = cvt_pk_bf16(v1[2], v1[3]);
                        *(u32x4*)(rowp + bj * HALF) = w; } }
        }
    }
};

template <class Epi, class Sched>
__device__ __forceinline__ void gemm_phase(PG8_LAS unsigned char* lds, const Gemm g, const Sched& S, const Epi& E) {
    const int tid = threadIdx.x, wid = __builtin_amdgcn_readfirstlane(tid >> 6), lane = tid & 63, wr = wid >> 2, wc = wid & 3, fr = lane & 15, fq = lane >> 4;
    const int K = g.K, nt = K / BK;
    unsigned voffA[2], voffB[2];
#pragma unroll
    for (int i = 0; i < 2; ++i) { int R, C; stage_rc(tid * 16 + i * 8192, R, C); const int Rb = Epi::PERM ? ((R & ~31) + perm32(R & 31)) : R;
        voffA[i] = (unsigned)(R * K + C) * 2u; voffB[i] = (unsigned)(Rb * K + C) * 2u; }
    const size_t kstep = (size_t)(BK * 2);
    const size_t hstep = (size_t)HALF * K * 2;
    const size_t tstep = 2 * hstep;
    const unsigned ldsw = (unsigned)wid * 1024u;
    const int aoff = lds_byte(wr * 64 + fr, fq * 8), boff = lds_byte(wc * 32 + fr, fq * 8);
#define PG8_SA(b, h) (((b) * 2 + (h)) * HTB)
#define PG8_SB(b, h) ((4 + (b) * 2 + (h)) * HTB)
#define PG8_STAGE(bufoff, gbase, voff) do { _Pragma("unroll") for (int _i = 0; _i < 2; ++_i) \
        __builtin_amdgcn_global_load_lds((const unsigned*)((const char*)(gbase) + (voff)[_i]), (PG8_LAS unsigned*)(lds + (bufoff) + ldsw + _i * 8192), 16, 0, 0); } while (0)
#define PG8_LDA(dst, b, h) do { _Pragma("unroll") for (int m = 0; m < 4; ++m) _Pragma("unroll") for (int k = 0; k < 2; ++k) dst[m][k] = *(const PG8_LAS bf16x8*)(lds + PG8_SA(b, h) + aoff + m * 2048 + k * 1024); } while (0)
#define PG8_LDB(dst, b, h) do { _Pragma("unroll") for (int n = 0; n < 2; ++n) _Pragma("unroll") for (int k = 0; k < 2; ++k) dst[n][k] = *(const PG8_LAS bf16x8*)(lds + PG8_SB(b, h) + boff + n * 2048 + k * 1024); } while (0)
#define PG8_MMA(ai, bj, At, Bt) do { __builtin_amdgcn_s_setprio(1); _Pragma("unroll") for (int m = 0; m < 4; ++m) _Pragma("unroll") for (int n = 0; n < 2; ++n) _Pragma("unroll") for (int k = 0; k < 2; ++k) \
        acc[ai][bj][m][n] = __builtin_amdgcn_mfma_f32_16x16x32_bf16(Bt[n][k], At[m][k], acc[ai][bj][m][n], 0, 0, 0); __builtin_amdgcn_s_setprio(0); } while (0)
#define PG8_WAIT_V(n) asm volatile("s_waitcnt vmcnt(" #n ")" ::: "memory")
#define PG8_WAIT_L(n) asm volatile("s_waitcnt lgkmcnt(" #n ")" ::: "memory")
#define PG8_BAR __builtin_amdgcn_s_barrier()
#define PG8_SCHED __builtin_amdgcn_sched_barrier(0)
    Unit cur, nxt; int ui = 0;
    if (!S.next(0, cur)) return;
    f32x4 acc[2][2][4][2];
#pragma unroll
    for (int a = 0; a < 2; ++a)
#pragma unroll
        for (int b = 0; b < 2; ++b)
#pragma unroll
            for (int m = 0; m < 4; ++m)
#pragma unroll
                for (int n = 0; n < 2; ++n) acc[a][b][m][n] = (f32x4){0.f, 0.f, 0.f, 0.f};
    bf16x8 At[4][2], B0[2][2], B1[2][2];
    const char* cA = (const char*)g.A + (size_t)cur.pm * tstep; const char* cB = (const char*)g.Bt + (size_t)cur.pn * tstep;
    S.a_ready(cur);
    PG8_STAGE(PG8_SB(0, 0), cB, voffB); PG8_STAGE(PG8_SA(0, 0), cA, voffA); PG8_STAGE(PG8_SB(0, 1), cB + hstep, voffB); PG8_STAGE(PG8_SA(0, 1), cA + hstep, voffA);
    if (wr == 1) PG8_BAR;
    PG8_WAIT_V(4); PG8_BAR;
    PG8_STAGE(PG8_SB(1, 0), cB + kstep, voffB); PG8_STAGE(PG8_SA(1, 0), cA + kstep, voffA); PG8_STAGE(PG8_SB(1, 1), cB + hstep + kstep, voffB);
    PG8_WAIT_V(6); PG8_BAR;
    for (;;) {
        const bool has_next = S.next(ui + 1, nxt);
        const char* nA = has_next ? (const char*)g.A + (size_t)nxt.pm * tstep : cA; const char* nB = has_next ? (const char*)g.Bt + (size_t)nxt.pn * tstep : cB;
        for (int t = 0; t < nt; t += 2) {
            const bool last = (t == nt - 2);
            const char* a1 = cA + (size_t)(t + 1) * kstep;
            const char* a2 = last ? nA : cA + (size_t)(t + 2) * kstep; const char* b2 = last ? nB : cB + (size_t)(t + 2) * kstep;
            const char* a3 = a2 + kstep; const char* b3 = b2 + kstep;
            if (last && has_next) S.a_ready(nxt);
            PG8_LDB(B0, 0, 0); PG8_SCHED; PG8_LDA(At, 0, 0); PG8_STAGE(PG8_SA(1, 1), a1 + hstep, voffA);
            PG8_WAIT_L(8); PG8_BAR; PG8_WAIT_L(0); PG8_MMA(0, 0, At, B0); PG8_BAR; PG8_SCHED;
            PG8_LDB(B1, 0, 1); PG8_STAGE(PG8_SB(0, 0), b2, voffB);
            PG8_BAR; PG8_WAIT_L(0); PG8_MMA(0, 1, At, B1); PG8_BAR;
            PG8_LDA(At, 0, 1); PG8_STAGE(PG8_SA(0, 0), a2, voffA);
            PG8_BAR; PG8_WAIT_L(0); PG8_MMA(1, 0, At, B0); PG8_BAR; PG8_SCHED;
            PG8_STAGE(PG8_SB(0, 1), b2 + hstep, voffB);
            PG8_WAIT_V(6); PG8_BAR; PG8_MMA(1, 1, At, B1); PG8_BAR;
            PG8_LDB(B0, 1, 0); PG8_SCHED; PG8_LDA(At, 1, 0); PG8_STAGE(PG8_SA(0, 1), a2 + hstep, voffA);
            PG8_WAIT_L(8); PG8_BAR; PG8_WAIT_L(0); PG8_MMA(0, 0, At, B0); PG8_BAR; PG8_SCHED;
            PG8_LDB(B1, 1, 1); PG8_STAGE(PG8_SB(1, 0), b3, voffB);
            PG8_BAR; PG8_WAIT_L(0); PG8_MMA(0, 1, At, B1); PG8_BAR;
            PG8_LDA(At, 1, 1); PG8_STAGE(PG8_SA(1, 0), a3, voffA);
            PG8_BAR; PG8_WAIT_L(0); PG8_MMA(1, 0, At, B0); PG8_BAR; PG8_SCHED;
            PG8_STAGE(PG8_SB(1, 1), b3 + hstep, voffB);
            PG8_WAIT_V(6); PG8_BAR; PG8_MMA(1, 1, At, B1); PG8_BAR;
        }
        if constexpr (!Epi::AFTER_DRAIN) { E(acc, cur, wr, wc, fr, fq); S.done(cur); }
        if (!has_next) break;
#pragma unroll
        for (int a = 0; a < 2; ++a)
#pragma unroll
            for (int b = 0; b < 2; ++b)
#pragma unroll
                for (int m = 0; m < 4; ++m)
#pragma unroll
                    for (int n = 0; n < 2; ++n) acc[a][b][m][n] = (f32x4){0.f, 0.f, 0.f, 0.f};
        cur = nxt; cA = nA; cB = nB; ++ui;
    }
    PG8_WAIT_V(0);
    if (wr == 0) PG8_BAR;
    PG8_BAR;
    if constexpr (Epi::AFTER_DRAIN) { E.fused(acc, cur, wr, wc, fr, fq, lds, wid, lane); S.done(cur); }
#undef PG8_SA
#undef PG8_SB
#undef PG8_STAGE
#undef PG8_LDA
#undef PG8_LDB
#undef PG8_MMA
#undef PG8_WAIT_V
#undef PG8_WAIT_L
#undef PG8_BAR
#undef PG8_SCHED
}
}

using pg8::bf16_t; using pg8::bf16x8; using pg8::f32x4; using pg8::u32x4; using pg8::cvt_pk_bf16; using pg8::silu_f;
#define LAS __attribute__((address_space(3)))
typedef unsigned u32x2 __attribute__((ext_vector_type(2)));
typedef short s16x4 __attribute__((ext_vector_type(4)));
#define MFMA16(a, b, c) __builtin_amdgcn_mfma_f32_16x16x32_bf16((a), (b), (c), 0, 0, 0)

constexpr int NTHR = 512;
constexpr int MTOK = 32768, DM = 1024, SEQ = 2048, DFF = 2816, DEPTH = 4, MODW = 9216;
constexpr float DN_ALPHA = 1.6817928305074290861f;
constexpr size_t MiB = (size_t)1 << 20;
constexpr size_t SZ_FFN_IN = (size_t)5632 * 1024 * 2, SZ_FFN_OUT = (size_t)1024 * 2816 * 2, SZ_RET_IN = (size_t)6144 * 1024 * 2, SZ_RET_OUT = (size_t)1024 * 2048 * 2,
                 SZ_NSA_IN = (size_t)2816 * 1024 * 2, SZ_NSA_OUT = (size_t)1024 * 1024 * 2, SZ_W1 = (size_t)256 * 2048 * 2, SZ_W2 = (size_t)64 * 256 * 2;
constexpr size_t OFF_FFN_IN = 0, OFF_FFN_OUT = OFF_FFN_IN + 8 * SZ_FFN_IN, OFF_RET_IN = OFF_FFN_OUT + 8 * SZ_FFN_OUT, OFF_RET_OUT = OFF_RET_IN + 2 * SZ_RET_IN,
                 OFF_NSA_IN = OFF_RET_OUT + 2 * SZ_RET_OUT, OFF_NSA_OUT = OFF_NSA_IN + 2 * SZ_NSA_IN, OFF_W1 = OFF_NSA_OUT + 2 * SZ_NSA_OUT, OFF_W2 = OFF_W1 + 4 * SZ_W1,
                 OFF_MOD = OFF_W2 + 4 * SZ_W2, OFF_H = OFF_MOD + (size_t)DEPTH * 16 * MODW * 4, OFF_U2 = OFF_H + (size_t)MTOK * DM * 2, WS_END = OFF_U2 + 384 * MiB;
constexpr size_t U_FFN_ACT = 0, U_FFN_Y = 192 * MiB;
constexpr size_t U_RET_QKV = 0, U_RET_G = 0, U_RET_O = 256 * MiB, U_RET_Y = 128 * MiB;
constexpr size_t U_NSA_PROJ = 0, U_NSA_Y = 192 * MiB, U_NSA_ACMPK = 256 * MiB, U_NSA_ACMPV = 288 * MiB, U_NSA_HK = 320 * MiB, U_NSA_HV = 324 * MiB, U_NSA_KCMP = 328 * MiB, U_NSA_VCMP = 329 * MiB, U_NSA_OATT = 256 * MiB;
constexpr int LDS_BYTES = 152 * 1024;

struct WJob { const float* src; bf16_t* dst; int K, N, Np, mode; };
struct Params {
    const float* x; const float* c; const float* ada_w; const float* ada_b; const float* ln_g; const float* ln_b; const float* pe_k; const float* pe_v;
    float* out; unsigned char* ws;
    WJob jobs[32]; int tile_end[32]; int njobs; int pad;
};

__device__ __forceinline__ float bf2f(unsigned short b) { return __uint_as_float(((unsigned)b) << 16); }
__device__ __forceinline__ float bflo(unsigned w) { return __uint_as_float(w << 16); }
__device__ __forceinline__ float bfhi(unsigned w) { return __uint_as_float(w & 0xffff0000u); }
__device__ __forceinline__ unsigned short f2bf(float f) { return (unsigned short)(cvt_pk_bf16(f, 0.f) & 0xffffu); }
__device__ __forceinline__ bf16x8 pack8(const f32x4& a, const f32x4& b) { u32x4 w; w.x = cvt_pk_bf16(a[0], a[1]); w.y = cvt_pk_bf16(a[2], a[3]); w.z = cvt_pk_bf16(b[0], b[1]); w.w = cvt_pk_bf16(b[2], b[3]); return __builtin_bit_cast(bf16x8, w); }
__device__ __forceinline__ u32x2 pack4(const f32x4& a) { u32x2 w; w.x = cvt_pk_bf16(a[0], a[1]); w.y = cvt_pk_bf16(a[2], a[3]); return w; }
__device__ __forceinline__ bf16x8 lds_rd16(LAS unsigned char* lds, int off) { return *(const LAS bf16x8*)(lds + off); }
__device__ __forceinline__ bf16x8 lds_rd8x2(LAS unsigned char* lds, int off) { const s16x4 lo = *(const LAS s16x4*)(lds + off), hi = *(const LAS s16x4*)(lds + off + 32); return __builtin_shufflevector(lo, hi, 0, 1, 2, 3, 4, 5, 6, 7); }
__device__ __forceinline__ float wsum(float v) { v += __shfl_xor(v, 32); v += __shfl_xor(v, 16); v += __shfl_xor(v, 8); v += __shfl_xor(v, 4); v += __shfl_xor(v, 2); v += __shfl_xor(v, 1); return v; }

__device__ __forceinline__ void wt_tile(const WJob& J, int t, LAS float* T) {
    int tid = threadIdx.x; asm volatile("" : "+v"(tid));
    const int ntn = J.Np >> 6; const int tn = t % ntn, tk = t / ntn; const int n0 = tn * 64, k0 = tk * 64;
    int sbase = n0; if (J.mode == 1) { const int pn = n0 >> 8, r = n0 & 255; sbase = (r >> 7) * DFF + pn * 128 + (r & 127); }
    const int kk = tid >> 4, nn = (tid & 15) * 4;
#pragma unroll
    for (int rep = 0; rep < 2; ++rep) { const int k = kk + rep * 32; f32x4 v = (f32x4){0.f, 0.f, 0.f, 0.f};
        if (sbase + nn < J.N) v = *(const f32x4*)(J.src + (size_t)(k0 + k) * J.N + sbase + nn);
        T[k * 65 + nn] = v[0]; T[k * 65 + nn + 1] = v[1]; T[k * 65 + nn + 2] = v[2]; T[k * 65 + nn + 3] = v[3]; }
    __syncthreads();
    const int n = tid >> 3, k8 = (tid & 7) * 8;
    f32x4 a, b;
    a[0] = T[(k8 + 0) * 65 + n]; a[1] = T[(k8 + 1) * 65 + n]; a[2] = T[(k8 + 2) * 65 + n]; a[3] = T[(k8 + 3) * 65 + n];
    b[0] = T[(k8 + 4) * 65 + n]; b[1] = T[(k8 + 5) * 65 + n]; b[2] = T[(k8 + 6) * 65 + n]; b[3] = T[(k8 + 7) * 65 + n];
    *(bf16x8*)(J.dst + (size_t)(n0 + n) * J.K + k0 + k8) = pack8(a, b);
    __syncthreads();
}

__device__ __forceinline__ void phase_prep(const Params& p, LAS unsigned char* lds) {
    int tid = threadIdx.x; asm volatile("" : "+v"(tid));
    LAS float* T = (LAS float*)lds;
    const int ntiles = p.tile_end[p.njobs - 1];
    for (int t = blockIdx.x; t < ntiles; t += gridDim.x) {
        int j = 0; while (j < p.njobs - 1 && t >= p.tile_end[j]) ++j;
        const int t0 = j ? p.tile_end[j - 1] : 0;
        wt_tile(p.jobs[j], t - t0, T);
    }
    if (blockIdx.x < 288) {
        LAS float* cs = (LAS float*)lds;
        LAS float* red = (LAS float*)(lds + 65536);
        float* mod = (float*)(p.ws + OFF_MOD);
        __syncthreads();
        for (int idx = tid; idx < 16 * 1024; idx += NTHR) { const int b = idx >> 10, k = idx & 1023; const float cv = p.c[idx]; cs[k * 16 + b] = cv / (1.0f + expf(-cv)); }
        __syncthreads();
        for (int unit = blockIdx.x; unit < 288; unit += gridDim.x) {
            const int i = unit / 72, n0 = (unit % 72) * 128, col = tid & 127, kq = tid >> 7;
            f32x4 a0 = (f32x4){0.f, 0.f, 0.f, 0.f}, a1 = a0, a2 = a0, a3 = a0;
            const float* wp = p.ada_w + ((size_t)i * 1024 + kq * 256) * MODW + n0 + col;
#pragma unroll 4
            for (int k = 0; k < 256; ++k) { const float w = wp[(size_t)k * MODW]; const LAS f32x4* cp = (const LAS f32x4*)(cs + (kq * 256 + k) * 16);
                a0 += cp[0] * w; a1 += cp[1] * w; a2 += cp[2] * w; a3 += cp[3] * w; }
#pragma unroll
            for (int b = 0; b < 4; ++b) { red[(kq * 16 + b) * 128 + col] = a0[b]; red[(kq * 16 + 4 + b) * 128 + col] = a1[b]; red[(kq * 16 + 8 + b) * 128 + col] = a2[b]; red[(kq * 16 + 12 + b) * 128 + col] = a3[b]; }
            __syncthreads();
#pragma unroll
            for (int r = 0; r < 4; ++r) { const int o = tid + r * NTHR, b = o >> 7, cc = o & 127;
                const float s = red[(0 * 16 + b) * 128 + cc] + red[(1 * 16 + b) * 128 + cc] + red[(2 * 16 + b) * 128 + cc] + red[(3 * 16 + b) * 128 + cc] + p.ada_b[i * MODW + n0 + cc];
                mod[((size_t)i * 16 + b) * MODW + n0 + cc] = s; }
            __syncthreads();
        }
    }
}

__device__ __forceinline__ void phase_init(const Params& p) {
    const float* mod = (const float*)(p.ws + OFF_MOD); bf16_t* H = (bf16_t*)(p.ws + OFF_H);
    int tid = threadIdx.x; asm volatile("" : "+v"(tid));
    for (size_t i = (size_t)blockIdx.x * NTHR + tid; i < (size_t)MTOK * 256; i += (size_t)gridDim.x * NTHR) {
        const int row = (int)(i >> 8), c4 = (int)(i & 255) * 4, b = row >> 11;
        const f32x4 xv = *(const f32x4*)(p.x + i * 4); *(f32x4*)(p.out + i * 4) = xv;
        const float* m = mod + (size_t)b * MODW; const f32x4 sh = *(const f32x4*)(m + c4), sc = *(const f32x4*)(m + 1024 + c4);
        const f32x4 h = xv * (sc + 1.0f) + sh; *(u32x2*)(H + i * 4) = pack4(h);
    }
}

__device__ __forceinline__ void phase_ln(float* xio, const bf16_t* y, const float* modG, float rw, const float* lng, const float* lnb, const float* modSh, const float* modSc, bf16_t* H) {
    int tid = threadIdx.x; asm volatile("" : "+v"(tid));
    const int wid = __builtin_amdgcn_readfirstlane(tid >> 6), lane = tid & 63;
    for (int row = blockIdx.x * 8 + wid; row < MTOK; row += gridDim.x * 8) {
        const int b = row >> 11; const size_t rb = (size_t)row * DM;
        f32x4 z[4]; float s = 0.f;
#pragma unroll
        for (int q = 0; q < 4; ++q) { const int c = q * 256 + lane * 4; const f32x4 xv = *(const f32x4*)(xio + rb + c); const u32x2 yv = *(const u32x2*)(y + rb + c);
            const f32x4 gt = *(const f32x4*)(modG + (size_t)b * MODW + c); const f32x4 yf = (f32x4){bflo(yv.x), bfhi(yv.x), bflo(yv.y), bfhi(yv.y)};
            z[q] = xv * DN_ALPHA + (gt + 1.0f) * yf * rw; s += (z[q][0] + z[q][1]) + (z[q][2] + z[q][3]); }
        const float mu = wsum(s) * (1.0f / 1024.0f); float v = 0.f;
#pragma unroll
        for (int q = 0; q < 4; ++q) { const f32x4 d = z[q] - mu; v += (d[0] * d[0] + d[1] * d[1]) + (d[2] * d[2] + d[3] * d[3]); }
        const float rstd = rsqrtf(wsum(v) * (1.0f / 1024.0f) + 1e-5f);
#pragma unroll
        for (int q = 0; q < 4; ++q) { const int c = q * 256 + lane * 4; const f32x4 g4 = *(const f32x4*)(lng + c), b4 = *(const f32x4*)(lnb + c);
            const f32x4 xn = (z[q] - mu) * rstd * g4 + b4; *(f32x4*)(xio + rb + c) = xn;
            const f32x4 sh = *(const f32x4*)(modSh + (size_t)b * MODW + c), sc = *(const f32x4*)(modSc + (size_t)b * MODW + c);
            *(u32x2*)(H + rb + c) = pack4(xn * (sc + 1.0f) + sh); }
    }
}

__device__ __forceinline__ void phase_ret_core(const bf16_t* QKV, bf16_t* O, LAS unsigned char* lds) {
    constexpr int PS = 136, STS = 264, OFF_P = 0, OFF_VT = 34816, OFF_KT = 52224, OFF_ST = 121856;
    int tid = threadIdx.x; asm volatile("" : "+v"(tid));
    const int wid = __builtin_amdgcn_readfirstlane(tid >> 6), lane = tid & 63, fr = lane & 15, fq = lane >> 4;
    for (int item = blockIdx.x; item < 512; item += gridDim.x) {
        const int es = item & 7, bh = item >> 3, hh = bh & 3, b = bh >> 2, e0 = es * 64;
        const float log_g = logf(1.0f - exp2f(-5.0f - (float)hh));
        const float gN = expf(log_g * 128.0f);
        __syncthreads();
        for (int i = tid; i < 64 * STS / 2; i += NTHR) ((LAS unsigned*)(lds + OFF_ST))[i] = 0u;
        f32x4 sacc[2][4];
#pragma unroll
        for (int dt = 0; dt < 2; ++dt)
#pragma unroll
            for (int et = 0; et < 4; ++et) sacc[dt][et] = (f32x4){0.f, 0.f, 0.f, 0.f};
        for (int n = 0; n < 16; ++n) {
            const size_t tok0 = (size_t)b * SEQ + n * 128;
            {
                const int c = tid & 127, pc = tid >> 7; const float kfac = 0.0625f * expf(log_g * (float)(127 - c));
                const bf16_t* krow = QKV + (tok0 + c) * 4096 + 1024 + hh * 256;
#pragma unroll
                for (int it = 0; it < 8; ++it) { const int d0 = (pc + 4 * it) * 8; const bf16x8 v = *(const bf16x8*)(krow + d0);
#pragma unroll
                    for (int i = 0; i < 8; ++i) *(LAS bf16_t*)(lds + OFF_KT + ((d0 + i) * PS + c) * 2) = f2bf(bf2f((unsigned short)v[i]) * kfac); }
                const bf16_t* vrow = QKV + (tok0 + c) * 4096 + 2048 + hh * 512 + e0;
#pragma unroll
                for (int it = 0; it < 2; ++it) { const int e = (pc + 4 * it) * 8; const bf16x8 v = *(const bf16x8*)(vrow + e);
#pragma unroll
                    for (int i = 0; i < 8; ++i) *(LAS bf16_t*)(lds + OFF_VT + ((e + i) * PS + c) * 2) = (bf16_t)v[i]; }
            }
            __syncthreads();
            const int cc = wid * 16 + fr;
            bf16x8 qf[8];
            { const bf16_t* qrow = QKV + (tok0 + cc) * 4096 + hh * 256 + fq * 8;
#pragma unroll
              for (int ks = 0; ks < 8; ++ks) qf[ks] = *(const bf16x8*)(qrow + ks * 32); }
            const int ctmax = wid | 1;
            for (int ct = 0; ct <= ctmax; ++ct) {
                f32x4 acc = (f32x4){0.f, 0.f, 0.f, 0.f}; const bf16_t* kr = QKV + (tok0 + ct * 16 + fr) * 4096 + 1024 + hh * 256 + fq * 8;
#pragma unroll
                for (int ks = 0; ks < 8; ++ks) acc = MFMA16(*(const bf16x8*)(kr + ks * 32), qf[ks], acc);
                f32x4 pv;
#pragma unroll
                for (int j = 0; j < 4; ++j) { const int cp = ct * 16 + fq * 4 + j; pv[j] = (cc >= cp) ? acc[j] * 0.0625f * expf(log_g * (float)(cc - cp)) : 0.f; }
                *(LAS u32x2*)(lds + OFF_P + (cc * PS + ct * 16 + fq * 4) * 2) = pack4(pv);
            }
            __syncthreads();
            {
                f32x4 a1[4], a2[4];
#pragma unroll
                for (int et = 0; et < 4; ++et) { a1[et] = (f32x4){0.f, 0.f, 0.f, 0.f}; a2[et] = a1[et]; }
                const int ksmax = wid >> 1;
                for (int ks = 0; ks <= ksmax; ++ks) { const bf16x8 pf = lds_rd16(lds, OFF_P + (cc * PS + ks * 32 + fq * 8) * 2);
#pragma unroll
                    for (int et = 0; et < 4; ++et) a1[et] = MFMA16(lds_rd16(lds, OFF_VT + ((et * 16 + fr) * PS + ks * 32 + fq * 8) * 2), pf, a1[et]); }
#pragma unroll
                for (int ks = 0; ks < 8; ++ks)
#pragma unroll
                    for (int et = 0; et < 4; ++et) a2[et] = MFMA16(lds_rd16(lds, OFF_ST + ((et * 16 + fr) * STS + ks * 32 + fq * 8) * 2), qf[ks], a2[et]);
                const float dq = expf(log_g * (float)(cc + 1));
                bf16_t* orow = O + (tok0 + cc) * 2048 + hh * 512 + e0 + fq * 4;
#pragma unroll
                for (int et = 0; et < 4; ++et) *(u32x2*)(orow + et * 16) = pack4(a1[et] + a2[et] * dq);
            }
            __syncthreads();
            if (n < 15) {
#pragma unroll
                for (int dt = 0; dt < 2; ++dt)
#pragma unroll
                    for (int et = 0; et < 4; ++et) sacc[dt][et] *= gN;
#pragma unroll
                for (int ks = 0; ks < 4; ++ks) {
                    bf16x8 vf[4];
#pragma unroll
                    for (int et = 0; et < 4; ++et) vf[et] = lds_rd16(lds, OFF_VT + ((et * 16 + fr) * PS + ks * 32 + fq * 8) * 2);
#pragma unroll
                    for (int dt = 0; dt < 2; ++dt) { const bf16x8 kf = lds_rd16(lds, OFF_KT + (((2 * wid + dt) * 16 + fr) * PS + ks * 32 + fq * 8) * 2);
#pragma unroll
                        for (int et = 0; et < 4; ++et) sacc[dt][et] = MFMA16(kf, vf[et], sacc[dt][et]); }
                }
#pragma unroll
                for (int dt = 0; dt < 2; ++dt)
#pragma unroll
                    for (int et = 0; et < 4; ++et) *(LAS u32x2*)(lds + OFF_ST + ((et * 16 + fr) * STS + (2 * wid + dt) * 16 + fq * 4) * 2) = pack4(sacc[dt][et]);
            }
            __syncthreads();
        }
    }
}

__device__ __forceinline__ void phase_ret_gate(bf16_t* O, const bf16_t* G) {
    int tid = threadIdx.x; asm volatile("" : "+v"(tid));
    const int wid = __builtin_amdgcn_readfirstlane(tid >> 6), lane = tid & 63;
    for (int idx = blockIdx.x * 8 + wid; idx < MTOK * 4; idx += gridDim.x * 8) {
        const size_t base = (size_t)(idx >> 2) * 2048 + (idx & 3) * 512 + lane * 8;
        const u32x4 ov = *(const u32x4*)(O + base), gv = *(const u32x4*)(G + base);
        float o[8] = {bflo(ov.x), bfhi(ov.x), bflo(ov.y), bfhi(ov.y), bflo(ov.z), bfhi(ov.z), bflo(ov.w), bfhi(ov.w)};
        const float g[8] = {bflo(gv.x), bfhi(gv.x), bflo(gv.y), bfhi(gv.y), bflo(gv.z), bfhi(gv.z), bflo(gv.w), bfhi(gv.w)};
        float s = 0.f;
#pragma unroll
        for (int i = 0; i < 8; ++i) s += o[i];
        const float mu = wsum(s) * (1.0f / 512.0f); float v = 0.f;
#pragma unroll
        for (int i = 0; i < 8; ++i) { const float d = o[i] - mu; v += d * d; }
        const float rstd = rsqrtf(wsum(v) * (1.0f / 512.0f) + 1e-6f);
#pragma unroll
        for (int i = 0; i < 8; ++i) o[i] = (o[i] - mu) * rstd * silu_f(g[i]);
        u32x4 w; w.x = cvt_pk_bf16(o[0], o[1]); w.y = cvt_pk_bf16(o[2], o[3]); w.z = cvt_pk_bf16(o[4], o[5]); w.w = cvt_pk_bf16(o[6], o[7]);
        *(u32x4*)(O + base) = w;
    }
}

__device__ __forceinline__ void phase_nsa_mat(const bf16_t* PROJ, const float* pek, const float* pev, bf16_t* AK, bf16_t* AV) {
    const size_t per = (size_t)8128 * 256;
    int tid = threadIdx.x; asm volatile("" : "+v"(tid));
    for (size_t i = (size_t)blockIdx.x * NTHR + tid; i < 2 * per; i += (size_t)gridDim.x * NTHR) {
        const int kv = i >= per; const size_t rem = kv ? i - per : i; const int r = (int)(rem >> 8), pp = (int)(rem & 255), l = pp >> 3, d0 = (pp & 7) * 8;
        const int g = r & 3, bn = r >> 2, b = bn / 127, n = bn % 127;
        const u32x4 v = *(const u32x4*)(PROJ + ((size_t)b * SEQ + n * 16 + l) * 2816 + 1024 + kv * 256 + g * 64 + d0);
        const float* pe = (kv ? pev : pek) + l * 64 + d0; const f32x4 p0 = *(const f32x4*)pe, p1 = *(const f32x4*)(pe + 4);
        u32x4 w; w.x = cvt_pk_bf16(bflo(v.x) + p0[0], bfhi(v.x) + p0[1]); w.y = cvt_pk_bf16(bflo(v.y) + p0[2], bfhi(v.y) + p0[3]);
        w.z = cvt_pk_bf16(bflo(v.z) + p1[0], bfhi(v.z) + p1[1]); w.w = cvt_pk_bf16(bflo(v.w) + p1[2], bfhi(v.w) + p1[3]);
        *(u32x4*)((kv ? AV : AK) + (size_t)r * 2048 + l * 64 + d0) = w;
    }
}
__device__ __forceinline__ void phase_nsa_cmp2(const bf16_t* HK, const bf16_t* HV, const bf16_t* W2K, const bf16_t* W2V, bf16_t* KC, bf16_t* VC) {
    int tid = threadIdx.x; asm volatile("" : "+v"(tid));
    const int wid = __builtin_amdgcn_readfirstlane(tid >> 6), lane = tid & 63, fr = lane & 15, fq = lane >> 4;
    for (int tt = blockIdx.x * 8 + wid; tt < 508 * 2; tt += gridDim.x * 8) {
        const int kv = tt >= 508, rt = kv ? tt - 508 : tt; const bf16_t* Hd = kv ? HV : HK; const bf16_t* W = kv ? W2V : W2K; bf16_t* Od = kv ? VC : KC;
        f32x4 acc[4];
#pragma unroll
        for (int nt = 0; nt < 4; ++nt) acc[nt] = (f32x4){0.f, 0.f, 0.f, 0.f};
#pragma unroll
        for (int ks = 0; ks < 8; ++ks) { const bf16x8 hf = *(const bf16x8*)(Hd + (size_t)(rt * 16 + fr) * 256 + ks * 32 + fq * 8);
#pragma unroll
            for (int nt = 0; nt < 4; ++nt) acc[nt] = MFMA16(*(const bf16x8*)(W + (size_t)(nt * 16 + fr) * 256 + ks * 32 + fq * 8), hf, acc[nt]); }
#pragma unroll
        for (int nt = 0; nt < 4; ++nt) *(u32x2*)(Od + (size_t)(rt * 16 + fr) * 64 + nt * 16 + fq * 4) = pack4(acc[nt]);
    }
}

struct AttnCtx { int b, g, cur, head, hp, t; float slope; bf16x8 qf[2]; float gate[3]; unsigned selq; unsigned anym; };
constexpr int A_KS = 72, A_VS = 72, A_KCS = 72, A_VCS = 136, A_OFF_K = 0, A_OFF_VT = 9216, A_OFF_KC = 18432, A_OFF_VCT = 36864, A_OFF_IMP = 54272, A_OFF_SEL = 71168, A_OFF_SELP = 71296;

template <int BR>
__device__ __forceinline__ void attn_branch(const bf16_t* PROJ, LAS unsigned char* lds, const AttnCtx& C, f32x4 (&otot)[4], int tid) {
    const int lane = tid & 63, fr = lane & 15, fq = lane >> 4;
    float m_ = -1e30f, l_ = 0.f;
    f32x4 oa[4];
#pragma unroll
    for (int dt = 0; dt < 4; ++dt) oa[dt] = (f32x4){0.f, 0.f, 0.f, 0.f};
    const int jlo = (BR == 1) ? 0 : (C.cur > 8 ? C.cur - 8 : 0);
    const int koff = (BR == 1 ? 1536 : 2048) + C.g * 64, voff = (BR == 1 ? 1792 : 2304) + C.g * 64;
    for (int j = jlo; j <= C.cur; ++j) {
#ifndef NOSKIP
        if (BR == 1 && !((C.anym >> j) & 1u)) continue;
#endif
        __syncthreads();
        { const int key = tid >> 3, d0 = (tid & 7) * 8; const bf16_t* src = PROJ + ((size_t)C.b * SEQ + j * 64 + key) * 2816 + d0;
          *(LAS bf16x8*)(lds + A_OFF_K + (key * A_KS + d0) * 2) = *(const bf16x8*)(src + koff);
          const bf16x8 vv = *(const bf16x8*)(src + voff);
#pragma unroll
          for (int i = 0; i < 8; ++i) *(LAS bf16_t*)(lds + A_OFF_VT + ((d0 + i) * A_VS + key) * 2) = (bf16_t)vv[i]; }
        __syncthreads();
        f32x4 s4[4]; float tmax = -1e30f;
#pragma unroll
        for (int kt = 0; kt < 4; ++kt) { f32x4 acc = (f32x4){0.f, 0.f, 0.f, 0.f};
#pragma unroll
            for (int ks = 0; ks < 2; ++ks) acc = MFMA16(lds_rd16(lds, A_OFF_K + ((kt * 16 + fr) * A_KS + ks * 32 + fq * 8) * 2), C.qf[ks], acc);
#pragma unroll
            for (int jj = 0; jj < 4; ++jj) { const int pos = j * 64 + kt * 16 + fq * 4 + jj, dist = C.t - pos;
                const bool ok = (dist >= 0) && (BR == 1 ? (((C.selq >> j) & 1u) != 0u) : (dist < 512));
                const float s = ok ? acc[jj] * 0.125f - C.slope * (float)dist : -1e30f; s4[kt][jj] = s; tmax = fmaxf(tmax, s); } }
        tmax = fmaxf(tmax, __shfl_xor(tmax, 16)); tmax = fmaxf(tmax, __shfl_xor(tmax, 32));
        const float mnew = fmaxf(m_, tmax), alpha = __expf(m_ - mnew); m_ = mnew;
        float psum = 0.f;
#pragma unroll
        for (int kt = 0; kt < 4; ++kt)
#pragma unroll
            for (int jj = 0; jj < 4; ++jj) { const float pp = (s4[kt][jj] > -1e29f) ? __expf(s4[kt][jj] - mnew) : 0.f; s4[kt][jj] = pp; psum += pp; }
        l_ = l_ * alpha + psum;
#pragma unroll
        for (int dt = 0; dt < 4; ++dt) oa[dt] *= alpha;
#pragma unroll
        for (int ks2 = 0; ks2 < 2; ++ks2) { const bf16x8 pf = pack8(s4[2 * ks2], s4[2 * ks2 + 1]);
#pragma unroll
            for (int dt = 0; dt < 4; ++dt) oa[dt] = MFMA16(lds_rd8x2(lds, A_OFF_VT + ((dt * 16 + fr) * A_VS + ks2 * 32 + fq * 4) * 2), pf, oa[dt]); }
    }
    float lt = l_; lt += __shfl_xor(lt, 16); lt += __shfl_xor(lt, 32); const float inv = lt > 0.f ? C.gate[BR] / lt : 0.f;
#pragma unroll
    for (int dt = 0; dt < 4; ++dt) otot[dt] += oa[dt] * inv;
}

__device__ __forceinline__ void phase_nsa_attn(const bf16_t* PROJ, const bf16_t* KCMP, const bf16_t* VCMP, bf16_t* OATT, LAS unsigned char* lds) {
    int tid = threadIdx.x; asm volatile("" : "+v"(tid));
    const int wid = __builtin_amdgcn_readfirstlane(tid >> 6), lane = tid & 63, fr = lane & 15, fq = lane >> 4;
    LAS float* IMP = (LAS float*)(lds + A_OFF_IMP); LAS unsigned* SEL = (LAS unsigned*)(lds + A_OFF_SEL); LAS unsigned* SELP = (LAS unsigned*)(lds + A_OFF_SELP);
    for (int id = blockIdx.x; id < 4096; id += gridDim.x) {
        const int k8 = id & 255, ii = id >> 8, bg = k8 & 63, kk = k8 >> 6;
        const int qt32 = (ii & 1) ? 63 - (kk + 4 * (ii - 1)) : kk + 4 * ii;
        AttnCtx C; C.cur = qt32 >> 1; C.b = bg >> 2; C.g = bg & 3; C.hp = wid >> 1; C.head = C.g * 4 + C.hp; C.slope = exp2f(-0.5f * (float)(C.head + 1));
        const int qq = (wid & 1) * 16 + fr; C.t = qt32 * 32 + qq; const size_t trow = (size_t)C.b * SEQ + C.t;
        { const bf16_t* pr = PROJ + trow * 2816;
#pragma unroll
          for (int ks = 0; ks < 2; ++ks) C.qf[ks] = *(const bf16x8*)(pr + C.head * 64 + ks * 32 + fq * 8);
#pragma unroll
          for (int br = 0; br < 3; ++br) C.gate[br] = 1.0f / (1.0f + __expf(-bf2f(pr[2560 + C.head * 3 + br]))); }
#ifdef ONLY_BR
#pragma unroll
        for (int br = 0; br < 3; ++br) if (br != ONLY_BR) C.gate[br] = 0.f;
#endif
        f32x4 otot[4];
#pragma unroll
        for (int dt = 0; dt < 4; ++dt) otot[dt] = (f32x4){0.f, 0.f, 0.f, 0.f};
        __syncthreads();
#pragma unroll
        for (int rep = 0; rep < 2; ++rep) { const int idx = tid + rep * NTHR, n = idx >> 3, d0 = (idx & 7) * 8, nc = n < 126 ? n : 126; const size_t src = ((size_t)(C.b * 127 + nc) * 4 + C.g) * 64 + d0;
            *(LAS bf16x8*)(lds + A_OFF_KC + (n * A_KCS + d0) * 2) = *(const bf16x8*)(KCMP + src);
            const bf16x8 vv = *(const bf16x8*)(VCMP + src);
#pragma unroll
            for (int i = 0; i < 8; ++i) *(LAS bf16_t*)(lds + A_OFF_VCT + ((d0 + i) * A_VCS + n) * 2) = (bf16_t)vv[i]; }
        __syncthreads();
        {
            f32x4 sc[8]; float mx = -1e30f;
#pragma unroll
            for (int kt = 0; kt < 8; ++kt) { f32x4 acc = (f32x4){0.f, 0.f, 0.f, 0.f};
#pragma unroll
                for (int ks = 0; ks < 2; ++ks) acc = MFMA16(lds_rd16(lds, A_OFF_KC + ((kt * 16 + fr) * A_KCS + ks * 32 + fq * 8) * 2), C.qf[ks], acc);
#pragma unroll
                for (int jj = 0; jj < 4; ++jj) { const int n = kt * 16 + fq * 4 + jj, ce = n * 16 + 31; const bool ok = (n <= 126) && (ce <= C.t);
                    const float s = ok ? acc[jj] * 0.125f - C.slope * (float)(C.t - ce) : -1e30f; sc[kt][jj] = s; mx = fmaxf(mx, s); } }
            mx = fmaxf(mx, __shfl_xor(mx, 16)); mx = fmaxf(mx, __shfl_xor(mx, 32));
            float sum = 0.f;
#pragma unroll
            for (int kt = 0; kt < 8; ++kt)
#pragma unroll
                for (int jj = 0; jj < 4; ++jj) { const float pp = (sc[kt][jj] > -1e29f) ? __expf(sc[kt][jj] - mx) : 0.f; sc[kt][jj] = pp; sum += pp; }
            sum += __shfl_xor(sum, 16); sum += __shfl_xor(sum, 32);
            const float inv = sum > 0.f ? 1.0f / sum : 0.f;
#pragma unroll
            for (int kt = 0; kt < 8; ++kt) sc[kt] *= inv;
#pragma unroll
            for (int kt = 0; kt < 8; ++kt) { const float a = __shfl(sc[kt][3], (lane + 48) & 63); const float bp = kt > 0 ? __shfl(sc[kt > 0 ? kt - 1 : 0][3], (lane + 48) & 63) : 0.f;
                const float prev3 = fq > 0 ? a : bp;
                IMP[(C.hp * 32 + qq) * 33 + 4 * kt + fq] = sc[kt][0] + sc[kt][1] + sc[kt][2] + 0.5f * sc[kt][3] + 0.5f * prev3; }
            f32x4 oc[4];
#pragma unroll
            for (int dt = 0; dt < 4; ++dt) oc[dt] = (f32x4){0.f, 0.f, 0.f, 0.f};
#pragma unroll
            for (int ks2 = 0; ks2 < 4; ++ks2) { const bf16x8 pf = pack8(sc[2 * ks2], sc[2 * ks2 + 1]);
#pragma unroll
                for (int dt = 0; dt < 4; ++dt) oc[dt] = MFMA16(lds_rd8x2(lds, A_OFF_VCT + ((dt * 16 + fr) * A_VCS + ks2 * 32 + fq * 4) * 2), pf, oc[dt]); }
#pragma unroll
            for (int dt = 0; dt < 4; ++dt) otot[dt] += oc[dt] * C.gate[0];
        }
        __syncthreads();
        if (C.cur >= 16) {
            const int sq = tid & 31, jg = tid >> 5;
#pragma unroll
            for (int jj = 0; jj < 2; ++jj) { const int j = jg * 2 + jj; const float imp = IMP[(0 * 32 + sq) * 33 + j] + IMP[(1 * 32 + sq) * 33 + j] + IMP[(2 * 32 + sq) * 33 + j] + IMP[(3 * 32 + sq) * 33 + j];
                const bool valid = j <= C.cur, forced = (j == 0) || (j == C.cur) || (j == C.cur - 1);
                IMP[sq * 33 + j] = valid ? (forced ? 1e4f : imp) : -1.0f; }
            __syncthreads();
            unsigned bits = 0u;
#pragma unroll
            for (int jj = 0; jj < 2; ++jj) { const int j = jg * 2 + jj; const float sj = IMP[sq * 33 + j]; int cnt = 0;
                for (int j2 = 0; j2 < 32; ++j2) { const float s2 = IMP[sq * 33 + j2]; cnt += ((s2 > sj) || (s2 == sj && j2 < j)) ? 1 : 0; }
                if (cnt < 16) bits |= 1u << j; }
            SELP[jg * 32 + sq] = bits;
            __syncthreads();
            if (tid < 32) { unsigned m = 0u;
#pragma unroll
                for (int q = 0; q < 16; ++q) m |= SELP[q * 32 + tid];
                SEL[tid] = m; }
        } else { if (tid < 32) SEL[tid] = (2u << C.cur) - 1u; }
        __syncthreads();
        C.selq = SEL[qq];
        { unsigned m = SEL[lane & 31]; m |= __shfl_xor(m, 16); m |= __shfl_xor(m, 8); m |= __shfl_xor(m, 4); m |= __shfl_xor(m, 2); m |= __shfl_xor(m, 1); C.anym = (unsigned)__builtin_amdgcn_readfirstlane((int)m); }
        attn_branch<1>(PROJ, lds, C, otot, tid);
        attn_branch<2>(PROJ, lds, C, otot, tid);
#pragma unroll
        for (int dt = 0; dt < 4; ++dt) *(u32x2*)(OATT + trow * 1024 + C.head * 64 + dt * 16 + fq * 4) = pack4(otot[dt]);
    }
}

__device__ __forceinline__ void grid_barrier(cg::grid_group& grid) {
    __builtin_amdgcn_fence(__ATOMIC_RELEASE, "agent");
    asm volatile("s_waitcnt vmcnt(0)" ::: "memory");
    grid.sync();
    __builtin_amdgcn_fence(__ATOMIC_ACQUIRE, "agent");
    asm volatile("s_waitcnt vmcnt(0)" ::: "memory");
}
struct GemmDesc { const bf16_t* A; const bf16_t* Bt; bf16_t* O; int M, N, K, ldc, act, cshift; };
__device__ __forceinline__ void run_gemm(const GemmDesc& d, LAS unsigned char* lds) {
    pg8::Gemm g{d.A, d.Bt, d.M, d.N, d.K}; pg8::StaticOrder S; const int G = (int)gridDim.x; S.init(d.M, d.N, G, ((int)blockIdx.x + G - d.cshift % G) % G);
    if (d.act == 0) { pg8::Epi<0> E{d.O, d.ldc}; pg8::gemm_phase<pg8::Epi<0>, pg8::StaticOrder>(lds, g, S, E); }
    else if (d.act == 1) { pg8::Epi<1> E{d.O, d.ldc}; pg8::gemm_phase<pg8::Epi<1>, pg8::StaticOrder>(lds, g, S, E); }
    else { pg8::Epi<2> E{d.O, d.ldc}; pg8::gemm_phase<pg8::Epi<2>, pg8::StaticOrder>(lds, g, S, E); }
}

__global__ void __launch_bounds__(NTHR) fwd_megakernel(Params p) {
    extern __shared__ __attribute__((aligned(16))) unsigned char smem[];
    LAS unsigned char* lds = (LAS unsigned char*)smem;
    cg::grid_group grid = cg::this_grid();
    unsigned char* ws = p.ws; unsigned char* U = ws + OFF_U2;
    const float* mod = (const float*)(ws + OFF_MOD); bf16_t* H = (bf16_t*)(ws + OFF_H);

#ifdef PREFILL
    { const u32x4 pz = (u32x4){0xAAAAAAAAu, 0xAAAAAAAAu, 0xAAAAAAAAu, 0xAAAAAAAAu}; for (size_t i = (size_t)blockIdx.x * NTHR + threadIdx.x; i < WS_END / 16; i += (size_t)gridDim.x * NTHR) ((u32x4*)ws)[i] = pz; }
    grid_barrier(grid);
#endif
    phase_prep(p, lds);
    grid_barrier(grid);
    phase_init(p);
    grid_barrier(grid);

    for (int layer = 0; layer < DEPTH; ++layer) {
        const int jm = layer >> 1; const bool is_ret = (layer & 1) == 0;
        const float* modL = mod + (size_t)layer * 16 * MODW;
        for (int st = 0; st < 13; ++st) {
            GemmDesc d[2]; int ng = 0;
            d[0].cshift = 0; d[1].cshift = 0;
            if (st == 0 || st == 10) {
                const int s = st == 0 ? 0 : 1;
                d[0] = GemmDesc{H, (const bf16_t*)(ws + OFF_FFN_IN + (size_t)(layer * 2 + s) * SZ_FFN_IN), (bf16_t*)(U + U_FFN_ACT), MTOK, 5632, 1024, DFF, 1, 0}; ng = 1;
            } else if (st == 1 || st == 11) {
                const int s = st == 1 ? 0 : 1;
                d[0] = GemmDesc{(const bf16_t*)(U + U_FFN_ACT), (const bf16_t*)(ws + OFF_FFN_OUT + (size_t)(layer * 2 + s) * SZ_FFN_OUT), (bf16_t*)(U + U_FFN_Y), MTOK, 1024, DFF, 1024, 0, 0}; ng = 1;
            } else if (st == 2 || st == 9 || st == 12) {
                const int sub = st == 2 ? 0 : (st == 9 ? 1 : 2);
                const bf16_t* y = (const bf16_t*)(U + (sub == 1 ? (is_ret ? U_RET_Y : U_NSA_Y) : U_FFN_Y));
                const float* modN = (sub == 2) ? (layer + 1 < DEPTH ? modL + (size_t)16 * MODW : modL) : modL;
                const int shc = (sub == 2) ? 0 : (sub + 1) * 3;
                phase_ln(p.out, y, modL + (sub * 3 + 2) * 1024, sub == 1 ? 1.0f : 0.5f, p.ln_g + (size_t)(layer * 3 + sub) * 1024, p.ln_b + (size_t)(layer * 3 + sub) * 1024,
                         modN + shc * 1024, modN + (shc + 1) * 1024, H);
            } else if (is_ret) {
                const bf16_t* Wi = (const bf16_t*)(ws + OFF_RET_IN + (size_t)jm * SZ_RET_IN);
                if (st == 3) { d[0] = GemmDesc{H, Wi, (bf16_t*)(U + U_RET_QKV), MTOK, 4096, 1024, 4096, 0, 0}; ng = 1; }
                else if (st == 4) phase_ret_core((const bf16_t*)(U + U_RET_QKV), (bf16_t*)(U + U_RET_O), lds);
                else if (st == 5) { d[0] = GemmDesc{H, Wi + (size_t)4096 * 1024, (bf16_t*)(U + U_RET_G), MTOK, 2048, 1024, 2048, 0, 0}; ng = 1; }
                else if (st == 6) phase_ret_gate((bf16_t*)(U + U_RET_O), (const bf16_t*)(U + U_RET_G));
                else if (st == 7) { d[0] = GemmDesc{(const bf16_t*)(U + U_RET_O), (const bf16_t*)(ws + OFF_RET_OUT + (size_t)jm * SZ_RET_OUT), (bf16_t*)(U + U_RET_Y), MTOK, 1024, 2048, 1024, 0, 0}; ng = 1; }
                else continue;
            } else {
                if (st == 3) { d[0] = GemmDesc{H, (const bf16_t*)(ws + OFF_NSA_IN + (size_t)jm * SZ_NSA_IN), (bf16_t*)(U + U_NSA_PROJ), MTOK, 2816, 1024, 2816, 0, 0}; ng = 1; }
                else if (st == 4) phase_nsa_mat((const bf16_t*)(U + U_NSA_PROJ), p.pe_k + (size_t)jm * 2048, p.pe_v + (size_t)jm * 2048, (bf16_t*)(U + U_NSA_ACMPK), (bf16_t*)(U + U_NSA_ACMPV));
                else if (st == 5) {
                    d[0] = GemmDesc{(const bf16_t*)(U + U_NSA_ACMPK), (const bf16_t*)(ws + OFF_W1 + (size_t)(0 * 2 + jm) * SZ_W1), (bf16_t*)(U + U_NSA_HK), 8192, 256, 2048, 256, 2, 0};
                    d[1] = GemmDesc{(const bf16_t*)(U + U_NSA_ACMPV), (const bf16_t*)(ws + OFF_W1 + (size_t)(1 * 2 + jm) * SZ_W1), (bf16_t*)(U + U_NSA_HV), 8192, 256, 2048, 256, 2, 32}; ng = 2;
                } else if (st == 6) phase_nsa_cmp2((const bf16_t*)(U + U_NSA_HK), (const bf16_t*)(U + U_NSA_HV), (const bf16_t*)(ws + OFF_W2 + (size_t)(0 * 2 + jm) * SZ_W2), (const bf16_t*)(ws + OFF_W2 + (size_t)(1 * 2 + jm) * SZ_W2),
                                               (bf16_t*)(U + U_NSA_KCMP), (bf16_t*)(U + U_NSA_VCMP));
                else if (st == 7) phase_nsa_attn((const bf16_t*)(U + U_NSA_PROJ), (const bf16_t*)(U + U_NSA_KCMP), (const bf16_t*)(U + U_NSA_VCMP), (bf16_t*)(U + U_NSA_OATT), lds);
                else { d[0] = GemmDesc{(const bf16_t*)(U + U_NSA_OATT), (const bf16_t*)(ws + OFF_NSA_OUT + (size_t)jm * SZ_NSA_OUT), (bf16_t*)(U + U_NSA_Y), MTOK, 1024, 1024, 1024, 0, 0}; ng = 1; }
            }
            for (int r = 0; r < ng; ++r) { GemmDesc dd = d[0]; if (r == 1) dd = d[1]; run_gemm(dd, lds); }
            grid_barrier(grid);
#ifdef STOP_L
            if (layer == STOP_L && st == STOP_S) return;
#endif
        }
    }
}

extern "C" void kernel_launch(void* const* d_in, const int* in_sizes, int n_in, void* d_out, int out_size, void* d_ws, size_t ws_size, hipStream_t stream) {
    static int grid_blocks = 0;
    if (grid_blocks == 0) {
        int dev = 0, cus = 0, per_cu = 0;
        hipGetDevice(&dev); hipDeviceGetAttribute(&cus, hipDeviceAttributeMultiprocessorCount, dev);
        if (hipFuncSetAttribute((const void*)fwd_megakernel, hipFuncAttributeMaxDynamicSharedMemorySize, LDS_BYTES) != hipSuccess) fprintf(stderr, "hipFuncSetAttribute failed\n");
        if (hipOccupancyMaxActiveBlocksPerMultiprocessor(&per_cu, (const void*)fwd_megakernel, NTHR, LDS_BYTES) != hipSuccess || per_cu < 1) { fprintf(stderr, "occupancy query: %d\n", per_cu); per_cu = 1; }
        (void)hipGetLastError();
        grid_blocks = cus * 1;
        if (ws_size < WS_END + 256) fprintf(stderr, "workspace too small: %zu < %zu\n", ws_size, (size_t)WS_END);
    }
    Params p{};
    p.x = (const float*)d_in[0]; p.c = (const float*)d_in[1]; p.ada_w = (const float*)d_in[2]; p.ada_b = (const float*)d_in[3]; p.ln_g = (const float*)d_in[4]; p.ln_b = (const float*)d_in[5];
    p.pe_k = (const float*)d_in[12]; p.pe_v = (const float*)d_in[13]; p.out = (float*)d_out; p.ws = (unsigned char*)d_ws;
    unsigned char* ws = (unsigned char*)d_ws; int nj = 0, te = 0;
    auto add = [&](const float* src, size_t dst_off, int K, int N, int Np, int mode) { p.jobs[nj] = WJob{src, (bf16_t*)(ws + dst_off), K, N, Np, mode}; te += (Np / 64) * (K / 64); p.tile_end[nj] = te; ++nj; };
    const float* ffn_in = (const float*)d_in[6]; const float* ffn_out = (const float*)d_in[7]; const float* ret_in = (const float*)d_in[8]; const float* ret_out = (const float*)d_in[9];
    const float* nsa_in = (const float*)d_in[10]; const float* nsa_out = (const float*)d_in[11];
    const float* ck1 = (const float*)d_in[14]; const float* ck2 = (const float*)d_in[15]; const float* cv1 = (const float*)d_in[16]; const float* cv2 = (const float*)d_in[17];
    for (int i = 0; i < 8; ++i) add(ffn_in + (size_t)i * 1024 * 5632, OFF_FFN_IN + i * SZ_FFN_IN, 1024, 5632, 5632, 1);
    for (int i = 0; i < 8; ++i) add(ffn_out + (size_t)i * 2816 * 1024, OFF_FFN_OUT + i * SZ_FFN_OUT, 2816, 1024, 1024, 0);
    for (int i = 0; i < 2; ++i) add(ret_in + (size_t)i * 1024 * 6144, OFF_RET_IN + i * SZ_RET_IN, 1024, 6144, 6144, 0);
    for (int i = 0; i < 2; ++i) add(ret_out + (size_t)i * 2048 * 1024, OFF_RET_OUT + i * SZ_RET_OUT, 2048, 1024, 1024, 0);
    for (int i = 0; i < 2; ++i) add(nsa_in + (size_t)i * 1024 * 2608, OFF_NSA_IN + i * SZ_NSA_IN, 1024, 2608, 2816, 0);
    for (int i = 0; i < 2; ++i) add(nsa_out + (size_t)i * 1024 * 1024, OFF_NSA_OUT + i * SZ_NSA_OUT, 1024, 1024, 1024, 0);
    for (int i = 0; i < 2; ++i) add(ck1 + (size_t)i * 2048 * 256, OFF_W1 + (0 * 2 + i) * SZ_W1, 2048, 256, 256, 0);
    for (int i = 0; i < 2; ++i) add(cv1 + (size_t)i * 2048 * 256, OFF_W1 + (1 * 2 + i) * SZ_W1, 2048, 256, 256, 0);
    for (int i = 0; i < 2; ++i) add(ck2 + (size_t)i * 256 * 64, OFF_W2 + (0 * 2 + i) * SZ_W2, 256, 64, 64, 0);
    for (int i = 0; i < 2; ++i) add(cv2 + (size_t)i * 256 * 64, OFF_W2 + (1 * 2 + i) * SZ_W2, 256, 64, 64, 0);
    p.njobs = nj;
    void* args[] = {&p};
    hipError_t e = hipLaunchCooperativeKernel((const void*)fwd_megakernel, dim3(grid_blocks), dim3(NTHR), args, LDS_BYTES, stream);
    if (e != hipSuccess) fprintf(stderr, "cooperative launch failed: %s (grid %d)\n", hipGetErrorString(e), grid_blocks);
}
```

```cpp
#include <hip/hip_runtime.h>
#include <hip/hip_cooperative_groups.h>
#include <cstdio>
namespace cg = cooperative_groups;

namespace pg8 {
#define PG8_LAS __attribute__((address_space(3)))
typedef unsigned short bf16_t;
typedef short bf16x8 __attribute__((ext_vector_type(8)));
typedef float f32x4 __attribute__((ext_vector_type(4)));
typedef unsigned u32x4 __attribute__((ext_vector_type(4)));
constexpr int BM = 256, BK = 64, HALF = 128, HTB = HALF * BK * 2  , STAGE_BYTES = 8 * HTB, NXCD = 8, WGM = 8;

__host__ __device__ __forceinline__ int lds_byte(int r, int c) { const int st = (r >> 4) * 2 + (c >> 5), rr = r & 15, cc = c & 31, ob = rr * 64 + cc * 2; return st * 1024 + (ob ^ (((ob >> 9) & 1) << 5)); }
__host__ __device__ __forceinline__ void stage_rc(int b, int& R, int& C) { const int st = b / 1024, sb = b % 1024, swz = sb ^ (((sb >> 9) & 1) << 5); R = (st >> 1) * 16 + swz / 64; C = (st & 1) * 32 + (swz % 64) / 2; }
__host__ __device__ __forceinline__ int perm32(int rho) { const int n = rho >> 4, i = rho & 15; return 8 * (i >> 2) + 4 * n + (i & 3); }

struct Unit { int pm, pn; };
struct Gemm { const bf16_t* A; const bf16_t* Bt; int M, N, K; };

struct StaticOrder {
    int nM, nN, nwg, G, c;
    __host__ __device__ void init(int M, int N, int G_, int c_) { nM = M / BM; nN = N / BM; nwg = nM * nN; G = G_; c = c_; }
    __host__ __device__ bool next(int i, Unit& u) const {
        const long L = (long)i * G + c; if (L >= nwg) return false;
        int wgid = (int)L; { const int q = nwg / NXCD, r = nwg % NXCD, xcd = wgid % NXCD, off = wgid / NXCD; wgid = (xcd < r ? xcd * (q + 1) : r * (q + 1) + (xcd - r) * q) + off; }
        const int nig = WGM * nN, gid = wgid / nig, fm = gid * WGM, gsz = (nM - fm) < WGM ? (nM - fm) : WGM;
        u.pm = fm + ((wgid % nig) % gsz); u.pn = (wgid % nig) / gsz; return true;
    }
    __device__ __forceinline__ void a_ready(const Unit&) const {}
    __device__ __forceinline__ void done(const Unit&) const {}
};

typedef float f32x2_t __attribute__((ext_vector_type(2)));
typedef __bf16 bf16x2_t __attribute__((ext_vector_type(2)));
__device__ __forceinline__ unsigned cvt_pk_bf16(float lo, float hi) { const f32x2_t v = {lo, hi}; return __builtin_bit_cast(unsigned, __builtin_convertvector(v, bf16x2_t)); }
__device__ __forceinline__ float silu_f(float a) { return a / (1.0f + __expf(-a)); }
__device__ __forceinline__ float gelu_tanh_f(float x) { const float u = 0.7978845608028654f * (x + 0.044715f * x * x * x); const float t = 1.0f - 2.0f / (1.0f + __expf(2.0f * u)); return 0.5f * x * (1.0f + t); }

template <int ACT> struct Epi {
    static constexpr bool PERM = true, AFTER_DRAIN = false;
    bf16_t* O; int ldc;
    __device__ __forceinline__ void operator()(const f32x4 (&acc)[2][2][4][2], const Unit& u, int wr, int wc, int fr, int fq) const {
        const int row0 = u.pm * BM + wr * 64 + fr;
        if (ACT == 1) {
            const int col0 = u.pn * HALF + wc * 32 + 8 * fq;
#pragma unroll
            for (int ai = 0; ai < 2; ++ai)
#pragma unroll
                for (int m = 0; m < 4; ++m) { bf16_t* rowp = O + (size_t)(row0 + ai * HALF + m * 16) * ldc + col0;
                    const f32x4 a0 = acc[ai][0][m][0], a1 = acc[ai][0][m][1], u0 = acc[ai][1][m][0], u1 = acc[ai][1][m][1];
                    u32x4 w; w.x = cvt_pk_bf16(silu_f(a0[0]) * u0[0], silu_f(a0[1]) * u0[1]); w.y = cvt_pk_bf16(silu_f(a0[2]) * u0[2], silu_f(a0[3]) * u0[3]);
                    w.z = cvt_pk_bf16(silu_f(a1[0]) * u1[0], silu_f(a1[1]) * u1[1]); w.w = cvt_pk_bf16(silu_f(a1[2]) * u1[2], silu_f(a1[3]) * u1[3]);
                    *(u32x4*)rowp = w; }
        } else {
            const int col0 = u.pn * BM + wc * 32 + 8 * fq;
#pragma unroll
            for (int ai = 0; ai < 2; ++ai)
#pragma unroll
                for (int m = 0; m < 4; ++m) { bf16_t* rowp = O + (size_t)(row0 + ai * HALF + m * 16) * ldc + col0;
#pragma unroll
                    for (int bj = 0; bj < 2; ++bj) { f32x4 v0 = acc[ai][bj][m][0], v1 = acc[ai][bj][m][1];
                        if (ACT == 2) {
#pragma unroll
                            for (int j = 0; j < 4; ++j) { v0[j] = gelu_tanh_f(v0[j]); v1[j] = gelu_tanh_f(v1[j]); } }
                        u32x4 w; w.x = cvt_pk_bf16(v0[0], v0[1]); w.y = cvt_pk_bf16(v0[2], v0[3]); w.z = cvt_pk_bf16(v1[0], v1[1]); w.w = cvt_pk_bf16(v1[2], v1[3]);
                        *(u32x4*)(rowp + bj * HALF) = w; } }
        }
    }
};

template <class Epi, class Sched>
__device__ __forceinline__ void gemm_phase(PG8_LAS unsigned char* lds, const Gemm g, const Sched& S, const Epi& E) {
    const int tid = threadIdx.x, wid = __builtin_amdgcn_readfirstlane(tid >> 6), lane = tid & 63, wr = wid >> 2, wc = wid & 3, fr = lane & 15, fq = lane >> 4;
    const int K = g.K, nt = K / BK;
    unsigned voffA[2], voffB[2];
#pragma unroll
    for (int i = 0; i < 2; ++i) { int R, C; stage_rc(tid * 16 + i * 8192, R, C); const int Rb = Epi::PERM ? ((R & ~31) + perm32(R & 31)) : R;
        voffA[i] = (unsigned)(R * K + C) * 2u; voffB[i] = (unsigned)(Rb * K + C) * 2u; }
    const size_t kstep = (size_t)(BK * 2);
    const size_t hstep = (size_t)HALF * K * 2;
    const size_t tstep = 2 * hstep;
    const unsigned ldsw = (unsigned)wid * 1024u;
    const int aoff = lds_byte(wr * 64 + fr, fq * 8), boff = lds_byte(wc * 32 + fr, fq * 8);
#define PG8_SA(b, h) (((b) * 2 + (h)) * HTB)
#define PG8_SB(b, h) ((4 + (b) * 2 + (h)) * HTB)
#define PG8_STAGE(bufoff, gbase, voff) do { _Pragma("unroll") for (int _i = 0; _i < 2; ++_i) \
        __builtin_amdgcn_global_load_lds((const unsigned*)((const char*)(gbase) + (voff)[_i]), (PG8_LAS unsigned*)(lds + (bufoff) + ldsw + _i * 8192), 16, 0, 0); } while (0)
#define PG8_LDA(dst, b, h) do { _Pragma("unroll") for (int m = 0; m < 4; ++m) _Pragma("unroll") for (int k = 0; k < 2; ++k) dst[m][k] = *(const PG8_LAS bf16x8*)(lds + PG8_SA(b, h) + aoff + m * 2048 + k * 1024); } while (0)
#define PG8_LDB(dst, b, h) do { _Pragma("unroll") for (int n = 0; n < 2; ++n) _Pragma("unroll") for (int k = 0; k < 2; ++k) dst[n][k] = *(const PG8_LAS bf16x8*)(lds + PG8_SB(b, h) + boff + n * 2048 + k * 1024); } while (0)
#define PG8_MMA(ai, bj, At, Bt) do { __builtin_amdgcn_s_setprio(1); _Pragma("unroll") for (int m = 0; m < 4; ++m) _Pragma("unroll") for (int n = 0; n < 2; ++n) _Pragma("unroll") for (int k = 0; k < 2; ++k) \
        acc[ai][bj][m][n] = __builtin_amdgcn_mfma_f32_16x16x32_bf16(Bt[n][k], At[m][k], acc[ai][bj][m][n], 0, 0, 0); __builtin_amdgcn_s_setprio(0); } while (0)
#define PG8_WAIT_V(n) asm volatile("s_waitcnt vmcnt(" #n ")" ::: "memory")
#define PG8_WAIT_L(n) asm volatile("s_waitcnt lgkmcnt(" #n ")" ::: "memory")
#define PG8_BAR __builtin_amdgcn_s_barrier()
#define PG8_SCHED __builtin_amdgcn_sched_barrier(0)
    Unit cur, nxt; int ui = 0;
    if (!S.next(0, cur)) return;
    f32x4 acc[2][2][4][2];
#pragma unroll
    for (int a = 0; a < 2; ++a)
#pragma unroll
        for (int b = 0; b < 2; ++b)
#pragma unroll
            for (int m = 0; m < 4; ++m)
#pragma unroll
                for (int n = 0; n < 2; ++n) acc[a][b][m][n] = (f32x4){0.f, 0.f, 0.f, 0.f};
    bf16x8 At[4][2], B0[2][2], B1[2][2];
    const char* cA = (const char*)g.A + (size_t)cur.pm * tstep; const char* cB = (const char*)g.Bt + (size_t)cur.pn * tstep;
    S.a_ready(cur);
    PG8_STAGE(PG8_SB(0, 0), cB, voffB); PG8_STAGE(PG8_SA(0, 0), cA, voffA); PG8_STAGE(PG8_SB(0, 1), cB + hstep, voffB); PG8_STAGE(PG8_SA(0, 1), cA + hstep, voffA);
    if (wr == 1) PG8_BAR;
    PG8_WAIT_V(4); PG8_BAR;
    PG8_STAGE(PG8_SB(1, 0), cB + kstep, voffB); PG8_STAGE(PG8_SA(1, 0), cA + kstep, voffA); PG8_STAGE(PG8_SB(1, 1), cB + hstep + kstep, voffB);
    PG8_WAIT_V(6); PG8_BAR;
    for (;;) {
        const bool has_next = S.next(ui + 1, nxt);
        const char* nA = has_next ? (const char*)g.A + (size_t)nxt.pm * tstep : cA; const char* nB = has_next ? (const char*)g.Bt + (size_t)nxt.pn * tstep : cB;
        for (int t = 0; t < nt; t += 2) {
            const bool last = (t == nt - 2);
            const char* a1 = cA + (size_t)(t + 1) * kstep;
            const char* a2 = last ? nA : cA + (size_t)(t + 2) * kstep; const char* b2 = last ? nB : cB + (size_t)(t + 2) * kstep;
            const char* a3 = a2 + kstep; const char* b3 = b2 + kstep;
            if (last && has_next) S.a_ready(nxt);
            PG8_LDB(B0, 0, 0); PG8_SCHED; PG8_LDA(At, 0, 0); PG8_STAGE(PG8_SA(1, 1), a1 + hstep, voffA);
            PG8_WAIT_L(8); PG8_BAR; PG8_WAIT_L(0); PG8_MMA(0, 0, At, B0); PG8_BAR; PG8_SCHED;
            PG8_LDB(B1, 0, 1); PG8_STAGE(PG8_SB(0, 0), b2, voffB);
            PG8_BAR; PG8_WAIT_L(0); PG8_MMA(0, 1, At, B1); PG8_BAR;
            PG8_LDA(At, 0, 1); PG8_STAGE(PG8_SA(0, 0), a2, voffA);
            PG8_BAR; PG8_WAIT_L(0); PG8_MMA(1, 0, At, B0); PG8_BAR; PG8_SCHED;
            PG8_STAGE(PG8_SB(0, 1), b2 + hstep, voffB);
            PG8_WAIT_V(6); PG8_BAR; PG8_MMA(1, 1, At, B1); PG8_BAR;
            PG8_LDB(B0, 1, 0); PG8_SCHED; PG8_LDA(At, 1, 0); PG8_STAGE(PG8_SA(0, 1), a2 + hstep, voffA);
            PG8_WAIT_L(8); PG8_BAR; PG8_WAIT_L(0); PG8_MMA(0, 0, At, B0); PG8_BAR; PG8_SCHED;
            PG8_LDB(B1, 1, 1); PG8_STAGE(PG8_SB(1, 0), b3, voffB);
            PG8_BAR; PG8_WAIT_L(0); PG8_MMA(0, 1, At, B1); PG8_BAR;
            PG8_LDA(At, 1, 1); PG8_STAGE(PG8_SA(1, 0), a3, voffA);
            PG8_BAR; PG8_WAIT_L(0); PG8_MMA(1, 0, At, B0); PG8_BAR; PG8_SCHED;
            PG8_STAGE(PG8_SB(1, 1), b3 + hstep, voffB);
            PG8_WAIT_V(6); PG8_BAR; PG8_MMA(1, 1, At, B1); PG8_BAR;
        }
        if constexpr (!Epi::AFTER_DRAIN) { E(acc, cur, wr, wc, fr, fq); S.done(cur); }
        if (!has_next) break;
#pragma unroll
        for (int a = 0; a < 2; ++a)
#pragma unroll
            for (int b = 0; b < 2; ++b)
#pragma unroll
                for (int m = 0; m < 4; ++m)
#pragma unroll
                    for (int n = 0; n < 2; ++n) acc[a][b][m][n] = (f32x4){0.f, 0.f, 0.f, 0.f};
        cur = nxt; cA = nA; cB = nB; ++ui;
    }
    PG8_WAIT_V(0);
    if (wr == 0) PG8_BAR;
    PG8_BAR;
    if constexpr (Epi::AFTER_DRAIN) { E.fused(acc, cur, wr, wc, fr, fq, lds, wid, lane); S.done(cur); }
#undef PG8_SA
#undef PG8_SB
#undef PG8_STAGE
#undef PG8_LDA
#undef PG8_LDB
#undef PG8_MMA
#undef PG8_WAIT_V
#undef PG8_WAIT_L
#undef PG8_BAR
#undef PG8_SCHED
}
}

using pg8::bf16_t; using pg8::bf16x8; using pg8::f32x4; using pg8::u32x4; using pg8::cvt_pk_bf16; using pg8::silu_f;
#define LAS __attribute__((address_space(3)))
typedef unsigned u32x2 __attribute__((ext_vector_type(2)));
typedef short s16x4 __attribute__((ext_vector_type(4)));
#define MFMA16(a, b, c) __builtin_amdgcn_mfma_f32_16x16x32_bf16((a), (b), (c), 0, 0, 0)

constexpr int NTHR = 512;
constexpr int MTOK = 32768, DM = 1024, SEQ = 2048, DFF = 2816, DEPTH = 4, MODW = 9216;
constexpr float DN_ALPHA = 1.6817928305074290861f;
constexpr size_t MiB = (size_t)1 << 20;
constexpr size_t SZ_FFN_IN = (size_t)5632 * 1024 * 2, SZ_FFN_OUT = (size_t)1024 * 2816 * 2, SZ_RET_IN = (size_t)6144 * 1024 * 2, SZ_RET_OUT = (size_t)1024 * 2048 * 2,
                 SZ_NSA_IN = (size_t)2816 * 1024 * 2, SZ_NSA_OUT = (size_t)1024 * 1024 * 2, SZ_W1 = (size_t)256 * 2048 * 2, SZ_W2 = (size_t)64 * 256 * 2;
constexpr size_t OFF_FFN_IN = 0, OFF_FFN_OUT = OFF_FFN_IN + 8 * SZ_FFN_IN, OFF_RET_IN = OFF_FFN_OUT + 8 * SZ_FFN_OUT, OFF_RET_OUT = OFF_RET_IN + 2 * SZ_RET_IN,
                 OFF_NSA_IN = OFF_RET_OUT + 2 * SZ_RET_OUT, OFF_NSA_OUT = OFF_NSA_IN + 2 * SZ_NSA_IN, OFF_W1 = OFF_NSA_OUT + 2 * SZ_NSA_OUT, OFF_W2 = OFF_W1 + 4 * SZ_W1,
                 OFF_MOD = OFF_W2 + 4 * SZ_W2, OFF_H = OFF_MOD + (size_t)DEPTH * 16 * MODW * 4, OFF_U2 = OFF_H + (size_t)MTOK * DM * 2, WS_END = OFF_U2 + 384 * MiB;
constexpr size_t U_FFN_ACT = 0, U_FFN_Y = 192 * MiB;
constexpr size_t U_RET_QKV = 0, U_RET_G = 0, U_RET_O = 256 * MiB, U_RET_Y = 128 * MiB;
constexpr size_t U_NSA_PROJ = 0, U_NSA_Y = 192 * MiB, U_NSA_ACMPK = 256 * MiB, U_NSA_ACMPV = 288 * MiB, U_NSA_HK = 320 * MiB, U_NSA_HV = 324 * MiB, U_NSA_KCMP = 328 * MiB, U_NSA_VCMP = 329 * MiB, U_NSA_OATT = 256 * MiB;
constexpr int LDS_BYTES = 152 * 1024;

struct WJob { const float* src; bf16_t* dst; int K, N, Np, mode; };
struct Params {
    const float* x; const float* c; const float* ada_w; const float* ada_b; const float* ln_g; const float* ln_b; const float* pe_k; const float* pe_v;
    float* out; unsigned char* ws;
    WJob jobs[32]; int tile_end[32]; int njobs; int pad;
};

__device__ __forceinline__ float bf2f(unsigned short b) { return __uint_as_float(((unsigned)b) << 16); }
__device__ __forceinline__ float bflo(unsigned w) { return __uint_as_float(w << 16); }
__device__ __forceinline__ float bfhi(unsigned w) { return __uint_as_float(w & 0xffff0000u); }
__device__ __forceinline__ unsigned short f2bf(float f) { return (unsigned short)(cvt_pk_bf16(f, 0.f) & 0xffffu); }
__device__ __forceinline__ bf16x8 pack8(const f32x4& a, const f32x4& b) { u32x4 w; w.x = cvt_pk_bf16(a[0], a[1]); w.y = cvt_pk_bf16(a[2], a[3]); w.z = cvt_pk_bf16(b[0], b[1]); w.w = cvt_pk_bf16(b[2], b[3]); return __builtin_bit_cast(bf16x8, w); }
__device__ __forceinline__ u32x2 pack4(const f32x4& a) { u32x2 w; w.x = cvt_pk_bf16(a[0], a[1]); w.y = cvt_pk_bf16(a[2], a[3]); return w; }
__device__ __forceinline__ bf16x8 lds_rd16(LAS unsigned char* lds, int off) { return *(const LAS bf16x8*)(lds + off); }
__device__ __forceinline__ bf16x8 lds_rd8x2(LAS unsigned char* lds, int off) { const s16x4 lo = *(const LAS s16x4*)(lds + off), hi = *(const LAS s16x4*)(lds + off + 32); return __builtin_shufflevector(lo, hi, 0, 1, 2, 3, 4, 5, 6, 7); }
__device__ __forceinline__ float wsum(float v) { v += __shfl_xor(v, 32); v += __shfl_xor(v, 16); v += __shfl_xor(v, 8); v += __shfl_xor(v, 4); v += __shfl_xor(v, 2); v += __shfl_xor(v, 1); return v; }

__device__ __forceinline__ void wt_tile(const WJob& J, int t, LAS float* T) {
    int tid = threadIdx.x; asm volatile("" : "+v"(tid));
    const int ntn = J.Np >> 6; const int tn = t % ntn, tk = t / ntn; const int n0 = tn * 64, k0 = tk * 64;
    int sbase = n0; if (J.mode == 1) { const int pn = n0 >> 8, r = n0 & 255; sbase = (r >> 7) * DFF + pn * 128 + (r & 127); }
    const int kk = tid >> 4, nn = (tid & 15) * 4;
#pragma unroll
    for (int rep = 0; rep < 2; ++rep) { const int k = kk + rep * 32; f32x4 v = (f32x4){0.f, 0.f, 0.f, 0.f};
        if (sbase + nn < J.N) v = *(const f32x4*)(J.src + (size_t)(k0 + k) * J.N + sbase + nn);
        T[k * 65 + nn] = v[0]; T[k * 65 + nn + 1] = v[1]; T[k * 65 + nn + 2] = v[2]; T[k * 65 + nn + 3] = v[3]; }
    __syncthreads();
    const int n = tid >> 3, k8 = (tid & 7) * 8;
    f32x4 a, b;
    a[0] = T[(k8 + 0) * 65 + n]; a[1] = T[(k8 + 1) * 65 + n]; a[2] = T[(k8 + 2) * 65 + n]; a[3] = T[(k8 + 3) * 65 + n];
    b[0] = T[(k8 + 4) * 65 + n]; b[1] = T[(k8 + 5) * 65 + n]; b[2] = T[(k8 + 6) * 65 + n]; b[3] = T[(k8 + 7) * 65 + n];
    *(bf16x8*)(J.dst + (size_t)(n0 + n) * J.K + k0 + k8) = pack8(a, b);
    __syncthreads();
}

__device__ __forceinline__ void phase_prep(const Params& p, LAS unsigned char* lds) {
    int tid = threadIdx.x; asm volatile("" : "+v"(tid));
    LAS float* T = (LAS float*)lds;
    const int ntiles = p.tile_end[p.njobs - 1];
    for (int t = blockIdx.x; t < ntiles; t += gridDim.x) {
        int j = 0; while (j < p.njobs - 1 && t >= p.tile_end[j]) ++j;
        const int t0 = j ? p.tile_end[j - 1] : 0;
        wt_tile(p.jobs[j], t - t0, T);
    }
    if (blockIdx.x < 288) {
        LAS float* cs = (LAS float*)lds;
        LAS float* red = (LAS float*)(lds + 65536);
        float* mod = (float*)(p.ws + OFF_MOD);
        __syncthreads();
        for (int idx = tid; idx < 16 * 1024; idx += NTHR) { const int b = idx >> 10, k = idx & 1023; const float cv = p.c[idx]; cs[k * 16 + b] = cv / (1.0f + expf(-cv)); }
        __syncthreads();
        for (int unit = blockIdx.x; unit < 288; unit += gridDim.x) {
            const int i = unit / 72, n0 = (unit % 72) * 128, col = tid & 127, kq = tid >> 7;
            f32x4 a0 = (f32x4){0.f, 0.f, 0.f, 0.f}, a1 = a0, a2 = a0, a3 = a0;
            const float* wp = p.ada_w + ((size_t)i * 1024 + kq * 256) * MODW + n0 + col;
#pragma unroll 4
            for (int k = 0; k < 256; ++k) { const float w = wp[(size_t)k * MODW]; const LAS f32x4* cp = (const LAS f32x4*)(cs + (kq * 256 + k) * 16);
                a0 += cp[0] * w; a1 += cp[1] * w; a2 += cp[2] * w; a3 += cp[3] * w; }
#pragma unroll
            for (int b = 0; b < 4; ++b) { red[(kq * 16 + b) * 128 + col] = a0[b]; red[(kq * 16 + 4 + b) * 128 + col] = a1[b]; red[(kq * 16 + 8 + b) * 128 + col] = a2[b]; red[(kq * 16 + 12 + b) * 128 + col] = a3[b]; }
            __syncthreads();
#pragma unroll
            for (int r = 0; r < 4; ++r) { const int o = tid + r * NTHR, b = o >> 7, cc = o & 127;
                const float s = red[(0 * 16 + b) * 128 + cc] + red[(1 * 16 + b) * 128 + cc] + red[(2 * 16 + b) * 128 + cc] + red[(3 * 16 + b) * 128 + cc] + p.ada_b[i * MODW + n0 + cc];
                mod[((size_t)i * 16 + b) * MODW + n0 + cc] = s; }
            __syncthreads();
        }
    }
}

__device__ __forceinline__ void phase_init(const Params& p) {
    const float* mod = (const float*)(p.ws + OFF_MOD); bf16_t* H = (bf16_t*)(p.ws + OFF_H);
    int tid = threadIdx.x; asm volatile("" : "+v"(tid));
    for (size_t i = (size_t)blockIdx.x * NTHR + tid; i < (size_t)MTOK * 256; i += (size_t)gridDim.x * NTHR) {
        const int row = (int)(i >> 8), c4 = (int)(i & 255) * 4, b = row >> 11;
        const f32x4 xv = *(const f32x4*)(p.x + i * 4); *(f32x4*)(p.out + i * 4) = xv;
        const float* m = mod + (size_t)b * MODW; const f32x4 sh = *(const f32x4*)(m + c4), sc = *(const f32x4*)(m + 1024 + c4);
        const f32x4 h = xv * (sc + 1.0f) + sh; *(u32x2*)(H + i * 4) = pack4(h);
    }
}

__device__ __forceinline__ void phase_ln(float* xio, const bf16_t* y, const float* modG, float rw, const float* lng, const float* lnb, const float* modSh, const float* modSc, bf16_t* H) {
    int tid = threadIdx.x; asm volatile("" : "+v"(tid));
    const int wid = __builtin_amdgcn_readfirstlane(tid >> 6), lane = tid & 63;
    for (int row = blockIdx.x * 8 + wid; row < MTOK; row += gridDim.x * 8) {
        const int b = row >> 11; const size_t rb = (size_t)row * DM;
        f32x4 z[4]; float s = 0.f;
#pragma unroll
        for (int q = 0; q < 4; ++q) { const int c = q * 256 + lane * 4; const f32x4 xv = *(const f32x4*)(xio + rb + c); const u32x2 yv = *(const u32x2*)(y + rb + c);
            const f32x4 gt = *(const f32x4*)(modG + (size_t)b * MODW + c); const f32x4 yf = (f32x4){bflo(yv.x), bfhi(yv.x), bflo(yv.y), bfhi(yv.y)};
            z[q] = xv * DN_ALPHA + (gt + 1.0f) * yf * rw; s += (z[q][0] + z[q][1]) + (z[q][2] + z[q][3]); }
        const float mu = wsum(s) * (1.0f / 1024.0f); float v = 0.f;
#pragma unroll
        for (int q = 0; q < 4; ++q) { const f32x4 d = z[q] - mu; v += (d[0] * d[0] + d[1] * d[1]) + (d[2] * d[2] + d[3] * d[3]); }
        const float rstd = rsqrtf(wsum(v) * (1.0f / 1024.0f) + 1e-5f);
#pragma unroll
        for (int q = 0; q < 4; ++q) { const int c = q * 256 + lane * 4; const f32x4 g4 = *(const f32x4*)(lng + c), b4 = *(const f32x4*)(lnb + c);
            const f32x4 xn = (z[q] - mu) * rstd * g4 + b4; *(f32x4*)(xio + rb + c) = xn;
            const f32x4 sh = *(const f32x4*)(modSh + (size_t)b * MODW + c), sc = *(const f32x4*)(modSc + (size_t)b * MODW + c);
            *(u32x2*)(H + rb + c) = pack4(xn * (sc + 1.0f) + sh); }
    }
}

__device__ __forceinline__ void phase_ret_core(const bf16_t* QKV, bf16_t* O, LAS unsigned char* lds) {
    constexpr int PS = 136, STS = 264, OFF_P = 0, OFF_VT = 34816, OFF_KT = 52224, OFF_ST = 121856;
    int tid = threadIdx.x; asm volatile("" : "+v"(tid));
    const int wid = __builtin_amdgcn_readfirstlane(tid >> 6), lane = tid & 63, fr = lane & 15, fq = lane >> 4;
    for (int item = blockIdx.x; item < 512; item += gridDim.x) {
        const int es = item & 7, bh = item >> 3, hh = bh & 3, b = bh >> 2, e0 = es * 64;
        const float log_g = logf(1.0f - exp2f(-5.0f - (float)hh));
        const float gN = expf(log_g * 128.0f);
        __syncthreads();
        for (int i = tid; i < 64 * STS / 2; i += NTHR) ((LAS unsigned*)(lds + OFF_ST))[i] = 0u;
        f32x4 sacc[2][4];
#pragma unroll
        for (int dt = 0; dt < 2; ++dt)
#pragma unroll
            for (int et = 0; et < 4; ++et) sacc[dt][et] = (f32x4){0.f, 0.f, 0.f, 0.f};
        for (int n = 0; n < 16; ++n) {
            const size_t tok0 = (size_t)b * SEQ + n * 128;
            {
                const int c = tid & 127, pc = tid >> 7; const float kfac = 0.0625f * expf(log_g * (float)(127 - c));
                const bf16_t* krow = QKV + (tok0 + c) * 4096 + 1024 + hh * 256;
#pragma unroll
                for (int it = 0; it < 8; ++it) { const int d0 = (pc + 4 * it) * 8; const bf16x8 v = *(const bf16x8*)(krow + d0);
#pragma unroll
                    for (int i = 0; i < 8; ++i) *(LAS bf16_t*)(lds + OFF_KT + ((d0 + i) * PS + c) * 2) = f2bf(bf2f((unsigned short)v[i]) * kfac); }
                const bf16_t* vrow = QKV + (tok0 + c) * 4096 + 2048 + hh * 512 + e0;
#pragma unroll
                for (int it = 0; it < 2; ++it) { const int e = (pc + 4 * it) * 8; const bf16x8 v = *(const bf16x8*)(vrow + e);
#pragma unroll
                    for (int i = 0; i < 8; ++i) *(LAS bf16_t*)(lds + OFF_VT + ((e + i) * PS + c) * 2) = (bf16_t)v[i]; }
            }
            __syncthreads();
            const int cc = wid * 16 + fr;
            bf16x8 qf[8];
            { const bf16_t* qrow = QKV + (tok0 + cc) * 4096 + hh * 256 + fq * 8;
#pragma unroll
              for (int ks = 0; ks < 8; ++ks) qf[ks] = *(const bf16x8*)(qrow + ks * 32); }
            const int ctmax = wid | 1;
            for (int ct = 0; ct <= ctmax; ++ct) {
                f32x4 acc = (f32x4){0.f, 0.f, 0.f, 0.f}; const bf16_t* kr = QKV + (tok0 + ct * 16 + fr) * 4096 + 1024 + hh * 256 + fq * 8;
#pragma unroll
                for (int ks = 0; ks < 8; ++ks) acc = MFMA16(*(const bf16x8*)(kr + ks * 32), qf[ks], acc);
                f32x4 pv;
#pragma unroll
                for (int j = 0; j < 4; ++j) { const int cp = ct * 16 + fq * 4 + j; pv[j] = (cc >= cp) ? acc[j] * 0.0625f * expf(log_g * (float)(cc - cp)) : 0.f; }
                *(LAS u32x2*)(lds + OFF_P + (cc * PS + ct * 16 + fq * 4) * 2) = pack4(pv);
            }
            __syncthreads();
            {
                f32x4 a1[4], a2[4];
#pragma unroll
                for (int et = 0; et < 4; ++et) { a1[et] = (f32x4){0.f, 0.f, 0.f, 0.f}; a2[et] = a1[et]; }
                const int ksmax = wid >> 1;
                for (int ks = 0; ks <= ksmax; ++ks) { const bf16x8 pf = lds_rd16(lds, OFF_P + (cc * PS + ks * 32 + fq * 8) * 2);
#pragma unroll
                    for (int et = 0; et < 4; ++et) a1[et] = MFMA16(lds_rd16(lds, OFF_VT + ((et * 16 + fr) * PS + ks * 32 + fq * 8) * 2), pf, a1[et]); }
#pragma unroll
                for (int ks = 0; ks < 8; ++ks)
#pragma unroll
                    for (int et = 0; et < 4; ++et) a2[et] = MFMA16(lds_rd16(lds, OFF_ST + ((et * 16 + fr) * STS + ks * 32 + fq * 8) * 2), qf[ks], a2[et]);
                const float dq = expf(log_g * (float)(cc + 1));
                bf16_t* orow = O + (tok0 + cc) * 2048 + hh * 512 + e0 + fq * 4;
#pragma unroll
                for (int et = 0; et < 4; ++et) *(u32x2*)(orow + et * 16) = pack4(a1[et] + a2[et] * dq);
            }
            __syncthreads();
            if (n < 15) {
#pragma unroll
                for (int dt = 0; dt < 2; ++dt)
#pragma unroll
                    for (int et = 0; et < 4; ++et) sacc[dt][et] *= gN;
#pragma unroll
                for (int ks = 0; ks < 4; ++ks) {
                    bf16x8 vf[4];
#pragma unroll
                    for (int et = 0; et < 4; ++et) vf[et] = lds_rd16(lds, OFF_VT + ((et * 16 + fr) * PS + ks * 32 + fq * 8) * 2);
#pragma unroll
                    for (int dt = 0; dt < 2; ++dt) { const bf16x8 kf = lds_rd16(lds, OFF_KT + (((2 * wid + dt) * 16 + fr) * PS + ks * 32 + fq * 8) * 2);
#pragma unroll
                        for (int et = 0; et < 4; ++et) sacc[dt][et] = MFMA16(kf, vf[et], sacc[dt][et]); }
                }
#pragma unroll
                for (int dt = 0; dt < 2; ++dt)
#pragma unroll
                    for (int et = 0; et < 4; ++et) *(LAS u32x2*)(lds + OFF_ST + ((et * 16 + fr) * STS + (2 * wid + dt) * 16 + fq * 4) * 2) = pack4(sacc[dt][et]);
            }
            __syncthreads();
        }
    }
}

__device__ __forceinline__ void phase_ret_gate(bf16_t* O, const bf16_t* G) {
    int tid = threadIdx.x; asm volatile("" : "+v"(tid));
    const int wid = __builtin_amdgcn_readfirstlane(tid >> 6), lane = tid & 63;
    for (int idx = blockIdx.x * 8 + wid; idx < MTOK * 4; idx += gridDim.x * 8) {
        const size_t base = (size_t)(idx >> 2) * 2048 + (idx & 3) * 512 + lane * 8;
        const u32x4 ov = *(const u32x4*)(O + base), gv = *(const u32x4*)(G + base);
        float o[8] = {bflo(ov.x), bfhi(ov.x), bflo(ov.y), bfhi(ov.y), bflo(ov.z), bfhi(ov.z), bflo(ov.w), bfhi(ov.w)};
        const float g[8] = {bflo(gv.x), bfhi(gv.x), bflo(gv.y), bfhi(gv.y), bflo(gv.z), bfhi(gv.z), bflo(gv.w), bfhi(gv.w)};
        float s = 0.f;
#pragma unroll
        for (int i = 0; i < 8; ++i) s += o[i];
        const float mu = wsum(s) * (1.0f / 512.0f); float v = 0.f;
#pragma unroll
        for (int i = 0; i < 8; ++i) { const float d = o[i] - mu; v += d * d; }
        const float rstd = rsqrtf(wsum(v) * (1.0f / 512.0f) + 1e-6f);
#pragma unroll
        for (int i = 0; i < 8; ++i) o[i] = (o[i] - mu) * rstd * silu_f(g[i]);
        u32x4 w; w.x = cvt_pk_bf16(o[0], o[1]); w.y = cvt_pk_bf16(o[2], o[3]); w.z = cvt_pk_bf16(o[4], o[5]); w.w = cvt_pk_bf16(o[6], o[7]);
        *(u32x4*)(O + base) = w;
    }
}

__device__ __forceinline__ void phase_nsa_mat(const bf16_t* PROJ, const float* pek, const float* pev, bf16_t* AK, bf16_t* AV) {
    const size_t per = (size_t)8128 * 256;
    int tid = threadIdx.x; asm volatile("" : "+v"(tid));
    for (size_t i = (size_t)blockIdx.x * NTHR + tid; i < 2 * per; i += (size_t)gridDim.x * NTHR) {
        const int kv = i >= per; const size_t rem = kv ? i - per : i; const int r = (int)(rem >> 8), pp = (int)(rem & 255), l = pp >> 3, d0 = (pp & 7) * 8;
        const int g = r & 3, bn = r >> 2, b = bn / 127, n = bn % 127;
        const u32x4 v = *(const u32x4*)(PROJ + ((size_t)b * SEQ + n * 16 + l) * 2816 + 1024 + kv * 256 + g * 64 + d0);
        const float* pe = (kv ? pev : pek) + l * 64 + d0; const f32x4 p0 = *(const f32x4*)pe, p1 = *(const f32x4*)(pe + 4);
        u32x4 w; w.x = cvt_pk_bf16(bflo(v.x) + p0[0], bfhi(v.x) + p0[1]); w.y = cvt_pk_bf16(bflo(v.y) + p0[2], bfhi(v.y) + p0[3]);
        w.z = cvt_pk_bf16(bflo(v.z) + p1[0], bfhi(v.z) + p1[1]); w.w = cvt_pk_bf16(bflo(v.w) + p1[2], bfhi(v.w) + p1[3]);
        *(u32x4*)((kv ? AV : AK) + (size_t)r * 2048 + l * 64 + d0) = w;
    }
}
__device__ __forceinline__ void phase_nsa_cmp2(const bf16_t* HK, const bf16_t* HV, const bf16_t* W2K, const bf16_t* W2V, bf16_t* KC, bf16_t* VC) {
    int tid = threadIdx.x; asm volatile("" : "+v"(tid));
    const int wid = __builtin_amdgcn_readfirstlane(tid >> 6), lane = tid & 63, fr = lane & 15, fq = lane >> 4;
    for (int tt = blockIdx.x * 8 + wid; tt < 508 * 2; tt += gridDim.x * 8) {
        const int kv = tt >= 508, rt = kv ? tt - 508 : tt; const bf16_t* Hd = kv ? HV : HK; const bf16_t* W = kv ? W2V : W2K; bf16_t* Od = kv ? VC : KC;
        f32x4 acc[4];
#pragma unroll
        for (int nt = 0; nt < 4; ++nt) acc[nt] = (f32x4){0.f, 0.f, 0.f, 0.f};
#pragma unroll
        for (int ks = 0; ks < 8; ++ks) { const bf16x8 hf = *(const bf16x8*)(Hd + (size_t)(rt * 16 + fr) * 256 + ks * 32 + fq * 8);
#pragma unroll
            for (int nt = 0; nt < 4; ++nt) acc[nt] = MFMA16(*(const bf16x8*)(W + (size_t)(nt * 16 + fr) * 256 + ks * 32 + fq * 8), hf, acc[nt]); }
#pragma unroll
        for (int nt = 0; nt < 4; ++nt) *(u32x2*)(Od + (size_t)(rt * 16 + fr) * 64 + nt * 16 + fq * 4) = pack4(acc[nt]);
    }
}

struct AttnCtx { int b, g, cur, head, hp, t; float slope; bf16x8 qf[2]; float gate[3]; unsigned selq; unsigned anym; };
constexpr int A_KS = 72, A_VS = 68, A_KCS = 72, A_VCS = 136, A_KBYTES = 9216, A_VBYTES = 8704, A_OFF_K = 0, A_OFF_VT = 18432, A_OFF_KC = 35840, A_OFF_VCT = 54272, A_OFF_IMP = 71680, A_OFF_SEL = 88576, A_OFF_SELP = 88704;

template <int BR>
__device__ __forceinline__ void attn_branch(const bf16_t* PROJ, LAS unsigned char* lds, const AttnCtx& C, f32x4 (&otot)[4], int tid) {
    const int lane = tid & 63, fr = lane & 15, fq = lane >> 4;
    float m_ = -1e30f, l_ = 0.f;
    f32x4 oa[4];
#pragma unroll
    for (int dt = 0; dt < 4; ++dt) oa[dt] = (f32x4){0.f, 0.f, 0.f, 0.f};
    const int jlo = (BR == 1) ? 0 : (C.cur > 8 ? C.cur - 8 : 0);
    const int koff = (BR == 1 ? 1536 : 2048) + C.g * 64, voff = (BR == 1 ? 1792 : 2304) + C.g * 64;
    const int key = tid >> 3, d0 = (tid & 7) * 8;
    const bf16_t* srcb = PROJ + ((size_t)C.b * SEQ + key) * 2816 + d0;
    int j = jlo;
    if (BR == 1) { while (j <= C.cur && !((C.anym >> j) & 1u)) ++j; }
    bf16x8 kreg = *(const bf16x8*)(srcb + (size_t)j * 64 * 2816 + koff), vreg = *(const bf16x8*)(srcb + (size_t)j * 64 * 2816 + voff);
    __syncthreads();
    int buf = 0;
    { *(LAS bf16x8*)(lds + A_OFF_K + (key * A_KS + d0) * 2) = kreg;
#pragma unroll
      for (int i = 0; i < 8; ++i) *(LAS bf16_t*)(lds + A_OFF_VT + ((d0 + i) * A_VS + key) * 2) = (bf16_t)vreg[i]; }
    __syncthreads();
    while (j <= C.cur) {
        int jn = j + 1;
        if (BR == 1) { while (jn <= C.cur && !((C.anym >> jn) & 1u)) ++jn; }
        const bool more = jn <= C.cur;
        if (more) { kreg = *(const bf16x8*)(srcb + (size_t)jn * 64 * 2816 + koff); vreg = *(const bf16x8*)(srcb + (size_t)jn * 64 * 2816 + voff); }
        const int kb = A_OFF_K + buf * A_KBYTES, vb = A_OFF_VT + buf * A_VBYTES;
        f32x4 s4[4]; float tmax = -1e30f;
#pragma unroll
        for (int kt = 0; kt < 4; ++kt) { f32x4 acc = (f32x4){0.f, 0.f, 0.f, 0.f};
#pragma unroll
            for (int ks = 0; ks < 2; ++ks) acc = MFMA16(lds_rd16(lds, kb + ((kt * 16 + fr) * A_KS + ks * 32 + fq * 8) * 2), C.qf[ks], acc);
#pragma unroll
            for (int jj = 0; jj < 4; ++jj) { const int pos = j * 64 + kt * 16 + fq * 4 + jj, dist = C.t - pos;
                const bool ok = (dist >= 0) && (BR == 1 ? (((C.selq >> j) & 1u) != 0u) : (dist < 512));
                const float s = ok ? acc[jj] * 0.125f - C.slope * (float)dist : -1e30f; s4[kt][jj] = s; tmax = fmaxf(tmax, s); } }
        tmax = fmaxf(tmax, __shfl_xor(tmax, 16)); tmax = fmaxf(tmax, __shfl_xor(tmax, 32));
        const float mnew = fmaxf(m_, tmax), alpha = __expf(m_ - mnew); m_ = mnew;
        float psum = 0.f;
#pragma unroll
        for (int kt = 0; kt < 4; ++kt)
#pragma unroll
            for (int jj = 0; jj < 4; ++jj) { const float pp = (s4[kt][jj] > -1e29f) ? __expf(s4[kt][jj] - mnew) : 0.f; s4[kt][jj] = pp; psum += pp; }
        l_ = l_ * alpha + psum;
#pragma unroll
        for (int dt = 0; dt < 4; ++dt) oa[dt] *= alpha;
#pragma unroll
        for (int ks2 = 0; ks2 < 2; ++ks2) { const bf16x8 pf = pack8(s4[2 * ks2], s4[2 * ks2 + 1]);
#pragma unroll
            for (int dt = 0; dt < 4; ++dt) oa[dt] = MFMA16(lds_rd8x2(lds, vb + ((dt * 16 + fr) * A_VS + ks2 * 32 + fq * 4) * 2), pf, oa[dt]); }
        if (more) { const int kb2 = A_OFF_K + (buf ^ 1) * A_KBYTES, vb2 = A_OFF_VT + (buf ^ 1) * A_VBYTES;
            *(LAS bf16x8*)(lds + kb2 + (key * A_KS + d0) * 2) = kreg;
#pragma unroll
            for (int i = 0; i < 8; ++i) *(LAS bf16_t*)(lds + vb2 + ((d0 + i) * A_VS + key) * 2) = (bf16_t)vreg[i]; }
        __syncthreads();
        buf ^= 1; j = jn;
    }
    float lt = l_; lt += __shfl_xor(lt, 16); lt += __shfl_xor(lt, 32); const float inv = lt > 0.f ? C.gate[BR] / lt : 0.f;
#pragma unroll
    for (int dt = 0; dt < 4; ++dt) otot[dt] += oa[dt] * inv;
}

__device__ __forceinline__ void phase_nsa_attn(const bf16_t* PROJ, const bf16_t* KCMP, const bf16_t* VCMP, bf16_t* OATT, LAS unsigned char* lds) {
    int tid = threadIdx.x; asm volatile("" : "+v"(tid));
    const int wid = __builtin_amdgcn_readfirstlane(tid >> 6), lane = tid & 63, fr = lane & 15, fq = lane >> 4;
    LAS float* IMP = (LAS float*)(lds + A_OFF_IMP); LAS unsigned* SEL = (LAS unsigned*)(lds + A_OFF_SEL); LAS unsigned* SELP = (LAS unsigned*)(lds + A_OFF_SELP);
    for (int id = blockIdx.x; id < 4096; id += gridDim.x) {
        const int k8 = id & 255, ii = id >> 8, bg = k8 & 63, kk = k8 >> 6;
        const int qt32 = (ii & 1) ? 63 - (kk + 4 * (ii - 1)) : kk + 4 * ii;
        AttnCtx C; C.cur = qt32 >> 1; C.b = bg >> 2; C.g = bg & 3; C.hp = wid >> 1; C.head = C.g * 4 + C.hp; C.slope = exp2f(-0.5f * (float)(C.head + 1));
        const int qq = (wid & 1) * 16 + fr; C.t = qt32 * 32 + qq; const size_t trow = (size_t)C.b * SEQ + C.t;
        { const bf16_t* pr = PROJ + trow * 2816;
#pragma unroll
          for (int ks = 0; ks < 2; ++ks) C.qf[ks] = *(const bf16x8*)(pr + C.head * 64 + ks * 32 + fq * 8);
#pragma unroll
          for (int br = 0; br < 3; ++br) C.gate[br] = 1.0f / (1.0f + __expf(-bf2f(pr[2560 + C.head * 3 + br]))); }
#ifdef ONLY_BR
#pragma unroll
        for (int br = 0; br < 3; ++br) if (br != ONLY_BR) C.gate[br] = 0.f;
#endif
        f32x4 otot[4];
#pragma unroll
        for (int dt = 0; dt < 4; ++dt) otot[dt] = (f32x4){0.f, 0.f, 0.f, 0.f};
        __syncthreads();
#pragma unroll
        for (int rep = 0; rep < 2; ++rep) { const int idx = tid + rep * NTHR, n = idx >> 3, d0 = (idx & 7) * 8, nc = n < 126 ? n : 126; const size_t src = ((size_t)(C.b * 127 + nc) * 4 + C.g) * 64 + d0;
            *(LAS bf16x8*)(lds + A_OFF_KC + (n * A_KCS + d0) * 2) = *(const bf16x8*)(KCMP + src);
            const bf16x8 vv = *(const bf16x8*)(VCMP + src);
#pragma unroll
            for (int i = 0; i < 8; ++i) *(LAS bf16_t*)(lds + A_OFF_VCT + ((d0 + i) * A_VCS + n) * 2) = (bf16_t)vv[i]; }
        __syncthreads();
        {
            f32x4 sc[8]; float mx = -1e30f;
#pragma unroll
            for (int kt = 0; kt < 8; ++kt) { f32x4 acc = (f32x4){0.f, 0.f, 0.f, 0.f};
#pragma unroll
                for (int ks = 0; ks < 2; ++ks) acc = MFMA16(lds_rd16(lds, A_OFF_KC + ((kt * 16 + fr) * A_KCS + ks * 32 + fq * 8) * 2), C.qf[ks], acc);
#pragma unroll
                for (int jj = 0; jj < 4; ++jj) { const int n = kt * 16 + fq * 4 + jj, ce = n * 16 + 31; const bool ok = (n <= 126) && (ce <= C.t);
                    const float s = ok ? acc[jj] * 0.125f - C.slope * (float)(C.t - ce) : -1e30f; sc[kt][jj] = s; mx = fmaxf(mx, s); } }
            mx = fmaxf(mx, __shfl_xor(mx, 16)); mx = fmaxf(mx, __shfl_xor(mx, 32));
            float sum = 0.f;
#pragma unroll
            for (int kt = 0; kt < 8; ++kt)
#pragma unroll
                for (int jj = 0; jj < 4; ++jj) { const float pp = (sc[kt][jj] > -1e29f) ? __expf(sc[kt][jj] - mx) : 0.f; sc[kt][jj] = pp; sum += pp; }
            sum += __shfl_xor(sum, 16); sum += __shfl_xor(sum, 32);
            const float inv = sum > 0.f ? 1.0f / sum : 0.f;
#pragma unroll
            for (int kt = 0; kt < 8; ++kt) sc[kt] *= inv;
#pragma unroll
            for (int kt = 0; kt < 8; ++kt) { const float a = __shfl(sc[kt][3], (lane + 48) & 63); const float bp = kt > 0 ? __shfl(sc[kt > 0 ? kt - 1 : 0][3], (lane + 48) & 63) : 0.f;
                const float prev3 = fq > 0 ? a : bp;
                IMP[(C.hp * 32 + qq) * 33 + 4 * kt + fq] = sc[kt][0] + sc[kt][1] + sc[kt][2] + 0.5f * sc[kt][3] + 0.5f * prev3; }
            f32x4 oc[4];
#pragma unroll
            for (int dt = 0; dt < 4; ++dt) oc[dt] = (f32x4){0.f, 0.f, 0.f, 0.f};
#pragma unroll
            for (int ks2 = 0; ks2 < 4; ++ks2) { const bf16x8 pf = pack8(sc[2 * ks2], sc[2 * ks2 + 1]);
#pragma unroll
                for (int dt = 0; dt < 4; ++dt) oc[dt] = MFMA16(lds_rd8x2(lds, A_OFF_VCT + ((dt * 16 + fr) * A_VCS + ks2 * 32 + fq * 4) * 2), pf, oc[dt]); }
#pragma unroll
            for (int dt = 0; dt < 4; ++dt) otot[dt] += oc[dt] * C.gate[0];
        }
        __syncthreads();
        if (C.cur >= 16) {
            const int sq = tid & 31, jg = tid >> 5;
#pragma unroll
            for (int jj = 0; jj < 2; ++jj) { const int j = jg * 2 + jj; const float imp = IMP[(0 * 32 + sq) * 33 + j] + IMP[(1 * 32 + sq) * 33 + j] + IMP[(2 * 32 + sq) * 33 + j] + IMP[(3 * 32 + sq) * 33 + j];
                const bool valid = j <= C.cur, forced = (j == 0) || (j == C.cur) || (j == C.cur - 1);
                IMP[sq * 33 + j] = valid ? (forced ? 1e4f : imp) : -1.0f; }
            __syncthreads();
            unsigned bits = 0u;
#pragma unroll
            for (int jj = 0; jj < 2; ++jj) { const int j = jg * 2 + jj; const float sj = IMP[sq * 33 + j]; int cnt = 0;
                for (int j2 = 0; j2 < 32; ++j2) { const float s2 = IMP[sq * 33 + j2]; cnt += ((s2 > sj) || (s2 == sj && j2 < j)) ? 1 : 0; }
                if (cnt < 16) bits |= 1u << j; }
            SELP[jg * 32 + sq] = bits;
            __syncthreads();
            if (tid < 32) { unsigned m = 0u;
#pragma unroll
                for (int q = 0; q < 16; ++q) m |= SELP[q * 32 + tid];
                SEL[tid] = m; }
        } else { if (tid < 32) SEL[tid] = (2u << C.cur) - 1u; }
        __syncthreads();
        C.selq = SEL[qq];
        { unsigned m = SEL[lane & 31]; m |= __shfl_xor(m, 16); m |= __shfl_xor(m, 8); m |= __shfl_xor(m, 4); m |= __shfl_xor(m, 2); m |= __shfl_xor(m, 1); C.anym = (unsigned)__builtin_amdgcn_readfirstlane((int)m); }
        attn_branch<1>(PROJ, lds, C, otot, tid);
        attn_branch<2>(PROJ, lds, C, otot, tid);
#pragma unroll
        for (int dt = 0; dt < 4; ++dt) *(u32x2*)(OATT + trow * 1024 + C.head * 64 + dt * 16 + fq * 4) = pack4(otot[dt]);
    }
}

__device__ __forceinline__ void grid_barrier(unsigned* bar, unsigned& epoch) {
    asm volatile("s_waitcnt vmcnt(0)" ::: "memory");
    __syncthreads();
    epoch += gridDim.x;
    if (threadIdx.x == 0) {
        __builtin_amdgcn_fence(__ATOMIC_RELEASE, "agent");
        asm volatile("s_waitcnt vmcnt(0)" ::: "memory");
        __hip_atomic_fetch_add(bar, 1u, __ATOMIC_RELAXED, __HIP_MEMORY_SCOPE_AGENT);
        while (__hip_atomic_load(bar, __ATOMIC_RELAXED, __HIP_MEMORY_SCOPE_AGENT) < epoch) __builtin_amdgcn_s_sleep(1);
        __builtin_amdgcn_fence(__ATOMIC_ACQUIRE, "agent");
        asm volatile("s_waitcnt vmcnt(0)" ::: "memory");
    }
    __syncthreads();
}
#ifndef R_CORE
#define R_CORE 1
#endif
#ifndef R_ATTN
#define R_ATTN 1
#endif
#ifndef R_GEMM
#define R_GEMM 1
#endif
#ifndef R_BAR
#define R_BAR 1
#endif
struct GemmDesc { const bf16_t* A; const bf16_t* Bt; bf16_t* O; int M, N, K, ldc, act, cshift; };
__device__ __forceinline__ void run_gemm(const GemmDesc& d, LAS unsigned char* lds) {
    pg8::Gemm g{d.A, d.Bt, d.M, d.N, d.K}; pg8::StaticOrder S; const int G = (int)gridDim.x; S.init(d.M, d.N, G, ((int)blockIdx.x + G - d.cshift % G) % G);
    if (d.act == 0) { pg8::Epi<0> E{d.O, d.ldc}; pg8::gemm_phase<pg8::Epi<0>, pg8::StaticOrder>(lds, g, S, E); }
    else if (d.act == 1) { pg8::Epi<1> E{d.O, d.ldc}; pg8::gemm_phase<pg8::Epi<1>, pg8::StaticOrder>(lds, g, S, E); }
    else { pg8::Epi<2> E{d.O, d.ldc}; pg8::gemm_phase<pg8::Epi<2>, pg8::StaticOrder>(lds, g, S, E); }
}

__global__ void __launch_bounds__(NTHR) fwd_megakernel(Params p) {
    extern __shared__ __attribute__((aligned(16))) unsigned char smem[];
    LAS unsigned char* lds = (LAS unsigned char*)smem;
    cg::grid_group grid = cg::this_grid();
    unsigned char* ws = p.ws; unsigned char* U = ws + OFF_U2;
    const float* mod = (const float*)(ws + OFF_MOD); bf16_t* H = (bf16_t*)(ws + OFF_H);
    unsigned* bar = (unsigned*)(ws + WS_END); unsigned epoch = 0u;
    grid.sync();

#ifdef PREFILL
    { const u32x4 pz = (u32x4){0xAAAAAAAAu, 0xAAAAAAAAu, 0xAAAAAAAAu, 0xAAAAAAAAu}; for (size_t i = (size_t)blockIdx.x * NTHR + threadIdx.x; i < WS_END / 16; i += (size_t)gridDim.x * NTHR) ((u32x4*)ws)[i] = pz; }
    grid_barrier(bar, epoch);
#endif
    phase_prep(p, lds);
    grid_barrier(bar, epoch);
    phase_init(p);
    grid_barrier(bar, epoch);

    for (int layer = 0; layer < DEPTH; ++layer) {
        const int jm = layer >> 1; const bool is_ret = (layer & 1) == 0;
        const float* modL = mod + (size_t)layer * 16 * MODW;
        for (int st = 0; st < 13; ++st) {
            GemmDesc d[2]; int ng = 0;
            d[0].cshift = 0; d[1].cshift = 0;
            if (st == 0 || st == 10) {
                const int s = st == 0 ? 0 : 1;
                d[0] = GemmDesc{H, (const bf16_t*)(ws + OFF_FFN_IN + (size_t)(layer * 2 + s) * SZ_FFN_IN), (bf16_t*)(U + U_FFN_ACT), MTOK, 5632, 1024, DFF, 1, 0}; ng = 1;
            } else if (st == 1 || st == 11) {
                const int s = st == 1 ? 0 : 1;
                d[0] = GemmDesc{(const bf16_t*)(U + U_FFN_ACT), (const bf16_t*)(ws + OFF_FFN_OUT + (size_t)(layer * 2 + s) * SZ_FFN_OUT), (bf16_t*)(U + U_FFN_Y), MTOK, 1024, DFF, 1024, 0, 0}; ng = 1;
            } else if (st == 2 || st == 9 || st == 12) {
                const int sub = st == 2 ? 0 : (st == 9 ? 1 : 2);
                const bf16_t* y = (const bf16_t*)(U + (sub == 1 ? (is_ret ? U_RET_Y : U_NSA_Y) : U_FFN_Y));
                const float* modN = (sub == 2) ? (layer + 1 < DEPTH ? modL + (size_t)16 * MODW : modL) : modL;
                const int shc = (sub == 2) ? 0 : (sub + 1) * 3;
                phase_ln(p.out, y, modL + (sub * 3 + 2) * 1024, sub == 1 ? 1.0f : 0.5f, p.ln_g + (size_t)(layer * 3 + sub) * 1024, p.ln_b + (size_t)(layer * 3 + sub) * 1024,
                         modN + shc * 1024, modN + (shc + 1) * 1024, H);
            } else if (is_ret) {
                const bf16_t* Wi = (const bf16_t*)(ws + OFF_RET_IN + (size_t)jm * SZ_RET_IN);
                if (st == 3) { d[0] = GemmDesc{H, Wi, (bf16_t*)(U + U_RET_QKV), MTOK, 4096, 1024, 4096, 0, 0}; ng = 1; }
                else if (st == 4) { for (int rr = 0; rr < R_CORE; ++rr) phase_ret_core((const bf16_t*)(U + U_RET_QKV), (bf16_t*)(U + U_RET_O), lds); }
                else if (st == 5) { d[0] = GemmDesc{H, Wi + (size_t)4096 * 1024, (bf16_t*)(U + U_RET_G), MTOK, 2048, 1024, 2048, 0, 0}; ng = 1; }
                else if (st == 6) phase_ret_gate((bf16_t*)(U + U_RET_O), (const bf16_t*)(U + U_RET_G));
                else if (st == 7) { d[0] = GemmDesc{(const bf16_t*)(U + U_RET_O), (const bf16_t*)(ws + OFF_RET_OUT + (size_t)jm * SZ_RET_OUT), (bf16_t*)(U + U_RET_Y), MTOK, 1024, 2048, 1024, 0, 0}; ng = 1; }
                else continue;
            } else {
                if (st == 3) { d[0] = GemmDesc{H, (const bf16_t*)(ws + OFF_NSA_IN + (size_t)jm * SZ_NSA_IN), (bf16_t*)(U + U_NSA_PROJ), MTOK, 2816, 1024, 2816, 0, 0}; ng = 1; }
                else if (st == 4) phase_nsa_mat((const bf16_t*)(U + U_NSA_PROJ), p.pe_k + (size_t)jm * 2048, p.pe_v + (size_t)jm * 2048, (bf16_t*)(U + U_NSA_ACMPK), (bf16_t*)(U + U_NSA_ACMPV));
                else if (st == 5) {
                    d[0] = GemmDesc{(const bf16_t*)(U + U_NSA_ACMPK), (const bf16_t*)(ws + OFF_W1 + (size_t)(0 * 2 + jm) * SZ_W1), (bf16_t*)(U + U_NSA_HK), 8192, 256, 2048, 256, 2, 0};
                    d[1] = GemmDesc{(const bf16_t*)(U + U_NSA_ACMPV), (const bf16_t*)(ws + OFF_W1 + (size_t)(1 * 2 + jm) * SZ_W1), (bf16_t*)(U + U_NSA_HV), 8192, 256, 2048, 256, 2, 32}; ng = 2;
                } else if (st == 6) phase_nsa_cmp2((const bf16_t*)(U + U_NSA_HK), (const bf16_t*)(U + U_NSA_HV), (const bf16_t*)(ws + OFF_W2 + (size_t)(0 * 2 + jm) * SZ_W2), (const bf16_t*)(ws + OFF_W2 + (size_t)(1 * 2 + jm) * SZ_W2),
                                               (bf16_t*)(U + U_NSA_KCMP), (bf16_t*)(U + U_NSA_VCMP));
                else if (st == 7) { for (int rr = 0; rr < R_ATTN; ++rr) phase_nsa_attn((const bf16_t*)(U + U_NSA_PROJ), (const bf16_t*)(U + U_NSA_KCMP), (const bf16_t*)(U + U_NSA_VCMP), (bf16_t*)(U + U_NSA_OATT), lds); }
                else { d[0] = GemmDesc{(const bf16_t*)(U + U_NSA_OATT), (const bf16_t*)(ws + OFF_NSA_OUT + (size_t)jm * SZ_NSA_OUT), (bf16_t*)(U + U_NSA_Y), MTOK, 1024, 1024, 1024, 0, 0}; ng = 1; }
            }
            for (int rr = 0; rr < R_GEMM; ++rr) for (int r = 0; r < ng; ++r) { GemmDesc dd = d[0]; if (r == 1) dd = d[1]; run_gemm(dd, lds); }
            for (int rr = 0; rr < R_BAR; ++rr) grid_barrier(bar, epoch);
#ifdef STOP_L
            if (layer == STOP_L && st == STOP_S) return;
#endif
        }
    }
}

extern "C" void kernel_launch(void* const* d_in, const int* in_sizes, int n_in, void* d_out, int out_size, void* d_ws, size_t ws_size, hipStream_t stream) {
    static int grid_blocks = 0;
    if (grid_blocks == 0) {
        int dev = 0, cus = 0, per_cu = 0;
        hipGetDevice(&dev); hipDeviceGetAttribute(&cus, hipDeviceAttributeMultiprocessorCount, dev);
        if (hipFuncSetAttribute((const void*)fwd_megakernel, hipFuncAttributeMaxDynamicSharedMemorySize, LDS_BYTES) != hipSuccess) fprintf(stderr, "hipFuncSetAttribute failed\n");
        if (hipOccupancyMaxActiveBlocksPerMultiprocessor(&per_cu, (const void*)fwd_megakernel, NTHR, LDS_BYTES) != hipSuccess || per_cu < 1) { fprintf(stderr, "occupancy query: %d\n", per_cu); per_cu = 1; }
        (void)hipGetLastError();
        grid_blocks = cus * 1;
        if (ws_size < WS_END + 256) fprintf(stderr, "workspace too small: %zu < %zu\n", ws_size, (size_t)WS_END);
    }
    Params p{};
    p.x = (const float*)d_in[0]; p.c = (const float*)d_in[1]; p.ada_w = (const float*)d_in[2]; p.ada_b = (const float*)d_in[3]; p.ln_g = (const float*)d_in[4]; p.ln_b = (const float*)d_in[5];
    p.pe_k = (const float*)d_in[12]; p.pe_v = (const float*)d_in[13]; p.out = (float*)d_out; p.ws = (unsigned char*)d_ws;
    unsigned char* ws = (unsigned char*)d_ws; int nj = 0, te = 0;
    auto add = [&](const float* src, size_t dst_off, int K, int N, int Np, int mode) { p.jobs[nj] = WJob{src, (bf16_t*)(ws + dst_off), K, N, Np, mode}; te += (Np / 64) * (K / 64); p.tile_end[nj] = te; ++nj; };
    const float* ffn_in = (const float*)d_in[6]; const float* ffn_out = (const float*)d_in[7]; const float* ret_in = (const float*)d_in[8]; const float* ret_out = (const float*)d_in[9];
    const float* nsa_in = (const float*)d_in[10]; const float* nsa_out = (const float*)d_in[11];
    const float* ck1 = (const float*)d_in[14]; const float* ck2 = (const float*)d_in[15]; const float* cv1 = (const float*)d_in[16]; const float* cv2 = (const float*)d_in[17];
    for (int i = 0; i < 8; ++i) add(ffn_in + (size_t)i * 1024 * 5632, OFF_FFN_IN + i * SZ_FFN_IN, 1024, 5632, 5632, 1);
    for (int i = 0; i < 8; ++i) add(ffn_out + (size_t)i * 2816 * 1024, OFF_FFN_OUT + i * SZ_FFN_OUT, 2816, 1024, 1024, 0);
    for (int i = 0; i < 2; ++i) add(ret_in + (size_t)i * 1024 * 6144, OFF_RET_IN + i * SZ_RET_IN, 1024, 6144, 6144, 0);
    for (int i = 0; i < 2; ++i) add(ret_out + (size_t)i * 2048 * 1024, OFF_RET_OUT + i * SZ_RET_OUT, 2048, 1024, 1024, 0);
    for (int i = 0; i < 2; ++i) add(nsa_in + (size_t)i * 1024 * 2608, OFF_NSA_IN + i * SZ_NSA_IN, 1024, 2608, 2816, 0);
    for (int i = 0; i < 2; ++i) add(nsa_out + (size_t)i * 1024 * 1024, OFF_NSA_OUT + i * SZ_NSA_OUT, 1024, 1024, 1024, 0);
    for (int i = 0; i < 2; ++i) add(ck1 + (size_t)i * 2048 * 256, OFF_W1 + (0 * 2 + i) * SZ_W1, 2048, 256, 256, 0);
    for (int i = 0; i < 2; ++i) add(cv1 + (size_t)i * 2048 * 256, OFF_W1 + (1 * 2 + i) * SZ_W1, 2048, 256, 256, 0);
    for (int i = 0; i < 2; ++i) add(ck2 + (size_t)i * 256 * 64, OFF_W2 + (0 * 2 + i) * SZ_W2, 256, 64, 64, 0);
    for (int i = 0; i < 2; ++i) add(cv2 + (size_t)i * 256 * 64, OFF_W2 + (1 * 2 + i) * SZ_W2, 256, 64, 64, 0);
    p.njobs = nj;
    if (hipMemsetAsync(ws + WS_END, 0, 256, stream) != hipSuccess) fprintf(stderr, "barrier memset failed\n");
    void* args[] = {&p};
    hipError_t e = hipLaunchCooperativeKernel((const void*)fwd_megakernel, dim3(grid_blocks), dim3(NTHR), args, LDS_BYTES, stream);
    if (e != hipSuccess) fprintf(stderr, "cooperative launch failed: %s (grid %d)\n", hipGetErrorString(e), grid_blocks);
}
```

```cpp
#include <hip/hip_runtime.h>
#include <hip/hip_cooperative_groups.h>
#include <cstdio>
namespace cg = cooperative_groups;

namespace pg8 {
#define PG8_LAS __attribute__((address_space(3)))
typedef unsigned short bf16_t;
typedef short bf16x8 __attribute__((ext_vector_type(8)));
typedef float f32x4 __attribute__((ext_vector_type(4)));
typedef unsigned u32x4 __attribute__((ext_vector_type(4)));
constexpr int BM = 256, BK = 64, HALF = 128, HTB = HALF * BK * 2  , STAGE_BYTES = 8 * HTB, NXCD = 8, WGM = 8;

__host__ __device__ __forceinline__ int lds_byte(int r, int c) { const int st = (r >> 4) * 2 + (c >> 5), rr = r & 15, cc = c & 31, ob = rr * 64 + cc * 2; return st * 1024 + (ob ^ (((ob >> 9) & 1) << 5)); }
__host__ __device__ __forceinline__ void stage_rc(int b, int& R, int& C) { const int st = b / 1024, sb = b % 1024, swz = sb ^ (((sb >> 9) & 1) << 5); R = (st >> 1) * 16 + swz / 64; C = (st & 1) * 32 + (swz % 64) / 2; }
__host__ __device__ __forceinline__ int perm32(int rho) { const int n = rho >> 4, i = rho & 15; return 8 * (i >> 2) + 4 * n + (i & 3); }

struct Unit { int pm, pn; };
struct Gemm { const bf16_t* A; const bf16_t* Bt; int M, N, K; };

struct StaticOrder {
    int nM, nN, nwg, G, c;
    __host__ __device__ void init(int M, int N, int G_, int c_) { nM = M / BM; nN = N / BM; nwg = nM * nN; G = G_; c = c_; }
    __host__ __device__ bool next(int i, Unit& u) const {
        const long L = (long)i * G + c; if (L >= nwg) return false;
        int wgid = (int)L; { const int q = nwg / NXCD, r = nwg % NXCD, xcd = wgid % NXCD, off = wgid / NXCD; wgid = (xcd < r ? xcd * (q + 1) : r * (q + 1) + (xcd - r) * q) + off; }
        const int nig = WGM * nN, gid = wgid / nig, fm = gid * WGM, gsz = (nM - fm) < WGM ? (nM - fm) : WGM;
        u.pm = fm + ((wgid % nig) % gsz); u.pn = (wgid % nig) / gsz; return true;
    }
    __device__ __forceinline__ void a_ready(const Unit&) const {}
    __device__ __forceinline__ void done(const Unit&) const {}
};

typedef float f32x2_t __attribute__((ext_vector_type(2)));
typedef __bf16 bf16x2_t __attribute__((ext_vector_type(2)));
__device__ __forceinline__ unsigned cvt_pk_bf16(float lo, float hi) { const f32x2_t v = {lo, hi}; return __builtin_bit_cast(unsigned, __builtin_convertvector(v, bf16x2_t)); }
__device__ __forceinline__ float silu_f(float a) { return a / (1.0f + __expf(-a)); }
__device__ __forceinline__ float gelu_tanh_f(float x) { const float u = 0.7978845608028654f * (x + 0.044715f * x * x * x); const float t = 1.0f - 2.0f / (1.0f + __expf(2.0f * u)); return 0.5f * x * (1.0f + t); }

template <int ACT> struct Epi {
    static constexpr bool PERM = true, AFTER_DRAIN = false;
    bf16_t* O; int ldc;
    __device__ __forceinline__ void operator()(const f32x4 (&acc)[2][2][4][2], const Unit& u, int wr, int wc, int fr, int fq) const {
        const int row0 = u.pm * BM + wr * 64 + fr;
        if (ACT == 1) {
            const int col0 = u.pn * HALF + wc * 32 + 8 * fq;
#pragma unroll
            for (int ai = 0; ai < 2; ++ai)
#pragma unroll
                for (int m = 0; m < 4; ++m) { bf16_t* rowp = O + (size_t)(row0 + ai * HALF + m * 16) * ldc + col0;
                    const f32x4 a0 = acc[ai][0][m][0], a1 = acc[ai][0][m][1], u0 = acc[ai][1][m][0], u1 = acc[ai][1][m][1];
                    u32x4 w; w.x = cvt_pk_bf16(silu_f(a0[0]) * u0[0], silu_f(a0[1]) * u0[1]); w.y = cvt_pk_bf16(silu_f(a0[2]) * u0[2], silu_f(a0[3]) * u0[3]);
                    w.z = cvt_pk_bf16(silu_f(a1[0]) * u1[0], silu_f(a1[1]) * u1[1]); w.w = cvt_pk_bf16(silu_f(a1[2]) * u1[2], silu_f(a1[3]) * u1[3]);
                    *(u32x4*)rowp = w; }
        } else {
            const int col0 = u.pn * BM + wc * 32 + 8 * fq;
#pragma unroll
            for (int ai = 0; ai < 2; ++ai)
#pragma unroll
                for (int m = 0; m < 4; ++m) { bf16_t* rowp = O + (size_t)(row0 + ai * HALF + m * 16) * ldc + col0;
#pragma unroll
                    for (int bj = 0; bj < 2; ++bj) { f32x4 v0 = acc[ai][bj][m][0], v1 = acc[ai][bj][m][1];
                        if (ACT == 2) {
#pragma unroll
                            for (int j = 0; j < 4; ++j) { v0[j] = gelu_tanh_f(v0[j]); v1[j] = gelu_tanh_f(v1[j]); } }
                        u32x4 w; w.x = cvt_pk_bf16(v0[0], v0[1]); w.y = cvt_pk_bf16(v0[2], v0[3]); w.z = cvt_pk_bf16(v1[0], v1[1]); w.w = cvt_pk_bf16(v1[2], v1[3]);
                        *(u32x4*)(rowp + bj * HALF) = w; } }
        }
    }
};

template <class Epi, class Sched>
__device__ __forceinline__ void gemm_phase(PG8_LAS unsigned char* lds, const Gemm g, const Sched& S, const Epi& E) {
    const int tid = threadIdx.x, wid = __builtin_amdgcn_readfirstlane(tid >> 6), lane = tid & 63, wr = wid >> 2, wc = wid & 3, fr = lane & 15, fq = lane >> 4;
    const int K = g.K, nt = K / BK;
    unsigned voffA[2], voffB[2];
#pragma unroll
    for (int i = 0; i < 2; ++i) { int R, C; stage_rc(tid * 16 + i * 8192, R, C); const int Rb = Epi::PERM ? ((R & ~31) + perm32(R & 31)) : R;
        voffA[i] = (unsigned)(R * K + C) * 2u; voffB[i] = (unsigned)(Rb * K + C) * 2u; }
    const size_t kstep = (size_t)(BK * 2);
    const size_t hstep = (size_t)HALF * K * 2;
    const size_t tstep = 2 * hstep;
    const unsigned ldsw = (unsigned)wid * 1024u;
    const int aoff = lds_byte(wr * 64 + fr, fq * 8), boff = lds_byte(wc * 32 + fr, fq * 8);
#define PG8_SA(b, h) (((b) * 2 + (h)) * HTB)
#define PG8_SB(b, h) ((4 + (b) * 2 + (h)) * HTB)
#define PG8_STAGE(bufoff, gbase, voff) do { _Pragma("unroll") for (int _i = 0; _i < 2; ++_i) \
        __builtin_amdgcn_global_load_lds((const unsigned*)((const char*)(gbase) + (voff)[_i]), (PG8_LAS unsigned*)(lds + (bufoff) + ldsw + _i * 8192), 16, 0, 0); } while (0)
#define PG8_LDA(dst, b, h) do { _Pragma("unroll") for (int m = 0; m < 4; ++m) _Pragma("unroll") for (int k = 0; k < 2; ++k) dst[m][k] = *(const PG8_LAS bf16x8*)(lds + PG8_SA(b, h) + aoff + m * 2048 + k * 1024); } while (0)
#define PG8_LDB(dst, b, h) do { _Pragma("unroll") for (int n = 0; n < 2; ++n) _Pragma("unroll") for (int k = 0; k < 2; ++k) dst[n][k] = *(const PG8_LAS bf16x8*)(lds + PG8_SB(b, h) + boff + n * 2048 + k * 1024); } while (0)
#define PG8_MMA(ai, bj, At, Bt) do { __builtin_amdgcn_s_setprio(1); _Pragma("unroll") for (int m = 0; m < 4; ++m) _Pragma("unroll") for (int n = 0; n < 2; ++n) _Pragma("unroll") for (int k = 0; k < 2; ++k) \
        acc[ai][bj][m][n] = __builtin_amdgcn_mfma_f32_16x16x32_bf16(Bt[n][k], At[m][k], acc[ai][bj][m][n], 0, 0, 0); __builtin_amdgcn_s_setprio(0); } while (0)
#define PG8_WAIT_V(n) asm volatile("s_waitcnt vmcnt(" #n ")" ::: "memory")
#define PG8_WAIT_L(n) asm volatile("s_waitcnt lgkmcnt(" #n ")" ::: "memory")
#define PG8_BAR __builtin_amdgcn_s_barrier()
#define PG8_SCHED __builtin_amdgcn_sched_barrier(0)
    Unit cur, nxt; int ui = 0;
    if (!S.next(0, cur)) return;
    f32x4 acc[2][2][4][2];
#pragma unroll
    for (int a = 0; a < 2; ++a)
#pragma unroll
        for (int b = 0; b < 2; ++b)
#pragma unroll
            for (int m = 0; m < 4; ++m)
#pragma unroll
                for (int n = 0; n < 2; ++n) acc[a][b][m][n] = (f32x4){0.f, 0.f, 0.f, 0.f};
    bf16x8 At[4][2], B0[2][2], B1[2][2];
    const char* cA = (const char*)g.A + (size_t)cur.pm * tstep; const char* cB = (const char*)g.Bt + (size_t)cur.pn * tstep;
    S.a_ready(cur);
    PG8_STAGE(PG8_SB(0, 0), cB, voffB); PG8_STAGE(PG8_SA(0, 0), cA, voffA); PG8_STAGE(PG8_SB(0, 1), cB + hstep, voffB); PG8_STAGE(PG8_SA(0, 1), cA + hstep, voffA);
    if (wr == 1) PG8_BAR;
    PG8_WAIT_V(4); PG8_BAR;
    PG8_STAGE(PG8_SB(1, 0), cB + kstep, voffB); PG8_STAGE(PG8_SA(1, 0), cA + kstep, voffA); PG8_STAGE(PG8_SB(1, 1), cB + hstep + kstep, voffB);
    PG8_WAIT_V(6); PG8_BAR;
    for (;;) {
        const bool has_next = S.next(ui + 1, nxt);
        const char* nA = has_next ? (const char*)g.A + (size_t)nxt.pm * tstep : cA; const char* nB = has_next ? (const char*)g.Bt + (size_t)nxt.pn * tstep : cB;
        for (int t = 0; t < nt; t += 2) {
            const bool last = (t == nt - 2);
            const char* a1 = cA + (size_t)(t + 1) * kstep;
            const char* a2 = last ? nA : cA + (size_t)(t + 2) * kstep; const char* b2 = last ? nB : cB + (size_t)(t + 2) * kstep;
            const char* a3 = a2 + kstep; const char* b3 = b2 + kstep;
            if (last && has_next) S.a_ready(nxt);
            PG8_LDB(B0, 0, 0); PG8_SCHED; PG8_LDA(At, 0, 0); PG8_STAGE(PG8_SA(1, 1), a1 + hstep, voffA);
            PG8_WAIT_L(8); PG8_BAR; PG8_WAIT_L(0); PG8_MMA(0, 0, At, B0); PG8_BAR; PG8_SCHED;
            PG8_LDB(B1, 0, 1); PG8_STAGE(PG8_SB(0, 0), b2, voffB);
            PG8_BAR; PG8_WAIT_L(0); PG8_MMA(0, 1, At, B1); PG8_BAR;
            PG8_LDA(At, 0, 1); PG8_STAGE(PG8_SA(0, 0), a2, voffA);
            PG8_BAR; PG8_WAIT_L(0); PG8_MMA(1, 0, At, B0); PG8_BAR; PG8_SCHED;
            PG8_STAGE(PG8_SB(0, 1), b2 + hstep, voffB);
            PG8_WAIT_V(6); PG8_BAR; PG8_MMA(1, 1, At, B1); PG8_BAR;
            PG8_LDB(B0, 1, 0); PG8_SCHED; PG8_LDA(At, 1, 0); PG8_STAGE(PG8_SA(0, 1), a2 + hstep, voffA);
            PG8_WAIT_L(8); PG8_BAR; PG8_WAIT_L(0); PG8_MMA(0, 0, At, B0); PG8_BAR; PG8_SCHED;
            PG8_LDB(B1, 1, 1); PG8_STAGE(PG8_SB(1, 0), b3, voffB);
            PG8_BAR; PG8_WAIT_L(0); PG8_MMA(0, 1, At, B1); PG8_BAR;
            PG8_LDA(At, 1, 1); PG8_STAGE(PG8_SA(1, 0), a3, voffA);
            PG8_BAR; PG8_WAIT_L(0); PG8_MMA(1, 0, At, B0); PG8_BAR; PG8_SCHED;
            PG8_STAGE(PG8_SB(1, 1), b3 + hstep, voffB);
            PG8_WAIT_V(6); PG8_BAR; PG8_MMA(1, 1, At, B1); PG8_BAR;
        }
        if constexpr (!Epi::AFTER_DRAIN) { E(acc, cur, wr, wc, fr, fq); S.done(cur); }
        if (!has_next) break;
#pragma unroll
        for (int a = 0; a < 2; ++a)
#pragma unroll
            for (int b = 0; b < 2; ++b)
#pragma unroll
                for (int m = 0; m < 4; ++m)
#pragma unroll
                    for (int n = 0; n < 2; ++n) acc[a][b][m][n] = (f32x4){0.f, 0.f, 0.f, 0.f};
        cur = nxt; cA = nA; cB = nB; ++ui;
    }
    PG8_WAIT_V(0);
    if (wr == 0) PG8_BAR;
    PG8_BAR;
    if constexpr (Epi::AFTER_DRAIN) { E.fused(acc, cur, wr, wc, fr, fq, lds, wid, lane); S.done(cur); }
#undef PG8_SA
#undef PG8_SB
#undef PG8_STAGE
#undef PG8_LDA
#undef PG8_LDB
#undef PG8_MMA
#undef PG8_WAIT_V
#undef PG8_WAIT_L
#undef PG8_BAR
#undef PG8_SCHED
}
}

using pg8::bf16_t; using pg8::bf16x8; using pg8::f32x4; using pg8::u32x4; using pg8::cvt_pk_bf16; using pg8::silu_f;
#define LAS __attribute__((address_space(3)))
typedef unsigned u32x2 __attribute__((ext_vector_type(2)));
typedef short s16x4 __attribute__((ext_vector_type(4)));
#define MFMA16(a, b, c) __builtin_amdgcn_mfma_f32_16x16x32_bf16((a), (b), (c), 0, 0, 0)

constexpr int NTHR = 512;
constexpr int MTOK = 32768, DM = 1024, SEQ = 2048, DFF = 2816, DEPTH = 4, MODW = 9216;
constexpr float DN_ALPHA = 1.6817928305074290861f;
constexpr size_t MiB = (size_t)1 << 20;
constexpr size_t SZ_FFN_IN = (size_t)5632 * 1024 * 2, SZ_FFN_OUT = (size_t)1024 * 2816 * 2, SZ_RET_IN = (size_t)6144 * 1024 * 2, SZ_RET_OUT = (size_t)1024 * 2048 * 2,
                 SZ_NSA_IN = (size_t)2816 * 1024 * 2, SZ_NSA_OUT = (size_t)1024 * 1024 * 2, SZ_W1 = (size_t)256 * 2048 * 2, SZ_W2 = (size_t)64 * 256 * 2;
constexpr size_t OFF_FFN_IN = 0, OFF_FFN_OUT = OFF_FFN_IN + 8 * SZ_FFN_IN, OFF_RET_IN = OFF_FFN_OUT + 8 * SZ_FFN_OUT, OFF_RET_OUT = OFF_RET_IN + 2 * SZ_RET_IN,
                 OFF_NSA_IN = OFF_RET_OUT + 2 * SZ_RET_OUT, OFF_NSA_OUT = OFF_NSA_IN + 2 * SZ_NSA_IN, OFF_W1 = OFF_NSA_OUT + 2 * SZ_NSA_OUT, OFF_W2 = OFF_W1 + 4 * SZ_W1,
                 OFF_MOD = OFF_W2 + 4 * SZ_W2, OFF_H = OFF_MOD + (size_t)DEPTH * 16 * MODW * 4, OFF_U2 = OFF_H + (size_t)MTOK * DM * 2, WS_END = OFF_U2 + 384 * MiB;
constexpr size_t U_FFN_ACT = 0, U_FFN_Y = 192 * MiB;
constexpr size_t U_RET_QKV = 0, U_RET_G = 0, U_RET_O = 256 * MiB, U_RET_Y = 128 * MiB;
constexpr size_t U_NSA_PROJ = 0, U_NSA_Y = 192 * MiB, U_NSA_ACMPK = 256 * MiB, U_NSA_ACMPV = 288 * MiB, U_NSA_HK = 320 * MiB, U_NSA_HV = 324 * MiB, U_NSA_KCMP = 328 * MiB, U_NSA_VCMP = 329 * MiB, U_NSA_OATT = 256 * MiB;
constexpr int LDS_BYTES = 152 * 1024;

struct WJob { const float* src; bf16_t* dst; int K, N, Np, mode; };
struct Params {
    const float* x; const float* c; const float* ada_w; const float* ada_b; const float* ln_g; const float* ln_b; const float* pe_k; const float* pe_v;
    float* out; unsigned char* ws;
    WJob jobs[32]; int tile_end[32]; int njobs; int pad;
};

__device__ __forceinline__ float bf2f(unsigned short b) { return __uint_as_float(((unsigned)b) << 16); }
__device__ __forceinline__ float bflo(unsigned w) { return __uint_as_float(w << 16); }
__device__ __forceinline__ float bfhi(unsigned w) { return __uint_as_float(w & 0xffff0000u); }
__device__ __forceinline__ unsigned short f2bf(float f) { return (unsigned short)(cvt_pk_bf16(f, 0.f) & 0xffffu); }
__device__ __forceinline__ bf16x8 pack8(const f32x4& a, const f32x4& b) { u32x4 w; w.x = cvt_pk_bf16(a[0], a[1]); w.y = cvt_pk_bf16(a[2], a[3]); w.z = cvt_pk_bf16(b[0], b[1]); w.w = cvt_pk_bf16(b[2], b[3]); return __builtin_bit_cast(bf16x8, w); }
__device__ __forceinline__ u32x2 pack4(const f32x4& a) { u32x2 w; w.x = cvt_pk_bf16(a[0], a[1]); w.y = cvt_pk_bf16(a[2], a[3]); return w; }
__device__ __forceinline__ bf16x8 lds_rd16(LAS unsigned char* lds, int off) { return *(const LAS bf16x8*)(lds + off); }
__device__ __forceinline__ bf16x8 lds_rd8x2(LAS unsigned char* lds, int off) { const s16x4 lo = *(const LAS s16x4*)(lds + off), hi = *(const LAS s16x4*)(lds + off + 32); return __builtin_shufflevector(lo, hi, 0, 1, 2, 3, 4, 5, 6, 7); }
template <int M> __device__ __forceinline__ float shx(float v, int lane) {
    if (M < 32) return __int_as_float(__builtin_amdgcn_ds_swizzle(__float_as_int(v), (M << 10) | 0x1f));
    return __int_as_float(__builtin_amdgcn_ds_bpermute((lane ^ M) << 2, __float_as_int(v)));
}
template <int M> __device__ __forceinline__ unsigned shxu(unsigned v, int lane) {
    if (M < 32) return (unsigned)__builtin_amdgcn_ds_swizzle((int)v, (M << 10) | 0x1f);
    return (unsigned)__builtin_amdgcn_ds_bpermute((lane ^ M) << 2, (int)v);
}
__device__ __forceinline__ float shi(float v, int src_lane) { return __int_as_float(__builtin_amdgcn_ds_bpermute(src_lane << 2, __float_as_int(v))); }
__device__ __forceinline__ float wsum(float v, int lane) { v += shx<32>(v, lane); v += shx<16>(v, lane); v += shx<8>(v, lane); v += shx<4>(v, lane); v += shx<2>(v, lane); v += shx<1>(v, lane); return v; }

__device__ __forceinline__ void wt_tile(const WJob& J, int t, LAS float* T) {
    int tid = threadIdx.x; asm volatile("" : "+v"(tid));
    const int ntn = J.Np >> 6; const int tn = t % ntn, tk = t / ntn; const int n0 = tn * 64, k0 = tk * 64;
    int sbase = n0; if (J.mode == 1) { const int pn = n0 >> 8, r = n0 & 255; sbase = (r >> 7) * DFF + pn * 128 + (r & 127); }
    const int kk = tid >> 4, nn = (tid & 15) * 4;
#pragma unroll
    for (int rep = 0; rep < 2; ++rep) { const int k = kk + rep * 32; f32x4 v = (f32x4){0.f, 0.f, 0.f, 0.f};
        if (sbase + nn < J.N) v = *(const f32x4*)(J.src + (size_t)(k0 + k) * J.N + sbase + nn);
        T[k * 65 + nn] = v[0]; T[k * 65 + nn + 1] = v[1]; T[k * 65 + nn + 2] = v[2]; T[k * 65 + nn + 3] = v[3]; }
    __syncthreads();
    const int n = tid >> 3, k8 = (tid & 7) * 8;
    f32x4 a, b;
    a[0] = T[(k8 + 0) * 65 + n]; a[1] = T[(k8 + 1) * 65 + n]; a[2] = T[(k8 + 2) * 65 + n]; a[3] = T[(k8 + 3) * 65 + n];
    b[0] = T[(k8 + 4) * 65 + n]; b[1] = T[(k8 + 5) * 65 + n]; b[2] = T[(k8 + 6) * 65 + n]; b[3] = T[(k8 + 7) * 65 + n];
    *(bf16x8*)(J.dst + (size_t)(n0 + n) * J.K + k0 + k8) = pack8(a, b);
    __syncthreads();
}

__device__ __forceinline__ void phase_prep(const Params& p, LAS unsigned char* lds) {
    int tid = threadIdx.x; asm volatile("" : "+v"(tid));
    LAS float* T = (LAS float*)lds;
    const int ntiles = p.tile_end[p.njobs - 1];
    for (int t = blockIdx.x; t < ntiles; t += gridDim.x) {
        int j = 0; while (j < p.njobs - 1 && t >= p.tile_end[j]) ++j;
        const int t0 = j ? p.tile_end[j - 1] : 0;
        wt_tile(p.jobs[j], t - t0, T);
    }
    if (blockIdx.x < 288) {
        LAS float* cs = (LAS float*)lds;
        LAS float* red = (LAS float*)(lds + 65536);
        float* mod = (float*)(p.ws + OFF_MOD);
        __syncthreads();
        for (int idx = tid; idx < 16 * 1024; idx += NTHR) { const int b = idx >> 10, k = idx & 1023; const float cv = p.c[idx]; cs[k * 16 + b] = cv / (1.0f + expf(-cv)); }
        __syncthreads();
        for (int unit = blockIdx.x; unit < 288; unit += gridDim.x) {
            const int i = unit / 72, n0 = (unit % 72) * 128, col = tid & 127, kq = tid >> 7;
            f32x4 a0 = (f32x4){0.f, 0.f, 0.f, 0.f}, a1 = a0, a2 = a0, a3 = a0;
            const float* wp = p.ada_w + ((size_t)i * 1024 + kq * 256) * MODW + n0 + col;
#pragma unroll 4
            for (int k = 0; k < 256; ++k) { const float w = wp[(size_t)k * MODW]; const LAS f32x4* cp = (const LAS f32x4*)(cs + (kq * 256 + k) * 16);
                a0 += cp[0] * w; a1 += cp[1] * w; a2 += cp[2] * w; a3 += cp[3] * w; }
#pragma unroll
            for (int b = 0; b < 4; ++b) { red[(kq * 16 + b) * 128 + col] = a0[b]; red[(kq * 16 + 4 + b) * 128 + col] = a1[b]; red[(kq * 16 + 8 + b) * 128 + col] = a2[b]; red[(kq * 16 + 12 + b) * 128 + col] = a3[b]; }
            __syncthreads();
#pragma unroll
            for (int r = 0; r < 4; ++r) { const int o = tid + r * NTHR, b = o >> 7, cc = o & 127;
                const float s = red[(0 * 16 + b) * 128 + cc] + red[(1 * 16 + b) * 128 + cc] + red[(2 * 16 + b) * 128 + cc] + red[(3 * 16 + b) * 128 + cc] + p.ada_b[i * MODW + n0 + cc];
                mod[((size_t)i * 16 + b) * MODW + n0 + cc] = s; }
            __syncthreads();
        }
    }
}

__device__ __forceinline__ void phase_init(const Params& p) {
    const float* mod = (const float*)(p.ws + OFF_MOD); bf16_t* H = (bf16_t*)(p.ws + OFF_H);
    int tid = threadIdx.x; asm volatile("" : "+v"(tid));
    for (size_t i = (size_t)blockIdx.x * NTHR + tid; i < (size_t)MTOK * 256; i += (size_t)gridDim.x * NTHR) {
        const int row = (int)(i >> 8), c4 = (int)(i & 255) * 4, b = row >> 11;
        const f32x4 xv = *(const f32x4*)(p.x + i * 4); *(f32x4*)(p.out + i * 4) = xv;
        const float* m = mod + (size_t)b * MODW; const f32x4 sh = *(const f32x4*)(m + c4), sc = *(const f32x4*)(m + 1024 + c4);
        const f32x4 h = xv * (sc + 1.0f) + sh; *(u32x2*)(H + i * 4) = pack4(h);
    }
}

__device__ __forceinline__ void phase_ln(float* xio, const bf16_t* y, const float* modG, float rw, const float* lng, const float* lnb, const float* modSh, const float* modSc, bf16_t* H) {
    int tid = threadIdx.x; asm volatile("" : "+v"(tid));
    const int wid = __builtin_amdgcn_readfirstlane(tid >> 6), lane = tid & 63;
    for (int row = blockIdx.x * 8 + wid; row < MTOK; row += gridDim.x * 8) {
        const int b = row >> 11; const size_t rb = (size_t)row * DM;
        f32x4 z[4]; float s = 0.f;
#pragma unroll
        for (int q = 0; q < 4; ++q) { const int c = q * 256 + lane * 4; const f32x4 xv = *(const f32x4*)(xio + rb + c); const u32x2 yv = *(const u32x2*)(y + rb + c);
            const f32x4 gt = *(const f32x4*)(modG + (size_t)b * MODW + c); const f32x4 yf = (f32x4){bflo(yv.x), bfhi(yv.x), bflo(yv.y), bfhi(yv.y)};
            z[q] = xv * DN_ALPHA + (gt + 1.0f) * yf * rw; s += (z[q][0] + z[q][1]) + (z[q][2] + z[q][3]); }
        const float mu = wsum(s, lane) * (1.0f / 1024.0f); float v = 0.f;
#pragma unroll
        for (int q = 0; q < 4; ++q) { const f32x4 d = z[q] - mu; v += (d[0] * d[0] + d[1] * d[1]) + (d[2] * d[2] + d[3] * d[3]); }
        const float rstd = rsqrtf(wsum(v, lane) * (1.0f / 1024.0f) + 1e-5f);
#pragma unroll
        for (int q = 0; q < 4; ++q) { const int c = q * 256 + lane * 4; const f32x4 g4 = *(const f32x4*)(lng + c), b4 = *(const f32x4*)(lnb + c);
            const f32x4 xn = (z[q] - mu) * rstd * g4 + b4; *(f32x4*)(xio + rb + c) = xn;
            const f32x4 sh = *(const f32x4*)(modSh + (size_t)b * MODW + c), sc = *(const f32x4*)(modSc + (size_t)b * MODW + c);
            *(u32x2*)(H + rb + c) = pack4(xn * (sc + 1.0f) + sh); }
    }
}

__device__ __forceinline__ void phase_ret_core(const bf16_t* QKV, bf16_t* O, LAS unsigned char* lds) {
    constexpr int PS = 136, STS = 264, OFF_P = 0, OFF_VT = 34816, OFF_KT = 52224, OFF_ST = 121856;
    int tid = threadIdx.x; asm volatile("" : "+v"(tid));
    const int wid = __builtin_amdgcn_readfirstlane(tid >> 6), lane = tid & 63, fr = lane & 15, fq = lane >> 4;
    for (int item = blockIdx.x; item < 512; item += gridDim.x) {
        const int es = item & 7, bh = item >> 3, hh = bh & 3, b = bh >> 2, e0 = es * 64;
        const float log_g = logf(1.0f - exp2f(-5.0f - (float)hh));
        const float gN = expf(log_g * 128.0f);
        __syncthreads();
        for (int i = tid; i < 64 * STS / 2; i += NTHR) ((LAS unsigned*)(lds + OFF_ST))[i] = 0u;
        f32x4 sacc[2][4];
#pragma unroll
        for (int dt = 0; dt < 2; ++dt)
#pragma unroll
            for (int et = 0; et < 4; ++et) sacc[dt][et] = (f32x4){0.f, 0.f, 0.f, 0.f};
        const float l2g = log_g * 1.44269504089f;
        const int sc0 = tid & 127, spc0 = tid >> 7; const float kfac = 0.0625f * __builtin_amdgcn_exp2f(l2g * (float)(127 - sc0));
        bf16x8 kst[8], vst[2];
        {   const bf16_t* krow = QKV + ((size_t)b * SEQ + sc0) * 4096 + 1024 + hh * 256; const bf16_t* vrow = QKV + ((size_t)b * SEQ + sc0) * 4096 + 2048 + hh * 512 + e0;
#pragma unroll
            for (int it = 0; it < 8; ++it) kst[it] = *(const bf16x8*)(krow + (spc0 + 4 * it) * 8);
#pragma unroll
            for (int it = 0; it < 2; ++it) vst[it] = *(const bf16x8*)(vrow + (spc0 + 4 * it) * 8); }
        for (int n = 0; n < 16; ++n) {
            const size_t tok0 = (size_t)b * SEQ + n * 128;
            int t2 = tid; asm volatile("" : "+v"(t2));
            const int sc_ = t2 & 127, spc = t2 >> 7, lane = t2 & 63, fr = lane & 15, fq = lane >> 4;
            {
#pragma unroll
                for (int it = 0; it < 8; ++it) { const int d0 = (spc + 4 * it) * 8;
#pragma unroll
                    for (int i = 0; i < 8; ++i) *(LAS bf16_t*)(lds + OFF_KT + ((d0 + i) * PS + sc_) * 2) = f2bf(bf2f((unsigned short)kst[it][i]) * kfac); }
#pragma unroll
                for (int it = 0; it < 2; ++it) { const int e = (spc + 4 * it) * 8;
#pragma unroll
                    for (int i = 0; i < 8; ++i) *(LAS bf16_t*)(lds + OFF_VT + ((e + i) * PS + sc_) * 2) = (bf16_t)vst[it][i]; }
            }
            const int cc = wid * 16 + fr;
            bf16x8 qf[8];
            { const bf16_t* qrow = QKV + (tok0 + cc) * 4096 + hh * 256 + fq * 8;
#pragma unroll
              for (int ks = 0; ks < 8; ++ks) qf[ks] = *(const bf16x8*)(qrow + ks * 32); }
            const int npair = (wid >> 1) + 1;
            for (int cp2 = 0; cp2 < npair; ++cp2) {
                const bf16_t* kr0 = QKV + (tok0 + cp2 * 32 + fr) * 4096 + 1024 + hh * 256 + fq * 8; const bf16_t* kr1 = kr0 + (size_t)16 * 4096;
                bf16x8 k0[8], k1[8];
#pragma unroll
                for (int ks = 0; ks < 8; ++ks) { k0[ks] = *(const bf16x8*)(kr0 + ks * 32); k1[ks] = *(const bf16x8*)(kr1 + ks * 32); }
                f32x4 acc0 = (f32x4){0.f, 0.f, 0.f, 0.f}, acc1 = acc0;
#pragma unroll
                for (int ks = 0; ks < 8; ++ks) { acc0 = MFMA16(k0[ks], qf[ks], acc0); acc1 = MFMA16(k1[ks], qf[ks], acc1); }
                f32x4 pv0, pv1;
#pragma unroll
                for (int j = 0; j < 4; ++j) { const int cp = cp2 * 32 + fq * 4 + j;
                    pv0[j] = (cc >= cp) ? acc0[j] * 0.0625f * __builtin_amdgcn_exp2f(l2g * (float)(cc - cp)) : 0.f;
                    pv1[j] = (cc >= cp + 16) ? acc1[j] * 0.0625f * __builtin_amdgcn_exp2f(l2g * (float)(cc - cp - 16)) : 0.f; }
                *(LAS u32x2*)(lds + OFF_P + (cc * PS + cp2 * 32 + fq * 4) * 2) = pack4(pv0);
                *(LAS u32x2*)(lds + OFF_P + (cc * PS + cp2 * 32 + 16 + fq * 4) * 2) = pack4(pv1);
            }
            if (n < 15) { const bf16_t* krow = QKV + (tok0 + 128 + sc_) * 4096 + 1024 + hh * 256; const bf16_t* vrow = QKV + (tok0 + 128 + sc_) * 4096 + 2048 + hh * 512 + e0;
#pragma unroll
                    for (int it = 0; it < 8; ++it) kst[it] = *(const bf16x8*)(krow + (spc + 4 * it) * 8);
#pragma unroll
                    for (int it = 0; it < 2; ++it) vst[it] = *(const bf16x8*)(vrow + (spc + 4 * it) * 8); }
            __syncthreads();
            {
                f32x4 a1[4], a2[4];
#pragma unroll
                for (int et = 0; et < 4; ++et) { a1[et] = (f32x4){0.f, 0.f, 0.f, 0.f}; a2[et] = a1[et]; }
                const int ksmax = wid >> 1;
                for (int ks = 0; ks <= ksmax; ++ks) { const bf16x8 pf = lds_rd16(lds, OFF_P + (cc * PS + ks * 32 + fq * 8) * 2);
#pragma unroll
                    for (int et = 0; et < 4; ++et) a1[et] = MFMA16(lds_rd16(lds, OFF_VT + ((et * 16 + fr) * PS + ks * 32 + fq * 8) * 2), pf, a1[et]); }
#pragma unroll
                for (int ks = 0; ks < 8; ++ks)
#pragma unroll
                    for (int et = 0; et < 4; ++et) a2[et] = MFMA16(lds_rd16(lds, OFF_ST + ((et * 16 + fr) * STS + ks * 32 + fq * 8) * 2), qf[ks], a2[et]);
                const float dq = __builtin_amdgcn_exp2f(l2g * (float)(cc + 1));
                bf16_t* orow = O + (tok0 + cc) * 2048 + hh * 512 + e0 + fq * 4;
#pragma unroll
                for (int et = 0; et < 4; ++et) *(u32x2*)(orow + et * 16) = pack4(a1[et] + a2[et] * dq);
            }
            __syncthreads();
            if (n < 15) {
#pragma unroll
                for (int dt = 0; dt < 2; ++dt)
#pragma unroll
                    for (int et = 0; et < 4; ++et) sacc[dt][et] *= gN;
#pragma unroll
                for (int ks = 0; ks < 4; ++ks) {
                    bf16x8 vf[4];
#pragma unroll
                    for (int et = 0; et < 4; ++et) vf[et] = lds_rd16(lds, OFF_VT + ((et * 16 + fr) * PS + ks * 32 + fq * 8) * 2);
#pragma unroll
                    for (int dt = 0; dt < 2; ++dt) { const bf16x8 kf = lds_rd16(lds, OFF_KT + (((2 * wid + dt) * 16 + fr) * PS + ks * 32 + fq * 8) * 2);
#pragma unroll
                        for (int et = 0; et < 4; ++et) sacc[dt][et] = MFMA16(kf, vf[et], sacc[dt][et]); }
                }
#pragma unroll
                for (int dt = 0; dt < 2; ++dt)
#pragma unroll
                    for (int et = 0; et < 4; ++et) *(LAS u32x2*)(lds + OFF_ST + ((et * 16 + fr) * STS + (2 * wid + dt) * 16 + fq * 4) * 2) = pack4(sacc[dt][et]);
            }
            __syncthreads();
        }
    }
}

__device__ __forceinline__ void phase_ret_gate(bf16_t* O, const bf16_t* G) {
    int tid = threadIdx.x; asm volatile("" : "+v"(tid));
    const int wid = __builtin_amdgcn_readfirstlane(tid >> 6), lane = tid & 63;
    for (int idx = blockIdx.x * 8 + wid; idx < MTOK * 4; idx += gridDim.x * 8) {
        const size_t base = (size_t)(idx >> 2) * 2048 + (idx & 3) * 512 + lane * 8;
        const u32x4 ov = *(const u32x4*)(O + base), gv = *(const u32x4*)(G + base);
        float o[8] = {bflo(ov.x), bfhi(ov.x), bflo(ov.y), bfhi(ov.y), bflo(ov.z), bfhi(ov.z), bflo(ov.w), bfhi(ov.w)};
        const float g[8] = {bflo(gv.x), bfhi(gv.x), bflo(gv.y), bfhi(gv.y), bflo(gv.z), bfhi(gv.z), bflo(gv.w), bfhi(gv.w)};
        float s = 0.f;
#pragma unroll
        for (int i = 0; i < 8; ++i) s += o[i];
        const float mu = wsum(s, lane) * (1.0f / 512.0f); float v = 0.f;
#pragma unroll
        for (int i = 0; i < 8; ++i) { const float d = o[i] - mu; v += d * d; }
        const float rstd = rsqrtf(wsum(v, lane) * (1.0f / 512.0f) + 1e-6f);
#pragma unroll
        for (int i = 0; i < 8; ++i) o[i] = (o[i] - mu) * rstd * silu_f(g[i]);
        u32x4 w; w.x = cvt_pk_bf16(o[0], o[1]); w.y = cvt_pk_bf16(o[2], o[3]); w.z = cvt_pk_bf16(o[4], o[5]); w.w = cvt_pk_bf16(o[6], o[7]);
        *(u32x4*)(O + base) = w;
    }
}

__device__ __forceinline__ void phase_nsa_mat(const bf16_t* PROJ, const float* pek, const float* pev, bf16_t* AK, bf16_t* AV) {
    const size_t per = (size_t)8128 * 256;
    int tid = threadIdx.x; asm volatile("" : "+v"(tid));
    for (size_t i = (size_t)blockIdx.x * NTHR + tid; i < 2 * per; i += (size_t)gridDim.x * NTHR) {
        const int kv = i >= per; const size_t rem = kv ? i - per : i; const int r = (int)(rem >> 8), pp = (int)(rem & 255), l = pp >> 3, d0 = (pp & 7) * 8;
        const int g = r & 3, bn = r >> 2, b = bn / 127, n = bn % 127;
        const u32x4 v = *(const u32x4*)(PROJ + ((size_t)b * SEQ + n * 16 + l) * 2816 + 1024 + kv * 256 + g * 64 + d0);
        const float* pe = (kv ? pev : pek) + l * 64 + d0; const f32x4 p0 = *(const f32x4*)pe, p1 = *(const f32x4*)(pe + 4);
        u32x4 w; w.x = cvt_pk_bf16(bflo(v.x) + p0[0], bfhi(v.x) + p0[1]); w.y = cvt_pk_bf16(bflo(v.y) + p0[2], bfhi(v.y) + p0[3]);
        w.z = cvt_pk_bf16(bflo(v.z) + p1[0], bfhi(v.z) + p1[1]); w.w = cvt_pk_bf16(bflo(v.w) + p1[2], bfhi(v.w) + p1[3]);
        *(u32x4*)((kv ? AV : AK) + (size_t)r * 2048 + l * 64 + d0) = w;
    }
}
__device__ __forceinline__ void phase_nsa_cmp2(const bf16_t* HK, const bf16_t* HV, const bf16_t* W2K, const bf16_t* W2V, bf16_t* KC, bf16_t* VC) {
    int tid = threadIdx.x; asm volatile("" : "+v"(tid));
    const int wid = __builtin_amdgcn_readfirstlane(tid >> 6), lane = tid & 63, fr = lane & 15, fq = lane >> 4;
    for (int tt = blockIdx.x * 8 + wid; tt < 508 * 2; tt += gridDim.x * 8) {
        const int kv = tt >= 508, rt = kv ? tt - 508 : tt; const bf16_t* Hd = kv ? HV : HK; const bf16_t* W = kv ? W2V : W2K; bf16_t* Od = kv ? VC : KC;
        f32x4 acc[4];
#pragma unroll
        for (int nt = 0; nt < 4; ++nt) acc[nt] = (f32x4){0.f, 0.f, 0.f, 0.f};
#pragma unroll
        for (int ks = 0; ks < 8; ++ks) { const bf16x8 hf = *(const bf16x8*)(Hd + (size_t)(rt * 16 + fr) * 256 + ks * 32 + fq * 8);
#pragma unroll
            for (int nt = 0; nt < 4; ++nt) acc[nt] = MFMA16(*(const bf16x8*)(W + (size_t)(nt * 16 + fr) * 256 + ks * 32 + fq * 8), hf, acc[nt]); }
#pragma unroll
        for (int nt = 0; nt < 4; ++nt) *(u32x2*)(Od + (size_t)(rt * 16 + fr) * 64 + nt * 16 + fq * 4) = pack4(acc[nt]);
    }
}

struct AttnCtx { int b, g, cur, head, hp, t; float slope; bf16x8 qf[2]; float gate[3]; unsigned selq; unsigned anym; };
constexpr int A_KS = 72, A_VS = 68, A_KCS = 72, A_VCS = 136, A_KBYTES = 9216, A_VBYTES = 8704, A_OFF_K = 0, A_OFF_VT = 18432, A_OFF_KC = 35840, A_OFF_VCT = 54272, A_OFF_IMP = 71680, A_OFF_SEL = 88576, A_OFF_SELP = 88704;

template <int BR>
__device__ __forceinline__ void attn_branch(const bf16_t* PROJ, LAS unsigned char* lds, const AttnCtx& C, f32x4 (&otot)[4], int tid) {
    const int lane = tid & 63, fr = lane & 15, fq = lane >> 4;
    const float qs = 0.125f * 1.44269504089f, slope2 = C.slope * 1.44269504089f;
    f32x4 sl[4];
#pragma unroll
    for (int kt = 0; kt < 4; ++kt)
#pragma unroll
        for (int jj = 0; jj < 4; ++jj) sl[kt][jj] = slope2 * (float)(kt * 16 + jj);
    float m_ = -1e30f, l_ = 0.f;
    f32x4 oa[4];
#pragma unroll
    for (int dt = 0; dt < 4; ++dt) oa[dt] = (f32x4){0.f, 0.f, 0.f, 0.f};
    const int jlo = (BR == 1) ? 0 : (C.cur > 8 ? C.cur - 8 : 0);
    const int koff = (BR == 1 ? 1536 : 2048) + C.g * 64, voff = (BR == 1 ? 1792 : 2304) + C.g * 64;
    const int key = tid >> 3, d0 = (tid & 7) * 8;
    const bf16_t* srcb = PROJ + ((size_t)C.b * SEQ + key) * 2816 + d0;
    int j = jlo;
    if (BR == 1) { while (j <= C.cur && !((C.anym >> j) & 1u)) ++j; }
    bf16x8 kreg = *(const bf16x8*)(srcb + (size_t)j * 64 * 2816 + koff), vreg = *(const bf16x8*)(srcb + (size_t)j * 64 * 2816 + voff);
    __syncthreads();
    int buf = 0;
    { *(LAS bf16x8*)(lds + A_OFF_K + (key * A_KS + d0) * 2) = kreg;
#pragma unroll
      for (int i = 0; i < 8; ++i) *(LAS bf16_t*)(lds + A_OFF_VT + ((d0 + i) * A_VS + key) * 2) = (bf16_t)vreg[i]; }
    __syncthreads();
    while (j <= C.cur) {
        int jn = j + 1;
        if (BR == 1) { while (jn <= C.cur && !((C.anym >> jn) & 1u)) ++jn; }
        const bool more = jn <= C.cur;
        if (more) { kreg = *(const bf16x8*)(srcb + (size_t)jn * 64 * 2816 + koff); vreg = *(const bf16x8*)(srcb + (size_t)jn * 64 * 2816 + voff); }
        const int kb = A_OFF_K + buf * A_KBYTES, vb = A_OFF_VT + buf * A_VBYTES;
        f32x4 s4[4]; float alpha;
        const int dbase = C.t - j * 64 - fq * 4;
        const bool partial = (j == C.cur) || (BR == 2 && j + 8 <= C.cur);
        if (partial) {
            float tmax = -1e30f;
#pragma unroll
            for (int kt = 0; kt < 4; ++kt) { f32x4 acc = (f32x4){0.f, 0.f, 0.f, 0.f};
#pragma unroll
                for (int ks = 0; ks < 2; ++ks) acc = MFMA16(lds_rd16(lds, kb + ((kt * 16 + fr) * A_KS + ks * 32 + fq * 8) * 2), C.qf[ks], acc);
#pragma unroll
                for (int jj = 0; jj < 4; ++jj) { const int dist = dbase - (kt * 16 + jj);
                    const bool ok = (dist >= 0) && (BR == 1 ? (((C.selq >> j) & 1u) != 0u) : (dist < 512));
                    const float s = ok ? acc[jj] * qs - slope2 * (float)dist : -1e30f; s4[kt][jj] = s; tmax = fmaxf(tmax, s); } }
            tmax = fmaxf(tmax, shx<16>(tmax, lane)); tmax = fmaxf(tmax, shx<32>(tmax, lane));
            const float mnew = fmaxf(m_, tmax); alpha = __builtin_amdgcn_exp2f(m_ - mnew); m_ = mnew;
            float psum = 0.f;
#pragma unroll
            for (int kt = 0; kt < 4; ++kt)
#pragma unroll
                for (int jj = 0; jj < 4; ++jj) { const float pp = (s4[kt][jj] > -1e29f) ? __builtin_amdgcn_exp2f(s4[kt][jj] - mnew) : 0.f; s4[kt][jj] = pp; psum += pp; }
            l_ = l_ * alpha + psum;
        } else {
            float c0 = -slope2 * (float)dbase;
            if (BR == 1 && !((C.selq >> j) & 1u)) c0 = -1e30f;
            float tmax = -1e30f;
#pragma unroll
            for (int kt = 0; kt < 4; ++kt) { f32x4 acc = (f32x4){0.f, 0.f, 0.f, 0.f};
#pragma unroll
                for (int ks = 0; ks < 2; ++ks) acc = MFMA16(lds_rd16(lds, kb + ((kt * 16 + fr) * A_KS + ks * 32 + fq * 8) * 2), C.qf[ks], acc);
#pragma unroll
                for (int jj = 0; jj < 4; ++jj) { const float u = acc[jj] * qs + sl[kt][jj]; s4[kt][jj] = u; tmax = fmaxf(tmax, u); } }
            tmax += c0;
            tmax = fmaxf(tmax, shx<16>(tmax, lane)); tmax = fmaxf(tmax, shx<32>(tmax, lane));
            const float mnew = fmaxf(m_, tmax); alpha = __builtin_amdgcn_exp2f(m_ - mnew); m_ = mnew;
            const float sh = mnew - c0; float psum = 0.f;
#pragma unroll
            for (int kt = 0; kt < 4; ++kt)
#pragma unroll
                for (int jj = 0; jj < 4; ++jj) { const float pp = __builtin_amdgcn_exp2f(s4[kt][jj] - sh); s4[kt][jj] = pp; psum += pp; }
            l_ = l_ * alpha + psum;
        }
#pragma unroll
        for (int dt = 0; dt < 4; ++dt) oa[dt] *= alpha;
#pragma unroll
        for (int ks2 = 0; ks2 < 2; ++ks2) { const bf16x8 pf = pack8(s4[2 * ks2], s4[2 * ks2 + 1]);
#pragma unroll
            for (int dt = 0; dt < 4; ++dt) oa[dt] = MFMA16(lds_rd8x2(lds, vb + ((dt * 16 + fr) * A_VS + ks2 * 32 + fq * 4) * 2), pf, oa[dt]); }
        if (more) { const int kb2 = A_OFF_K + (buf ^ 1) * A_KBYTES, vb2 = A_OFF_VT + (buf ^ 1) * A_VBYTES;
            *(LAS bf16x8*)(lds + kb2 + (key * A_KS + d0) * 2) = kreg;
#pragma unroll
            for (int i = 0; i < 8; ++i) *(LAS bf16_t*)(lds + vb2 + ((d0 + i) * A_VS + key) * 2) = (bf16_t)vreg[i]; }
        __syncthreads();
        buf ^= 1; j = jn;
    }
    float lt = l_; lt += shx<16>(lt, lane); lt += shx<32>(lt, lane); const float inv = lt > 0.f ? C.gate[BR] / lt : 0.f;
#pragma unroll
    for (int dt = 0; dt < 4; ++dt) otot[dt] += oa[dt] * inv;
}

__device__ __forceinline__ void phase_nsa_attn(const bf16_t* PROJ, const bf16_t* KCMP, const bf16_t* VCMP, bf16_t* OATT, LAS unsigned char* lds) {
    int tid = threadIdx.x; asm volatile("" : "+v"(tid));
    const int wid = __builtin_amdgcn_readfirstlane(tid >> 6), lane = tid & 63, fr = lane & 15, fq = lane >> 4;
    LAS float* IMP = (LAS float*)(lds + A_OFF_IMP); LAS unsigned* SEL = (LAS unsigned*)(lds + A_OFF_SEL); LAS unsigned* SELP = (LAS unsigned*)(lds + A_OFF_SELP);
    for (int id = blockIdx.x; id < 4096; id += gridDim.x) {
        const int k8 = id & 255, ii = id >> 8, bg = k8 & 63, kk = k8 >> 6;
        const int qt32 = (ii & 1) ? 63 - (kk + 4 * (ii - 1)) : kk + 4 * ii;
        AttnCtx C; C.cur = qt32 >> 1; C.b = bg >> 2; C.g = bg & 3; C.hp = wid >> 1; C.head = C.g * 4 + C.hp; C.slope = exp2f(-0.5f * (float)(C.head + 1));
        const int qq = (wid & 1) * 16 + fr; C.t = qt32 * 32 + qq; const size_t trow = (size_t)C.b * SEQ + C.t;
        { const bf16_t* pr = PROJ + trow * 2816;
#pragma unroll
          for (int ks = 0; ks < 2; ++ks) C.qf[ks] = *(const bf16x8*)(pr + C.head * 64 + ks * 32 + fq * 8);
#pragma unroll
          for (int br = 0; br < 3; ++br) C.gate[br] = 1.0f / (1.0f + __expf(-bf2f(pr[2560 + C.head * 3 + br]))); }
#ifdef ONLY_BR
#pragma unroll
        for (int br = 0; br < 3; ++br) if (br != ONLY_BR) C.gate[br] = 0.f;
#endif
        f32x4 otot[4];
#pragma unroll
        for (int dt = 0; dt < 4; ++dt) otot[dt] = (f32x4){0.f, 0.f, 0.f, 0.f};
        __syncthreads();
#pragma unroll
        for (int rep = 0; rep < 2; ++rep) { const int idx = tid + rep * NTHR, n = idx >> 3, d0 = (idx & 7) * 8, nc = n < 126 ? n : 126; const size_t src = ((size_t)(C.b * 127 + nc) * 4 + C.g) * 64 + d0;
            *(LAS bf16x8*)(lds + A_OFF_KC + (n * A_KCS + d0) * 2) = *(const bf16x8*)(KCMP + src);
            const bf16x8 vv = *(const bf16x8*)(VCMP + src);
#pragma unroll
            for (int i = 0; i < 8; ++i) *(LAS bf16_t*)(lds + A_OFF_VCT + ((d0 + i) * A_VCS + n) * 2) = (bf16_t)vv[i]; }
        __syncthreads();
        {
            f32x4 sc[8]; float mx = -1e30f;
#pragma unroll
            for (int kt = 0; kt < 8; ++kt) { f32x4 acc = (f32x4){0.f, 0.f, 0.f, 0.f};
#pragma unroll
                for (int ks = 0; ks < 2; ++ks) acc = MFMA16(lds_rd16(lds, A_OFF_KC + ((kt * 16 + fr) * A_KCS + ks * 32 + fq * 8) * 2), C.qf[ks], acc);
#pragma unroll
                for (int jj = 0; jj < 4; ++jj) { const int n = kt * 16 + fq * 4 + jj, ce = n * 16 + 31; const bool ok = (n <= 126) && (ce <= C.t);
                    const float s = ok ? acc[jj] * 0.125f - C.slope * (float)(C.t - ce) : -1e30f; sc[kt][jj] = s; mx = fmaxf(mx, s); } }
            mx = fmaxf(mx, shx<16>(mx, lane)); mx = fmaxf(mx, shx<32>(mx, lane));
            float sum = 0.f;
#pragma unroll
            for (int kt = 0; kt < 8; ++kt)
#pragma unroll
                for (int jj = 0; jj < 4; ++jj) { const float pp = (sc[kt][jj] > -1e29f) ? __expf(sc[kt][jj] - mx) : 0.f; sc[kt][jj] = pp; sum += pp; }
            sum += shx<16>(sum, lane); sum += shx<32>(sum, lane);
            const float inv = sum > 0.f ? 1.0f / sum : 0.f;
#pragma unroll
            for (int kt = 0; kt < 8; ++kt) sc[kt] *= inv;
#pragma unroll
            for (int kt = 0; kt < 8; ++kt) { const float a = shi(sc[kt][3], (lane + 48) & 63); const float bp = kt > 0 ? shi(sc[kt > 0 ? kt - 1 : 0][3], (lane + 48) & 63) : 0.f;
                const float prev3 = fq > 0 ? a : bp;
                IMP[(C.hp * 32 + qq) * 33 + 4 * kt + fq] = sc[kt][0] + sc[kt][1] + sc[kt][2] + 0.5f * sc[kt][3] + 0.5f * prev3; }
            f32x4 oc[4];
#pragma unroll
            for (int dt = 0; dt < 4; ++dt) oc[dt] = (f32x4){0.f, 0.f, 0.f, 0.f};
#pragma unroll
            for (int ks2 = 0; ks2 < 4; ++ks2) { const bf16x8 pf = pack8(sc[2 * ks2], sc[2 * ks2 + 1]);
#pragma unroll
                for (int dt = 0; dt < 4; ++dt) oc[dt] = MFMA16(lds_rd8x2(lds, A_OFF_VCT + ((dt * 16 + fr) * A_VCS + ks2 * 32 + fq * 4) * 2), pf, oc[dt]); }
#pragma unroll
            for (int dt = 0; dt < 4; ++dt) otot[dt] += oc[dt] * C.gate[0];
        }
        __syncthreads();
        if (C.cur >= 16) {
            const int sq = tid & 31, jg = tid >> 5;
#pragma unroll
            for (int jj = 0; jj < 2; ++jj) { const int j = jg * 2 + jj; const float imp = IMP[(0 * 32 + sq) * 33 + j] + IMP[(1 * 32 + sq) * 33 + j] + IMP[(2 * 32 + sq) * 33 + j] + IMP[(3 * 32 + sq) * 33 + j];
                const bool valid = j <= C.cur, forced = (j == 0) || (j == C.cur) || (j == C.cur - 1);
                IMP[sq * 33 + j] = valid ? (forced ? 1e4f : imp) : -1.0f; }
            __syncthreads();
            unsigned bits = 0u;
#pragma unroll
            for (int jj = 0; jj < 2; ++jj) { const int j = jg * 2 + jj; const float sj = IMP[sq * 33 + j]; int cnt = 0;
                for (int j2 = 0; j2 < 32; ++j2) { const float s2 = IMP[sq * 33 + j2]; cnt += ((s2 > sj) || (s2 == sj && j2 < j)) ? 1 : 0; }
                if (cnt < 16) bits |= 1u << j; }
            SELP[jg * 32 + sq] = bits;
            __syncthreads();
            if (tid < 32) { unsigned m = 0u;
#pragma unroll
                for (int q = 0; q < 16; ++q) m |= SELP[q * 32 + tid];
                SEL[tid] = m; }
        } else { if (tid < 32) SEL[tid] = (2u << C.cur) - 1u; }
        __syncthreads();
        C.selq = SEL[qq];
        { unsigned m = SEL[lane & 31]; m |= shxu<16>(m, lane); m |= shxu<8>(m, lane); m |= shxu<4>(m, lane); m |= shxu<2>(m, lane); m |= shxu<1>(m, lane); C.anym = (unsigned)__builtin_amdgcn_readfirstlane((int)m); }
        attn_branch<1>(PROJ, lds, C, otot, tid);
        attn_branch<2>(PROJ, lds, C, otot, tid);
#pragma unroll
        for (int dt = 0; dt < 4; ++dt) *(u32x2*)(OATT + trow * 1024 + C.head * 64 + dt * 16 + fq * 4) = pack4(otot[dt]);
    }
}

__device__ __forceinline__ void grid_barrier(unsigned* bar, unsigned& epoch) {
    asm volatile("s_waitcnt vmcnt(0)" ::: "memory");
    __syncthreads();
    epoch += gridDim.x;
    if (threadIdx.x == 0) {
        __builtin_amdgcn_fence(__ATOMIC_RELEASE, "agent");
        asm volatile("s_waitcnt vmcnt(0)" ::: "memory");
        __hip_atomic_fetch_add(bar, 1u, __ATOMIC_RELAXED, __HIP_MEMORY_SCOPE_AGENT);
        while (__hip_atomic_load(bar, __ATOMIC_RELAXED, __HIP_MEMORY_SCOPE_AGENT) < epoch) __builtin_amdgcn_s_sleep(1);
        __builtin_amdgcn_fence(__ATOMIC_ACQUIRE, "agent");
        asm volatile("s_waitcnt vmcnt(0)" ::: "memory");
    }
    __syncthreads();
}
#ifndef R_CORE
#define R_CORE 1
#endif
#ifndef R_ATTN
#define R_ATTN 1
#endif
#ifndef R_GEMM
#define R_GEMM 1
#endif
#ifndef R_BAR
#define R_BAR 1
#endif
struct GemmDesc { const bf16_t* A; const bf16_t* Bt; bf16_t* O; int M, N, K, ldc, act, cshift; };
__device__ __forceinline__ void run_gemm(const GemmDesc& d, LAS unsigned char* lds) {
    pg8::Gemm g{d.A, d.Bt, d.M, d.N, d.K}; pg8::StaticOrder S; const int G = (int)gridDim.x; S.init(d.M, d.N, G, ((int)blockIdx.x + G - d.cshift % G) % G);
    if (d.act == 0) { pg8::Epi<0> E{d.O, d.ldc}; pg8::gemm_phase<pg8::Epi<0>, pg8::StaticOrder>(lds, g, S, E); }
    else if (d.act == 1) { pg8::Epi<1> E{d.O, d.ldc}; pg8::gemm_phase<pg8::Epi<1>, pg8::StaticOrder>(lds, g, S, E); }
    else { pg8::Epi<2> E{d.O, d.ldc}; pg8::gemm_phase<pg8::Epi<2>, pg8::StaticOrder>(lds, g, S, E); }
}

__global__ void __launch_bounds__(NTHR) fwd_megakernel(Params p) {
    extern __shared__ __attribute__((aligned(16))) unsigned char smem[];
    LAS unsigned char* lds = (LAS unsigned char*)smem;
    cg::grid_group grid = cg::this_grid();
    unsigned char* ws = p.ws; unsigned char* U = ws + OFF_U2;
    const float* mod = (const float*)(ws + OFF_MOD); bf16_t* H = (bf16_t*)(ws + OFF_H);
    unsigned* bar = (unsigned*)(ws + WS_END); unsigned epoch = 0u;
    grid.sync();

#ifdef PREFILL
    { const u32x4 pz = (u32x4){0xAAAAAAAAu, 0xAAAAAAAAu, 0xAAAAAAAAu, 0xAAAAAAAAu}; for (size_t i = (size_t)blockIdx.x * NTHR + threadIdx.x; i < WS_END / 16; i += (size_t)gridDim.x * NTHR) ((u32x4*)ws)[i] = pz; }
    grid_barrier(bar, epoch);
#endif
    phase_prep(p, lds);
    grid_barrier(bar, epoch);
    phase_init(p);
    grid_barrier(bar, epoch);

    for (int layer = 0; layer < DEPTH; ++layer) {
        const int jm = layer >> 1; const bool is_ret = (layer & 1) == 0;
        const float* modL = mod + (size_t)layer * 16 * MODW;
        for (int st = 0; st < 13; ++st) {
            GemmDesc d[2]; int ng = 0;
            d[0].cshift = 0; d[1].cshift = 0;
            if (st == 0 || st == 10) {
                const int s = st == 0 ? 0 : 1;
                d[0] = GemmDesc{H, (const bf16_t*)(ws + OFF_FFN_IN + (size_t)(layer * 2 + s) * SZ_FFN_IN), (bf16_t*)(U + U_FFN_ACT), MTOK, 5632, 1024, DFF, 1, 0}; ng = 1;
            } else if (st == 1 || st == 11) {
                const int s = st == 1 ? 0 : 1;
                d[0] = GemmDesc{(const bf16_t*)(U + U_FFN_ACT), (const bf16_t*)(ws + OFF_FFN_OUT + (size_t)(layer * 2 + s) * SZ_FFN_OUT), (bf16_t*)(U + U_FFN_Y), MTOK, 1024, DFF, 1024, 0, 0}; ng = 1;
            } else if (st == 2 || st == 9 || st == 12) {
                const int sub = st == 2 ? 0 : (st == 9 ? 1 : 2);
                const bf16_t* y = (const bf16_t*)(U + (sub == 1 ? (is_ret ? U_RET_Y : U_NSA_Y) : U_FFN_Y));
                const float* modN = (sub == 2) ? (layer + 1 < DEPTH ? modL + (size_t)16 * MODW : modL) : modL;
                const int shc = (sub == 2) ? 0 : (sub + 1) * 3;
                phase_ln(p.out, y, modL + (sub * 3 + 2) * 1024, sub == 1 ? 1.0f : 0.5f, p.ln_g + (size_t)(layer * 3 + sub) * 1024, p.ln_b + (size_t)(layer * 3 + sub) * 1024,
                         modN + shc * 1024, modN + (shc + 1) * 1024, H);
            } else if (is_ret) {
                const bf16_t* Wi = (const bf16_t*)(ws + OFF_RET_IN + (size_t)jm * SZ_RET_IN);
                if (st == 3) { d[0] = GemmDesc{H, Wi, (bf16_t*)(U + U_RET_QKV), MTOK, 4096, 1024, 4096, 0, 0}; ng = 1; }
                else if (st == 4) { for (int rr = 0; rr < R_CORE; ++rr) phase_ret_core((const bf16_t*)(U + U_RET_QKV), (bf16_t*)(U + U_RET_O), lds); }
                else if (st == 5) { d[0] = GemmDesc{H, Wi + (size_t)4096 * 1024, (bf16_t*)(U + U_RET_G), MTOK, 2048, 1024, 2048, 0, 0}; ng = 1; }
                else if (st == 6) phase_ret_gate((bf16_t*)(U + U_RET_O), (const bf16_t*)(U + U_RET_G));
                else if (st == 7) { d[0] = GemmDesc{(const bf16_t*)(U + U_RET_O), (const bf16_t*)(ws + OFF_RET_OUT + (size_t)jm * SZ_RET_OUT), (bf16_t*)(U + U_RET_Y), MTOK, 1024, 2048, 1024, 0, 0}; ng = 1; }
                else continue;
            } else {
                if (st == 3) { d[0] = GemmDesc{H, (const bf16_t*)(ws + OFF_NSA_IN + (size_t)jm * SZ_NSA_IN), (bf16_t*)(U + U_NSA_PROJ), MTOK, 2816, 1024, 2816, 0, 0}; ng = 1; }
                else if (st == 4) phase_nsa_mat((const bf16_t*)(U + U_NSA_PROJ), p.pe_k + (size_t)jm * 2048, p.pe_v + (size_t)jm * 2048, (bf16_t*)(U + U_NSA_ACMPK), (bf16_t*)(U + U_NSA_ACMPV));
                else if (st == 5) {
                    d[0] = GemmDesc{(const bf16_t*)(U + U_NSA_ACMPK), (const bf16_t*)(ws + OFF_W1 + (size_t)(0 * 2 + jm) * SZ_W1), (bf16_t*)(U + U_NSA_HK), 8192, 256, 2048, 256, 2, 0};
                    d[1] = GemmDesc{(const bf16_t*)(U + U_NSA_ACMPV), (const bf16_t*)(ws + OFF_W1 + (size_t)(1 * 2 + jm) * SZ_W1), (bf16_t*)(U + U_NSA_HV), 8192, 256, 2048, 256, 2, 32}; ng = 2;
                } else if (st == 6) phase_nsa_cmp2((const bf16_t*)(U + U_NSA_HK), (const bf16_t*)(U + U_NSA_HV), (const bf16_t*)(ws + OFF_W2 + (size_t)(0 * 2 + jm) * SZ_W2), (const bf16_t*)(ws + OFF_W2 + (size_t)(1 * 2 + jm) * SZ_W2),
                                               (bf16_t*)(U + U_NSA_KCMP), (bf16_t*)(U + U_NSA_VCMP));
                else if (st == 7) { for (int rr = 0; rr < R_ATTN; ++rr) phase_nsa_attn((const bf16_t*)(U + U_NSA_PROJ), (const bf16_t*)(U + U_NSA_KCMP), (const bf16_t*)(U + U_NSA_VCMP), (bf16_t*)(U + U_NSA_OATT), lds); }
                else { d[0] = GemmDesc{(const bf16_t*)(U + U_NSA_OATT), (const bf16_t*)(ws + OFF_NSA_OUT + (size_t)jm * SZ_NSA_OUT), (bf16_t*)(U + U_NSA_Y), MTOK, 1024, 1024, 1024, 0, 0}; ng = 1; }
            }
            for (int rr = 0; rr < R_GEMM; ++rr) for (int r = 0; r < ng; ++r) { GemmDesc dd = d[0]; if (r == 1) dd = d[1]; run_gemm(dd, lds); }
            for (int rr = 0; rr < R_BAR; ++rr) grid_barrier(bar, epoch);
#ifdef STOP_L
            if (layer == STOP_L && st == STOP_S) return;
#endif
        }
    }
}

extern "C" void kernel_launch(void* const* d_in, const int* in_sizes, int n_in, void* d_out, int out_size, void* d_ws, size_t ws_size, hipStream_t stream) {
    static int grid_blocks = 0;
    if (grid_blocks == 0) {
        int dev = 0, cus = 0, per_cu = 0;
        hipGetDevice(&dev); hipDeviceGetAttribute(&cus, hipDeviceAttributeMultiprocessorCount, dev);
        if (hipFuncSetAttribute((const void*)fwd_megakernel, hipFuncAttributeMaxDynamicSharedMemorySize, LDS_BYTES) != hipSuccess) fprintf(stderr, "hipFuncSetAttribute failed\n");
        if (hipOccupancyMaxActiveBlocksPerMultiprocessor(&per_cu, (const void*)fwd_megakernel, NTHR, LDS_BYTES) != hipSuccess || per_cu < 1) { fprintf(stderr, "occupancy query: %d\n", per_cu); per_cu = 1; }
        (void)hipGetLastError();
        grid_blocks = cus * 1;
        if (ws_size < WS_END + 256) fprintf(stderr, "workspace too small: %zu < %zu\n", ws_size, (size_t)WS_END);
    }
    Params p{};
    p.x = (const float*)d_in[0]; p.c = (const float*)d_in[1]; p.ada_w = (const float*)d_in[2]; p.ada_b = (const float*)d_in[3]; p.ln_g = (const float*)d_in[4]; p.ln_b = (const float*)d_in[5];
    p.pe_k = (const float*)d_in[12]; p.pe_v = (const float*)d_in[13]; p.out = (float*)d_out; p.ws = (unsigned char*)d_ws;
    unsigned char* ws = (unsigned char*)d_ws; int nj = 0, te = 0;
    auto add = [&](const float* src, size_t dst_off, int K, int N, int Np, int mode) { p.jobs[nj] = WJob{src, (bf16_t*)(ws + dst_off), K, N, Np, mode}; te += (Np / 64) * (K / 64); p.tile_end[nj] = te; ++nj; };
    const float* ffn_in = (const float*)d_in[6]; const float* ffn_out = (const float*)d_in[7]; const float* ret_in = (const float*)d_in[8]; const float* ret_out = (const float*)d_in[9];
    const float* nsa_in = (const float*)d_in[10]; const float* nsa_out = (const float*)d_in[11];
    const float* ck1 = (const float*)d_in[14]; const float* ck2 = (const float*)d_in[15]; const float* cv1 = (const float*)d_in[16]; const float* cv2 = (const float*)d_in[17];
    for (int i = 0; i < 8; ++i) add(ffn_in + (size_t)i * 1024 * 5632, OFF_FFN_IN + i * SZ_FFN_IN, 1024, 5632, 5632, 1);
    for (int i = 0; i < 8; ++i) add(ffn_out + (size_t)i * 2816 * 1024, OFF_FFN_OUT + i * SZ_FFN_OUT, 2816, 1024, 1024, 0);
    for (int i = 0; i < 2; ++i) add(ret_in + (size_t)i * 1024 * 6144, OFF_RET_IN + i * SZ_RET_IN, 1024, 6144, 6144, 0);
    for (int i = 0; i < 2; ++i) add(ret_out + (size_t)i * 2048 * 1024, OFF_RET_OUT + i * SZ_RET_OUT, 2048, 1024, 1024, 0);
    for (int i = 0; i < 2; ++i) add(nsa_in + (size_t)i * 1024 * 2608, OFF_NSA_IN + i * SZ_NSA_IN, 1024, 2608, 2816, 0);
    for (int i = 0; i < 2; ++i) add(nsa_out + (size_t)i * 1024 * 1024, OFF_NSA_OUT + i * SZ_NSA_OUT, 1024, 1024, 1024, 0);
    for (int i = 0; i < 2; ++i) add(ck1 + (size_t)i * 2048 * 256, OFF_W1 + (0 * 2 + i) * SZ_W1, 2048, 256, 256, 0);
    for (int i = 0; i < 2; ++i) add(cv1 + (size_t)i * 2048 * 256, OFF_W1 + (1 * 2 + i) * SZ_W1, 2048, 256, 256, 0);
    for (int i = 0; i < 2; ++i) add(ck2 + (size_t)i * 256 * 64, OFF_W2 + (0 * 2 + i) * SZ_W2, 256, 64, 64, 0);
    for (int i = 0; i < 2; ++i) add(cv2 + (size_t)i * 256 * 64, OFF_W2 + (1 * 2 + i) * SZ_W2, 256, 64, 64, 0);
    p.njobs = nj;
    if (hipMemsetAsync(ws + WS_END, 0, 256, stream) != hipSuccess) fprintf(stderr, "barrier memset failed\n");
    void* args[] = {&p};
    hipError_t e = hipLaunchCooperativeKernel((const void*)fwd_megakernel, dim3(grid_blocks), dim3(NTHR), args, LDS_BYTES, stream);
    if (e != hipSuccess) fprintf(stderr, "cooperative launch failed: %s (grid %d)\n", hipGetErrorString(e), grid_blocks);
}
```

```cpp
#include <hip/hip_runtime.h>
#include <hip/hip_cooperative_groups.h>
#include <cstdio>
namespace cg = cooperative_groups;

namespace pg8 {
#define PG8_LAS __attribute__((address_space(3)))
typedef unsigned short bf16_t;
typedef short bf16x8 __attribute__((ext_vector_type(8)));
typedef float f32x4 __attribute__((ext_vector_type(4)));
typedef unsigned u32x4 __attribute__((ext_vector_type(4)));
constexpr int BM = 256, BK = 64, HALF = 128, HTB = HALF * BK * 2  , STAGE_BYTES = 8 * HTB, NXCD = 8, WGM = 8;

__host__ __device__ __forceinline__ int lds_byte(int r, int c) { const int st = (r >> 4) * 2 + (c >> 5), rr = r & 15, cc = c & 31, ob = rr * 64 + cc * 2; return st * 1024 + (ob ^ (((ob >> 9) & 1) << 5)); }
__host__ __device__ __forceinline__ void stage_rc(int b, int& R, int& C) { const int st = b / 1024, sb = b % 1024, swz = sb ^ (((sb >> 9) & 1) << 5); R = (st >> 1) * 16 + swz / 64; C = (st & 1) * 32 + (swz % 64) / 2; }
__host__ __device__ __forceinline__ int perm32(int rho) { const int n = rho >> 4, i = rho & 15; return 8 * (i >> 2) + 4 * n + (i & 3); }

struct Unit { int pm, pn; };
struct Gemm { const bf16_t* A; const bf16_t* Bt; int M, N, K; };

struct StaticOrder {
    int nM, nN, nwg, G, c;
    __host__ __device__ void init(int M, int N, int G_, int c_) { nM = M / BM; nN = N / BM; nwg = nM * nN; G = G_; c = c_; }
    __host__ __device__ bool next(int i, Unit& u) const {
        const long L = (long)i * G + c; if (L >= nwg) return false;
        int wgid = (int)L; { const int q = nwg / NXCD, r = nwg % NXCD, xcd = wgid % NXCD, off = wgid / NXCD; wgid = (xcd < r ? xcd * (q + 1) : r * (q + 1) + (xcd - r) * q) + off; }
        const int nig = WGM * nN, gid = wgid / nig, fm = gid * WGM, gsz = (nM - fm) < WGM ? (nM - fm) : WGM;
        u.pm = fm + ((wgid % nig) % gsz); u.pn = (wgid % nig) / gsz; return true;
    }
    __device__ __forceinline__ void a_ready(const Unit&) const {}
    __device__ __forceinline__ void done(const Unit&) const {}
};

typedef float f32x2_t __attribute__((ext_vector_type(2)));
typedef __bf16 bf16x2_t __attribute__((ext_vector_type(2)));
__device__ __forceinline__ unsigned cvt_pk_bf16(float lo, float hi) { const f32x2_t v = {lo, hi}; return __builtin_bit_cast(unsigned, __builtin_convertvector(v, bf16x2_t)); }
__device__ __forceinline__ float silu_f(float a) { return a * __builtin_amdgcn_rcpf(1.0f + __builtin_amdgcn_exp2f(-1.44269504089f * a)); }
__device__ __forceinline__ float gelu_tanh_f(float x) { const float u = 0.7978845608028654f * (x + 0.044715f * x * x * x); const float t = 1.0f - 2.0f * __builtin_amdgcn_rcpf(1.0f + __builtin_amdgcn_exp2f(2.88539008178f * u)); return 0.5f * x * (1.0f + t); }

template <int ACT> struct Epi {
    static constexpr bool PERM = true, AFTER_DRAIN = false;
    bf16_t* O; int ldc;
    __device__ __forceinline__ void operator()(const f32x4 (&acc)[2][2][4][2], const Unit& u, int wr, int wc, int fr, int fq) const {
        const int row0 = u.pm * BM + wr * 64 + fr;
        if (ACT == 1) {
            const int col0 = u.pn * HALF + wc * 32 + 8 * fq;
#pragma unroll
            for (int ai = 0; ai < 2; ++ai)
#pragma unroll
                for (int m = 0; m < 4; ++m) { bf16_t* rowp = O + (size_t)(row0 + ai * HALF + m * 16) * ldc + col0;
                    const f32x4 a0 = acc[ai][0][m][0], a1 = acc[ai][0][m][1], u0 = acc[ai][1][m][0], u1 = acc[ai][1][m][1];
                    u32x4 w; w.x = cvt_pk_bf16(silu_f(a0[0]) * u0[0], silu_f(a0[1]) * u0[1]); w.y = cvt_pk_bf16(silu_f(a0[2]) * u0[2], silu_f(a0[3]) * u0[3]);
                    w.z = cvt_pk_bf16(silu_f(a1[0]) * u1[0], silu_f(a1[1]) * u1[1]); w.w = cvt_pk_bf16(silu_f(a1[2]) * u1[2], silu_f(a1[3]) * u1[3]);
                    *(u32x4*)rowp = w; }
        } else {
            const int col0 = u.pn * BM + wc * 32 + 8 * fq;
#pragma unroll
            for (int ai = 0; ai < 2; ++ai)
#pragma unroll
                for (int m = 0; m < 4; ++m) { bf16_t* rowp = O + (size_t)(row0 + ai * HALF + m * 16) * ldc + col0;
#pragma unroll
                    for (int bj = 0; bj < 2; ++bj) { f32x4 v0 = acc[ai][bj][m][0], v1 = acc[ai][bj][m][1];
                        if (ACT == 2) {
#pragma unroll
                            for (int j = 0; j < 4; ++j) { v0[j] = gelu_tanh_f(v0[j]); v1[j] = gelu_tanh_f(v1[j]); } }
                        u32x4 w; w.x = cvt_pk_bf16(v0[0], v0[1]); w.y = cvt_pk_bf16(v0[2], v0[3]); w.z = cvt_pk_bf16(v1[0], v1[1]); w.w = cvt_pk_bf16(v1[2], v1[3]);
                        *(u32x4*)(rowp + bj * HALF) = w; } }
        }
    }
};

template <class Epi, class Sched>
__device__ __forceinline__ void gemm_phase(PG8_LAS unsigned char* lds, const Gemm g, const Sched& S, const Epi& E) {
    const int tid = threadIdx.x, wid = __builtin_amdgcn_readfirstlane(tid >> 6), lane = tid & 63, wr = wid >> 2, wc = wid & 3, fr = lane & 15, fq = lane >> 4;
    const int K = g.K, nt = K / BK;
    unsigned voffA[2], voffB[2];
#pragma unroll
    for (int i = 0; i < 2; ++i) { int R, C; stage_rc(tid * 16 + i * 8192, R, C); const int Rb = Epi::PERM ? ((R & ~31) + perm32(R & 31)) : R;
        voffA[i] = (unsigned)(R * K + C) * 2u; voffB[i] = (unsigned)(Rb * K + C) * 2u; }
    const size_t kstep = (size_t)(BK * 2);
    const size_t hstep = (size_t)HALF * K * 2;
    const size_t tstep = 2 * hstep;
    const unsigned ldsw = (unsigned)wid * 1024u;
    const int aoff = lds_byte(wr * 64 + fr, fq * 8), boff = lds_byte(wc * 32 + fr, fq * 8);
#define PG8_SA(b, h) (((b) * 2 + (h)) * HTB)
#define PG8_SB(b, h) ((4 + (b) * 2 + (h)) * HTB)
#define PG8_STAGE(bufoff, gbase, voff) do { _Pragma("unroll") for (int _i = 0; _i < 2; ++_i) \
        __builtin_amdgcn_global_load_lds((const unsigned*)((const char*)(gbase) + (voff)[_i]), (PG8_LAS unsigned*)(lds + (bufoff) + ldsw + _i * 8192), 16, 0, 0); } while (0)
#define PG8_LDA(dst, b, h) do { _Pragma("unroll") for (int m = 0; m < 4; ++m) _Pragma("unroll") for (int k = 0; k < 2; ++k) dst[m][k] = *(const PG8_LAS bf16x8*)(lds + PG8_SA(b, h) + aoff + m * 2048 + k * 1024); } while (0)
#define PG8_LDB(dst, b, h) do { _Pragma("unroll") for (int n = 0; n < 2; ++n) _Pragma("unroll") for (int k = 0; k < 2; ++k) dst[n][k] = *(const PG8_LAS bf16x8*)(lds + PG8_SB(b, h) + boff + n * 2048 + k * 1024); } while (0)
#define PG8_MMA(ai, bj, At, Bt) do { __builtin_amdgcn_s_setprio(1); _Pragma("unroll") for (int m = 0; m < 4; ++m) _Pragma("unroll") for (int n = 0; n < 2; ++n) _Pragma("unroll") for (int k = 0; k < 2; ++k) \
        acc[ai][bj][m][n] = __builtin_amdgcn_mfma_f32_16x16x32_bf16(Bt[n][k], At[m][k], acc[ai][bj][m][n], 0, 0, 0); __builtin_amdgcn_s_setprio(0); } while (0)
#define PG8_WAIT_V(n) asm volatile("s_waitcnt vmcnt(" #n ")" ::: "memory")
#define PG8_WAIT_L(n) asm volatile("s_waitcnt lgkmcnt(" #n ")" ::: "memory")
#define PG8_BAR __builtin_amdgcn_s_barrier()
#define PG8_SCHED __builtin_amdgcn_sched_barrier(0)
    Unit cur, nxt; int ui = 0;
    if (!S.next(0, cur)) return;
    f32x4 acc[2][2][4][2];
#pragma unroll
    for (int a = 0; a < 2; ++a)
#pragma unroll
        for (int b = 0; b < 2; ++b)
#pragma unroll
            for (int m = 0; m < 4; ++m)
#pragma unroll
                for (int n = 0; n < 2; ++n) acc[a][b][m][n] = (f32x4){0.f, 0.f, 0.f, 0.f};
    bf16x8 At[4][2], B0[2][2], B1[2][2];
    const char* cA = (const char*)g.A + (size_t)cur.pm * tstep; const char* cB = (const char*)g.Bt + (size_t)cur.pn * tstep;
    S.a_ready(cur);
    PG8_STAGE(PG8_SB(0, 0), cB, voffB); PG8_STAGE(PG8_SA(0, 0), cA, voffA); PG8_STAGE(PG8_SB(0, 1), cB + hstep, voffB); PG8_STAGE(PG8_SA(0, 1), cA + hstep, voffA);
    if (wr == 1) PG8_BAR;
    PG8_WAIT_V(4); PG8_BAR;
    PG8_STAGE(PG8_SB(1, 0), cB + kstep, voffB); PG8_STAGE(PG8_SA(1, 0), cA + kstep, voffA); PG8_STAGE(PG8_SB(1, 1), cB + hstep + kstep, voffB);
    PG8_WAIT_V(6); PG8_BAR;
    for (;;) {
        const bool has_next = S.next(ui + 1, nxt);
        const char* nA = has_next ? (const char*)g.A + (size_t)nxt.pm * tstep : cA; const char* nB = has_next ? (const char*)g.Bt + (size_t)nxt.pn * tstep : cB;
        for (int t = 0; t < nt; t += 2) {
            const bool last = (t == nt - 2);
            const char* a1 = cA + (size_t)(t + 1) * kstep;
            const char* a2 = last ? nA : cA + (size_t)(t + 2) * kstep; const char* b2 = last ? nB : cB + (size_t)(t + 2) * kstep;
            const char* a3 = a2 + kstep; const char* b3 = b2 + kstep;
            if (last && has_next) S.a_ready(nxt);
            PG8_LDB(B0, 0, 0); PG8_SCHED; PG8_LDA(At, 0, 0); PG8_STAGE(PG8_SA(1, 1), a1 + hstep, voffA);
            PG8_WAIT_L(8); PG8_BAR; PG8_WAIT_L(0); PG8_MMA(0, 0, At, B0); PG8_BAR; PG8_SCHED;
            PG8_LDB(B1, 0, 1); PG8_STAGE(PG8_SB(0, 0), b2, voffB);
            PG8_BAR; PG8_WAIT_L(0); PG8_MMA(0, 1, At, B1); PG8_BAR;
            PG8_LDA(At, 0, 1); PG8_STAGE(PG8_SA(0, 0), a2, voffA);
            PG8_BAR; PG8_WAIT_L(0); PG8_MMA(1, 0, At, B0); PG8_BAR; PG8_SCHED;
            PG8_STAGE(PG8_SB(0, 1), b2 + hstep, voffB);
            PG8_WAIT_V(6); PG8_BAR; PG8_MMA(1, 1, At, B1); PG8_BAR;
            PG8_LDB(B0, 1, 0); PG8_SCHED; PG8_LDA(At, 1, 0); PG8_STAGE(PG8_SA(0, 1), a2 + hstep, voffA);
            PG8_WAIT_L(8); PG8_BAR; PG8_WAIT_L(0); PG8_MMA(0, 0, At, B0); PG8_BAR; PG8_SCHED;
            PG8_LDB(B1, 1, 1); PG8_STAGE(PG8_SB(1, 0), b3, voffB);
            PG8_BAR; PG8_WAIT_L(0); PG8_MMA(0, 1, At, B1); PG8_BAR;
            PG8_LDA(At, 1, 1); PG8_STAGE(PG8_SA(1, 0), a3, voffA);
            PG8_BAR; PG8_WAIT_L(0); PG8_MMA(1, 0, At, B0); PG8_BAR; PG8_SCHED;
            PG8_STAGE(PG8_SB(1, 1), b3 + hstep, voffB);
            PG8_WAIT_V(6); PG8_BAR; PG8_MMA(1, 1, At, B1); PG8_BAR;
        }
        if constexpr (!Epi::AFTER_DRAIN) { E(acc, cur, wr, wc, fr, fq); S.done(cur); }
        if (!has_next) break;
#pragma unroll
        for (int a = 0; a < 2; ++a)
#pragma unroll
            for (int b = 0; b < 2; ++b)
#pragma unroll
                for (int m = 0; m < 4; ++m)
#pragma unroll
                    for (int n = 0; n < 2; ++n) acc[a][b][m][n] = (f32x4){0.f, 0.f, 0.f, 0.f};
        cur = nxt; cA = nA; cB = nB; ++ui;
    }
    PG8_WAIT_V(0);
    if (wr == 0) PG8_BAR;
    PG8_BAR;
    if constexpr (Epi::AFTER_DRAIN) { E.fused(acc, cur, wr, wc, fr, fq, lds, wid, lane); S.done(cur); }
#undef PG8_SA
#undef PG8_SB
#undef PG8_STAGE
#undef PG8_LDA
#undef PG8_LDB
#undef PG8_MMA
#undef PG8_WAIT_V
#undef PG8_WAIT_L
#undef PG8_BAR
#undef PG8_SCHED
}
}

using pg8::bf16_t; using pg8::bf16x8; using pg8::f32x4; using pg8::u32x4; using pg8::cvt_pk_bf16; using pg8::silu_f;
#define LAS __attribute__((address_space(3)))
typedef unsigned u32x2 __attribute__((ext_vector_type(2)));
typedef short s16x4 __attribute__((ext_vector_type(4)));
#define MFMA16(a, b, c) __builtin_amdgcn_mfma_f32_16x16x32_bf16((a), (b), (c), 0, 0, 0)

constexpr int NTHR = 512;
constexpr int MTOK = 32768, DM = 1024, SEQ = 2048, DFF = 2816, DEPTH = 4, MODW = 9216;
constexpr float DN_ALPHA = 1.6817928305074290861f;
constexpr size_t MiB = (size_t)1 << 20;
constexpr size_t SZ_FFN_IN = (size_t)5632 * 1024 * 2, SZ_FFN_OUT = (size_t)1024 * 2816 * 2, SZ_RET_IN = (size_t)6144 * 1024 * 2, SZ_RET_OUT = (size_t)1024 * 2048 * 2,
                 SZ_NSA_IN = (size_t)2816 * 1024 * 2, SZ_NSA_OUT = (size_t)1024 * 1024 * 2, SZ_W1 = (size_t)256 * 2048 * 2, SZ_W2 = (size_t)64 * 256 * 2;
constexpr size_t OFF_FFN_IN = 0, OFF_FFN_OUT = OFF_FFN_IN + 8 * SZ_FFN_IN, OFF_RET_IN = OFF_FFN_OUT + 8 * SZ_FFN_OUT, OFF_RET_OUT = OFF_RET_IN + 2 * SZ_RET_IN,
                 OFF_NSA_IN = OFF_RET_OUT + 2 * SZ_RET_OUT, OFF_NSA_OUT = OFF_NSA_IN + 2 * SZ_NSA_IN, OFF_W1 = OFF_NSA_OUT + 2 * SZ_NSA_OUT, OFF_W2 = OFF_W1 + 4 * SZ_W1,
                 OFF_MOD = OFF_W2 + 4 * SZ_W2, OFF_H = OFF_MOD + (size_t)DEPTH * 16 * MODW * 4, OFF_U2 = OFF_H + (size_t)MTOK * DM * 2, WS_END = OFF_U2 + 384 * MiB;
constexpr size_t U_FFN_ACT = 0, U_FFN_Y = 192 * MiB;
constexpr size_t U_RET_QKV = 0, U_RET_G = 0, U_RET_O = 256 * MiB, U_RET_Y = 128 * MiB;
constexpr size_t U_NSA_PROJ = 0, U_NSA_Y = 192 * MiB, U_NSA_ACMPK = 256 * MiB, U_NSA_ACMPV = 288 * MiB, U_NSA_HK = 320 * MiB, U_NSA_HV = 324 * MiB, U_NSA_KCMP = 328 * MiB, U_NSA_VCMP = 329 * MiB, U_NSA_OATT = 256 * MiB;
constexpr int XB_LDS_OFF = 152 * 1024, LDS_BYTES = 152 * 1024 + 16;

struct WJob { const float* src; bf16_t* dst; int K, N, Np, mode; };
struct Params {
    const float* x; const float* c; const float* ada_w; const float* ada_b; const float* ln_g; const float* ln_b; const float* pe_k; const float* pe_v;
    float* out; unsigned char* ws;
    WJob jobs[32]; int tile_end[32]; int njobs; int pad;
};

__device__ __forceinline__ float bf2f(unsigned short b) { return __uint_as_float(((unsigned)b) << 16); }
__device__ __forceinline__ float bflo(unsigned w) { return __uint_as_float(w << 16); }
__device__ __forceinline__ float bfhi(unsigned w) { return __uint_as_float(w & 0xffff0000u); }
__device__ __forceinline__ unsigned short f2bf(float f) { return (unsigned short)(cvt_pk_bf16(f, 0.f) & 0xffffu); }
__device__ __forceinline__ bf16x8 pack8(const f32x4& a, const f32x4& b) { u32x4 w; w.x = cvt_pk_bf16(a[0], a[1]); w.y = cvt_pk_bf16(a[2], a[3]); w.z = cvt_pk_bf16(b[0], b[1]); w.w = cvt_pk_bf16(b[2], b[3]); return __builtin_bit_cast(bf16x8, w); }
__device__ __forceinline__ u32x2 pack4(const f32x4& a) { u32x2 w; w.x = cvt_pk_bf16(a[0], a[1]); w.y = cvt_pk_bf16(a[2], a[3]); return w; }
__device__ __forceinline__ bf16x8 lds_rd16(LAS unsigned char* lds, int off) { return *(const LAS bf16x8*)(lds + off); }
__device__ __forceinline__ bf16x8 lds_rd8x2(LAS unsigned char* lds, int off) { const s16x4 lo = *(const LAS s16x4*)(lds + off), hi = *(const LAS s16x4*)(lds + off + 32); return __builtin_shufflevector(lo, hi, 0, 1, 2, 3, 4, 5, 6, 7); }
template <int M> __device__ __forceinline__ float shx(float v, int lane) {
    if (M < 32) return __int_as_float(__builtin_amdgcn_ds_swizzle(__float_as_int(v), (M << 10) | 0x1f));
    return __int_as_float(__builtin_amdgcn_ds_bpermute((lane ^ M) << 2, __float_as_int(v)));
}
template <int M> __device__ __forceinline__ unsigned shxu(unsigned v, int lane) {
    if (M < 32) return (unsigned)__builtin_amdgcn_ds_swizzle((int)v, (M << 10) | 0x1f);
    return (unsigned)__builtin_amdgcn_ds_bpermute((lane ^ M) << 2, (int)v);
}
__device__ __forceinline__ float shi(float v, int src_lane) { return __int_as_float(__builtin_amdgcn_ds_bpermute(src_lane << 2, __float_as_int(v))); }
__device__ __forceinline__ float wsum(float v, int lane) { v += shx<32>(v, lane); v += shx<16>(v, lane); v += shx<8>(v, lane); v += shx<4>(v, lane); v += shx<2>(v, lane); v += shx<1>(v, lane); return v; }

__device__ __forceinline__ void wt_tile(const WJob& J, int t, LAS float* T) {
    int tid = threadIdx.x; asm volatile("" : "+v"(tid));
    const int ntn = J.Np >> 6; const int tn = t % ntn, tk = t / ntn; const int n0 = tn * 64, k0 = tk * 64;
    int sbase = n0; if (J.mode == 1) { const int pn = n0 >> 8, r = n0 & 255; sbase = (r >> 7) * DFF + pn * 128 + (r & 127); }
    const int kk = tid >> 4, nn = (tid & 15) * 4;
#pragma unroll
    for (int rep = 0; rep < 2; ++rep) { const int k = kk + rep * 32; f32x4 v = (f32x4){0.f, 0.f, 0.f, 0.f};
        if (sbase + nn < J.N) v = *(const f32x4*)(J.src + (size_t)(k0 + k) * J.N + sbase + nn);
        T[k * 65 + nn] = v[0]; T[k * 65 + nn + 1] = v[1]; T[k * 65 + nn + 2] = v[2]; T[k * 65 + nn + 3] = v[3]; }
    __syncthreads();
    const int n = tid >> 3, k8 = (tid & 7) * 8;
    f32x4 a, b;
    a[0] = T[(k8 + 0) * 65 + n]; a[1] = T[(k8 + 1) * 65 + n]; a[2] = T[(k8 + 2) * 65 + n]; a[3] = T[(k8 + 3) * 65 + n];
    b[0] = T[(k8 + 4) * 65 + n]; b[1] = T[(k8 + 5) * 65 + n]; b[2] = T[(k8 + 6) * 65 + n]; b[3] = T[(k8 + 7) * 65 + n];
    *(bf16x8*)(J.dst + (size_t)(n0 + n) * J.K + k0 + k8) = pack8(a, b);
    __syncthreads();
}

__device__ __forceinline__ void phase_prep(const Params& p, LAS unsigned char* lds) {
    int tid = threadIdx.x; asm volatile("" : "+v"(tid));
    LAS float* T = (LAS float*)lds;
    const int ntiles = p.tile_end[p.njobs - 1];
    for (int t = blockIdx.x; t < ntiles; t += gridDim.x) {
        int j = 0; while (j < p.njobs - 1 && t >= p.tile_end[j]) ++j;
        const int t0 = j ? p.tile_end[j - 1] : 0;
        wt_tile(p.jobs[j], t - t0, T);
    }
    if (blockIdx.x < 288) {
        LAS float* cs = (LAS float*)lds;
        LAS float* red = (LAS float*)(lds + 65536);
        float* mod = (float*)(p.ws + OFF_MOD);
        __syncthreads();
        for (int idx = tid; idx < 16 * 1024; idx += NTHR) { const int b = idx >> 10, k = idx & 1023; const float cv = p.c[idx]; cs[k * 16 + b] = cv / (1.0f + expf(-cv)); }
        __syncthreads();
        for (int unit = blockIdx.x; unit < 288; unit += gridDim.x) {
            const int i = unit / 72, n0 = (unit % 72) * 128, col = tid & 127, kq = tid >> 7;
            f32x4 a0 = (f32x4){0.f, 0.f, 0.f, 0.f}, a1 = a0, a2 = a0, a3 = a0;
            const float* wp = p.ada_w + ((size_t)i * 1024 + kq * 256) * MODW + n0 + col;
#pragma unroll 4
            for (int k = 0; k < 256; ++k) { const float w = wp[(size_t)k * MODW]; const LAS f32x4* cp = (const LAS f32x4*)(cs + (kq * 256 + k) * 16);
                a0 += cp[0] * w; a1 += cp[1] * w; a2 += cp[2] * w; a3 += cp[3] * w; }
#pragma unroll
            for (int b = 0; b < 4; ++b) { red[(kq * 16 + b) * 128 + col] = a0[b]; red[(kq * 16 + 4 + b) * 128 + col] = a1[b]; red[(kq * 16 + 8 + b) * 128 + col] = a2[b]; red[(kq * 16 + 12 + b) * 128 + col] = a3[b]; }
            __syncthreads();
#pragma unroll
            for (int r = 0; r < 4; ++r) { const int o = tid + r * NTHR, b = o >> 7, cc = o & 127;
                const float s = red[(0 * 16 + b) * 128 + cc] + red[(1 * 16 + b) * 128 + cc] + red[(2 * 16 + b) * 128 + cc] + red[(3 * 16 + b) * 128 + cc] + p.ada_b[i * MODW + n0 + cc];
                mod[((size_t)i * 16 + b) * MODW + n0 + cc] = s; }
            __syncthreads();
        }
    }
}

__device__ __forceinline__ void phase_init(const Params& p) {
    const float* mod = (const float*)(p.ws + OFF_MOD); bf16_t* H = (bf16_t*)(p.ws + OFF_H);
    int tid = threadIdx.x; asm volatile("" : "+v"(tid));
    for (size_t i = (size_t)blockIdx.x * NTHR + tid; i < (size_t)MTOK * 256; i += (size_t)gridDim.x * NTHR) {
        const int row = (int)(i >> 8), c4 = (int)(i & 255) * 4, b = row >> 11;
        const f32x4 xv = *(const f32x4*)(p.x + i * 4); *(f32x4*)(p.out + i * 4) = xv;
        const float* m = mod + (size_t)b * MODW; const f32x4 sh = *(const f32x4*)(m + c4), sc = *(const f32x4*)(m + 1024 + c4);
        const f32x4 h = xv * (sc + 1.0f) + sh; *(u32x2*)(H + i * 4) = pack4(h);
    }
}

__device__ __forceinline__ void phase_ln(float* xio, float* xout, const bf16_t* y, const float* modG, float rw, const float* lng, const float* lnb, const float* modSh, const float* modSc, bf16_t* H) {
    int tid = threadIdx.x; asm volatile("" : "+v"(tid));
    const int wid = __builtin_amdgcn_readfirstlane(tid >> 6), lane = tid & 63;
    for (int row = blockIdx.x * 8 + wid; row < MTOK; row += gridDim.x * 8) {
        const int b = row >> 11; const size_t rb = (size_t)row * DM;
        f32x4 z[4]; float s = 0.f;
#pragma unroll
        for (int q = 0; q < 4; ++q) { const int c = q * 256 + lane * 4; const f32x4 xv = *(const f32x4*)(xio + rb + c); const u32x2 yv = *(const u32x2*)(y + rb + c);
            const f32x4 gt = *(const f32x4*)(modG + (size_t)b * MODW + c); const f32x4 yf = (f32x4){bflo(yv.x), bfhi(yv.x), bflo(yv.y), bfhi(yv.y)};
            z[q] = xv * DN_ALPHA + (gt + 1.0f) * yf * rw; s += (z[q][0] + z[q][1]) + (z[q][2] + z[q][3]); }
        const float mu = wsum(s, lane) * (1.0f / 1024.0f); float v = 0.f;
#pragma unroll
        for (int q = 0; q < 4; ++q) { const f32x4 d = z[q] - mu; v += (d[0] * d[0] + d[1] * d[1]) + (d[2] * d[2] + d[3] * d[3]); }
        const float rstd = rsqrtf(wsum(v, lane) * (1.0f / 1024.0f) + 1e-5f);
#pragma unroll
        for (int q = 0; q < 4; ++q) { const int c = q * 256 + lane * 4; const f32x4 g4 = *(const f32x4*)(lng + c), b4 = *(const f32x4*)(lnb + c);
            const f32x4 xn = (z[q] - mu) * rstd * g4 + b4; *(f32x4*)(xout + rb + c) = xn;
            const f32x4 sh = *(const f32x4*)(modSh + (size_t)b * MODW + c), sc = *(const f32x4*)(modSc + (size_t)b * MODW + c);
            *(u32x2*)(H + rb + c) = pack4(xn * (sc + 1.0f) + sh); }
    }
}

__device__ __forceinline__ void phase_ret_core(const bf16_t* QKV, bf16_t* O, LAS unsigned char* lds) {
    constexpr int PS = 136, STS = 264, OFF_P = 0, OFF_VT = 34816, OFF_KT = 52224, OFF_ST = 121856;
    int tid = threadIdx.x; asm volatile("" : "+v"(tid));
    const int wid = __builtin_amdgcn_readfirstlane(tid >> 6), lane = tid & 63, fr = lane & 15, fq = lane >> 4;
    for (int item = blockIdx.x; item < 512; item += gridDim.x) {
        const int es = item & 7, bh = item >> 3, hh = bh & 3, b = bh >> 2, e0 = es * 64;
        const float log_g = logf(1.0f - exp2f(-5.0f - (float)hh));
        const float gN = expf(log_g * 128.0f);
        __syncthreads();
        for (int i = tid; i < 64 * STS / 2; i += NTHR) ((LAS unsigned*)(lds + OFF_ST))[i] = 0u;
        f32x4 sacc[2][4];
#pragma unroll
        for (int dt = 0; dt < 2; ++dt)
#pragma unroll
            for (int et = 0; et < 4; ++et) sacc[dt][et] = (f32x4){0.f, 0.f, 0.f, 0.f};
        const float l2g = log_g * 1.44269504089f;
        const int sc0 = tid & 127, spc0 = tid >> 7; const float kfac = 0.0625f * __builtin_amdgcn_exp2f(l2g * (float)(127 - sc0));
        bf16x8 kst[8], vst[2];
        {   const bf16_t* krow = QKV + ((size_t)b * SEQ + sc0) * 4096 + 1024 + hh * 256; const bf16_t* vrow = QKV + ((size_t)b * SEQ + sc0) * 4096 + 2048 + hh * 512 + e0;
#pragma unroll
            for (int it = 0; it < 8; ++it) kst[it] = *(const bf16x8*)(krow + (spc0 + 4 * it) * 8);
#pragma unroll
            for (int it = 0; it < 2; ++it) vst[it] = *(const bf16x8*)(vrow + (spc0 + 4 * it) * 8); }
        for (int n = 0; n < 16; ++n) {
            const size_t tok0 = (size_t)b * SEQ + n * 128;
            int t2 = tid; asm volatile("" : "+v"(t2));
            const int sc_ = t2 & 127, spc = t2 >> 7, lane = t2 & 63, fr = lane & 15, fq = lane >> 4;
            {
#pragma unroll
                for (int it = 0; it < 8; ++it) { const int d0 = (spc + 4 * it) * 8;
#pragma unroll
                    for (int i = 0; i < 8; ++i) *(LAS bf16_t*)(lds + OFF_KT + ((d0 + i) * PS + sc_) * 2) = f2bf(bf2f((unsigned short)kst[it][i]) * kfac); }
#pragma unroll
                for (int it = 0; it < 2; ++it) { const int e = (spc + 4 * it) * 8;
#pragma unroll
                    for (int i = 0; i < 8; ++i) *(LAS bf16_t*)(lds + OFF_VT + ((e + i) * PS + sc_) * 2) = (bf16_t)vst[it][i]; }
            }
            const int cc = wid * 16 + fr;
            bf16x8 qf[8];
            { const bf16_t* qrow = QKV + (tok0 + cc) * 4096 + hh * 256 + fq * 8;
#pragma unroll
              for (int ks = 0; ks < 8; ++ks) qf[ks] = *(const bf16x8*)(qrow + ks * 32); }
            const int npair = (wid >> 1) + 1;
            for (int cp2 = 0; cp2 < npair; ++cp2) {
                const bf16_t* kr0 = QKV + (tok0 + cp2 * 32 + fr) * 4096 + 1024 + hh * 256 + fq * 8; const bf16_t* kr1 = kr0 + (size_t)16 * 4096;
                bf16x8 k0[8], k1[8];
#pragma unroll
                for (int ks = 0; ks < 8; ++ks) { k0[ks] = *(const bf16x8*)(kr0 + ks * 32); k1[ks] = *(const bf16x8*)(kr1 + ks * 32); }
                f32x4 acc0 = (f32x4){0.f, 0.f, 0.f, 0.f}, acc1 = acc0;
#pragma unroll
                for (int ks = 0; ks < 8; ++ks) { acc0 = MFMA16(k0[ks], qf[ks], acc0); acc1 = MFMA16(k1[ks], qf[ks], acc1); }
                f32x4 pv0, pv1;
#pragma unroll
                for (int j = 0; j < 4; ++j) { const int cp = cp2 * 32 + fq * 4 + j;
                    pv0[j] = (cc >= cp) ? acc0[j] * 0.0625f * __builtin_amdgcn_exp2f(l2g * (float)(cc - cp)) : 0.f;
                    pv1[j] = (cc >= cp + 16) ? acc1[j] * 0.0625f * __builtin_amdgcn_exp2f(l2g * (float)(cc - cp - 16)) : 0.f; }
                *(LAS u32x2*)(lds + OFF_P + (cc * PS + cp2 * 32 + fq * 4) * 2) = pack4(pv0);
                *(LAS u32x2*)(lds + OFF_P + (cc * PS + cp2 * 32 + 16 + fq * 4) * 2) = pack4(pv1);
            }
            if (n < 15) { const bf16_t* krow = QKV + (tok0 + 128 + sc_) * 4096 + 1024 + hh * 256; const bf16_t* vrow = QKV + (tok0 + 128 + sc_) * 4096 + 2048 + hh * 512 + e0;
#pragma unroll
                    for (int it = 0; it < 8; ++it) kst[it] = *(const bf16x8*)(krow + (spc + 4 * it) * 8);
#pragma unroll
                    for (int it = 0; it < 2; ++it) vst[it] = *(const bf16x8*)(vrow + (spc + 4 * it) * 8); }
            __syncthreads();
            {
                f32x4 a1[4], a2[4];
#pragma unroll
                for (int et = 0; et < 4; ++et) { a1[et] = (f32x4){0.f, 0.f, 0.f, 0.f}; a2[et] = a1[et]; }
                const int ksmax = wid >> 1;
                for (int ks = 0; ks <= ksmax; ++ks) { const bf16x8 pf = lds_rd16(lds, OFF_P + (cc * PS + ks * 32 + fq * 8) * 2);
#pragma unroll
                    for (int et = 0; et < 4; ++et) a1[et] = MFMA16(lds_rd16(lds, OFF_VT + ((et * 16 + fr) * PS + ks * 32 + fq * 8) * 2), pf, a1[et]); }
#pragma unroll
                for (int ks = 0; ks < 8; ++ks)
#pragma unroll
                    for (int et = 0; et < 4; ++et) a2[et] = MFMA16(lds_rd16(lds, OFF_ST + ((et * 16 + fr) * STS + ks * 32 + fq * 8) * 2), qf[ks], a2[et]);
                const float dq = __builtin_amdgcn_exp2f(l2g * (float)(cc + 1));
                bf16_t* orow = O + (tok0 + cc) * 2048 + hh * 512 + e0 + fq * 4;
#pragma unroll
                for (int et = 0; et < 4; ++et) *(u32x2*)(orow + et * 16) = pack4(a1[et] + a2[et] * dq);
            }
            __syncthreads();
            if (n < 15) {
#pragma unroll
                for (int dt = 0; dt < 2; ++dt)
#pragma unroll
                    for (int et = 0; et < 4; ++et) sacc[dt][et] *= gN;
#pragma unroll
                for (int ks = 0; ks < 4; ++ks) {
                    bf16x8 vf[4];
#pragma unroll
                    for (int et = 0; et < 4; ++et) vf[et] = lds_rd16(lds, OFF_VT + ((et * 16 + fr) * PS + ks * 32 + fq * 8) * 2);
#pragma unroll
                    for (int dt = 0; dt < 2; ++dt) { const bf16x8 kf = lds_rd16(lds, OFF_KT + (((2 * wid + dt) * 16 + fr) * PS + ks * 32 + fq * 8) * 2);
#pragma unroll
                        for (int et = 0; et < 4; ++et) sacc[dt][et] = MFMA16(kf, vf[et], sacc[dt][et]); }
                }
#pragma unroll
                for (int dt = 0; dt < 2; ++dt)
#pragma unroll
                    for (int et = 0; et < 4; ++et) *(LAS u32x2*)(lds + OFF_ST + ((et * 16 + fr) * STS + (2 * wid + dt) * 16 + fq * 4) * 2) = pack4(sacc[dt][et]);
            }
            __syncthreads();
        }
    }
}

__device__ __forceinline__ void phase_ret_gate(bf16_t* O, const bf16_t* G) {
    int tid = threadIdx.x; asm volatile("" : "+v"(tid));
    const int wid = __builtin_amdgcn_readfirstlane(tid >> 6), lane = tid & 63;
    for (int idx = blockIdx.x * 8 + wid; idx < MTOK * 4; idx += gridDim.x * 8) {
        const size_t base = (size_t)(idx >> 2) * 2048 + (idx & 3) * 512 + lane * 8;
        const u32x4 ov = *(const u32x4*)(O + base), gv = *(const u32x4*)(G + base);
        float o[8] = {bflo(ov.x), bfhi(ov.x), bflo(ov.y), bfhi(ov.y), bflo(ov.z), bfhi(ov.z), bflo(ov.w), bfhi(ov.w)};
        const float g[8] = {bflo(gv.x), bfhi(gv.x), bflo(gv.y), bfhi(gv.y), bflo(gv.z), bfhi(gv.z), bflo(gv.w), bfhi(gv.w)};
        float s = 0.f;
#pragma unroll
        for (int i = 0; i < 8; ++i) s += o[i];
        const float mu = wsum(s, lane) * (1.0f / 512.0f); float v = 0.f;
#pragma unroll
        for (int i = 0; i < 8; ++i) { const float d = o[i] - mu; v += d * d; }
        const float rstd = rsqrtf(wsum(v, lane) * (1.0f / 512.0f) + 1e-6f);
#pragma unroll
        for (int i = 0; i < 8; ++i) o[i] = (o[i] - mu) * rstd * silu_f(g[i]);
        u32x4 w; w.x = cvt_pk_bf16(o[0], o[1]); w.y = cvt_pk_bf16(o[2], o[3]); w.z = cvt_pk_bf16(o[4], o[5]); w.w = cvt_pk_bf16(o[6], o[7]);
        *(u32x4*)(O + base) = w;
    }
}

__device__ __forceinline__ void phase_nsa_mat(const bf16_t* PROJ, const float* pek, const float* pev, bf16_t* AK, bf16_t* AV) {
    const size_t per = (size_t)8128 * 256;
    int tid = threadIdx.x; asm volatile("" : "+v"(tid));
    for (size_t i = (size_t)blockIdx.x * NTHR + tid; i < 2 * per; i += (size_t)gridDim.x * NTHR) {
        const int kv = i >= per; const size_t rem = kv ? i - per : i; const int r = (int)(rem >> 8), pp = (int)(rem & 255), l = pp >> 3, d0 = (pp & 7) * 8;
        const int g = r & 3, bn = r >> 2, b = bn / 127, n = bn % 127;
        const u32x4 v = *(const u32x4*)(PROJ + ((size_t)b * SEQ + n * 16 + l) * 2816 + 1024 + kv * 256 + g * 64 + d0);
        const float* pe = (kv ? pev : pek) + l * 64 + d0; const f32x4 p0 = *(const f32x4*)pe, p1 = *(const f32x4*)(pe + 4);
        u32x4 w; w.x = cvt_pk_bf16(bflo(v.x) + p0[0], bfhi(v.x) + p0[1]); w.y = cvt_pk_bf16(bflo(v.y) + p0[2], bfhi(v.y) + p0[3]);
        w.z = cvt_pk_bf16(bflo(v.z) + p1[0], bfhi(v.z) + p1[1]); w.w = cvt_pk_bf16(bflo(v.w) + p1[2], bfhi(v.w) + p1[3]);
        *(u32x4*)((kv ? AV : AK) + (size_t)r * 2048 + l * 64 + d0) = w;
    }
}
__device__ __forceinline__ void phase_nsa_cmp2(const bf16_t* HK, const bf16_t* HV, const bf16_t* W2K, const bf16_t* W2V, bf16_t* KC, bf16_t* VC) {
    int tid = threadIdx.x; asm volatile("" : "+v"(tid));
    const int wid = __builtin_amdgcn_readfirstlane(tid >> 6), lane = tid & 63, fr = lane & 15, fq = lane >> 4;
    for (int tt = blockIdx.x * 8 + wid; tt < 508 * 2; tt += gridDim.x * 8) {
        const int kv = tt >= 508, rt = kv ? tt - 508 : tt; const bf16_t* Hd = kv ? HV : HK; const bf16_t* W = kv ? W2V : W2K; bf16_t* Od = kv ? VC : KC;
        f32x4 acc[4];
#pragma unroll
        for (int nt = 0; nt < 4; ++nt) acc[nt] = (f32x4){0.f, 0.f, 0.f, 0.f};
#pragma unroll
        for (int ks = 0; ks < 8; ++ks) { const bf16x8 hf = *(const bf16x8*)(Hd + (size_t)(rt * 16 + fr) * 256 + ks * 32 + fq * 8);
#pragma unroll
            for (int nt = 0; nt < 4; ++nt) acc[nt] = MFMA16(*(const bf16x8*)(W + (size_t)(nt * 16 + fr) * 256 + ks * 32 + fq * 8), hf, acc[nt]); }
#pragma unroll
        for (int nt = 0; nt < 4; ++nt) *(u32x2*)(Od + (size_t)(rt * 16 + fr) * 64 + nt * 16 + fq * 4) = pack4(acc[nt]);
    }
}

struct AttnCtx { int b, g, cur, head, hp, t; float slope; bf16x8 qf[2]; float gate[3]; unsigned selq; unsigned anym; };
constexpr int A_KS = 72, A_VS = 68, A_KCS = 72, A_VCS = 136, A_KBYTES = 9216, A_VBYTES = 8704, A_OFF_K = 0, A_OFF_VT = 18432, A_OFF_KC = 35840, A_OFF_VCT = 54272, A_OFF_IMP = 71680, A_OFF_SEL = 88576, A_OFF_SELP = 88704;

template <int BR>
__device__ __forceinline__ void attn_branch(const bf16_t* PROJ, LAS unsigned char* lds, const AttnCtx& C, f32x4 (&otot)[4], int tid) {
    const int lane = tid & 63, fr = lane & 15, fq = lane >> 4;
    const float qs = 0.125f * 1.44269504089f, slope2 = C.slope * 1.44269504089f;
    f32x4 sl[4];
#pragma unroll
    for (int kt = 0; kt < 4; ++kt)
#pragma unroll
        for (int jj = 0; jj < 4; ++jj) sl[kt][jj] = slope2 * (float)(kt * 16 + jj);
    float m_ = -1e30f, l_ = 0.f;
    f32x4 oa[4];
#pragma unroll
    for (int dt = 0; dt < 4; ++dt) oa[dt] = (f32x4){0.f, 0.f, 0.f, 0.f};
    const int jlo = (BR == 1) ? 0 : (C.cur > 8 ? C.cur - 8 : 0);
    const int koff = (BR == 1 ? 1536 : 2048) + C.g * 64, voff = (BR == 1 ? 1792 : 2304) + C.g * 64;
    const int key = tid >> 3, d0 = (tid & 7) * 8;
    const bf16_t* srcb = PROJ + ((size_t)C.b * SEQ + key) * 2816 + d0;
    int j = jlo;
    if (BR == 1) { while (j <= C.cur && !((C.anym >> j) & 1u)) ++j; }
    bf16x8 kreg = *(const bf16x8*)(srcb + (size_t)j * 64 * 2816 + koff), vreg = *(const bf16x8*)(srcb + (size_t)j * 64 * 2816 + voff);
    __syncthreads();
    int buf = 0;
    { *(LAS bf16x8*)(lds + A_OFF_K + (key * A_KS + d0) * 2) = kreg;
#pragma unroll
      for (int i = 0; i < 8; ++i) *(LAS bf16_t*)(lds + A_OFF_VT + ((d0 + i) * A_VS + key) * 2) = (bf16_t)vreg[i]; }
    __syncthreads();
    while (j <= C.cur) {
        int jn = j + 1;
        if (BR == 1) { while (jn <= C.cur && !((C.anym >> jn) & 1u)) ++jn; }
        const bool more = jn <= C.cur;
        if (more) { kreg = *(const bf16x8*)(srcb + (size_t)jn * 64 * 2816 + koff); vreg = *(const bf16x8*)(srcb + (size_t)jn * 64 * 2816 + voff); }
        const int kb = A_OFF_K + buf * A_KBYTES, vb = A_OFF_VT + buf * A_VBYTES;
        f32x4 s4[4]; float alpha;
        const int dbase = C.t - j * 64 - fq * 4;
        const bool partial = (j == C.cur) || (BR == 2 && j + 8 <= C.cur);
        if (partial) {
            float tmax = -1e30f;
#pragma unroll
            for (int kt = 0; kt < 4; ++kt) { f32x4 acc = (f32x4){0.f, 0.f, 0.f, 0.f};
#pragma unroll
                for (int ks = 0; ks < 2; ++ks) acc = MFMA16(lds_rd16(lds, kb + ((kt * 16 + fr) * A_KS + ks * 32 + fq * 8) * 2), C.qf[ks], acc);
#pragma unroll
                for (int jj = 0; jj < 4; ++jj) { const int dist = dbase - (kt * 16 + jj);
                    const bool ok = (dist >= 0) && (BR == 1 ? (((C.selq >> j) & 1u) != 0u) : (dist < 512));
                    const float s = ok ? acc[jj] * qs - slope2 * (float)dist : -1e30f; s4[kt][jj] = s; tmax = fmaxf(tmax, s); } }
            tmax = fmaxf(tmax, shx<16>(tmax, lane)); tmax = fmaxf(tmax, shx<32>(tmax, lane));
            const float mnew = fmaxf(m_, tmax); alpha = __builtin_amdgcn_exp2f(m_ - mnew); m_ = mnew;
            float psum = 0.f;
#pragma unroll
            for (int kt = 0; kt < 4; ++kt)
#pragma unroll
                for (int jj = 0; jj < 4; ++jj) { const float pp = (s4[kt][jj] > -1e29f) ? __builtin_amdgcn_exp2f(s4[kt][jj] - mnew) : 0.f; s4[kt][jj] = pp; psum += pp; }
            l_ = l_ * alpha + psum;
        } else {
            float c0 = -slope2 * (float)dbase;
            if (BR == 1 && !((C.selq >> j) & 1u)) c0 = -1e30f;
            float tmax = -1e30f;
#pragma unroll
            for (int kt = 0; kt < 4; ++kt) { f32x4 acc = (f32x4){0.f, 0.f, 0.f, 0.f};
#pragma unroll
                for (int ks = 0; ks < 2; ++ks) acc = MFMA16(lds_rd16(lds, kb + ((kt * 16 + fr) * A_KS + ks * 32 + fq * 8) * 2), C.qf[ks], acc);
#pragma unroll
                for (int jj = 0; jj < 4; ++jj) { const float u = acc[jj] * qs + sl[kt][jj]; s4[kt][jj] = u; tmax = fmaxf(tmax, u); } }
            tmax += c0;
            tmax = fmaxf(tmax, shx<16>(tmax, lane)); tmax = fmaxf(tmax, shx<32>(tmax, lane));
            const float mnew = fmaxf(m_, tmax); alpha = __builtin_amdgcn_exp2f(m_ - mnew); m_ = mnew;
            const float sh = mnew - c0; float psum = 0.f;
#pragma unroll
            for (int kt = 0; kt < 4; ++kt)
#pragma unroll
                for (int jj = 0; jj < 4; ++jj) { const float pp = __builtin_amdgcn_exp2f(s4[kt][jj] - sh); s4[kt][jj] = pp; psum += pp; }
            l_ = l_ * alpha + psum;
        }
#pragma unroll
        for (int dt = 0; dt < 4; ++dt) oa[dt] *= alpha;
#pragma unroll
        for (int ks2 = 0; ks2 < 2; ++ks2) { const bf16x8 pf = pack8(s4[2 * ks2], s4[2 * ks2 + 1]);
#pragma unroll
            for (int dt = 0; dt < 4; ++dt) oa[dt] = MFMA16(lds_rd8x2(lds, vb + ((dt * 16 + fr) * A_VS + ks2 * 32 + fq * 4) * 2), pf, oa[dt]); }
        if (more) { const int kb2 = A_OFF_K + (buf ^ 1) * A_KBYTES, vb2 = A_OFF_VT + (buf ^ 1) * A_VBYTES;
            *(LAS bf16x8*)(lds + kb2 + (key * A_KS + d0) * 2) = kreg;
#pragma unroll
            for (int i = 0; i < 8; ++i) *(LAS bf16_t*)(lds + vb2 + ((d0 + i) * A_VS + key) * 2) = (bf16_t)vreg[i]; }
        __syncthreads();
        buf ^= 1; j = jn;
    }
    float lt = l_; lt += shx<16>(lt, lane); lt += shx<32>(lt, lane); const float inv = lt > 0.f ? C.gate[BR] / lt : 0.f;
#pragma unroll
    for (int dt = 0; dt < 4; ++dt) otot[dt] += oa[dt] * inv;
}

__device__ __forceinline__ void phase_nsa_attn(const bf16_t* PROJ, const bf16_t* KCMP, const bf16_t* VCMP, bf16_t* OATT, LAS unsigned char* lds) {
    int tid = threadIdx.x; asm volatile("" : "+v"(tid));
    const int wid = __builtin_amdgcn_readfirstlane(tid >> 6), lane = tid & 63, fr = lane & 15, fq = lane >> 4;
    LAS float* IMP = (LAS float*)(lds + A_OFF_IMP); LAS unsigned* SEL = (LAS unsigned*)(lds + A_OFF_SEL); LAS unsigned* SELP = (LAS unsigned*)(lds + A_OFF_SELP);
    for (int id = blockIdx.x; id < 4096; id += gridDim.x) {
        const int k8 = id & 255, ii = id >> 8, bg = k8 & 63, kk = k8 >> 6;
        const int qt32 = (ii & 1) ? 63 - (kk + 4 * (ii - 1)) : kk + 4 * ii;
        AttnCtx C; C.cur = qt32 >> 1; C.b = bg >> 2; C.g = bg & 3; C.hp = wid >> 1; C.head = C.g * 4 + C.hp; C.slope = exp2f(-0.5f * (float)(C.head + 1));
        const int qq = (wid & 1) * 16 + fr; C.t = qt32 * 32 + qq; const size_t trow = (size_t)C.b * SEQ + C.t;
        { const bf16_t* pr = PROJ + trow * 2816;
#pragma unroll
          for (int ks = 0; ks < 2; ++ks) C.qf[ks] = *(const bf16x8*)(pr + C.head * 64 + ks * 32 + fq * 8);
#pragma unroll
          for (int br = 0; br < 3; ++br) C.gate[br] = 1.0f / (1.0f + __expf(-bf2f(pr[2560 + C.head * 3 + br]))); }
#ifdef ONLY_BR
#pragma unroll
        for (int br = 0; br < 3; ++br) if (br != ONLY_BR) C.gate[br] = 0.f;
#endif
        f32x4 otot[4];
#pragma unroll
        for (int dt = 0; dt < 4; ++dt) otot[dt] = (f32x4){0.f, 0.f, 0.f, 0.f};
        __syncthreads();
#pragma unroll
        for (int rep = 0; rep < 2; ++rep) { const int idx = tid + rep * NTHR, n = idx >> 3, d0 = (idx & 7) * 8, nc = n < 126 ? n : 126; const size_t src = ((size_t)(C.b * 127 + nc) * 4 + C.g) * 64 + d0;
            *(LAS bf16x8*)(lds + A_OFF_KC + (n * A_KCS + d0) * 2) = *(const bf16x8*)(KCMP + src);
            const bf16x8 vv = *(const bf16x8*)(VCMP + src);
#pragma unroll
            for (int i = 0; i < 8; ++i) *(LAS bf16_t*)(lds + A_OFF_VCT + ((d0 + i) * A_VCS + n) * 2) = (bf16_t)vv[i]; }
        __syncthreads();
        {
            f32x4 sc[8]; float mx = -1e30f;
#pragma unroll
            for (int kt = 0; kt < 8; ++kt) { f32x4 acc = (f32x4){0.f, 0.f, 0.f, 0.f};
#pragma unroll
                for (int ks = 0; ks < 2; ++ks) acc = MFMA16(lds_rd16(lds, A_OFF_KC + ((kt * 16 + fr) * A_KCS + ks * 32 + fq * 8) * 2), C.qf[ks], acc);
#pragma unroll
                for (int jj = 0; jj < 4; ++jj) { const int n = kt * 16 + fq * 4 + jj, ce = n * 16 + 31; const bool ok = (n <= 126) && (ce <= C.t);
                    const float s = ok ? acc[jj] * 0.125f - C.slope * (float)(C.t - ce) : -1e30f; sc[kt][jj] = s; mx = fmaxf(mx, s); } }
            mx = fmaxf(mx, shx<16>(mx, lane)); mx = fmaxf(mx, shx<32>(mx, lane));
            float sum = 0.f;
#pragma unroll
            for (int kt = 0; kt < 8; ++kt)
#pragma unroll
                for (int jj = 0; jj < 4; ++jj) { const float pp = (sc[kt][jj] > -1e29f) ? __expf(sc[kt][jj] - mx) : 0.f; sc[kt][jj] = pp; sum += pp; }
            sum += shx<16>(sum, lane); sum += shx<32>(sum, lane);
            const float inv = sum > 0.f ? 1.0f / sum : 0.f;
#pragma unroll
            for (int kt = 0; kt < 8; ++kt) sc[kt] *= inv;
#pragma unroll
            for (int kt = 0; kt < 8; ++kt) { const float a = shi(sc[kt][3], (lane + 48) & 63); const float bp = kt > 0 ? shi(sc[kt > 0 ? kt - 1 : 0][3], (lane + 48) & 63) : 0.f;
                const float prev3 = fq > 0 ? a : bp;
                IMP[(C.hp * 32 + qq) * 33 + 4 * kt + fq] = sc[kt][0] + sc[kt][1] + sc[kt][2] + 0.5f * sc[kt][3] + 0.5f * prev3; }
            f32x4 oc[4];
#pragma unroll
            for (int dt = 0; dt < 4; ++dt) oc[dt] = (f32x4){0.f, 0.f, 0.f, 0.f};
#pragma unroll
            for (int ks2 = 0; ks2 < 4; ++ks2) { const bf16x8 pf = pack8(sc[2 * ks2], sc[2 * ks2 + 1]);
#pragma unroll
                for (int dt = 0; dt < 4; ++dt) oc[dt] = MFMA16(lds_rd8x2(lds, A_OFF_VCT + ((dt * 16 + fr) * A_VCS + ks2 * 32 + fq * 4) * 2), pf, oc[dt]); }
#pragma unroll
            for (int dt = 0; dt < 4; ++dt) otot[dt] += oc[dt] * C.gate[0];
        }
        __syncthreads();
        if (C.cur >= 16) {
            const int sq = tid & 31, jg = tid >> 5;
#pragma unroll
            for (int jj = 0; jj < 2; ++jj) { const int j = jg * 2 + jj; const float imp = IMP[(0 * 32 + sq) * 33 + j] + IMP[(1 * 32 + sq) * 33 + j] + IMP[(2 * 32 + sq) * 33 + j] + IMP[(3 * 32 + sq) * 33 + j];
                const bool valid = j <= C.cur, forced = (j == 0) || (j == C.cur) || (j == C.cur - 1);
                IMP[sq * 33 + j] = valid ? (forced ? 1e4f : imp) : -1.0f; }
            __syncthreads();
            unsigned bits = 0u;
#pragma unroll
            for (int jj = 0; jj < 2; ++jj) { const int j = jg * 2 + jj; const float sj = IMP[sq * 33 + j]; int cnt = 0;
                for (int j2 = 0; j2 < 32; ++j2) { const float s2 = IMP[sq * 33 + j2]; cnt += ((s2 > sj) || (s2 == sj && j2 < j)) ? 1 : 0; }
                if (cnt < 16) bits |= 1u << j; }
            SELP[jg * 32 + sq] = bits;
            __syncthreads();
            if (tid < 32) { unsigned m = 0u;
#pragma unroll
                for (int q = 0; q < 16; ++q) m |= SELP[q * 32 + tid];
                SEL[tid] = m; }
        } else { if (tid < 32) SEL[tid] = (2u << C.cur) - 1u; }
        __syncthreads();
        C.selq = SEL[qq];
        { unsigned m = SEL[lane & 31]; m |= shxu<16>(m, lane); m |= shxu<8>(m, lane); m |= shxu<4>(m, lane); m |= shxu<2>(m, lane); m |= shxu<1>(m, lane); C.anym = (unsigned)__builtin_amdgcn_readfirstlane((int)m); }
        attn_branch<1>(PROJ, lds, C, otot, tid);
        attn_branch<2>(PROJ, lds, C, otot, tid);
#pragma unroll
        for (int dt = 0; dt < 4; ++dt) *(u32x2*)(OATT + trow * 1024 + C.head * 64 + dt * 16 + fq * 4) = pack4(otot[dt]);
    }
}

#define XB_TMO      128
#define XB_XCNT(j)  (256  + 64 * (j))
#define XB_XSUB(j)  (1280 + 64 * (j))
#define XB_XGEN(j)  (2304 + 64 * (j))
#define XB_TOP      3328
#define XB_TOPGEN   3392
#define XCD_BAR_WORDS 3456
#define XB_SPIN_CAP (1u << 18)

__device__ __forceinline__ unsigned xb_ld(unsigned* p)              { return __hip_atomic_load(p, __ATOMIC_RELAXED, __HIP_MEMORY_SCOPE_AGENT); }
__device__ __forceinline__ unsigned xb_add(unsigned* p, unsigned v) { return __hip_atomic_fetch_add(p, v, __ATOMIC_RELAXED, __HIP_MEMORY_SCOPE_AGENT); }
__device__ __forceinline__ unsigned xb_xcc_id() { return (unsigned)__builtin_amdgcn_s_getreg((3 << 11) | 20) & 0xFu; }
#define XB_SPIN(cond, bar) do { unsigned _sp = 0; while (cond) { __builtin_amdgcn_s_sleep(1); \
    if ((++_sp & 255u) == 0u) { if (xb_ld(&(bar)[XB_TMO])) break; if (_sp > XB_SPIN_CAP) { atomicAdd(&(bar)[XB_TMO], 1u); break; } } } } while (0)

struct XcdBarrier {
    unsigned* bar; unsigned x;
    volatile LAS unsigned* st;
};

__device__ __forceinline__ XcdBarrier xcd_barrier_post(unsigned* bar, volatile LAS unsigned* st) {
    XcdBarrier b; b.bar = bar; b.x = xb_xcc_id(); b.st = st;
    if (threadIdx.x == 0) (void)xb_add(&bar[XB_XCNT(b.x)], 1u);
    return b;
}
__device__ __forceinline__ void xcd_barrier_complete(unsigned* bar, unsigned x, unsigned& nloc, unsigned& nx) {
    const unsigned G = gridDim.x * gridDim.y * gridDim.z;
    unsigned sum, cnt, mine, sp = 0u;
    for (;;) {
        sum = 0u; cnt = 0u; mine = 0u;
#pragma unroll
        for (unsigned j = 0; j < 16; ++j) { const unsigned c = xb_ld(&bar[XB_XCNT(j)]); sum += c; cnt += (c > 0u) ? 1u : 0u; mine = (j == x) ? c : mine; }
        if (sum == G) break;
        __builtin_amdgcn_s_sleep(1);
        if ((++sp & 255u) == 0u) { if (xb_ld(&bar[XB_TMO])) break; if (sp > XB_SPIN_CAP) { atomicAdd(&bar[XB_TMO], 1u); break; } }
    }
    nloc = mine > 0u ? mine : 1u; nx = cnt > 0u ? cnt : 1u;
}

__device__ __forceinline__ void xcd_barrier(const XcdBarrier& b) {
    asm volatile("s_waitcnt vmcnt(0)" ::: "memory");
    __syncthreads();
    if (threadIdx.x == 0) {
        unsigned* bar = b.bar;
        __builtin_amdgcn_s_waitcnt(0);
        unsigned nloc = b.st[0], nx = b.st[1];
        if (nloc == 0u) { xcd_barrier_complete(bar, b.x, nloc, nx); b.st[0] = nloc; b.st[1] = nx; }
        const unsigned old = xb_add(&bar[XB_XSUB(b.x)], 1u);
        const unsigned gen = old / nloc;
        if (old + 1u == (gen + 1u) * nloc) {
            __builtin_amdgcn_fence(__ATOMIC_RELEASE, "agent");
            asm volatile("s_waitcnt vmcnt(0)" ::: "memory");
            const unsigned og = xb_add(&bar[XB_TOP], 1u);
            const unsigned tg = og / nx;
            if (og + 1u == (tg + 1u) * nx) xb_add(&bar[XB_TOPGEN], 1u);
            else XB_SPIN(xb_ld(&bar[XB_TOPGEN]) == tg, bar);
            __builtin_amdgcn_fence(__ATOMIC_ACQUIRE, "agent");
            xb_add(&bar[XB_XGEN(b.x)], 1u);
            asm volatile("s_waitcnt vmcnt(0)" ::: "memory");
        } else {
            XB_SPIN(xb_ld(&bar[XB_XGEN(b.x)]) == gen, bar);
            __builtin_amdgcn_fence(__ATOMIC_ACQUIRE, "agent");
            asm volatile("s_waitcnt vmcnt(0)" ::: "memory");
        }
    }
    __syncthreads();
}


#ifndef R_CORE
#define R_CORE 1
#endif
#ifndef R_ATTN
#define R_ATTN 1
#endif
#ifndef R_GEMM
#define R_GEMM 1
#endif
#ifndef R_BAR
#define R_BAR 1
#endif
#ifndef R_PREP
#define R_PREP 1
#endif
struct GemmDesc { const bf16_t* A; const bf16_t* Bt; bf16_t* O; int M, N, K, ldc, act, cshift; };
__device__ __forceinline__ void run_gemm(const GemmDesc& d, LAS unsigned char* lds) {
    pg8::Gemm g{d.A, d.Bt, d.M, d.N, d.K}; pg8::StaticOrder S; const int G = (int)gridDim.x; S.init(d.M, d.N, G, ((int)blockIdx.x + G - d.cshift % G) % G);
    if (d.act == 0) { pg8::Epi<0> E{d.O, d.ldc}; pg8::gemm_phase<pg8::Epi<0>, pg8::StaticOrder>(lds, g, S, E); }
    else if (d.act == 1) { pg8::Epi<1> E{d.O, d.ldc}; pg8::gemm_phase<pg8::Epi<1>, pg8::StaticOrder>(lds, g, S, E); }
    else { pg8::Epi<2> E{d.O, d.ldc}; pg8::gemm_phase<pg8::Epi<2>, pg8::StaticOrder>(lds, g, S, E); }
}

__global__ void __launch_bounds__(NTHR) fwd_megakernel(Params p) {
    extern __shared__ __attribute__((aligned(16))) unsigned char smem[];
    LAS unsigned char* lds = (LAS unsigned char*)smem;
    cg::grid_group grid = cg::this_grid();
    unsigned char* ws = p.ws; unsigned char* U = ws + OFF_U2;
    const float* mod = (const float*)(ws + OFF_MOD); bf16_t* H = (bf16_t*)(ws + OFF_H);
    if (threadIdx.x < 4) ((LAS unsigned*)(lds + XB_LDS_OFF))[threadIdx.x] = 0u;
    __syncthreads();
    XcdBarrier xbar = xcd_barrier_post((unsigned*)(ws + WS_END), (volatile LAS unsigned*)(lds + XB_LDS_OFF));
    grid.sync();

#ifdef PREFILL
    { const u32x4 pz = (u32x4){0xAAAAAAAAu, 0xAAAAAAAAu, 0xAAAAAAAAu, 0xAAAAAAAAu}; for (size_t i = (size_t)blockIdx.x * NTHR + threadIdx.x; i < WS_END / 16; i += (size_t)gridDim.x * NTHR) ((u32x4*)ws)[i] = pz; }
    xcd_barrier(xbar);
#endif
    for (int gs = 0; gs < 2 + DEPTH * 13; ++gs) {
        if (gs < 2) {
            if (gs == 0) { for (int rr = 0; rr < R_PREP; ++rr) phase_prep(p, lds); } else phase_init(p);
        } else {
        const int layer = (gs - 2) / 13, st = (gs - 2) % 13;
        const int jm = layer >> 1; const bool is_ret = (layer & 1) == 0;
        const float* modL = mod + (size_t)layer * 16 * MODW;
        {
            GemmDesc d[2]; int ng = 0;
            d[0].cshift = 0; d[1].cshift = 0;
            if (st == 0 || st == 10) {
                const int s = st == 0 ? 0 : 1;
                d[0] = GemmDesc{H, (const bf16_t*)(ws + OFF_FFN_IN + (size_t)(layer * 2 + s) * SZ_FFN_IN), (bf16_t*)(U + U_FFN_ACT), MTOK, 5632, 1024, DFF, 1, 0}; ng = 1;
            } else if (st == 1 || st == 11) {
                const int s = st == 1 ? 0 : 1;
                d[0] = GemmDesc{(const bf16_t*)(U + U_FFN_ACT), (const bf16_t*)(ws + OFF_FFN_OUT + (size_t)(layer * 2 + s) * SZ_FFN_OUT), (bf16_t*)(U + U_FFN_Y), MTOK, 1024, DFF, 1024, 0, 0}; ng = 1;
            } else if (st == 2 || st == 9 || st == 12) {
                const int sub = st == 2 ? 0 : (st == 9 ? 1 : 2);
                const bf16_t* y = (const bf16_t*)(U + (sub == 1 ? (is_ret ? U_RET_Y : U_NSA_Y) : U_FFN_Y));
                const float* modN = (sub == 2) ? (layer + 1 < DEPTH ? modL + (size_t)16 * MODW : modL) : modL;
                const int shc = (sub == 2) ? 0 : (sub + 1) * 3;
#ifdef LN_DRY
                if (sub != 1) phase_ln(p.out, (float*)(U + 0), y, modL + (sub * 3 + 2) * 1024, sub == 1 ? 1.0f : 0.5f, p.ln_g + (size_t)(layer * 3 + sub) * 1024, p.ln_b + (size_t)(layer * 3 + sub) * 1024,
                         modN + shc * 1024, modN + (shc + 1) * 1024, (bf16_t*)(U + 128 * MiB));
#endif
                phase_ln(p.out, p.out, y, modL + (sub * 3 + 2) * 1024, sub == 1 ? 1.0f : 0.5f, p.ln_g + (size_t)(layer * 3 + sub) * 1024, p.ln_b + (size_t)(layer * 3 + sub) * 1024,
                         modN + shc * 1024, modN + (shc + 1) * 1024, H);
            } else if (is_ret) {
                const bf16_t* Wi = (const bf16_t*)(ws + OFF_RET_IN + (size_t)jm * SZ_RET_IN);
                if (st == 3) { d[0] = GemmDesc{H, Wi, (bf16_t*)(U + U_RET_QKV), MTOK, 4096, 1024, 4096, 0, 0}; ng = 1; }
                else if (st == 4) { for (int rr = 0; rr < R_CORE; ++rr) phase_ret_core((const bf16_t*)(U + U_RET_QKV), (bf16_t*)(U + U_RET_O), lds); }
                else if (st == 5) { d[0] = GemmDesc{H, Wi + (size_t)4096 * 1024, (bf16_t*)(U + U_RET_G), MTOK, 2048, 1024, 2048, 0, 0}; ng = 1; }
                else if (st == 6) phase_ret_gate((bf16_t*)(U + U_RET_O), (const bf16_t*)(U + U_RET_G));
                else if (st == 7) { d[0] = GemmDesc{(const bf16_t*)(U + U_RET_O), (const bf16_t*)(ws + OFF_RET_OUT + (size_t)jm * SZ_RET_OUT), (bf16_t*)(U + U_RET_Y), MTOK, 1024, 2048, 1024, 0, 0}; ng = 1; }
                else continue;
            } else {
                if (st == 3) { d[0] = GemmDesc{H, (const bf16_t*)(ws + OFF_NSA_IN + (size_t)jm * SZ_NSA_IN), (bf16_t*)(U + U_NSA_PROJ), MTOK, 2816, 1024, 2816, 0, 0}; ng = 1; }
                else if (st == 4) phase_nsa_mat((const bf16_t*)(U + U_NSA_PROJ), p.pe_k + (size_t)jm * 2048, p.pe_v + (size_t)jm * 2048, (bf16_t*)(U + U_NSA_ACMPK), (bf16_t*)(U + U_NSA_ACMPV));
                else if (st == 5) {
                    d[0] = GemmDesc{(const bf16_t*)(U + U_NSA_ACMPK), (const bf16_t*)(ws + OFF_W1 + (size_t)(0 * 2 + jm) * SZ_W1), (bf16_t*)(U + U_NSA_HK), 8192, 256, 2048, 256, 2, 0};
                    d[1] = GemmDesc{(const bf16_t*)(U + U_NSA_ACMPV), (const bf16_t*)(ws + OFF_W1 + (size_t)(1 * 2 + jm) * SZ_W1), (bf16_t*)(U + U_NSA_HV), 8192, 256, 2048, 256, 2, 32}; ng = 2;
                } else if (st == 6) phase_nsa_cmp2((const bf16_t*)(U + U_NSA_HK), (const bf16_t*)(U + U_NSA_HV), (const bf16_t*)(ws + OFF_W2 + (size_t)(0 * 2 + jm) * SZ_W2), (const bf16_t*)(ws + OFF_W2 + (size_t)(1 * 2 + jm) * SZ_W2),
                                               (bf16_t*)(U + U_NSA_KCMP), (bf16_t*)(U + U_NSA_VCMP));
                else if (st == 7) { for (int rr = 0; rr < R_ATTN; ++rr) phase_nsa_attn((const bf16_t*)(U + U_NSA_PROJ), (const bf16_t*)(U + U_NSA_KCMP), (const bf16_t*)(U + U_NSA_VCMP), (bf16_t*)(U + U_NSA_OATT), lds); }
                else { d[0] = GemmDesc{(const bf16_t*)(U + U_NSA_OATT), (const bf16_t*)(ws + OFF_NSA_OUT + (size_t)jm * SZ_NSA_OUT), (bf16_t*)(U + U_NSA_Y), MTOK, 1024, 1024, 1024, 0, 0}; ng = 1; }
            }
            for (int rr = 0; rr < R_GEMM; ++rr) for (int r = 0; r < ng; ++r) { GemmDesc dd = d[0]; if (r == 1) dd = d[1]; run_gemm(dd, lds); }
        }
        }
        xcd_barrier(xbar);
    }
}

extern "C" void kernel_launch(void* const* d_in, const int* in_sizes, int n_in, void* d_out, int out_size, void* d_ws, size_t ws_size, hipStream_t stream) {
    static int grid_blocks = 0;
    if (grid_blocks == 0) {
        int dev = 0, cus = 0, per_cu = 0;
        hipGetDevice(&dev); hipDeviceGetAttribute(&cus, hipDeviceAttributeMultiprocessorCount, dev);
        if (hipFuncSetAttribute((const void*)fwd_megakernel, hipFuncAttributeMaxDynamicSharedMemorySize, LDS_BYTES) != hipSuccess) fprintf(stderr, "hipFuncSetAttribute failed\n");
        if (hipOccupancyMaxActiveBlocksPerMultiprocessor(&per_cu, (const void*)fwd_megakernel, NTHR, LDS_BYTES) != hipSuccess || per_cu < 1) { fprintf(stderr, "occupancy query: %d\n", per_cu); per_cu = 1; }
        (void)hipGetLastError();
        grid_blocks = cus * 1;
        if (ws_size < WS_END + 16384) fprintf(stderr, "workspace too small: %zu < %zu\n", ws_size, (size_t)WS_END);
    }
    Params p{};
    p.x = (const float*)d_in[0]; p.c = (const float*)d_in[1]; p.ada_w = (const float*)d_in[2]; p.ada_b = (const float*)d_in[3]; p.ln_g = (const float*)d_in[4]; p.ln_b = (const float*)d_in[5];
    p.pe_k = (const float*)d_in[12]; p.pe_v = (const float*)d_in[13]; p.out = (float*)d_out; p.ws = (unsigned char*)d_ws;
    unsigned char* ws = (unsigned char*)d_ws; int nj = 0, te = 0;
    auto add = [&](const float* src, size_t dst_off, int K, int N, int Np, int mode) { p.jobs[nj] = WJob{src, (bf16_t*)(ws + dst_off), K, N, Np, mode}; te += (Np / 64) * (K / 64); p.tile_end[nj] = te; ++nj; };
    const float* ffn_in = (const float*)d_in[6]; const float* ffn_out = (const float*)d_in[7]; const float* ret_in = (const float*)d_in[8]; const float* ret_out = (const float*)d_in[9];
    const float* nsa_in = (const float*)d_in[10]; const float* nsa_out = (const float*)d_in[11];
    const float* ck1 = (const float*)d_in[14]; const float* ck2 = (const float*)d_in[15]; const float* cv1 = (const float*)d_in[16]; const float* cv2 = (const float*)d_in[17];
    for (int i = 0; i < 8; ++i) add(ffn_in + (size_t)i * 1024 * 5632, OFF_FFN_IN + i * SZ_FFN_IN, 1024, 5632, 5632, 1);
    for (int i = 0; i < 8; ++i) add(ffn_out + (size_t)i * 2816 * 1024, OFF_FFN_OUT + i * SZ_FFN_OUT, 2816, 1024, 1024, 0);
    for (int i = 0; i < 2; ++i) add(ret_in + (size_t)i * 1024 * 6144, OFF_RET_IN + i * SZ_RET_IN, 1024, 6144, 6144, 0);
    for (int i = 0; i < 2; ++i) add(ret_out + (size_t)i * 2048 * 1024, OFF_RET_OUT + i * SZ_RET_OUT, 2048, 1024, 1024, 0);
    for (int i = 0; i < 2; ++i) add(nsa_in + (size_t)i * 1024 * 2608, OFF_NSA_IN + i * SZ_NSA_IN, 1024, 2608, 2816, 0);
    for (int i = 0; i < 2; ++i) add(nsa_out + (size_t)i * 1024 * 1024, OFF_NSA_OUT + i * SZ_NSA_OUT, 1024, 1024, 1024, 0);
    for (int i = 0; i < 2; ++i) add(ck1 + (size_t)i * 2048 * 256, OFF_W1 + (0 * 2 + i) * SZ_W1, 2048, 256, 256, 0);
    for (int i = 0; i < 2; ++i) add(cv1 + (size_t)i * 2048 * 256, OFF_W1 + (1 * 2 + i) * SZ_W1, 2048, 256, 256, 0);
    for (int i = 0; i < 2; ++i) add(ck2 + (size_t)i * 256 * 64, OFF_W2 + (0 * 2 + i) * SZ_W2, 256, 64, 64, 0);
    for (int i = 0; i < 2; ++i) add(cv2 + (size_t)i * 256 * 64, OFF_W2 + (1 * 2 + i) * SZ_W2, 256, 64, 64, 0);
    p.njobs = nj;
    if (hipMemsetAsync(ws + WS_END, 0, 16384, stream) != hipSuccess) fprintf(stderr, "barrier memset failed\n");
    void* args[] = {&p};
    hipError_t e = hipLaunchCooperativeKernel((const void*)fwd_megakernel, dim3(grid_blocks), dim3(NTHR), args, LDS_BYTES, stream);
    if (e != hipSuccess) fprintf(stderr, "cooperative launch failed: %s (grid %d)\n", hipGetErrorString(e), grid_blocks);
}
```

```cpp
#include <hip/hip_runtime.h>
#include <hip/hip_cooperative_groups.h>
#include <cstdio>
namespace cg = cooperative_groups;

namespace pg8 {
#define PG8_LAS __attribute__((address_space(3)))
typedef unsigned short bf16_t;
typedef short bf16x8 __attribute__((ext_vector_type(8)));
typedef float f32x4 __attribute__((ext_vector_type(4)));
typedef unsigned u32x4 __attribute__((ext_vector_type(4)));
constexpr int BM = 256, BK = 64, HALF = 128, HTB = HALF * BK * 2  , STAGE_BYTES = 8 * HTB, NXCD = 8, WGM = 8;

__host__ __device__ __forceinline__ int lds_byte(int r, int c) { const int st = (r >> 4) * 2 + (c >> 5), rr = r & 15, cc = c & 31, ob = rr * 64 + cc * 2; return st * 1024 + (ob ^ (((ob >> 9) & 1) << 5)); }
__host__ __device__ __forceinline__ void stage_rc(int b, int& R, int& C) { const int st = b / 1024, sb = b % 1024, swz = sb ^ (((sb >> 9) & 1) << 5); R = (st >> 1) * 16 + swz / 64; C = (st & 1) * 32 + (swz % 64) / 2; }
__host__ __device__ __forceinline__ int perm32(int rho) { const int n = rho >> 4, i = rho & 15; return 8 * (i >> 2) + 4 * n + (i & 3); }

struct Unit { int pm, pn; };
struct Gemm { const bf16_t* A; const bf16_t* Bt; int M, N, K; };

struct StaticOrder {
    int nM, nN, nwg, G, c;
    __host__ __device__ void init(int M, int N, int G_, int c_) { nM = M / BM; nN = N / BM; nwg = nM * nN; G = G_; c = c_; }
    __host__ __device__ bool next(int i, Unit& u) const {
        const long L = (long)i * G + c; if (L >= nwg) return false;
        int wgid = (int)L; { const int q = nwg / NXCD, r = nwg % NXCD, xcd = wgid % NXCD, off = wgid / NXCD; wgid = (xcd < r ? xcd * (q + 1) : r * (q + 1) + (xcd - r) * q) + off; }
        const int nig = WGM * nN, gid = wgid / nig, fm = gid * WGM, gsz = (nM - fm) < WGM ? (nM - fm) : WGM;
        u.pm = fm + ((wgid % nig) % gsz); u.pn = (wgid % nig) / gsz; return true;
    }
    __device__ __forceinline__ void a_ready(const Unit&) const {}
    __device__ __forceinline__ void done(const Unit&) const {}
};

typedef float f32x2_t __attribute__((ext_vector_type(2)));
typedef __bf16 bf16x2_t __attribute__((ext_vector_type(2)));
__device__ __forceinline__ unsigned cvt_pk_bf16(float lo, float hi) { const f32x2_t v = {lo, hi}; return __builtin_bit_cast(unsigned, __builtin_convertvector(v, bf16x2_t)); }
__device__ __forceinline__ float silu_f(float a) { return a * __builtin_amdgcn_rcpf(1.0f + __builtin_amdgcn_exp2f(-1.44269504089f * a)); }
__device__ __forceinline__ float gelu_tanh_f(float x) { const float u = 0.7978845608028654f * (x + 0.044715f * x * x * x); const float t = 1.0f - 2.0f * __builtin_amdgcn_rcpf(1.0f + __builtin_amdgcn_exp2f(2.88539008178f * u)); return 0.5f * x * (1.0f + t); }

template <int ACT> struct Epi {
    static constexpr bool PERM = true, AFTER_DRAIN = false;
    bf16_t* O; int ldc;
    __device__ __forceinline__ void operator()(const f32x4 (&acc)[2][2][4][2], const Unit& u, int wr, int wc, int fr, int fq) const {
        const int row0 = u.pm * BM + wr * 64 + fr;
        if (ACT == 1) {
            const int col0 = u.pn * HALF + wc * 32 + 8 * fq;
#pragma unroll
            for (int ai = 0; ai < 2; ++ai)
#pragma unroll
                for (int m = 0; m < 4; ++m) { bf16_t* rowp = O + (size_t)(row0 + ai * HALF + m * 16) * ldc + col0;
                    const f32x4 a0 = acc[ai][0][m][0], a1 = acc[ai][0][m][1], u0 = acc[ai][1][m][0], u1 = acc[ai][1][m][1];
                    u32x4 w; w.x = cvt_pk_bf16(silu_f(a0[0]) * u0[0], silu_f(a0[1]) * u0[1]); w.y = cvt_pk_bf16(silu_f(a0[2]) * u0[2], silu_f(a0[3]) * u0[3]);
                    w.z = cvt_pk_bf16(silu_f(a1[0]) * u1[0], silu_f(a1[1]) * u1[1]); w.w = cvt_pk_bf16(silu_f(a1[2]) * u1[2], silu_f(a1[3]) * u1[3]);
                    *(u32x4*)rowp = w; }
        } else {
            const int col0 = u.pn * BM + wc * 32 + 8 * fq;
#pragma unroll
            for (int ai = 0; ai < 2; ++ai)
#pragma unroll
                for (int m = 0; m < 4; ++m) { bf16_t* rowp = O + (size_t)(row0 + ai * HALF + m * 16) * ldc + col0;
#pragma unroll
                    for (int bj = 0; bj < 2; ++bj) { f32x4 v0 = acc[ai][bj][m][0], v1 = acc[ai][bj][m][1];
                        if (ACT == 2) {
#pragma unroll
                            for (int j = 0; j < 4; ++j) { v0[j] = gelu_tanh_f(v0[j]); v1[j] = gelu_tanh_f(v1[j]); } }
                        u32x4 w; w.x = cvt_pk_bf16(v0[0], v0[1]); w.y = cvt_pk_bf16(v0[2], v0[3]); w.z = cvt_pk_bf16(v1[0], v1[1]); w.w = cvt_pk_bf16(v1[2], v1[3]);
                        *(u32x4*)(rowp + bj * HALF) = w; } }
        }
    }
};

template <class Epi, class Sched>
__device__ __forceinline__ void gemm_phase(PG8_LAS unsigned char* lds, const Gemm g, const Sched& S, const Epi& E) {
    const int tid = threadIdx.x, wid = __builtin_amdgcn_readfirstlane(tid >> 6), lane = tid & 63, wr = wid >> 2, wc = wid & 3, fr = lane & 15, fq = lane >> 4;
    const int K = g.K, nt = K / BK;
    unsigned voffA[2], voffB[2];
#pragma unroll
    for (int i = 0; i < 2; ++i) { int R, C; stage_rc(tid * 16 + i * 8192, R, C); const int Rb = Epi::PERM ? ((R & ~31) + perm32(R & 31)) : R;
        voffA[i] = (unsigned)(R * K + C) * 2u; voffB[i] = (unsigned)(Rb * K + C) * 2u; }
    const size_t kstep = (size_t)(BK * 2);
    const size_t hstep = (size_t)HALF * K * 2;
    const size_t tstep = 2 * hstep;
    const unsigned ldsw = (unsigned)wid * 1024u;
    const int aoff = lds_byte(wr * 64 + fr, fq * 8), boff = lds_byte(wc * 32 + fr, fq * 8);
#define PG8_SA(b, h) (((b) * 2 + (h)) * HTB)
#define PG8_SB(b, h) ((4 + (b) * 2 + (h)) * HTB)
#define PG8_STAGE(bufoff, gbase, voff) do { _Pragma("unroll") for (int _i = 0; _i < 2; ++_i) \
        __builtin_amdgcn_global_load_lds((const unsigned*)((const char*)(gbase) + (voff)[_i]), (PG8_LAS unsigned*)(lds + (bufoff) + ldsw + _i * 8192), 16, 0, 0); } while (0)
#define PG8_LDA(dst, b, h) do { _Pragma("unroll") for (int m = 0; m < 4; ++m) _Pragma("unroll") for (int k = 0; k < 2; ++k) dst[m][k] = *(const PG8_LAS bf16x8*)(lds + PG8_SA(b, h) + aoff + m * 2048 + k * 1024); } while (0)
#define PG8_LDB(dst, b, h) do { _Pragma("unroll") for (int n = 0; n < 2; ++n) _Pragma("unroll") for (int k = 0; k < 2; ++k) dst[n][k] = *(const PG8_LAS bf16x8*)(lds + PG8_SB(b, h) + boff + n * 2048 + k * 1024); } while (0)
#define PG8_MMA(ai, bj, At, Bt) do { __builtin_amdgcn_s_setprio(1); _Pragma("unroll") for (int m = 0; m < 4; ++m) _Pragma("unroll") for (int n = 0; n < 2; ++n) _Pragma("unroll") for (int k = 0; k < 2; ++k) \
        acc[ai][bj][m][n] = __builtin_amdgcn_mfma_f32_16x16x32_bf16(Bt[n][k], At[m][k], acc[ai][bj][m][n], 0, 0, 0); __builtin_amdgcn_s_setprio(0); } while (0)
#define PG8_WAIT_V(n) asm volatile("s_waitcnt vmcnt(" #n ")" ::: "memory")
#define PG8_WAIT_L(n) asm volatile("s_waitcnt lgkmcnt(" #n ")" ::: "memory")
#define PG8_BAR __builtin_amdgcn_s_barrier()
#define PG8_SCHED __builtin_amdgcn_sched_barrier(0)
    Unit cur, nxt; int ui = 0;
    if (!S.next(0, cur)) return;
    f32x4 acc[2][2][4][2];
#pragma unroll
    for (int a = 0; a < 2; ++a)
#pragma unroll
        for (int b = 0; b < 2; ++b)
#pragma unroll
            for (int m = 0; m < 4; ++m)
#pragma unroll
                for (int n = 0; n < 2; ++n) acc[a][b][m][n] = (f32x4){0.f, 0.f, 0.f, 0.f};
    bf16x8 At[4][2], B0[2][2], B1[2][2];
    const char* cA = (const char*)g.A + (size_t)cur.pm * tstep; const char* cB = (const char*)g.Bt + (size_t)cur.pn * tstep;
    S.a_ready(cur);
    PG8_STAGE(PG8_SB(0, 0), cB, voffB); PG8_STAGE(PG8_SA(0, 0), cA, voffA); PG8_STAGE(PG8_SB(0, 1), cB + hstep, voffB); PG8_STAGE(PG8_SA(0, 1), cA + hstep, voffA);
    if (wr == 1) PG8_BAR;
    PG8_WAIT_V(4); PG8_BAR;
    PG8_STAGE(PG8_SB(1, 0), cB + kstep, voffB); PG8_STAGE(PG8_SA(1, 0), cA + kstep, voffA); PG8_STAGE(PG8_SB(1, 1), cB + hstep + kstep, voffB);
    PG8_WAIT_V(6); PG8_BAR;
    for (;;) {
        const bool has_next = S.next(ui + 1, nxt);
        const char* nA = has_next ? (const char*)g.A + (size_t)nxt.pm * tstep : cA; const char* nB = has_next ? (const char*)g.Bt + (size_t)nxt.pn * tstep : cB;
        for (int t = 0; t < nt; t += 2) {
            const bool last = (t == nt - 2);
            const char* a1 = cA + (size_t)(t + 1) * kstep;
            const char* a2 = last ? nA : cA + (size_t)(t + 2) * kstep; const char* b2 = last ? nB : cB + (size_t)(t + 2) * kstep;
            const char* a3 = a2 + kstep; const char* b3 = b2 + kstep;
            if (last && has_next) S.a_ready(nxt);
            PG8_LDB(B0, 0, 0); PG8_SCHED; PG8_LDA(At, 0, 0); PG8_STAGE(PG8_SA(1, 1), a1 + hstep, voffA);
            PG8_WAIT_L(8); PG8_BAR; PG8_WAIT_L(0); PG8_MMA(0, 0, At, B0); PG8_BAR; PG8_SCHED;
            PG8_LDB(B1, 0, 1); PG8_STAGE(PG8_SB(0, 0), b2, voffB);
            PG8_BAR; PG8_WAIT_L(0); PG8_MMA(0, 1, At, B1); PG8_BAR;
            PG8_LDA(At, 0, 1); PG8_STAGE(PG8_SA(0, 0), a2, voffA);
            PG8_BAR; PG8_WAIT_L(0); PG8_MMA(1, 0, At, B0); PG8_BAR; PG8_SCHED;
            PG8_STAGE(PG8_SB(0, 1), b2 + hstep, voffB);
            PG8_WAIT_V(6); PG8_BAR; PG8_MMA(1, 1, At, B1); PG8_BAR;
            PG8_LDB(B0, 1, 0); PG8_SCHED; PG8_LDA(At, 1, 0); PG8_STAGE(PG8_SA(0, 1), a2 + hstep, voffA);
            PG8_WAIT_L(8); PG8_BAR; PG8_WAIT_L(0); PG8_MMA(0, 0, At, B0); PG8_BAR; PG8_SCHED;
            PG8_LDB(B1, 1, 1); PG8_STAGE(PG8_SB(1, 0), b3, voffB);
            PG8_BAR; PG8_WAIT_L(0); PG8_MMA(0, 1, At, B1); PG8_BAR;
            PG8_LDA(At, 1, 1); PG8_STAGE(PG8_SA(1, 0), a3, voffA);
            PG8_BAR; PG8_WAIT_L(0); PG8_MMA(1, 0, At, B0); PG8_BAR; PG8_SCHED;
            PG8_STAGE(PG8_SB(1, 1), b3 + hstep, voffB);
            PG8_WAIT_V(6); PG8_BAR; PG8_MMA(1, 1, At, B1); PG8_BAR;
        }
        if constexpr (!Epi::AFTER_DRAIN) { E(acc, cur, wr, wc, fr, fq); S.done(cur); }
        if (!has_next) break;
#pragma unroll
        for (int a = 0; a < 2; ++a)
#pragma unroll
            for (int b = 0; b < 2; ++b)
#pragma unroll
                for (int m = 0; m < 4; ++m)
#pragma unroll
                    for (int n = 0; n < 2; ++n) acc[a][b][m][n] = (f32x4){0.f, 0.f, 0.f, 0.f};
        cur = nxt; cA = nA; cB = nB; ++ui;
    }
    PG8_WAIT_V(0);
    if (wr == 0) PG8_BAR;
    PG8_BAR;
    if constexpr (Epi::AFTER_DRAIN) { E.fused(acc, cur, wr, wc, fr, fq, lds, wid, lane); S.done(cur); }
#undef PG8_SA
#undef PG8_SB
#undef PG8_STAGE
#undef PG8_LDA
#undef PG8_LDB
#undef PG8_MMA
#undef PG8_WAIT_V
#undef PG8_WAIT_L
#undef PG8_BAR
#undef PG8_SCHED
}
}

using pg8::bf16_t; using pg8::bf16x8; using pg8::f32x4; using pg8::u32x4; using pg8::cvt_pk_bf16; using pg8::silu_f;
#define LAS __attribute__((address_space(3)))
typedef unsigned u32x2 __attribute__((ext_vector_type(2)));
typedef short s16x4 __attribute__((ext_vector_type(4)));
#define MFMA16(a, b, c) __builtin_amdgcn_mfma_f32_16x16x32_bf16((a), (b), (c), 0, 0, 0)

constexpr int NTHR = 512;
constexpr int MTOK = 32768, DM = 1024, SEQ = 2048, DFF = 2816, DEPTH = 4, MODW = 9216;
constexpr float DN_ALPHA = 1.6817928305074290861f;
constexpr size_t MiB = (size_t)1 << 20;
constexpr size_t SZ_FFN_IN = (size_t)5632 * 1024 * 2, SZ_FFN_OUT = (size_t)1024 * 2816 * 2, SZ_RET_IN = (size_t)6144 * 1024 * 2, SZ_RET_OUT = (size_t)1024 * 2048 * 2,
                 SZ_NSA_IN = (size_t)2816 * 1024 * 2, SZ_NSA_OUT = (size_t)1024 * 1024 * 2, SZ_W1 = (size_t)256 * 2048 * 2, SZ_W2 = (size_t)64 * 256 * 2;
constexpr size_t OFF_FFN_IN = 0, OFF_FFN_OUT = OFF_FFN_IN + 8 * SZ_FFN_IN, OFF_RET_IN = OFF_FFN_OUT + 8 * SZ_FFN_OUT, OFF_RET_OUT = OFF_RET_IN + 2 * SZ_RET_IN,
                 OFF_NSA_IN = OFF_RET_OUT + 2 * SZ_RET_OUT, OFF_NSA_OUT = OFF_NSA_IN + 2 * SZ_NSA_IN, OFF_W1 = OFF_NSA_OUT + 2 * SZ_NSA_OUT, OFF_W2 = OFF_W1 + 4 * SZ_W1,
                 OFF_MOD = OFF_W2 + 4 * SZ_W2, OFF_H = OFF_MOD + (size_t)DEPTH * 16 * MODW * 4, OFF_U2 = OFF_H + (size_t)MTOK * DM * 2, WS_END = OFF_U2 + 384 * MiB;
constexpr size_t U_FFN_ACT = 0, U_FFN_Y = 192 * MiB;
constexpr size_t U_RET_QKV = 0, U_RET_G = 0, U_RET_O = 256 * MiB, U_RET_Y = 128 * MiB;
constexpr size_t U_NSA_PROJ = 0, U_NSA_Y = 192 * MiB, U_NSA_ACMPK = 256 * MiB, U_NSA_ACMPV = 288 * MiB, U_NSA_HK = 320 * MiB, U_NSA_HV = 324 * MiB, U_NSA_KCMP = 328 * MiB, U_NSA_VCMP = 329 * MiB, U_NSA_OATT = 256 * MiB;
constexpr int XB_LDS_OFF = 152 * 1024, LDS_BYTES = 152 * 1024 + 16;

struct WJob { const float* src; bf16_t* dst; int K, N, Np, mode; };
struct Params {
    const float* x; const float* c; const float* ada_w; const float* ada_b; const float* ln_g; const float* ln_b; const float* pe_k; const float* pe_v;
    float* out; unsigned char* ws;
    WJob jobs[32]; int tile_end[32]; int njobs; int pad;
};

__device__ __forceinline__ float bf2f(unsigned short b) { return __uint_as_float(((unsigned)b) << 16); }
__device__ __forceinline__ float bflo(unsigned w) { return __uint_as_float(w << 16); }
__device__ __forceinline__ float bfhi(unsigned w) { return __uint_as_float(w & 0xffff0000u); }
__device__ __forceinline__ unsigned short f2bf(float f) { return (unsigned short)(cvt_pk_bf16(f, 0.f) & 0xffffu); }
__device__ __forceinline__ bf16x8 pack8(const f32x4& a, const f32x4& b) { u32x4 w; w.x = cvt_pk_bf16(a[0], a[1]); w.y = cvt_pk_bf16(a[2], a[3]); w.z = cvt_pk_bf16(b[0], b[1]); w.w = cvt_pk_bf16(b[2], b[3]); return __builtin_bit_cast(bf16x8, w); }
__device__ __forceinline__ u32x2 pack4(const f32x4& a) { u32x2 w; w.x = cvt_pk_bf16(a[0], a[1]); w.y = cvt_pk_bf16(a[2], a[3]); return w; }
__device__ __forceinline__ bf16x8 lds_rd16(LAS unsigned char* lds, int off) { return *(const LAS bf16x8*)(lds + off); }
__device__ __forceinline__ bf16x8 lds_rd8x2(LAS unsigned char* lds, int off) { const s16x4 lo = *(const LAS s16x4*)(lds + off), hi = *(const LAS s16x4*)(lds + off + 32); return __builtin_shufflevector(lo, hi, 0, 1, 2, 3, 4, 5, 6, 7); }
template <int M> __device__ __forceinline__ float shx(float v, int lane) {
    if (M < 32) return __int_as_float(__builtin_amdgcn_ds_swizzle(__float_as_int(v), (M << 10) | 0x1f));
    return __int_as_float(__builtin_amdgcn_ds_bpermute((lane ^ M) << 2, __float_as_int(v)));
}
template <int M> __device__ __forceinline__ unsigned shxu(unsigned v, int lane) {
    if (M < 32) return (unsigned)__builtin_amdgcn_ds_swizzle((int)v, (M << 10) | 0x1f);
    return (unsigned)__builtin_amdgcn_ds_bpermute((lane ^ M) << 2, (int)v);
}
__device__ __forceinline__ float shi(float v, int src_lane) { return __int_as_float(__builtin_amdgcn_ds_bpermute(src_lane << 2, __float_as_int(v))); }
__device__ __forceinline__ float wsum(float v, int lane) { v += shx<32>(v, lane); v += shx<16>(v, lane); v += shx<8>(v, lane); v += shx<4>(v, lane); v += shx<2>(v, lane); v += shx<1>(v, lane); return v; }

__device__ __forceinline__ void wt_tile(const WJob& J, int t, LAS float* T) {
    int tid = threadIdx.x; asm volatile("" : "+v"(tid));
    const int ntn = J.Np >> 6; const int tn = t % ntn, tk = t / ntn; const int n0 = tn * 64, k0 = tk * 64;
    int sbase = n0; if (J.mode == 1) { const int pn = n0 >> 8, r = n0 & 255; sbase = (r >> 7) * DFF + pn * 128 + (r & 127); }
    const int kk = tid >> 4, nn = (tid & 15) * 4;
#pragma unroll
    for (int rep = 0; rep < 2; ++rep) { const int k = kk + rep * 32; f32x4 v = (f32x4){0.f, 0.f, 0.f, 0.f};
        if (sbase + nn < J.N) v = *(const f32x4*)(J.src + (size_t)(k0 + k) * J.N + sbase + nn);
        T[k * 65 + nn] = v[0]; T[k * 65 + nn + 1] = v[1]; T[k * 65 + nn + 2] = v[2]; T[k * 65 + nn + 3] = v[3]; }
    __syncthreads();
    const int n = tid >> 3, k8 = (tid & 7) * 8;
    f32x4 a, b;
    a[0] = T[(k8 + 0) * 65 + n]; a[1] = T[(k8 + 1) * 65 + n]; a[2] = T[(k8 + 2) * 65 + n]; a[3] = T[(k8 + 3) * 65 + n];
    b[0] = T[(k8 + 4) * 65 + n]; b[1] = T[(k8 + 5) * 65 + n]; b[2] = T[(k8 + 6) * 65 + n]; b[3] = T[(k8 + 7) * 65 + n];
    *(bf16x8*)(J.dst + (size_t)(n0 + n) * J.K + k0 + k8) = pack8(a, b);
    __syncthreads();
}

__device__ __forceinline__ void phase_prep(const Params& p, LAS unsigned char* lds) {
    int tid = threadIdx.x; asm volatile("" : "+v"(tid));
    LAS float* T = (LAS float*)lds;
    const int ntiles = p.tile_end[p.njobs - 1];
    for (int t = blockIdx.x; t < ntiles; t += gridDim.x) {
        int j = 0; while (j < p.njobs - 1 && t >= p.tile_end[j]) ++j;
        const int t0 = j ? p.tile_end[j - 1] : 0;
        wt_tile(p.jobs[j], t - t0, T);
    }
    if (blockIdx.x < 288) {
        LAS float* cs = (LAS float*)lds;
        LAS float* red = (LAS float*)(lds + 65536);
        float* mod = (float*)(p.ws + OFF_MOD);
        __syncthreads();
        for (int idx = tid; idx < 16 * 1024; idx += NTHR) { const int b = idx >> 10, k = idx & 1023; const float cv = p.c[idx]; cs[k * 16 + b] = cv / (1.0f + expf(-cv)); }
        __syncthreads();
        for (int unit = blockIdx.x; unit < 288; unit += gridDim.x) {
            const int i = unit / 72, n0 = (unit % 72) * 128, col = tid & 127, kq = tid >> 7;
            f32x4 a0 = (f32x4){0.f, 0.f, 0.f, 0.f}, a1 = a0, a2 = a0, a3 = a0;
            const float* wp = p.ada_w + ((size_t)i * 1024 + kq * 256) * MODW + n0 + col;
#pragma unroll 4
            for (int k = 0; k < 256; ++k) { const float w = wp[(size_t)k * MODW]; const LAS f32x4* cp = (const LAS f32x4*)(cs + (kq * 256 + k) * 16);
                a0 += cp[0] * w; a1 += cp[1] * w; a2 += cp[2] * w; a3 += cp[3] * w; }
#pragma unroll
            for (int b = 0; b < 4; ++b) { red[(kq * 16 + b) * 128 + col] = a0[b]; red[(kq * 16 + 4 + b) * 128 + col] = a1[b]; red[(kq * 16 + 8 + b) * 128 + col] = a2[b]; red[(kq * 16 + 12 + b) * 128 + col] = a3[b]; }
            __syncthreads();
#pragma unroll
            for (int r = 0; r < 4; ++r) { const int o = tid + r * NTHR, b = o >> 7, cc = o & 127;
                const float s = red[(0 * 16 + b) * 128 + cc] + red[(1 * 16 + b) * 128 + cc] + red[(2 * 16 + b) * 128 + cc] + red[(3 * 16 + b) * 128 + cc] + p.ada_b[i * MODW + n0 + cc];
                mod[((size_t)i * 16 + b) * MODW + n0 + cc] = s; }
            __syncthreads();
        }
    }
}

__device__ __forceinline__ void phase_init(const Params& p) {
    const float* mod = (const float*)(p.ws + OFF_MOD); bf16_t* H = (bf16_t*)(p.ws + OFF_H);
    int tid = threadIdx.x; asm volatile("" : "+v"(tid));
    for (size_t i = (size_t)blockIdx.x * NTHR + tid; i < (size_t)MTOK * 256; i += (size_t)gridDim.x * NTHR) {
        const int row = (int)(i >> 8), c4 = (int)(i & 255) * 4, b = row >> 11;
        const f32x4 xv = *(const f32x4*)(p.x + i * 4); *(f32x4*)(p.out + i * 4) = xv;
        const float* m = mod + (size_t)b * MODW; const f32x4 sh = *(const f32x4*)(m + c4), sc = *(const f32x4*)(m + 1024 + c4);
        const f32x4 h = xv * (sc + 1.0f) + sh; *(u32x2*)(H + i * 4) = pack4(h);
    }
}

__device__ __forceinline__ void phase_ln(float* xio, float* xout, const bf16_t* y, const float* modG, float rw, const float* lng, const float* lnb, const float* modSh, const float* modSc, bf16_t* H) {
    int tid = threadIdx.x; asm volatile("" : "+v"(tid));
    const int wid = __builtin_amdgcn_readfirstlane(tid >> 6), lane = tid & 63;
    for (int row = blockIdx.x * 8 + wid; row < MTOK; row += gridDim.x * 8) {
        const int b = row >> 11; const size_t rb = (size_t)row * DM;
        f32x4 z[4]; float s = 0.f;
#pragma unroll
        for (int q = 0; q < 4; ++q) { const int c = q * 256 + lane * 4; const f32x4 xv = *(const f32x4*)(xio + rb + c); const u32x2 yv = *(const u32x2*)(y + rb + c);
            const f32x4 gt = *(const f32x4*)(modG + (size_t)b * MODW + c); const f32x4 yf = (f32x4){bflo(yv.x), bfhi(yv.x), bflo(yv.y), bfhi(yv.y)};
            z[q] = xv * DN_ALPHA + (gt + 1.0f) * yf * rw; s += (z[q][0] + z[q][1]) + (z[q][2] + z[q][3]); }
        const float mu = wsum(s, lane) * (1.0f / 1024.0f); float v = 0.f;
#pragma unroll
        for (int q = 0; q < 4; ++q) { const f32x4 d = z[q] - mu; v += (d[0] * d[0] + d[1] * d[1]) + (d[2] * d[2] + d[3] * d[3]); }
        const float rstd = rsqrtf(wsum(v, lane) * (1.0f / 1024.0f) + 1e-5f);
#pragma unroll
        for (int q = 0; q < 4; ++q) { const int c = q * 256 + lane * 4; const f32x4 g4 = *(const f32x4*)(lng + c), b4 = *(const f32x4*)(lnb + c);
            const f32x4 xn = (z[q] - mu) * rstd * g4 + b4; *(f32x4*)(xout + rb + c) = xn;
            const f32x4 sh = *(const f32x4*)(modSh + (size_t)b * MODW + c), sc = *(const f32x4*)(modSc + (size_t)b * MODW + c);
            *(u32x2*)(H + rb + c) = pack4(xn * (sc + 1.0f) + sh); }
    }
}

typedef short v4i16_t __attribute__((ext_vector_type(4)));
__device__ __forceinline__ s16x4 lds_tr8(LAS unsigned char* lds, int off) { return __builtin_bit_cast(s16x4, __builtin_amdgcn_ds_read_tr16_b64_v4i16((LAS v4i16_t*)(lds + off))); }

__device__ __forceinline__ bf16x8 lds_tr8x2(LAS unsigned char* lds, int off, int hi_off) { const s16x4 lo = lds_tr8(lds, off), hi = lds_tr8(lds, off + hi_off); return __builtin_shufflevector(lo, hi, 0, 1, 2, 3, 4, 5, 6, 7); }

__device__ __forceinline__ void phase_ret_core(const bf16_t* QKV, bf16_t* O, LAS unsigned char* lds) {
    constexpr int KSB = 528, PS = 136, STS = 264, OFF_K = 0, OFF_P = 67584, OFF_VT = 102400, OFF_ST = 119808;
    int tid = threadIdx.x; asm volatile("" : "+v"(tid));
    const int wid = __builtin_amdgcn_readfirstlane(tid >> 6), lane = tid & 63, fr = lane & 15, fq = lane >> 4;
    for (int item = blockIdx.x; item < 512; item += gridDim.x) {
        const int es = item & 7, bh = item >> 3, hh = bh & 3, b = bh >> 2, e0 = es * 64;
        const float log_g = logf(1.0f - exp2f(-5.0f - (float)hh));
        const float gN = expf(log_g * 128.0f);
        const float l2g = log_g * 1.44269504089f;
        __syncthreads();
        for (int i = tid; i < 64 * STS / 2; i += NTHR) ((LAS unsigned*)(lds + OFF_ST))[i] = 0u;
        f32x4 sacc[2][4];
#pragma unroll
        for (int dt = 0; dt < 2; ++dt)
#pragma unroll
            for (int et = 0; et < 4; ++et) sacc[dt][et] = (f32x4){0.f, 0.f, 0.f, 0.f};
        bf16x8 kst[8], vst[2];
        {   const bf16_t* kp = QKV + ((size_t)b * SEQ + (tid >> 5)) * 4096 + 1024 + hh * 256 + (tid & 31) * 8;
#pragma unroll
            for (int it = 0; it < 8; ++it) kst[it] = *(const bf16x8*)(kp + (size_t)it * 16 * 4096);
            const bf16_t* vrow = QKV + ((size_t)b * SEQ + 2 * (tid & 63)) * 4096 + 2048 + hh * 512 + e0 + (tid >> 6) * 8;
            vst[0] = *(const bf16x8*)(vrow); vst[1] = *(const bf16x8*)(vrow + 4096); }
        bf16x8 qf[8];
        { const bf16_t* qrow = QKV + ((size_t)b * SEQ + wid * 16 + fr) * 4096 + hh * 256 + fq * 8;
#pragma unroll
          for (int ks = 0; ks < 8; ++ks) qf[ks] = *(const bf16x8*)(qrow + ks * 32); }
        for (int n = 0; n < 16; ++n) {
            const size_t tok0 = (size_t)b * SEQ + n * 128;
            int t2 = tid; asm volatile("" : "+v"(t2));
            const int lane = t2 & 63, fr = lane & 15, fq = lane >> 4;
            {
#pragma unroll
                for (int it = 0; it < 8; ++it) *(LAS bf16x8*)(lds + OFF_K + ((t2 >> 5) + 16 * it) * KSB + (t2 & 31) * 16) = kst[it];
                const int cp_ = t2 & 63, q_ = t2 >> 6;
#pragma unroll
                for (int i = 0; i < 8; ++i) *(LAS unsigned*)(lds + OFF_VT + ((q_ * 8 + i) * PS + 2 * cp_) * 2) = (unsigned)(unsigned short)vst[0][i] | ((unsigned)(unsigned short)vst[1][i] << 16);
            }
            if (n < 15) {
                const bf16_t* kp = QKV + (tok0 + 128 + (t2 >> 5)) * 4096 + 1024 + hh * 256 + (t2 & 31) * 8;
#pragma unroll
                for (int it = 0; it < 8; ++it) kst[it] = *(const bf16x8*)(kp + (size_t)it * 16 * 4096);
                const bf16_t* vrow = QKV + (tok0 + 128 + 2 * (t2 & 63)) * 4096 + 2048 + hh * 512 + e0 + (t2 >> 6) * 8;
                vst[0] = *(const bf16x8*)(vrow); vst[1] = *(const bf16x8*)(vrow + 4096); }
            __syncthreads();
            const int cc = wid * 16 + fr;
            const int npair = (wid >> 1) + 1;
            for (int cp2 = 0; cp2 < npair; ++cp2) {
                const int kb0 = OFF_K + (cp2 * 32 + fr) * KSB + fq * 16;
                f32x4 acc0 = (f32x4){0.f, 0.f, 0.f, 0.f}, acc1 = acc0;
#pragma unroll
                for (int ks = 0; ks < 8; ++ks) { acc0 = MFMA16(lds_rd16(lds, kb0 + ks * 64), qf[ks], acc0); acc1 = MFMA16(lds_rd16(lds, kb0 + 16 * KSB + ks * 64), qf[ks], acc1); }
                f32x4 pv0, pv1;
#pragma unroll
                for (int j = 0; j < 4; ++j) { const int cp = cp2 * 32 + fq * 4 + j;
                    pv0[j] = (cc >= cp) ? acc0[j] * 0.0625f * __builtin_amdgcn_exp2f(l2g * (float)(cc - cp)) : 0.f;
                    pv1[j] = (cc >= cp + 16) ? acc1[j] * 0.0625f * __builtin_amdgcn_exp2f(l2g * (float)(cc - cp - 16)) : 0.f; }
                *(LAS u32x2*)(lds + OFF_P + (cc * PS + cp2 * 32 + fq * 4) * 2) = pack4(pv0);
                *(LAS u32x2*)(lds + OFF_P + (cc * PS + cp2 * 32 + 16 + fq * 4) * 2) = pack4(pv1);
            }
            __syncthreads();
            {
                f32x4 a1[4], a2[4];
#pragma unroll
                for (int et = 0; et < 4; ++et) { a1[et] = (f32x4){0.f, 0.f, 0.f, 0.f}; a2[et] = a1[et]; }
                const int ksmax = wid >> 1;
                for (int ks = 0; ks <= ksmax; ++ks) { const bf16x8 pf = lds_rd16(lds, OFF_P + (cc * PS + ks * 32 + fq * 8) * 2);
#pragma unroll
                    for (int et = 0; et < 4; ++et) a1[et] = MFMA16(lds_rd16(lds, OFF_VT + ((et * 16 + fr) * PS + ks * 32 + fq * 8) * 2), pf, a1[et]); }
#pragma unroll
                for (int ks = 0; ks < 8; ++ks)
#pragma unroll
                    for (int et = 0; et < 4; ++et) a2[et] = MFMA16(lds_rd16(lds, OFF_ST + ((et * 16 + fr) * STS + ks * 32 + fq * 8) * 2), qf[ks], a2[et]);
                const float dq = __builtin_amdgcn_exp2f(l2g * (float)(cc + 1));
                bf16_t* orow = O + (tok0 + cc) * 2048 + hh * 512 + e0 + fq * 4;
#pragma unroll
                for (int et = 0; et < 4; ++et) *(u32x2*)(orow + et * 16) = pack4(a1[et] + a2[et] * dq);
            }
            if (n < 15) {
                const bf16_t* qrow = QKV + (tok0 + 128 + cc) * 4096 + hh * 256 + fq * 8;
#pragma unroll
                for (int ks = 0; ks < 8; ++ks) qf[ks] = *(const bf16x8*)(qrow + ks * 32); }
            __syncthreads();
            if (n < 15) {
#pragma unroll
                for (int dt = 0; dt < 2; ++dt)
#pragma unroll
                    for (int et = 0; et < 4; ++et) sacc[dt][et] *= gN;
                const int q4 = (lane & 15) >> 2, p4 = lane & 3;
                const float fbase = 0.0625f * __builtin_amdgcn_exp2f(l2g * (float)(127 - 8 * fq));
#pragma unroll
                for (int ks = 0; ks < 4; ++ks) {
                    bf16x8 vf[4];
#pragma unroll
                    for (int et = 0; et < 4; ++et) vf[et] = lds_rd16(lds, OFF_VT + ((et * 16 + fr) * PS + ks * 32 + fq * 8) * 2);
                    const float fks = fbase * __builtin_amdgcn_exp2f(l2g * (float)(-32 * ks));
#pragma unroll
                    for (int dt = 0; dt < 2; ++dt) {
                        const int tb = OFF_K + (32 * ks + 8 * fq + q4) * KSB + (2 * wid + dt) * 32 + 8 * p4;
                        const s16x4 lo = lds_tr8(lds, tb), hi = lds_tr8(lds, tb + 4 * KSB);
                        f32x4 f0, f1;
#pragma unroll
                        for (int e = 0; e < 4; ++e) { f0[e] = bf2f((unsigned short)lo[e]) * (fks * __builtin_amdgcn_exp2f(l2g * (float)(-e))); f1[e] = bf2f((unsigned short)hi[e]) * (fks * __builtin_amdgcn_exp2f(l2g * (float)(-4 - e))); }
                        const bf16x8 kf = pack8(f0, f1);
#pragma unroll
                        for (int et = 0; et < 4; ++et) sacc[dt][et] = MFMA16(kf, vf[et], sacc[dt][et]); }
                }
#pragma unroll
                for (int dt = 0; dt < 2; ++dt)
#pragma unroll
                    for (int et = 0; et < 4; ++et) *(LAS u32x2*)(lds + OFF_ST + ((et * 16 + fr) * STS + (2 * wid + dt) * 16 + fq * 4) * 2) = pack4(sacc[dt][et]);
            }
            __syncthreads();
        }
    }
}

__device__ __forceinline__ void phase_ret_gate(bf16_t* O, const bf16_t* G) {
    int tid = threadIdx.x; asm volatile("" : "+v"(tid));
    const int wid = __builtin_amdgcn_readfirstlane(tid >> 6), lane = tid & 63;
    for (int idx = blockIdx.x * 8 + wid; idx < MTOK * 4; idx += gridDim.x * 8) {
        const size_t base = (size_t)(idx >> 2) * 2048 + (idx & 3) * 512 + lane * 8;
        const u32x4 ov = *(const u32x4*)(O + base), gv = *(const u32x4*)(G + base);
        float o[8] = {bflo(ov.x), bfhi(ov.x), bflo(ov.y), bfhi(ov.y), bflo(ov.z), bfhi(ov.z), bflo(ov.w), bfhi(ov.w)};
        const float g[8] = {bflo(gv.x), bfhi(gv.x), bflo(gv.y), bfhi(gv.y), bflo(gv.z), bfhi(gv.z), bflo(gv.w), bfhi(gv.w)};
        float s = 0.f;
#pragma unroll
        for (int i = 0; i < 8; ++i) s += o[i];
        const float mu = wsum(s, lane) * (1.0f / 512.0f); float v = 0.f;
#pragma unroll
        for (int i = 0; i < 8; ++i) { const float d = o[i] - mu; v += d * d; }
        const float rstd = rsqrtf(wsum(v, lane) * (1.0f / 512.0f) + 1e-6f);
#pragma unroll
        for (int i = 0; i < 8; ++i) o[i] = (o[i] - mu) * rstd * silu_f(g[i]);
        u32x4 w; w.x = cvt_pk_bf16(o[0], o[1]); w.y = cvt_pk_bf16(o[2], o[3]); w.z = cvt_pk_bf16(o[4], o[5]); w.w = cvt_pk_bf16(o[6], o[7]);
        *(u32x4*)(O + base) = w;
    }
}

__device__ __forceinline__ void phase_nsa_mat(const bf16_t* PROJ, const float* pek, const float* pev, bf16_t* AK, bf16_t* AV) {
    const size_t per = (size_t)8128 * 256;
    int tid = threadIdx.x; asm volatile("" : "+v"(tid));
    for (size_t i = (size_t)blockIdx.x * NTHR + tid; i < 2 * per; i += (size_t)gridDim.x * NTHR) {
        const int kv = i >= per; const size_t rem = kv ? i - per : i; const int r = (int)(rem >> 8), pp = (int)(rem & 255), l = pp >> 3, d0 = (pp & 7) * 8;
        const int g = r & 3, bn = r >> 2, b = bn / 127, n = bn % 127;
        const u32x4 v = *(const u32x4*)(PROJ + ((size_t)b * SEQ + n * 16 + l) * 2816 + 1024 + kv * 256 + g * 64 + d0);
        const float* pe = (kv ? pev : pek) + l * 64 + d0; const f32x4 p0 = *(const f32x4*)pe, p1 = *(const f32x4*)(pe + 4);
        u32x4 w; w.x = cvt_pk_bf16(bflo(v.x) + p0[0], bfhi(v.x) + p0[1]); w.y = cvt_pk_bf16(bflo(v.y) + p0[2], bfhi(v.y) + p0[3]);
        w.z = cvt_pk_bf16(bflo(v.z) + p1[0], bfhi(v.z) + p1[1]); w.w = cvt_pk_bf16(bflo(v.w) + p1[2], bfhi(v.w) + p1[3]);
        *(u32x4*)((kv ? AV : AK) + (size_t)r * 2048 + l * 64 + d0) = w;
    }
}
__device__ __forceinline__ void phase_nsa_cmp2(const bf16_t* HK, const bf16_t* HV, const bf16_t* W2K, const bf16_t* W2V, bf16_t* KC, bf16_t* VC) {
    int tid = threadIdx.x; asm volatile("" : "+v"(tid));
    const int wid = __builtin_amdgcn_readfirstlane(tid >> 6), lane = tid & 63, fr = lane & 15, fq = lane >> 4;
    for (int tt = blockIdx.x * 8 + wid; tt < 508 * 2; tt += gridDim.x * 8) {
        const int kv = tt >= 508, rt = kv ? tt - 508 : tt; const bf16_t* Hd = kv ? HV : HK; const bf16_t* W = kv ? W2V : W2K; bf16_t* Od = kv ? VC : KC;
        f32x4 acc[4];
#pragma unroll
        for (int nt = 0; nt < 4; ++nt) acc[nt] = (f32x4){0.f, 0.f, 0.f, 0.f};
#pragma unroll
        for (int ks = 0; ks < 8; ++ks) { const bf16x8 hf = *(const bf16x8*)(Hd + (size_t)(rt * 16 + fr) * 256 + ks * 32 + fq * 8);
#pragma unroll
            for (int nt = 0; nt < 4; ++nt) acc[nt] = MFMA16(*(const bf16x8*)(W + (size_t)(nt * 16 + fr) * 256 + ks * 32 + fq * 8), hf, acc[nt]); }
#pragma unroll
        for (int nt = 0; nt < 4; ++nt) *(u32x2*)(Od + (size_t)(rt * 16 + fr) * 64 + nt * 16 + fq * 4) = pack4(acc[nt]);
    }
}

struct AttnCtx { int b, g, cur, head, hp, t; float slope; bf16x8 qf[2]; float gate[3]; unsigned selq; unsigned anym; };
constexpr int A_KS = 72, A_VS = 72, A_KCS = 72, A_VCS = 72, A_KBYTES = 9216, A_VBYTES = 9216, A_OFF_K = 0, A_OFF_VT = 18432, A_OFF_KC = 36864, A_OFF_VCT = 55296, A_OFF_IMP = 73728, A_OFF_SEL = 90624, A_OFF_SELP = 90752;

template <int BR>
__device__ __forceinline__ void attn_branch(const bf16_t* PROJ, LAS unsigned char* lds, const AttnCtx& C, f32x4 (&otot)[4], int tid) {
    const int lane = tid & 63, fr = lane & 15, fq = lane >> 4;
    const float qs = 0.125f * 1.44269504089f, slope2 = C.slope * 1.44269504089f;
    f32x4 sl[4];
#pragma unroll
    for (int kt = 0; kt < 4; ++kt)
#pragma unroll
        for (int jj = 0; jj < 4; ++jj) sl[kt][jj] = slope2 * (float)(kt * 16 + jj);
    float m_ = -1e30f, l_ = 0.f;
    f32x4 oa[4];
#pragma unroll
    for (int dt = 0; dt < 4; ++dt) oa[dt] = (f32x4){0.f, 0.f, 0.f, 0.f};
    const int jlo = (BR == 1) ? 0 : (C.cur > 8 ? C.cur - 8 : 0);
    const int koff = (BR == 1 ? 1536 : 2048) + C.g * 64, voff = (BR == 1 ? 1792 : 2304) + C.g * 64;
    const int key = tid >> 3, d0 = (tid & 7) * 8;
    const bf16_t* srcb = PROJ + ((size_t)C.b * SEQ + key) * 2816 + d0;
    int j = jlo;
    if (BR == 1) { while (j <= C.cur && !((C.anym >> j) & 1u)) ++j; }
    bf16x8 kreg = *(const bf16x8*)(srcb + (size_t)j * 64 * 2816 + koff), vreg = *(const bf16x8*)(srcb + (size_t)j * 64 * 2816 + voff);
    __syncthreads();
    int buf = 0;
    { *(LAS bf16x8*)(lds + A_OFF_K + (key * A_KS + d0) * 2) = kreg; *(LAS bf16x8*)(lds + A_OFF_VT + (key * A_VS + d0) * 2) = vreg; }
    __syncthreads();
    while (j <= C.cur) {
        int jn = j + 1;
        if (BR == 1) { while (jn <= C.cur && !((C.anym >> jn) & 1u)) ++jn; }
        const bool more = jn <= C.cur;
        if (more) { kreg = *(const bf16x8*)(srcb + (size_t)jn * 64 * 2816 + koff); vreg = *(const bf16x8*)(srcb + (size_t)jn * 64 * 2816 + voff); }
        const int kb = A_OFF_K + buf * A_KBYTES, vb = A_OFF_VT + buf * A_VBYTES;
        f32x4 s4[4]; float alpha;
        const int dbase = C.t - j * 64 - fq * 4;
        const bool partial = (j == C.cur) || (BR == 2 && j + 8 <= C.cur);
        if (partial) {
            float tmax = -1e30f;
#pragma unroll
            for (int kt = 0; kt < 4; ++kt) { f32x4 acc = (f32x4){0.f, 0.f, 0.f, 0.f};
#pragma unroll
                for (int ks = 0; ks < 2; ++ks) acc = MFMA16(lds_rd16(lds, kb + ((kt * 16 + fr) * A_KS + ks * 32 + fq * 8) * 2), C.qf[ks], acc);
#pragma unroll
                for (int jj = 0; jj < 4; ++jj) { const int dist = dbase - (kt * 16 + jj);
                    const bool ok = (dist >= 0) && (BR == 1 ? (((C.selq >> j) & 1u) != 0u) : (dist < 512));
                    const float s = ok ? acc[jj] * qs - slope2 * (float)dist : -1e30f; s4[kt][jj] = s; tmax = fmaxf(tmax, s); } }
            tmax = fmaxf(tmax, shx<16>(tmax, lane)); tmax = fmaxf(tmax, shx<32>(tmax, lane));
            const float mnew = fmaxf(m_, tmax); alpha = __builtin_amdgcn_exp2f(m_ - mnew); m_ = mnew;
            float psum = 0.f;
#pragma unroll
            for (int kt = 0; kt < 4; ++kt)
#pragma unroll
                for (int jj = 0; jj < 4; ++jj) { const float pp = (s4[kt][jj] > -1e29f) ? __builtin_amdgcn_exp2f(s4[kt][jj] - mnew) : 0.f; s4[kt][jj] = pp; psum += pp; }
            l_ = l_ * alpha + psum;
        } else {
            float c0 = -slope2 * (float)dbase;
            if (BR == 1 && !((C.selq >> j) & 1u)) c0 = -1e30f;
            float tmax = -1e30f;
#pragma unroll
            for (int kt = 0; kt < 4; ++kt) { f32x4 acc = (f32x4){0.f, 0.f, 0.f, 0.f};
#pragma unroll
                for (int ks = 0; ks < 2; ++ks) acc = MFMA16(lds_rd16(lds, kb + ((kt * 16 + fr) * A_KS + ks * 32 + fq * 8) * 2), C.qf[ks], acc);
#pragma unroll
                for (int jj = 0; jj < 4; ++jj) { const float u = acc[jj] * qs + sl[kt][jj]; s4[kt][jj] = u; tmax = fmaxf(tmax, u); } }
            tmax += c0;
            tmax = fmaxf(tmax, shx<16>(tmax, lane)); tmax = fmaxf(tmax, shx<32>(tmax, lane));
            const float mnew = fmaxf(m_, tmax); alpha = __builtin_amdgcn_exp2f(m_ - mnew); m_ = mnew;
            const float sh = mnew - c0; float psum = 0.f;
#pragma unroll
            for (int kt = 0; kt < 4; ++kt)
#pragma unroll
                for (int jj = 0; jj < 4; ++jj) { const float pp = __builtin_amdgcn_exp2f(s4[kt][jj] - sh); s4[kt][jj] = pp; psum += pp; }
            l_ = l_ * alpha + psum;
        }
#pragma unroll
        for (int dt = 0; dt < 4; ++dt) oa[dt] *= alpha;
#pragma unroll
        for (int ks2 = 0; ks2 < 2; ++ks2) { const bf16x8 pf = pack8(s4[2 * ks2], s4[2 * ks2 + 1]);
#pragma unroll
            for (int dt = 0; dt < 4; ++dt) oa[dt] = MFMA16(lds_tr8x2(lds, vb + (ks2 * 32 + fq * 4 + ((lane & 15) >> 2)) * (A_VS * 2) + dt * 32 + 8 * (lane & 3), 16 * A_VS * 2), pf, oa[dt]); }
        if (more) { const int kb2 = A_OFF_K + (buf ^ 1) * A_KBYTES, vb2 = A_OFF_VT + (buf ^ 1) * A_VBYTES;
            *(LAS bf16x8*)(lds + kb2 + (key * A_KS + d0) * 2) = kreg; *(LAS bf16x8*)(lds + vb2 + (key * A_VS + d0) * 2) = vreg; }
        __syncthreads();
        buf ^= 1; j = jn;
    }
    float lt = l_; lt += shx<16>(lt, lane); lt += shx<32>(lt, lane); const float inv = lt > 0.f ? C.gate[BR] / lt : 0.f;
#pragma unroll
    for (int dt = 0; dt < 4; ++dt) otot[dt] += oa[dt] * inv;
}

__device__ __forceinline__ void phase_nsa_attn(const bf16_t* PROJ, const bf16_t* KCMP, const bf16_t* VCMP, bf16_t* OATT, LAS unsigned char* lds) {
    int tid = threadIdx.x; asm volatile("" : "+v"(tid));
    const int wid = __builtin_amdgcn_readfirstlane(tid >> 6), lane = tid & 63, fr = lane & 15, fq = lane >> 4;
    LAS float* IMP = (LAS float*)(lds + A_OFF_IMP); LAS unsigned* SEL = (LAS unsigned*)(lds + A_OFF_SEL); LAS unsigned* SELP = (LAS unsigned*)(lds + A_OFF_SELP);
    for (int id = blockIdx.x; id < 4096; id += gridDim.x) {
        const int k8 = id & 255, ii = id >> 8, bg = k8 & 63, kk = k8 >> 6;
        const int qt32 = (ii & 1) ? 63 - (kk + 4 * (ii - 1)) : kk + 4 * ii;
        AttnCtx C; C.cur = qt32 >> 1; C.b = bg >> 2; C.g = bg & 3; C.hp = wid >> 1; C.head = C.g * 4 + C.hp; C.slope = exp2f(-0.5f * (float)(C.head + 1));
        const int qq = (wid & 1) * 16 + fr; C.t = qt32 * 32 + qq; const size_t trow = (size_t)C.b * SEQ + C.t;
        { const bf16_t* pr = PROJ + trow * 2816;
#pragma unroll
          for (int ks = 0; ks < 2; ++ks) C.qf[ks] = *(const bf16x8*)(pr + C.head * 64 + ks * 32 + fq * 8);
#pragma unroll
          for (int br = 0; br < 3; ++br) C.gate[br] = 1.0f / (1.0f + __expf(-bf2f(pr[2560 + C.head * 3 + br]))); }
#ifdef ONLY_BR
#pragma unroll
        for (int br = 0; br < 3; ++br) if (br != ONLY_BR) C.gate[br] = 0.f;
#endif
        f32x4 otot[4];
#pragma unroll
        for (int dt = 0; dt < 4; ++dt) otot[dt] = (f32x4){0.f, 0.f, 0.f, 0.f};
        __syncthreads();
#pragma unroll
        for (int rep = 0; rep < 2; ++rep) { const int idx = tid + rep * NTHR, n = idx >> 3, d0 = (idx & 7) * 8, nc = n < 126 ? n : 126; const size_t src = ((size_t)(C.b * 127 + nc) * 4 + C.g) * 64 + d0;
            *(LAS bf16x8*)(lds + A_OFF_KC + (n * A_KCS + d0) * 2) = *(const bf16x8*)(KCMP + src);
            *(LAS bf16x8*)(lds + A_OFF_VCT + (n * A_VCS + d0) * 2) = *(const bf16x8*)(VCMP + src); }
        __syncthreads();
        {
            f32x4 sc[8]; float mx = -1e30f;
#pragma unroll
            for (int kt = 0; kt < 8; ++kt) { f32x4 acc = (f32x4){0.f, 0.f, 0.f, 0.f};
#pragma unroll
                for (int ks = 0; ks < 2; ++ks) acc = MFMA16(lds_rd16(lds, A_OFF_KC + ((kt * 16 + fr) * A_KCS + ks * 32 + fq * 8) * 2), C.qf[ks], acc);
#pragma unroll
                for (int jj = 0; jj < 4; ++jj) { const int n = kt * 16 + fq * 4 + jj, ce = n * 16 + 31; const bool ok = (n <= 126) && (ce <= C.t);
                    const float s = ok ? acc[jj] * 0.125f - C.slope * (float)(C.t - ce) : -1e30f; sc[kt][jj] = s; mx = fmaxf(mx, s); } }
            mx = fmaxf(mx, shx<16>(mx, lane)); mx = fmaxf(mx, shx<32>(mx, lane));
            float sum = 0.f;
#pragma unroll
            for (int kt = 0; kt < 8; ++kt)
#pragma unroll
                for (int jj = 0; jj < 4; ++jj) { const float pp = (sc[kt][jj] > -1e29f) ? __expf(sc[kt][jj] - mx) : 0.f; sc[kt][jj] = pp; sum += pp; }
            sum += shx<16>(sum, lane); sum += shx<32>(sum, lane);
            const float inv = sum > 0.f ? 1.0f / sum : 0.f;
#pragma unroll
            for (int kt = 0; kt < 8; ++kt) sc[kt] *= inv;
#pragma unroll
            for (int kt = 0; kt < 8; ++kt) { const float a = shi(sc[kt][3], (lane + 48) & 63); const float bp = kt > 0 ? shi(sc[kt > 0 ? kt - 1 : 0][3], (lane + 48) & 63) : 0.f;
                const float prev3 = fq > 0 ? a : bp;
                IMP[(C.hp * 32 + qq) * 33 + 4 * kt + fq] = sc[kt][0] + sc[kt][1] + sc[kt][2] + 0.5f * sc[kt][3] + 0.5f * prev3; }
            f32x4 oc[4];
#pragma unroll
            for (int dt = 0; dt < 4; ++dt) oc[dt] = (f32x4){0.f, 0.f, 0.f, 0.f};
#pragma unroll
            for (int ks2 = 0; ks2 < 4; ++ks2) { const bf16x8 pf = pack8(sc[2 * ks2], sc[2 * ks2 + 1]);
#pragma unroll
                for (int dt = 0; dt < 4; ++dt) oc[dt] = MFMA16(lds_tr8x2(lds, A_OFF_VCT + (ks2 * 32 + fq * 4 + ((lane & 15) >> 2)) * (A_VCS * 2) + dt * 32 + 8 * (lane & 3), 16 * A_VCS * 2), pf, oc[dt]); }
#pragma unroll
            for (int dt = 0; dt < 4; ++dt) otot[dt] += oc[dt] * C.gate[0];
        }
        __syncthreads();
        if (C.cur >= 16) {
            const int sq = tid & 31, jg = tid >> 5;
#pragma unroll
            for (int jj = 0; jj < 2; ++jj) { const int j = jg * 2 + jj; const float imp = IMP[(0 * 32 + sq) * 33 + j] + IMP[(1 * 32 + sq) * 33 + j] + IMP[(2 * 32 + sq) * 33 + j] + IMP[(3 * 32 + sq) * 33 + j];
                const bool valid = j <= C.cur, forced = (j == 0) || (j == C.cur) || (j == C.cur - 1);
                IMP[sq * 33 + j] = valid ? (forced ? 1e4f : imp) : -1.0f; }
            __syncthreads();
            unsigned bits = 0u;
#pragma unroll
            for (int jj = 0; jj < 2; ++jj) { const int j = jg * 2 + jj; const float sj = IMP[sq * 33 + j]; int cnt = 0;
                for (int j2 = 0; j2 < 32; ++j2) { const float s2 = IMP[sq * 33 + j2]; cnt += ((s2 > sj) || (s2 == sj && j2 < j)) ? 1 : 0; }
                if (cnt < 16) bits |= 1u << j; }
            SELP[jg * 32 + sq] = bits;
            __syncthreads();
            if (tid < 32) { unsigned m = 0u;
#pragma unroll
                for (int q = 0; q < 16; ++q) m |= SELP[q * 32 + tid];
                SEL[tid] = m; }
        } else { if (tid < 32) SEL[tid] = (2u << C.cur) - 1u; }
        __syncthreads();
        C.selq = SEL[qq];
        { unsigned m = SEL[lane & 31]; m |= shxu<16>(m, lane); m |= shxu<8>(m, lane); m |= shxu<4>(m, lane); m |= shxu<2>(m, lane); m |= shxu<1>(m, lane); C.anym = (unsigned)__builtin_amdgcn_readfirstlane((int)m); }
        attn_branch<1>(PROJ, lds, C, otot, tid);
        attn_branch<2>(PROJ, lds, C, otot, tid);
#pragma unroll
        for (int dt = 0; dt < 4; ++dt) *(u32x2*)(OATT + trow * 1024 + C.head * 64 + dt * 16 + fq * 4) = pack4(otot[dt]);
    }
}

#define XB_TMO      128
#define XB_XCNT(j)  (256  + 64 * (j))
#define XB_XSUB(j)  (1280 + 64 * (j))
#define XB_XGEN(j)  (2304 + 64 * (j))
#define XB_TOP      3328
#define XB_TOPGEN   3392
#define XCD_BAR_WORDS 3456
#define XB_SPIN_CAP (1u << 18)

__device__ __forceinline__ unsigned xb_ld(unsigned* p)              { return __hip_atomic_load(p, __ATOMIC_RELAXED, __HIP_MEMORY_SCOPE_AGENT); }
__device__ __forceinline__ unsigned xb_add(unsigned* p, unsigned v) { return __hip_atomic_fetch_add(p, v, __ATOMIC_RELAXED, __HIP_MEMORY_SCOPE_AGENT); }
__device__ __forceinline__ unsigned xb_xcc_id() { return (unsigned)__builtin_amdgcn_s_getreg((3 << 11) | 20) & 0xFu; }
#define XB_SPIN(cond, bar) do { unsigned _sp = 0; while (cond) { __builtin_amdgcn_s_sleep(1); \
    if ((++_sp & 255u) == 0u) { if (xb_ld(&(bar)[XB_TMO])) break; if (_sp > XB_SPIN_CAP) { atomicAdd(&(bar)[XB_TMO], 1u); break; } } } } while (0)

struct XcdBarrier {
    unsigned* bar; unsigned x;
    volatile LAS unsigned* st;
};

__device__ __forceinline__ XcdBarrier xcd_barrier_post(unsigned* bar, volatile LAS unsigned* st) {
    XcdBarrier b; b.bar = bar; b.x = xb_xcc_id(); b.st = st;
    if (threadIdx.x == 0) (void)xb_add(&bar[XB_XCNT(b.x)], 1u);
    return b;
}
__device__ __forceinline__ void xcd_barrier_complete(unsigned* bar, unsigned x, unsigned& nloc, unsigned& nx) {
    const unsigned G = gridDim.x * gridDim.y * gridDim.z;
    unsigned sum, cnt, mine, sp = 0u;
    for (;;) {
        sum = 0u; cnt = 0u; mine = 0u;
#pragma unroll
        for (unsigned j = 0; j < 16; ++j) { const unsigned c = xb_ld(&bar[XB_XCNT(j)]); sum += c; cnt += (c > 0u) ? 1u : 0u; mine = (j == x) ? c : mine; }
        if (sum == G) break;
        __builtin_amdgcn_s_sleep(1);
        if ((++sp & 255u) == 0u) { if (xb_ld(&bar[XB_TMO])) break; if (sp > XB_SPIN_CAP) { atomicAdd(&bar[XB_TMO], 1u); break; } }
    }
    nloc = mine > 0u ? mine : 1u; nx = cnt > 0u ? cnt : 1u;
}

__device__ __forceinline__ void xcd_barrier(const XcdBarrier& b) {
    asm volatile("s_waitcnt vmcnt(0)" ::: "memory");
    __syncthreads();
    if (threadIdx.x == 0) {
        unsigned* bar = b.bar;
        __builtin_amdgcn_s_waitcnt(0);
        unsigned nloc = b.st[0], nx = b.st[1];
        if (nloc == 0u) { xcd_barrier_complete(bar, b.x, nloc, nx); b.st[0] = nloc; b.st[1] = nx; }
        const unsigned old = xb_add(&bar[XB_XSUB(b.x)], 1u);
        const unsigned gen = old / nloc;
        if (old + 1u == (gen + 1u) * nloc) {
            __builtin_amdgcn_fence(__ATOMIC_RELEASE, "agent");
            asm volatile("s_waitcnt vmcnt(0)" ::: "memory");
            const unsigned og = xb_add(&bar[XB_TOP], 1u);
            const unsigned tg = og / nx;
            if (og + 1u == (tg + 1u) * nx) xb_add(&bar[XB_TOPGEN], 1u);
            else XB_SPIN(xb_ld(&bar[XB_TOPGEN]) == tg, bar);
            __builtin_amdgcn_fence(__ATOMIC_ACQUIRE, "agent");
            xb_add(&bar[XB_XGEN(b.x)], 1u);
            asm volatile("s_waitcnt vmcnt(0)" ::: "memory");
        } else {
            XB_SPIN(xb_ld(&bar[XB_XGEN(b.x)]) == gen, bar);
            __builtin_amdgcn_fence(__ATOMIC_ACQUIRE, "agent");
            asm volatile("s_waitcnt vmcnt(0)" ::: "memory");
        }
    }
    __syncthreads();
}


#ifndef R_CORE
#define R_CORE 1
#endif
#ifndef R_ATTN
#define R_ATTN 1
#endif
#ifndef R_GEMM
#define R_GEMM 1
#endif
#ifndef R_BAR
#define R_BAR 1
#endif
#ifndef R_PREP
#define R_PREP 1
#endif
struct GemmDesc { const bf16_t* A; const bf16_t* Bt; bf16_t* O; int M, N, K, ldc, act, cshift; };
__device__ __forceinline__ void run_gemm(const GemmDesc& d, LAS unsigned char* lds) {
    pg8::Gemm g{d.A, d.Bt, d.M, d.N, d.K}; pg8::StaticOrder S; const int G = (int)gridDim.x; S.init(d.M, d.N, G, ((int)blockIdx.x + G - d.cshift % G) % G);
    if (d.act == 0) { pg8::Epi<0> E{d.O, d.ldc}; pg8::gemm_phase<pg8::Epi<0>, pg8::StaticOrder>(lds, g, S, E); }
    else if (d.act == 1) { pg8::Epi<1> E{d.O, d.ldc}; pg8::gemm_phase<pg8::Epi<1>, pg8::StaticOrder>(lds, g, S, E); }
    else { pg8::Epi<2> E{d.O, d.ldc}; pg8::gemm_phase<pg8::Epi<2>, pg8::StaticOrder>(lds, g, S, E); }
}

__global__ void __launch_bounds__(NTHR) fwd_megakernel(Params p) {
    extern __shared__ __attribute__((aligned(16))) unsigned char smem[];
    LAS unsigned char* lds = (LAS unsigned char*)smem;
    cg::grid_group grid = cg::this_grid();
    unsigned char* ws = p.ws; unsigned char* U = ws + OFF_U2;
    const float* mod = (const float*)(ws + OFF_MOD); bf16_t* H = (bf16_t*)(ws + OFF_H);
    if (threadIdx.x < 4) ((LAS unsigned*)(lds + XB_LDS_OFF))[threadIdx.x] = 0u;
    __syncthreads();
    XcdBarrier xbar = xcd_barrier_post((unsigned*)(ws + WS_END), (volatile LAS unsigned*)(lds + XB_LDS_OFF));
    grid.sync();

#ifdef PREFILL
    { const u32x4 pz = (u32x4){0xAAAAAAAAu, 0xAAAAAAAAu, 0xAAAAAAAAu, 0xAAAAAAAAu}; for (size_t i = (size_t)blockIdx.x * NTHR + threadIdx.x; i < WS_END / 16; i += (size_t)gridDim.x * NTHR) ((u32x4*)ws)[i] = pz; }
    xcd_barrier(xbar);
#endif
    for (int gs = 0; gs < 2 + DEPTH * 13; ++gs) {
        if (gs < 2) {
            if (gs == 0) { for (int rr = 0; rr < R_PREP; ++rr) phase_prep(p, lds); } else phase_init(p);
        } else {
        const int layer = (gs - 2) / 13, st = (gs - 2) % 13;
        const int jm = layer >> 1; const bool is_ret = (layer & 1) == 0;
        const float* modL = mod + (size_t)layer * 16 * MODW;
        {
            GemmDesc d[2]; int ng = 0;
            d[0].cshift = 0; d[1].cshift = 0;
            if (st == 0 || st == 10) {
                const int s = st == 0 ? 0 : 1;
                d[0] = GemmDesc{H, (const bf16_t*)(ws + OFF_FFN_IN + (size_t)(layer * 2 + s) * SZ_FFN_IN), (bf16_t*)(U + U_FFN_ACT), MTOK, 5632, 1024, DFF, 1, 0}; ng = 1;
            } else if (st == 1 || st == 11) {
                const int s = st == 1 ? 0 : 1;
                d[0] = GemmDesc{(const bf16_t*)(U + U_FFN_ACT), (const bf16_t*)(ws + OFF_FFN_OUT + (size_t)(layer * 2 + s) * SZ_FFN_OUT), (bf16_t*)(U + U_FFN_Y), MTOK, 1024, DFF, 1024, 0, 0}; ng = 1;
            } else if (st == 2 || st == 9 || st == 12) {
                const int sub = st == 2 ? 0 : (st == 9 ? 1 : 2);
                const bf16_t* y = (const bf16_t*)(U + (sub == 1 ? (is_ret ? U_RET_Y : U_NSA_Y) : U_FFN_Y));
                const float* modN = (sub == 2) ? (layer + 1 < DEPTH ? modL + (size_t)16 * MODW : modL) : modL;
                const int shc = (sub == 2) ? 0 : (sub + 1) * 3;
#ifdef LN_DRY
                if (sub != 1) phase_ln(p.out, (float*)(U + 0), y, modL + (sub * 3 + 2) * 1024, sub == 1 ? 1.0f : 0.5f, p.ln_g + (size_t)(layer * 3 + sub) * 1024, p.ln_b + (size_t)(layer * 3 + sub) * 1024,
                         modN + shc * 1024, modN + (shc + 1) * 1024, (bf16_t*)(U + 128 * MiB));
#endif
                phase_ln(p.out, p.out, y, modL + (sub * 3 + 2) * 1024, sub == 1 ? 1.0f : 0.5f, p.ln_g + (size_t)(layer * 3 + sub) * 1024, p.ln_b + (size_t)(layer * 3 + sub) * 1024,
                         modN + shc * 1024, modN + (shc + 1) * 1024, H);
            } else if (is_ret) {
                const bf16_t* Wi = (const bf16_t*)(ws + OFF_RET_IN + (size_t)jm * SZ_RET_IN);
                if (st == 3) { d[0] = GemmDesc{H, Wi, (bf16_t*)(U + U_RET_QKV), MTOK, 4096, 1024, 4096, 0, 0}; ng = 1; }
                else if (st == 4) { for (int rr = 0; rr < R_CORE; ++rr) phase_ret_core((const bf16_t*)(U + U_RET_QKV), (bf16_t*)(U + U_RET_O), lds); }
                else if (st == 5) { d[0] = GemmDesc{H, Wi + (size_t)4096 * 1024, (bf16_t*)(U + U_RET_G), MTOK, 2048, 1024, 2048, 0, 0}; ng = 1; }
                else if (st == 6) phase_ret_gate((bf16_t*)(U + U_RET_O), (const bf16_t*)(U + U_RET_G));
                else if (st == 7) { d[0] = GemmDesc{(const bf16_t*)(U + U_RET_O), (const bf16_t*)(ws + OFF_RET_OUT + (size_t)jm * SZ_RET_OUT), (bf16_t*)(U + U_RET_Y), MTOK, 1024, 2048, 1024, 0, 0}; ng = 1; }
                else continue;
            } else {
                if (st == 3) { d[0] = GemmDesc{H, (const bf16_t*)(ws + OFF_NSA_IN + (size_t)jm * SZ_NSA_IN), (bf16_t*)(U + U_NSA_PROJ), MTOK, 2816, 1024, 2816, 0, 0}; ng = 1; }
                else if (st == 4) phase_nsa_mat((const bf16_t*)(U + U_NSA_PROJ), p.pe_k + (size_t)jm * 2048, p.pe_v + (size_t)jm * 2048, (bf16_t*)(U + U_NSA_ACMPK), (bf16_t*)(U + U_NSA_ACMPV));
                else if (st == 5) {
                    d[0] = GemmDesc{(const bf16_t*)(U + U_NSA_ACMPK), (const bf16_t*)(ws + OFF_W1 + (size_t)(0 * 2 + jm) * SZ_W1), (bf16_t*)(U + U_NSA_HK), 8192, 256, 2048, 256, 2, 0};
                    d[1] = GemmDesc{(const bf16_t*)(U + U_NSA_ACMPV), (const bf16_t*)(ws + OFF_W1 + (size_t)(1 * 2 + jm) * SZ_W1), (bf16_t*)(U + U_NSA_HV), 8192, 256, 2048, 256, 2, 32}; ng = 2;
                } else if (st == 6) phase_nsa_cmp2((const bf16_t*)(U + U_NSA_HK), (const bf16_t*)(U + U_NSA_HV), (const bf16_t*)(ws + OFF_W2 + (size_t)(0 * 2 + jm) * SZ_W2), (const bf16_t*)(ws + OFF_W2 + (size_t)(1 * 2 + jm) * SZ_W2),
                                               (bf16_t*)(U + U_NSA_KCMP), (bf16_t*)(U + U_NSA_VCMP));
                else if (st == 7) { for (int rr = 0; rr < R_ATTN; ++rr) phase_nsa_attn((const bf16_t*)(U + U_NSA_PROJ), (const bf16_t*)(U + U_NSA_KCMP), (const bf16_t*)(U + U_NSA_VCMP), (bf16_t*)(U + U_NSA_OATT), lds); }
                else { d[0] = GemmDesc{(const bf16_t*)(U + U_NSA_OATT), (const bf16_t*)(ws + OFF_NSA_OUT + (size_t)jm * SZ_NSA_OUT), (bf16_t*)(U + U_NSA_Y), MTOK, 1024, 1024, 1024, 0, 0}; ng = 1; }
            }
            for (int rr = 0; rr < R_GEMM; ++rr) for (int r = 0; r < ng; ++r) { GemmDesc dd = d[0]; if (r == 1) dd = d[1]; run_gemm(dd, lds); }
        }
        }
        xcd_barrier(xbar);
    }
}

extern "C" void kernel_launch(void* const* d_in, const int* in_sizes, int n_in, void* d_out, int out_size, void* d_ws, size_t ws_size, hipStream_t stream) {
    static int grid_blocks = 0;
    if (grid_blocks == 0) {
        int dev = 0, cus = 0, per_cu = 0;
        hipGetDevice(&dev); hipDeviceGetAttribute(&cus, hipDeviceAttributeMultiprocessorCount, dev);
        if (hipFuncSetAttribute((const void*)fwd_megakernel, hipFuncAttributeMaxDynamicSharedMemorySize, LDS_BYTES) != hipSuccess) fprintf(stderr, "hipFuncSetAttribute failed\n");
        if (hipOccupancyMaxActiveBlocksPerMultiprocessor(&per_cu, (const void*)fwd_megakernel, NTHR, LDS_BYTES) != hipSuccess || per_cu < 1) { fprintf(stderr, "occupancy query: %d\n", per_cu); per_cu = 1; }
        (void)hipGetLastError();
        grid_blocks = cus * 1;
        if (ws_size < WS_END + 16384) fprintf(stderr, "workspace too small: %zu < %zu\n", ws_size, (size_t)WS_END);
    }
    Params p{};
    p.x = (const float*)d_in[0]; p.c = (const float*)d_in[1]; p.ada_w = (const float*)d_in[2]; p.ada_b = (const float*)d_in[3]; p.ln_g = (const float*)d_in[4]; p.ln_b = (const float*)d_in[5];
    p.pe_k = (const float*)d_in[12]; p.pe_v = (const float*)d_in[13]; p.out = (float*)d_out; p.ws = (unsigned char*)d_ws;
    unsigned char* ws = (unsigned char*)d_ws; int nj = 0, te = 0;
    auto add = [&](const float* src, size_t dst_off, int K, int N, int Np, int mode) { p.jobs[nj] = WJob{src, (bf16_t*)(ws + dst_off), K, N, Np, mode}; te += (Np / 64) * (K / 64); p.tile_end[nj] = te; ++nj; };
    const float* ffn_in = (const float*)d_in[6]; const float* ffn_out = (const float*)d_in[7]; const float* ret_in = (const float*)d_in[8]; const float* ret_out = (const float*)d_in[9];
    const float* nsa_in = (const float*)d_in[10]; const float* nsa_out = (const float*)d_in[11];
    const float* ck1 = (const float*)d_in[14]; const float* ck2 = (const float*)d_in[15]; const float* cv1 = (const float*)d_in[16]; const float* cv2 = (const float*)d_in[17];
    for (int i = 0; i < 8; ++i) add(ffn_in + (size_t)i * 1024 * 5632, OFF_FFN_IN + i * SZ_FFN_IN, 1024, 5632, 5632, 1);
    for (int i = 0; i < 8; ++i) add(ffn_out + (size_t)i * 2816 * 1024, OFF_FFN_OUT + i * SZ_FFN_OUT, 2816, 1024, 1024, 0);
    for (int i = 0; i < 2; ++i) add(ret_in + (size_t)i * 1024 * 6144, OFF_RET_IN + i * SZ_RET_IN, 1024, 6144, 6144, 0);
    for (int i = 0; i < 2; ++i) add(ret_out + (size_t)i * 2048 * 1024, OFF_RET_OUT + i * SZ_RET_OUT, 2048, 1024, 1024, 0);
    for (int i = 0; i < 2; ++i) add(nsa_in + (size_t)i * 1024 * 2608, OFF_NSA_IN + i * SZ_NSA_IN, 1024, 2608, 2816, 0);
    for (int i = 0; i < 2; ++i) add(nsa_out + (size_t)i * 1024 * 1024, OFF_NSA_OUT + i * SZ_NSA_OUT, 1024, 1024, 1024, 0);
    for (int i = 0; i < 2; ++i) add(ck1 + (size_t)i * 2048 * 256, OFF_W1 + (0 * 2 + i) * SZ_W1, 2048, 256, 256, 0);
    for (int i = 0; i < 2; ++i) add(cv1 + (size_t)i * 2048 * 256, OFF_W1 + (1 * 2 + i) * SZ_W1, 2048, 256, 256, 0);
    for (int i = 0; i < 2; ++i) add(ck2 + (size_t)i * 256 * 64, OFF_W2 + (0 * 2 + i) * SZ_W2, 256, 64, 64, 0);
    for (int i = 0; i < 2; ++i) add(cv2 + (size_t)i * 256 * 64, OFF_W2 + (1 * 2 + i) * SZ_W2, 256, 64, 64, 0);
    p.njobs = nj;
    if (hipMemsetAsync(ws + WS_END, 0, 16384, stream) != hipSuccess) fprintf(stderr, "barrier memset failed\n");
    void* args[] = {&p};
    hipError_t e = hipLaunchCooperativeKernel((const void*)fwd_megakernel, dim3(grid_blocks), dim3(NTHR), args, LDS_BYTES, stream);
    if (e != hipSuccess) fprintf(stderr, "cooperative launch failed: %s (grid %d)\n", hipGetErrorString(e), grid_blocks);
}
```

```cpp
#include <hip/hip_runtime.h>
#include <hip/hip_cooperative_groups.h>
#include <cstdio>
namespace cg = cooperative_groups;

namespace pg8 {
#define PG8_LAS __attribute__((address_space(3)))
typedef unsigned short bf16_t;
typedef short bf16x8 __attribute__((ext_vector_type(8)));
typedef float f32x4 __attribute__((ext_vector_type(4)));
typedef unsigned u32x4 __attribute__((ext_vector_type(4)));
constexpr int BM = 256, BK = 64, HALF = 128, HTB = HALF * BK * 2  , STAGE_BYTES = 8 * HTB, NXCD = 8, WGM = 8;

__host__ __device__ __forceinline__ int lds_byte(int r, int c) { const int st = (r >> 4) * 2 + (c >> 5), rr = r & 15, cc = c & 31, ob = rr * 64 + cc * 2; return st * 1024 + (ob ^ (((ob >> 9) & 1) << 5)); }
__host__ __device__ __forceinline__ void stage_rc(int b, int& R, int& C) { const int st = b / 1024, sb = b % 1024, swz = sb ^ (((sb >> 9) & 1) << 5); R = (st >> 1) * 16 + swz / 64; C = (st & 1) * 32 + (swz % 64) / 2; }
__host__ __device__ __forceinline__ int perm32(int rho) { const int n = rho >> 4, i = rho & 15; return 8 * (i >> 2) + 4 * n + (i & 3); }

struct Unit { int pm, pn; };
struct Gemm { const bf16_t* A; const bf16_t* Bt; int M, N, K; };

struct StaticOrder {
    int nM, nN, nwg, G, c;
    __host__ __device__ void init(int M, int N, int G_, int c_) { nM = M / BM; nN = N / BM; nwg = nM * nN; G = G_; c = c_; }
    __host__ __device__ bool next(int i, Unit& u) const {
        const long L = (long)i * G + c; if (L >= nwg) return false;
        int wgid = (int)L; { const int q = nwg / NXCD, r = nwg % NXCD, xcd = wgid % NXCD, off = wgid / NXCD; wgid = (xcd < r ? xcd * (q + 1) : r * (q + 1) + (xcd - r) * q) + off; }
        const int nig = WGM * nN, gid = wgid / nig, fm = gid * WGM, gsz = (nM - fm) < WGM ? (nM - fm) : WGM;
        u.pm = fm + ((wgid % nig) % gsz); u.pn = (wgid % nig) / gsz; return true;
    }
    __device__ __forceinline__ void a_ready(const Unit&) const {}
    __device__ __forceinline__ void done(const Unit&) const {}
};

typedef float f32x2_t __attribute__((ext_vector_type(2)));
typedef __bf16 bf16x2_t __attribute__((ext_vector_type(2)));
__device__ __forceinline__ unsigned cvt_pk_bf16(float lo, float hi) { const f32x2_t v = {lo, hi}; return __builtin_bit_cast(unsigned, __builtin_convertvector(v, bf16x2_t)); }
__device__ __forceinline__ float silu_f(float a) { return a * __builtin_amdgcn_rcpf(1.0f + __builtin_amdgcn_exp2f(-1.44269504089f * a)); }
__device__ __forceinline__ float gelu_tanh_f(float x) { const float u = 0.7978845608028654f * (x + 0.044715f * x * x * x); const float t = 1.0f - 2.0f * __builtin_amdgcn_rcpf(1.0f + __builtin_amdgcn_exp2f(2.88539008178f * u)); return 0.5f * x * (1.0f + t); }

template <int ACT> struct Epi {
    static constexpr bool PERM = true, AFTER_DRAIN = false;
    bf16_t* O; int ldc;
    __device__ __forceinline__ void operator()(const f32x4 (&acc)[2][2][4][2], const Unit& u, int wr, int wc, int fr, int fq) const {
        const int row0 = u.pm * BM + wr * 64 + fr;
        if (ACT == 1) {
            const int col0 = u.pn * HALF + wc * 32 + 8 * fq;
#pragma unroll
            for (int ai = 0; ai < 2; ++ai)
#pragma unroll
                for (int m = 0; m < 4; ++m) { bf16_t* rowp = O + (size_t)(row0 + ai * HALF + m * 16) * ldc + col0;
                    const f32x4 a0 = acc[ai][0][m][0], a1 = acc[ai][0][m][1], u0 = acc[ai][1][m][0], u1 = acc[ai][1][m][1];
                    u32x4 w; w.x = cvt_pk_bf16(silu_f(a0[0]) * u0[0], silu_f(a0[1]) * u0[1]); w.y = cvt_pk_bf16(silu_f(a0[2]) * u0[2], silu_f(a0[3]) * u0[3]);
                    w.z = cvt_pk_bf16(silu_f(a1[0]) * u1[0], silu_f(a1[1]) * u1[1]); w.w = cvt_pk_bf16(silu_f(a1[2]) * u1[2], silu_f(a1[3]) * u1[3]);
                    *(u32x4*)rowp = w; }
        } else {
            const int col0 = u.pn * BM + wc * 32 + 8 * fq;
#pragma unroll
            for (int ai = 0; ai < 2; ++ai)
#pragma unroll
                for (int m = 0; m < 4; ++m) { bf16_t* rowp = O + (size_t)(row0 + ai * HALF + m * 16) * ldc + col0;
#pragma unroll
                    for (int bj = 0; bj < 2; ++bj) { f32x4 v0 = acc[ai][bj][m][0], v1 = acc[ai][bj][m][1];
                        if (ACT == 2) {
#pragma unroll
                            for (int j = 0; j < 4; ++j) { v0[j] = gelu_tanh_f(v0[j]); v1[j] = gelu_tanh_f(v1[j]); } }
                        u32x4 w; w.x = cvt_pk_bf16(v0[0], v0[1]); w.y = cvt_pk_bf16(v0[2], v0[3]); w.z = cvt_pk_bf16(v1[0], v1[1]); w.w = cvt_pk_bf16(v1[2], v1[3]);
                        *(u32x4*)(rowp + bj * HALF) = w; } }
        }
    }
};

template <class Epi, class Sched, bool ALIGN_EPI = false, bool SP2 = false>
__device__ __forceinline__ void gemm_phase(PG8_LAS unsigned char* lds, const Gemm g, const Sched& S, const Epi& E) {
    const int tid = threadIdx.x, wid = __builtin_amdgcn_readfirstlane(tid >> 6), lane = tid & 63, wr = wid >> 2, wc = wid & 3, fr = lane & 15, fq = lane >> 4;
    const int K = g.K, nt = K / BK;
    unsigned voffA[2], voffB[2];
#pragma unroll
    for (int i = 0; i < 2; ++i) { int R, C; stage_rc(tid * 16 + i * 8192, R, C); const int Rb = Epi::PERM ? ((R & ~31) + perm32(R & 31)) : R;
        voffA[i] = (unsigned)(R * K + C) * 2u; voffB[i] = (unsigned)(Rb * K + C) * 2u; }
    const size_t kstep = (size_t)(BK * 2);
    const size_t hstep = (size_t)HALF * K * 2;
    const size_t tstep = 2 * hstep;
    const unsigned ldsw = (unsigned)wid * 1024u;
    const int aoff = lds_byte(wr * 64 + fr, fq * 8), boff = lds_byte(wc * 32 + fr, fq * 8);
#define PG8_SA(b, h) (((b) * 2 + (h)) * HTB)
#define PG8_SB(b, h) ((4 + (b) * 2 + (h)) * HTB)
#define PG8_STAGE(bufoff, gbase, voff) do { _Pragma("unroll") for (int _i = 0; _i < 2; ++_i) \
        __builtin_amdgcn_global_load_lds((const unsigned*)((const char*)(gbase) + (voff)[_i]), (PG8_LAS unsigned*)(lds + (bufoff) + ldsw + _i * 8192), 16, 0, 0); } while (0)
#define PG8_LDA(dst, b, h) do { _Pragma("unroll") for (int m = 0; m < 4; ++m) _Pragma("unroll") for (int k = 0; k < 2; ++k) dst[m][k] = *(const PG8_LAS bf16x8*)(lds + PG8_SA(b, h) + aoff + m * 2048 + k * 1024); } while (0)
#define PG8_LDB(dst, b, h) do { _Pragma("unroll") for (int n = 0; n < 2; ++n) _Pragma("unroll") for (int k = 0; k < 2; ++k) dst[n][k] = *(const PG8_LAS bf16x8*)(lds + PG8_SB(b, h) + boff + n * 2048 + k * 1024); } while (0)
#define PG8_MMA(ai, bj, At, Bt) do { __builtin_amdgcn_s_setprio(1); _Pragma("unroll") for (int m = 0; m < 4; ++m) _Pragma("unroll") for (int n = 0; n < 2; ++n) _Pragma("unroll") for (int k = 0; k < 2; ++k) \
        acc[ai][bj][m][n] = __builtin_amdgcn_mfma_f32_16x16x32_bf16(Bt[n][k], At[m][k], acc[ai][bj][m][n], 0, 0, 0); __builtin_amdgcn_s_setprio(0); } while (0)
#define PG8_WAIT_V(n) asm volatile("s_waitcnt vmcnt(" #n ")" ::: "memory")
#define PG8_WAIT_L(n) asm volatile("s_waitcnt lgkmcnt(" #n ")" ::: "memory")
#define PG8_BAR __builtin_amdgcn_s_barrier()
#define PG8_SCHED __builtin_amdgcn_sched_barrier(0)
    Unit cur, nxt; int ui = 0;
    if (!S.next(0, cur)) return;
    f32x4 acc[2][2][4][2];
#pragma unroll
    for (int a = 0; a < 2; ++a)
#pragma unroll
        for (int b = 0; b < 2; ++b)
#pragma unroll
            for (int m = 0; m < 4; ++m)
#pragma unroll
                for (int n = 0; n < 2; ++n) acc[a][b][m][n] = (f32x4){0.f, 0.f, 0.f, 0.f};
    bf16x8 At[4][2], B0[2][2], B1[2][2];
    const char* cA = (const char*)g.A + (size_t)cur.pm * tstep; const char* cB = (const char*)g.Bt + (size_t)cur.pn * tstep;
    S.a_ready(cur);
    if constexpr (SP2) {
        PG8_STAGE(PG8_SB(0, 0), cB, voffB); PG8_STAGE(PG8_SB(0, 1), cB + hstep, voffB); PG8_STAGE(PG8_SA(0, 0), cA, voffA); PG8_STAGE(PG8_SA(0, 1), cA + hstep, voffA);
        if (wr == 1) PG8_BAR;
        PG8_WAIT_V(2); PG8_BAR;
        PG8_STAGE(PG8_SB(1, 0), cB + kstep, voffB); PG8_STAGE(PG8_SA(1, 0), cA + kstep, voffA); PG8_STAGE(PG8_SB(1, 1), cB + hstep + kstep, voffB);
        PG8_WAIT_V(6); PG8_BAR;
    } else {
        PG8_STAGE(PG8_SB(0, 0), cB, voffB); PG8_STAGE(PG8_SA(0, 0), cA, voffA); PG8_STAGE(PG8_SB(0, 1), cB + hstep, voffB); PG8_STAGE(PG8_SA(0, 1), cA + hstep, voffA);
        if (wr == 1) PG8_BAR;
        PG8_WAIT_V(4); PG8_BAR;
        PG8_STAGE(PG8_SB(1, 0), cB + kstep, voffB); PG8_STAGE(PG8_SA(1, 0), cA + kstep, voffA); PG8_STAGE(PG8_SB(1, 1), cB + hstep + kstep, voffB);
        PG8_WAIT_V(6); PG8_BAR;
    }
    for (;;) {
        const bool has_next = S.next(ui + 1, nxt);
        const char* nA = has_next ? (const char*)g.A + (size_t)nxt.pm * tstep : cA; const char* nB = has_next ? (const char*)g.Bt + (size_t)nxt.pn * tstep : cB;
        for (int t = 0; t < nt; t += 2) {
            const bool last = (t == nt - 2);
            const char* a1 = cA + (size_t)(t + 1) * kstep;
            const char* a2 = last ? nA : cA + (size_t)(t + 2) * kstep; const char* b2 = last ? nB : cB + (size_t)(t + 2) * kstep;
            const char* a3 = a2 + kstep; const char* b3 = b2 + kstep;
            if (last && has_next) S.a_ready(nxt);
            if constexpr (SP2) {
            PG8_LDB(B0, 0, 0); PG8_LDB(B1, 0, 1); PG8_SCHED; PG8_LDA(At, 0, 0); PG8_STAGE(PG8_SA(1, 1), a1 + hstep, voffA);
            PG8_WAIT_V(8); PG8_WAIT_L(0); PG8_BAR; PG8_MMA(0, 0, At, B0); PG8_MMA(0, 1, At, B1); PG8_BAR; PG8_SCHED;
            PG8_LDA(At, 0, 1); PG8_STAGE(PG8_SB(0, 0), b2, voffB); PG8_STAGE(PG8_SB(0, 1), b2 + hstep, voffB); PG8_STAGE(PG8_SA(0, 0), a2, voffA);
            PG8_WAIT_V(8); PG8_WAIT_L(0); PG8_BAR; PG8_MMA(1, 0, At, B0); PG8_MMA(1, 1, At, B1); PG8_BAR; PG8_SCHED;
            PG8_LDB(B0, 1, 0); PG8_LDB(B1, 1, 1); PG8_SCHED; PG8_LDA(At, 1, 0); PG8_STAGE(PG8_SA(0, 1), a2 + hstep, voffA);
            PG8_WAIT_V(8); PG8_WAIT_L(0); PG8_BAR; PG8_MMA(0, 0, At, B0); PG8_MMA(0, 1, At, B1); PG8_BAR; PG8_SCHED;
            PG8_LDA(At, 1, 1); PG8_STAGE(PG8_SB(1, 0), b3, voffB); PG8_STAGE(PG8_SB(1, 1), b3 + hstep, voffB); PG8_STAGE(PG8_SA(1, 0), a3, voffA);
            PG8_WAIT_V(8); PG8_WAIT_L(0); PG8_BAR; PG8_MMA(1, 0, At, B0); PG8_MMA(1, 1, At, B1); PG8_BAR; PG8_SCHED;
            } else {
            PG8_LDB(B0, 0, 0); PG8_SCHED; PG8_LDA(At, 0, 0); PG8_STAGE(PG8_SA(1, 1), a1 + hstep, voffA);
            PG8_WAIT_L(8); PG8_BAR; PG8_WAIT_L(0); PG8_MMA(0, 0, At, B0); PG8_BAR; PG8_SCHED;
            PG8_LDB(B1, 0, 1); PG8_STAGE(PG8_SB(0, 0), b2, voffB);
            PG8_BAR; PG8_WAIT_L(0); PG8_MMA(0, 1, At, B1); PG8_BAR;
            PG8_LDA(At, 0, 1); PG8_STAGE(PG8_SA(0, 0), a2, voffA);
            PG8_BAR; PG8_WAIT_L(0); PG8_MMA(1, 0, At, B0); PG8_BAR; PG8_SCHED;
            PG8_STAGE(PG8_SB(0, 1), b2 + hstep, voffB);
            PG8_WAIT_V(6); PG8_BAR; PG8_MMA(1, 1, At, B1); PG8_BAR;
            PG8_LDB(B0, 1, 0); PG8_SCHED; PG8_LDA(At, 1, 0); PG8_STAGE(PG8_SA(0, 1), a2 + hstep, voffA);
            PG8_WAIT_L(8); PG8_BAR; PG8_WAIT_L(0); PG8_MMA(0, 0, At, B0); PG8_BAR; PG8_SCHED;
            PG8_LDB(B1, 1, 1); PG8_STAGE(PG8_SB(1, 0), b3, voffB);
            PG8_BAR; PG8_WAIT_L(0); PG8_MMA(0, 1, At, B1); PG8_BAR;
            PG8_LDA(At, 1, 1); PG8_STAGE(PG8_SA(1, 0), a3, voffA);
            PG8_BAR; PG8_WAIT_L(0); PG8_MMA(1, 0, At, B0); PG8_BAR; PG8_SCHED;
            PG8_STAGE(PG8_SB(1, 1), b3 + hstep, voffB);
            PG8_WAIT_V(6); PG8_BAR; PG8_MMA(1, 1, At, B1); PG8_BAR;
            }
        }
        if constexpr (ALIGN_EPI) { if (wr == 0) PG8_BAR; }
        if constexpr (!Epi::AFTER_DRAIN) { E(acc, cur, wr, wc, fr, fq); S.done(cur); }
        if (!has_next) break;
#pragma unroll
        for (int a = 0; a < 2; ++a)
#pragma unroll
            for (int b = 0; b < 2; ++b)
#pragma unroll
                for (int m = 0; m < 4; ++m)
#pragma unroll
                    for (int n = 0; n < 2; ++n) acc[a][b][m][n] = (f32x4){0.f, 0.f, 0.f, 0.f};
        cur = nxt; cA = nA; cB = nB; ++ui;
        if constexpr (ALIGN_EPI) { if (wr == 1) PG8_BAR; }
    }
    PG8_WAIT_V(0);
    if constexpr (!ALIGN_EPI) { if (wr == 0) PG8_BAR; }
    PG8_BAR;
    if constexpr (Epi::AFTER_DRAIN) { E.fused(acc, cur, wr, wc, fr, fq, lds, wid, lane); S.done(cur); }
#undef PG8_SA
#undef PG8_SB
#undef PG8_STAGE
#undef PG8_LDA
#undef PG8_LDB
#undef PG8_MMA
#undef PG8_WAIT_V
#undef PG8_WAIT_L
#undef PG8_BAR
#undef PG8_SCHED
}
}

using pg8::bf16_t; using pg8::bf16x8; using pg8::f32x4; using pg8::u32x4; using pg8::cvt_pk_bf16; using pg8::silu_f;
#define LAS __attribute__((address_space(3)))
typedef unsigned u32x2 __attribute__((ext_vector_type(2)));
typedef short s16x4 __attribute__((ext_vector_type(4)));
#define MFMA16(a, b, c) __builtin_amdgcn_mfma_f32_16x16x32_bf16((a), (b), (c), 0, 0, 0)

constexpr int NTHR = 512;
constexpr int MTOK = 32768, DM = 1024, SEQ = 2048, DFF = 2816, DEPTH = 4, MODW = 9216;
constexpr float DN_ALPHA = 1.6817928305074290861f;
constexpr size_t MiB = (size_t)1 << 20;
constexpr size_t SZ_FFN_IN = (size_t)5632 * 1024 * 2, SZ_FFN_OUT = (size_t)1024 * 2816 * 2, SZ_RET_IN = (size_t)6144 * 1024 * 2, SZ_RET_OUT = (size_t)1024 * 2048 * 2,
                 SZ_NSA_IN = (size_t)2816 * 1024 * 2, SZ_NSA_OUT = (size_t)1024 * 1024 * 2, SZ_W1 = (size_t)256 * 2048 * 2, SZ_W2 = (size_t)64 * 256 * 2;
constexpr size_t OFF_FFN_IN = 0, OFF_FFN_OUT = OFF_FFN_IN + 8 * SZ_FFN_IN, OFF_RET_IN = OFF_FFN_OUT + 8 * SZ_FFN_OUT, OFF_RET_OUT = OFF_RET_IN + 2 * SZ_RET_IN,
                 OFF_NSA_IN = OFF_RET_OUT + 2 * SZ_RET_OUT, OFF_NSA_OUT = OFF_NSA_IN + 2 * SZ_NSA_IN, OFF_W1 = OFF_NSA_OUT + 2 * SZ_NSA_OUT, OFF_W2 = OFF_W1 + 4 * SZ_W1,
                 OFF_MOD = OFF_W2 + 4 * SZ_W2, OFF_H = OFF_MOD + (size_t)DEPTH * 16 * MODW * 4, OFF_U2 = OFF_H + (size_t)MTOK * DM * 2, WS_END = OFF_U2 + 384 * MiB;
constexpr size_t U_FFN_ACT = 0, U_FFN_Y = 192 * MiB;
constexpr size_t U_RET_QKV = 0, U_RET_G = 0, U_RET_O = 256 * MiB, U_RET_Y = 128 * MiB;
constexpr size_t U_NSA_PROJ = 0, U_NSA_Y = 192 * MiB, U_NSA_ACMPK = 256 * MiB, U_NSA_ACMPV = 288 * MiB, U_NSA_HK = 320 * MiB, U_NSA_HV = 324 * MiB, U_NSA_KCMP = 328 * MiB, U_NSA_VCMP = 329 * MiB, U_NSA_OATT = 256 * MiB;
constexpr int XB_LDS_OFF = 152 * 1024, LDS_BYTES = 152 * 1024 + 16;

struct WJob { const float* src; bf16_t* dst; int K, N, Np, mode; };
struct Params {
    const float* x; const float* c; const float* ada_w; const float* ada_b; const float* ln_g; const float* ln_b; const float* pe_k; const float* pe_v;
    float* out; unsigned char* ws;
    WJob jobs[32]; int tile_end[32]; int njobs; int pad;
};

__device__ __forceinline__ float bf2f(unsigned short b) { return __uint_as_float(((unsigned)b) << 16); }
__device__ __forceinline__ float bflo(unsigned w) { return __uint_as_float(w << 16); }
__device__ __forceinline__ float bfhi(unsigned w) { return __uint_as_float(w & 0xffff0000u); }
__device__ __forceinline__ unsigned short f2bf(float f) { return (unsigned short)(cvt_pk_bf16(f, 0.f) & 0xffffu); }
__device__ __forceinline__ bf16x8 pack8(const f32x4& a, const f32x4& b) { u32x4 w; w.x = cvt_pk_bf16(a[0], a[1]); w.y = cvt_pk_bf16(a[2], a[3]); w.z = cvt_pk_bf16(b[0], b[1]); w.w = cvt_pk_bf16(b[2], b[3]); return __builtin_bit_cast(bf16x8, w); }
__device__ __forceinline__ u32x2 pack4(const f32x4& a) { u32x2 w; w.x = cvt_pk_bf16(a[0], a[1]); w.y = cvt_pk_bf16(a[2], a[3]); return w; }
__device__ __forceinline__ bf16x8 lds_rd16(LAS unsigned char* lds, int off) { return *(const LAS bf16x8*)(lds + off); }
__device__ __forceinline__ bf16x8 lds_rd8x2(LAS unsigned char* lds, int off) { const s16x4 lo = *(const LAS s16x4*)(lds + off), hi = *(const LAS s16x4*)(lds + off + 32); return __builtin_shufflevector(lo, hi, 0, 1, 2, 3, 4, 5, 6, 7); }
template <int M> __device__ __forceinline__ float shx(float v, int lane) {
    if (M < 32) return __int_as_float(__builtin_amdgcn_ds_swizzle(__float_as_int(v), (M << 10) | 0x1f));
    return __int_as_float(__builtin_amdgcn_ds_bpermute((lane ^ M) << 2, __float_as_int(v)));
}
template <int M> __device__ __forceinline__ unsigned shxu(unsigned v, int lane) {
    if (M < 32) return (unsigned)__builtin_amdgcn_ds_swizzle((int)v, (M << 10) | 0x1f);
    return (unsigned)__builtin_amdgcn_ds_bpermute((lane ^ M) << 2, (int)v);
}
__device__ __forceinline__ float shi(float v, int src_lane) { return __int_as_float(__builtin_amdgcn_ds_bpermute(src_lane << 2, __float_as_int(v))); }
__device__ __forceinline__ float wsum(float v, int lane) { v += shx<32>(v, lane); v += shx<16>(v, lane); v += shx<8>(v, lane); v += shx<4>(v, lane); v += shx<2>(v, lane); v += shx<1>(v, lane); return v; }

__device__ __forceinline__ void wt_tile(const WJob& J, int t, LAS float* T) {
    int tid = threadIdx.x; asm volatile("" : "+v"(tid));
    const int ntn = J.Np >> 6; const int tn = t % ntn, tk = t / ntn; const int n0 = tn * 64, k0 = tk * 64;
    int sbase = n0; if (J.mode == 1) { const int pn = n0 >> 8, r = n0 & 255; sbase = (r >> 7) * DFF + pn * 128 + (r & 127); }
    const int kk = tid >> 4, nn = (tid & 15) * 4;
#pragma unroll
    for (int rep = 0; rep < 2; ++rep) { const int k = kk + rep * 32; f32x4 v = (f32x4){0.f, 0.f, 0.f, 0.f};
        if (sbase + nn < J.N) v = *(const f32x4*)(J.src + (size_t)(k0 + k) * J.N + sbase + nn);
        T[k * 65 + nn] = v[0]; T[k * 65 + nn + 1] = v[1]; T[k * 65 + nn + 2] = v[2]; T[k * 65 + nn + 3] = v[3]; }
    __syncthreads();
    const int n = tid >> 3, k8 = (tid & 7) * 8;
    f32x4 a, b;
    a[0] = T[(k8 + 0) * 65 + n]; a[1] = T[(k8 + 1) * 65 + n]; a[2] = T[(k8 + 2) * 65 + n]; a[3] = T[(k8 + 3) * 65 + n];
    b[0] = T[(k8 + 4) * 65 + n]; b[1] = T[(k8 + 5) * 65 + n]; b[2] = T[(k8 + 6) * 65 + n]; b[3] = T[(k8 + 7) * 65 + n];
    *(bf16x8*)(J.dst + (size_t)(n0 + n) * J.K + k0 + k8) = pack8(a, b);
    __syncthreads();
}

__device__ __forceinline__ void phase_prep(const Params& p, LAS unsigned char* lds) {
    int tid = threadIdx.x; asm volatile("" : "+v"(tid));
    LAS float* T = (LAS float*)lds;
    const int ntiles = p.tile_end[p.njobs - 1];
    for (int t = blockIdx.x; t < ntiles; t += gridDim.x) {
        int j = 0; while (j < p.njobs - 1 && t >= p.tile_end[j]) ++j;
        const int t0 = j ? p.tile_end[j - 1] : 0;
        wt_tile(p.jobs[j], t - t0, T);
    }
    if (blockIdx.x < 288) {
        LAS float* cs = (LAS float*)lds;
        LAS float* red = (LAS float*)(lds + 65536);
        float* mod = (float*)(p.ws + OFF_MOD);
        __syncthreads();
        for (int idx = tid; idx < 16 * 1024; idx += NTHR) { const int b = idx >> 10, k = idx & 1023; const float cv = p.c[idx]; cs[k * 16 + b] = cv / (1.0f + expf(-cv)); }
        __syncthreads();
        for (int unit = blockIdx.x; unit < 288; unit += gridDim.x) {
            const int i = unit / 72, n0 = (unit % 72) * 128, col = tid & 127, kq = tid >> 7;
            f32x4 a0 = (f32x4){0.f, 0.f, 0.f, 0.f}, a1 = a0, a2 = a0, a3 = a0;
            const float* wp = p.ada_w + ((size_t)i * 1024 + kq * 256) * MODW + n0 + col;
#pragma unroll 4
            for (int k = 0; k < 256; ++k) { const float w = wp[(size_t)k * MODW]; const LAS f32x4* cp = (const LAS f32x4*)(cs + (kq * 256 + k) * 16);
                a0 += cp[0] * w; a1 += cp[1] * w; a2 += cp[2] * w; a3 += cp[3] * w; }
#pragma unroll
            for (int b = 0; b < 4; ++b) { red[(kq * 16 + b) * 128 + col] = a0[b]; red[(kq * 16 + 4 + b) * 128 + col] = a1[b]; red[(kq * 16 + 8 + b) * 128 + col] = a2[b]; red[(kq * 16 + 12 + b) * 128 + col] = a3[b]; }
            __syncthreads();
#pragma unroll
            for (int r = 0; r < 4; ++r) { const int o = tid + r * NTHR, b = o >> 7, cc = o & 127;
                const float s = red[(0 * 16 + b) * 128 + cc] + red[(1 * 16 + b) * 128 + cc] + red[(2 * 16 + b) * 128 + cc] + red[(3 * 16 + b) * 128 + cc] + p.ada_b[i * MODW + n0 + cc];
                mod[((size_t)i * 16 + b) * MODW + n0 + cc] = s; }
            __syncthreads();
        }
    }
}

__device__ __forceinline__ void phase_init(const Params& p) {
    const float* mod = (const float*)(p.ws + OFF_MOD); bf16_t* H = (bf16_t*)(p.ws + OFF_H);
    int tid = threadIdx.x; asm volatile("" : "+v"(tid));
    for (size_t i = (size_t)blockIdx.x * NTHR + tid; i < (size_t)MTOK * 256; i += (size_t)gridDim.x * NTHR) {
        const int row = (int)(i >> 8), c4 = (int)(i & 255) * 4, b = row >> 11;
        const f32x4 xv = *(const f32x4*)(p.x + i * 4); *(f32x4*)(p.out + i * 4) = xv;
        const float* m = mod + (size_t)b * MODW; const f32x4 sh = *(const f32x4*)(m + c4), sc = *(const f32x4*)(m + 1024 + c4);
        const f32x4 h = xv * (sc + 1.0f) + sh; *(u32x2*)(H + i * 4) = pack4(h);
    }
}

__device__ __forceinline__ void phase_ln(float* xio, float* xout, const bf16_t* y, const float* modG, float rw, const float* lng, const float* lnb, const float* modSh, const float* modSc, bf16_t* H) {
    int tid = threadIdx.x; asm volatile("" : "+v"(tid));
    const int wid = __builtin_amdgcn_readfirstlane(tid >> 6), lane = tid & 63;
    for (int row = blockIdx.x * 8 + wid; row < MTOK; row += gridDim.x * 8) {
        const int b = row >> 11; const size_t rb = (size_t)row * DM;
        f32x4 z[4]; float s = 0.f;
#pragma unroll
        for (int q = 0; q < 4; ++q) { const int c = q * 256 + lane * 4; const f32x4 xv = *(const f32x4*)(xio + rb + c); const u32x2 yv = *(const u32x2*)(y + rb + c);
            const f32x4 gt = *(const f32x4*)(modG + (size_t)b * MODW + c); const f32x4 yf = (f32x4){bflo(yv.x), bfhi(yv.x), bflo(yv.y), bfhi(yv.y)};
            z[q] = xv * DN_ALPHA + (gt + 1.0f) * yf * rw; s += (z[q][0] + z[q][1]) + (z[q][2] + z[q][3]); }
        const float mu = wsum(s, lane) * (1.0f / 1024.0f); float v = 0.f;
#pragma unroll
        for (int q = 0; q < 4; ++q) { const f32x4 d = z[q] - mu; v += (d[0] * d[0] + d[1] * d[1]) + (d[2] * d[2] + d[3] * d[3]); }
        const float rstd = rsqrtf(wsum(v, lane) * (1.0f / 1024.0f) + 1e-5f);
#pragma unroll
        for (int q = 0; q < 4; ++q) { const int c = q * 256 + lane * 4; const f32x4 g4 = *(const f32x4*)(lng + c), b4 = *(const f32x4*)(lnb + c);
            const f32x4 xn = (z[q] - mu) * rstd * g4 + b4; *(f32x4*)(xout + rb + c) = xn;
            const f32x4 sh = *(const f32x4*)(modSh + (size_t)b * MODW + c), sc = *(const f32x4*)(modSc + (size_t)b * MODW + c);
            *(u32x2*)(H + rb + c) = pack4(xn * (sc + 1.0f) + sh); }
    }
}

typedef short v4i16_t __attribute__((ext_vector_type(4)));
__device__ __forceinline__ s16x4 lds_tr8(LAS unsigned char* lds, int off) { return __builtin_bit_cast(s16x4, __builtin_amdgcn_ds_read_tr16_b64_v4i16((LAS v4i16_t*)(lds + off))); }

__device__ __forceinline__ bf16x8 lds_tr8x2(LAS unsigned char* lds, int off, int hi_off) { const s16x4 lo = lds_tr8(lds, off), hi = lds_tr8(lds, off + hi_off); return __builtin_shufflevector(lo, hi, 0, 1, 2, 3, 4, 5, 6, 7); }

__device__ __forceinline__ void phase_ret_core(const bf16_t* QKV, bf16_t* O, LAS unsigned char* lds) {
    constexpr int KSB = 528, PS = 136, STS = 264, OFF_K = 0, OFF_P = 67584, OFF_VT = 102400, OFF_ST = 119808;
    int tid = threadIdx.x; asm volatile("" : "+v"(tid));
    const int wid = __builtin_amdgcn_readfirstlane(tid >> 6), lane = tid & 63, fr = lane & 15, fq = lane >> 4;
    for (int item = blockIdx.x; item < 512; item += gridDim.x) {
        const int es = item & 7, bh = item >> 3, hh = bh & 3, b = bh >> 2, e0 = es * 64;
        const float log_g = logf(1.0f - exp2f(-5.0f - (float)hh));
        const float gN = expf(log_g * 128.0f);
        const float l2g = log_g * 1.44269504089f;
        __syncthreads();
        for (int i = tid; i < 64 * STS / 2; i += NTHR) ((LAS unsigned*)(lds + OFF_ST))[i] = 0u;
        f32x4 sacc[2][4];
#pragma unroll
        for (int dt = 0; dt < 2; ++dt)
#pragma unroll
            for (int et = 0; et < 4; ++et) sacc[dt][et] = (f32x4){0.f, 0.f, 0.f, 0.f};
        bf16x8 kst[8], vst[2];
        {   const bf16_t* kp = QKV + ((size_t)b * SEQ + (tid >> 5)) * 4096 + 1024 + hh * 256 + (tid & 31) * 8;
#pragma unroll
            for (int it = 0; it < 8; ++it) kst[it] = *(const bf16x8*)(kp + (size_t)it * 16 * 4096);
            const bf16_t* vrow = QKV + ((size_t)b * SEQ + 2 * (tid & 63)) * 4096 + 2048 + hh * 512 + e0 + (tid >> 6) * 8;
            vst[0] = *(const bf16x8*)(vrow); vst[1] = *(const bf16x8*)(vrow + 4096); }
        bf16x8 qf[8];
        { const bf16_t* qrow = QKV + ((size_t)b * SEQ + wid * 16 + fr) * 4096 + hh * 256 + fq * 8;
#pragma unroll
          for (int ks = 0; ks < 8; ++ks) qf[ks] = *(const bf16x8*)(qrow + ks * 32); }
        for (int n = 0; n < 16; ++n) {
            const size_t tok0 = (size_t)b * SEQ + n * 128;
            int t2 = tid; asm volatile("" : "+v"(t2));
            const int lane = t2 & 63, fr = lane & 15, fq = lane >> 4;
            {
#pragma unroll
                for (int it = 0; it < 8; ++it) *(LAS bf16x8*)(lds + OFF_K + ((t2 >> 5) + 16 * it) * KSB + (t2 & 31) * 16) = kst[it];
                const int cp_ = t2 & 63, q_ = t2 >> 6;
#pragma unroll
                for (int i = 0; i < 8; ++i) *(LAS unsigned*)(lds + OFF_VT + ((q_ * 8 + i) * PS + 2 * cp_) * 2) = (unsigned)(unsigned short)vst[0][i] | ((unsigned)(unsigned short)vst[1][i] << 16);
            }
            if (n < 15) {
                const bf16_t* kp = QKV + (tok0 + 128 + (t2 >> 5)) * 4096 + 1024 + hh * 256 + (t2 & 31) * 8;
#pragma unroll
                for (int it = 0; it < 8; ++it) kst[it] = *(const bf16x8*)(kp + (size_t)it * 16 * 4096);
                const bf16_t* vrow = QKV + (tok0 + 128 + 2 * (t2 & 63)) * 4096 + 2048 + hh * 512 + e0 + (t2 >> 6) * 8;
                vst[0] = *(const bf16x8*)(vrow); vst[1] = *(const bf16x8*)(vrow + 4096); }
            __syncthreads();
            const int cc = wid * 16 + fr;
            const int npair = (wid >> 1) + 1;
            for (int cp2 = 0; cp2 < npair; ++cp2) {
                const int kb0 = OFF_K + (cp2 * 32 + fr) * KSB + fq * 16;
                f32x4 acc0 = (f32x4){0.f, 0.f, 0.f, 0.f}, acc1 = acc0;
#pragma unroll
                for (int ks = 0; ks < 8; ++ks) { acc0 = MFMA16(lds_rd16(lds, kb0 + ks * 64), qf[ks], acc0); acc1 = MFMA16(lds_rd16(lds, kb0 + 16 * KSB + ks * 64), qf[ks], acc1); }
                f32x4 pv0, pv1;
#pragma unroll
                for (int j = 0; j < 4; ++j) { const int cp = cp2 * 32 + fq * 4 + j;
                    pv0[j] = (cc >= cp) ? acc0[j] * 0.0625f * __builtin_amdgcn_exp2f(l2g * (float)(cc - cp)) : 0.f;
                    pv1[j] = (cc >= cp + 16) ? acc1[j] * 0.0625f * __builtin_amdgcn_exp2f(l2g * (float)(cc - cp - 16)) : 0.f; }
                *(LAS u32x2*)(lds + OFF_P + (cc * PS + cp2 * 32 + fq * 4) * 2) = pack4(pv0);
                *(LAS u32x2*)(lds + OFF_P + (cc * PS + cp2 * 32 + 16 + fq * 4) * 2) = pack4(pv1);
            }
            __syncthreads();
            {
                f32x4 a1[4], a2[4];
#pragma unroll
                for (int et = 0; et < 4; ++et) { a1[et] = (f32x4){0.f, 0.f, 0.f, 0.f}; a2[et] = a1[et]; }
                const int ksmax = wid >> 1;
                for (int ks = 0; ks <= ksmax; ++ks) { const bf16x8 pf = lds_rd16(lds, OFF_P + (cc * PS + ks * 32 + fq * 8) * 2);
#pragma unroll
                    for (int et = 0; et < 4; ++et) a1[et] = MFMA16(lds_rd16(lds, OFF_VT + ((et * 16 + fr) * PS + ks * 32 + fq * 8) * 2), pf, a1[et]); }
#pragma unroll
                for (int ks = 0; ks < 8; ++ks)
#pragma unroll
                    for (int et = 0; et < 4; ++et) a2[et] = MFMA16(lds_rd16(lds, OFF_ST + ((et * 16 + fr) * STS + ks * 32 + fq * 8) * 2), qf[ks], a2[et]);
                const float dq = __builtin_amdgcn_exp2f(l2g * (float)(cc + 1));
                bf16_t* orow = O + (tok0 + cc) * 2048 + hh * 512 + e0 + fq * 4;
#pragma unroll
                for (int et = 0; et < 4; ++et) *(u32x2*)(orow + et * 16) = pack4(a1[et] + a2[et] * dq);
            }
            if (n < 15) {
                const bf16_t* qrow = QKV + (tok0 + 128 + cc) * 4096 + hh * 256 + fq * 8;
#pragma unroll
                for (int ks = 0; ks < 8; ++ks) qf[ks] = *(const bf16x8*)(qrow + ks * 32); }
            __syncthreads();
            if (n < 15) {
#pragma unroll
                for (int dt = 0; dt < 2; ++dt)
#pragma unroll
                    for (int et = 0; et < 4; ++et) sacc[dt][et] *= gN;
                const int q4 = (lane & 15) >> 2, p4 = lane & 3;
                const float fbase = 0.0625f * __builtin_amdgcn_exp2f(l2g * (float)(127 - 8 * fq));
#pragma unroll
                for (int ks = 0; ks < 4; ++ks) {
                    bf16x8 vf[4];
#pragma unroll
                    for (int et = 0; et < 4; ++et) vf[et] = lds_rd16(lds, OFF_VT + ((et * 16 + fr) * PS + ks * 32 + fq * 8) * 2);
                    const float fks = fbase * __builtin_amdgcn_exp2f(l2g * (float)(-32 * ks));
#pragma unroll
                    for (int dt = 0; dt < 2; ++dt) {
                        const int tb = OFF_K + (32 * ks + 8 * fq + q4) * KSB + (2 * wid + dt) * 32 + 8 * p4;
                        const s16x4 lo = lds_tr8(lds, tb), hi = lds_tr8(lds, tb + 4 * KSB);
                        f32x4 f0, f1;
#pragma unroll
                        for (int e = 0; e < 4; ++e) { f0[e] = bf2f((unsigned short)lo[e]) * (fks * __builtin_amdgcn_exp2f(l2g * (float)(-e))); f1[e] = bf2f((unsigned short)hi[e]) * (fks * __builtin_amdgcn_exp2f(l2g * (float)(-4 - e))); }
                        const bf16x8 kf = pack8(f0, f1);
#pragma unroll
                        for (int et = 0; et < 4; ++et) sacc[dt][et] = MFMA16(kf, vf[et], sacc[dt][et]); }
                }
#pragma unroll
                for (int dt = 0; dt < 2; ++dt)
#pragma unroll
                    for (int et = 0; et < 4; ++et) *(LAS u32x2*)(lds + OFF_ST + ((et * 16 + fr) * STS + (2 * wid + dt) * 16 + fq * 4) * 2) = pack4(sacc[dt][et]);
            }
            __syncthreads();
        }
    }
}

__device__ __forceinline__ void phase_ret_gate(bf16_t* O, const bf16_t* G) {
    int tid = threadIdx.x; asm volatile("" : "+v"(tid));
    const int wid = __builtin_amdgcn_readfirstlane(tid >> 6), lane = tid & 63;
    for (int idx = blockIdx.x * 8 + wid; idx < MTOK * 4; idx += gridDim.x * 8) {
        const size_t base = (size_t)(idx >> 2) * 2048 + (idx & 3) * 512 + lane * 8;
        const u32x4 ov = *(const u32x4*)(O + base), gv = *(const u32x4*)(G + base);
        float o[8] = {bflo(ov.x), bfhi(ov.x), bflo(ov.y), bfhi(ov.y), bflo(ov.z), bfhi(ov.z), bflo(ov.w), bfhi(ov.w)};
        const float g[8] = {bflo(gv.x), bfhi(gv.x), bflo(gv.y), bfhi(gv.y), bflo(gv.z), bfhi(gv.z), bflo(gv.w), bfhi(gv.w)};
        float s = 0.f;
#pragma unroll
        for (int i = 0; i < 8; ++i) s += o[i];
        const float mu = wsum(s, lane) * (1.0f / 512.0f); float v = 0.f;
#pragma unroll
        for (int i = 0; i < 8; ++i) { const float d = o[i] - mu; v += d * d; }
        const float rstd = rsqrtf(wsum(v, lane) * (1.0f / 512.0f) + 1e-6f);
#pragma unroll
        for (int i = 0; i < 8; ++i) o[i] = (o[i] - mu) * rstd * silu_f(g[i]);
        u32x4 w; w.x = cvt_pk_bf16(o[0], o[1]); w.y = cvt_pk_bf16(o[2], o[3]); w.z = cvt_pk_bf16(o[4], o[5]); w.w = cvt_pk_bf16(o[6], o[7]);
        *(u32x4*)(O + base) = w;
    }
}

__device__ __forceinline__ void phase_nsa_mat(const bf16_t* PROJ, const float* pek, const float* pev, bf16_t* AK, bf16_t* AV) {
    const size_t per = (size_t)8128 * 256;
    int tid = threadIdx.x; asm volatile("" : "+v"(tid));
    for (size_t i = (size_t)blockIdx.x * NTHR + tid; i < 2 * per; i += (size_t)gridDim.x * NTHR) {
        const int kv = i >= per; const size_t rem = kv ? i - per : i; const int r = (int)(rem >> 8), pp = (int)(rem & 255), l = pp >> 3, d0 = (pp & 7) * 8;
        const int g = r & 3, bn = r >> 2, b = bn / 127, n = bn % 127;
        const u32x4 v = *(const u32x4*)(PROJ + ((size_t)b * SEQ + n * 16 + l) * 2816 + 1024 + kv * 256 + g * 64 + d0);
        const float* pe = (kv ? pev : pek) + l * 64 + d0; const f32x4 p0 = *(const f32x4*)pe, p1 = *(const f32x4*)(pe + 4);
        u32x4 w; w.x = cvt_pk_bf16(bflo(v.x) + p0[0], bfhi(v.x) + p0[1]); w.y = cvt_pk_bf16(bflo(v.y) + p0[2], bfhi(v.y) + p0[3]);
        w.z = cvt_pk_bf16(bflo(v.z) + p1[0], bfhi(v.z) + p1[1]); w.w = cvt_pk_bf16(bflo(v.w) + p1[2], bfhi(v.w) + p1[3]);
        *(u32x4*)((kv ? AV : AK) + (size_t)r * 2048 + l * 64 + d0) = w;
    }
}
__device__ __forceinline__ void phase_nsa_cmp2(const bf16_t* HK, const bf16_t* HV, const bf16_t* W2K, const bf16_t* W2V, bf16_t* KC, bf16_t* VC) {
    int tid = threadIdx.x; asm volatile("" : "+v"(tid));
    const int wid = __builtin_amdgcn_readfirstlane(tid >> 6), lane = tid & 63, fr = lane & 15, fq = lane >> 4;
    for (int tt = blockIdx.x * 8 + wid; tt < 508 * 2; tt += gridDim.x * 8) {
        const int kv = tt >= 508, rt = kv ? tt - 508 : tt; const bf16_t* Hd = kv ? HV : HK; const bf16_t* W = kv ? W2V : W2K; bf16_t* Od = kv ? VC : KC;
        f32x4 acc[4];
#pragma unroll
        for (int nt = 0; nt < 4; ++nt) acc[nt] = (f32x4){0.f, 0.f, 0.f, 0.f};
#pragma unroll
        for (int ks = 0; ks < 8; ++ks) { const bf16x8 hf = *(const bf16x8*)(Hd + (size_t)(rt * 16 + fr) * 256 + ks * 32 + fq * 8);
#pragma unroll
            for (int nt = 0; nt < 4; ++nt) acc[nt] = MFMA16(*(const bf16x8*)(W + (size_t)(nt * 16 + fr) * 256 + ks * 32 + fq * 8), hf, acc[nt]); }
#pragma unroll
        for (int nt = 0; nt < 4; ++nt) *(u32x2*)(Od + (size_t)(rt * 16 + fr) * 64 + nt * 16 + fq * 4) = pack4(acc[nt]);
    }
}

struct AttnCtx { int b, g, cur, head, hp, t; float slope; bf16x8 qf[2]; float gate[3]; unsigned selq; unsigned anym; };
constexpr int A_KS = 72, A_VS = 72, A_KCS = 72, A_VCS = 72, A_KBYTES = 9216, A_VBYTES = 9216, A_OFF_K = 0, A_OFF_VT = 18432, A_OFF_KC = 36864, A_OFF_VCT = 55296, A_OFF_IMP = 73728, A_OFF_SEL = 90624, A_OFF_SELP = 90752;

template <int BR>
__device__ __forceinline__ void attn_branch(const bf16_t* PROJ, LAS unsigned char* lds, const AttnCtx& C, f32x4 (&otot)[4], int tid) {
    const int lane = tid & 63, fr = lane & 15, fq = lane >> 4;
    const float qs = 0.125f * 1.44269504089f, slope2 = C.slope * 1.44269504089f;
    f32x4 sl[4];
#pragma unroll
    for (int kt = 0; kt < 4; ++kt)
#pragma unroll
        for (int jj = 0; jj < 4; ++jj) sl[kt][jj] = slope2 * (float)(kt * 16 + jj);
    float m_ = -1e30f, l_ = 0.f;
    f32x4 oa[4];
#pragma unroll
    for (int dt = 0; dt < 4; ++dt) oa[dt] = (f32x4){0.f, 0.f, 0.f, 0.f};
    const int jlo = (BR == 1) ? 0 : (C.cur > 8 ? C.cur - 8 : 0);
    const int koff = (BR == 1 ? 1536 : 2048) + C.g * 64, voff = (BR == 1 ? 1792 : 2304) + C.g * 64;
    const int key = tid >> 3, d0 = (tid & 7) * 8;
    const bf16_t* srcb = PROJ + ((size_t)C.b * SEQ + key) * 2816 + d0;
    int j = jlo;
    if (BR == 1) { while (j <= C.cur && !((C.anym >> j) & 1u)) ++j; }
    bf16x8 kreg = *(const bf16x8*)(srcb + (size_t)j * 64 * 2816 + koff), vreg = *(const bf16x8*)(srcb + (size_t)j * 64 * 2816 + voff);
    __syncthreads();
    int buf = 0;
    { *(LAS bf16x8*)(lds + A_OFF_K + (key * A_KS + d0) * 2) = kreg; *(LAS bf16x8*)(lds + A_OFF_VT + (key * A_VS + d0) * 2) = vreg; }
    __syncthreads();
    while (j <= C.cur) {
        int jn = j + 1;
        if (BR == 1) { while (jn <= C.cur && !((C.anym >> jn) & 1u)) ++jn; }
        const bool more = jn <= C.cur;
        if (more) { kreg = *(const bf16x8*)(srcb + (size_t)jn * 64 * 2816 + koff); vreg = *(const bf16x8*)(srcb + (size_t)jn * 64 * 2816 + voff); }
        const int kb = A_OFF_K + buf * A_KBYTES, vb = A_OFF_VT + buf * A_VBYTES;
        f32x4 s4[4]; float alpha;
        const int dbase = C.t - j * 64 - fq * 4;
        const bool partial = (j == C.cur) || (BR == 2 && j + 8 <= C.cur);
        if (partial) {
            float tmax = -1e30f;
#pragma unroll
            for (int kt = 0; kt < 4; ++kt) { f32x4 acc = (f32x4){0.f, 0.f, 0.f, 0.f};
#pragma unroll
                for (int ks = 0; ks < 2; ++ks) acc = MFMA16(lds_rd16(lds, kb + ((kt * 16 + fr) * A_KS + ks * 32 + fq * 8) * 2), C.qf[ks], acc);
#pragma unroll
                for (int jj = 0; jj < 4; ++jj) { const int dist = dbase - (kt * 16 + jj);
                    const bool ok = (dist >= 0) && (BR == 1 ? (((C.selq >> j) & 1u) != 0u) : (dist < 512));
                    const float s = ok ? acc[jj] * qs - slope2 * (float)dist : -1e30f; s4[kt][jj] = s; tmax = fmaxf(tmax, s); } }
            tmax = fmaxf(tmax, shx<16>(tmax, lane)); tmax = fmaxf(tmax, shx<32>(tmax, lane));
            const float mnew = fmaxf(m_, tmax); alpha = __builtin_amdgcn_exp2f(m_ - mnew); m_ = mnew;
            float psum = 0.f;
#pragma unroll
            for (int kt = 0; kt < 4; ++kt)
#pragma unroll
                for (int jj = 0; jj < 4; ++jj) { const float pp = (s4[kt][jj] > -1e29f) ? __builtin_amdgcn_exp2f(s4[kt][jj] - mnew) : 0.f; s4[kt][jj] = pp; psum += pp; }
            l_ = l_ * alpha + psum;
        } else {
            float c0 = -slope2 * (float)dbase;
            if (BR == 1 && !((C.selq >> j) & 1u)) c0 = -1e30f;
            float tmax = -1e30f;
#pragma unroll
            for (int kt = 0; kt < 4; ++kt) { f32x4 acc = (f32x4){0.f, 0.f, 0.f, 0.f};
#pragma unroll
                for (int ks = 0; ks < 2; ++ks) acc = MFMA16(lds_rd16(lds, kb + ((kt * 16 + fr) * A_KS + ks * 32 + fq * 8) * 2), C.qf[ks], acc);
#pragma unroll
                for (int jj = 0; jj < 4; ++jj) { const float u = acc[jj] * qs + sl[kt][jj]; s4[kt][jj] = u; tmax = fmaxf(tmax, u); } }
            tmax += c0;
            tmax = fmaxf(tmax, shx<16>(tmax, lane)); tmax = fmaxf(tmax, shx<32>(tmax, lane));
            const float mnew = fmaxf(m_, tmax); alpha = __builtin_amdgcn_exp2f(m_ - mnew); m_ = mnew;
            const float sh = mnew - c0; float psum = 0.f;
#pragma unroll
            for (int kt = 0; kt < 4; ++kt)
#pragma unroll
                for (int jj = 0; jj < 4; ++jj) { const float pp = __builtin_amdgcn_exp2f(s4[kt][jj] - sh); s4[kt][jj] = pp; psum += pp; }
            l_ = l_ * alpha + psum;
        }
#pragma unroll
        for (int dt = 0; dt < 4; ++dt) oa[dt] *= alpha;
#pragma unroll
        for (int ks2 = 0; ks2 < 2; ++ks2) { const bf16x8 pf = pack8(s4[2 * ks2], s4[2 * ks2 + 1]);
#pragma unroll
            for (int dt = 0; dt < 4; ++dt) oa[dt] = MFMA16(lds_tr8x2(lds, vb + (ks2 * 32 + fq * 4 + ((lane & 15) >> 2)) * (A_VS * 2) + dt * 32 + 8 * (lane & 3), 16 * A_VS * 2), pf, oa[dt]); }
        if (more) { const int kb2 = A_OFF_K + (buf ^ 1) * A_KBYTES, vb2 = A_OFF_VT + (buf ^ 1) * A_VBYTES;
            *(LAS bf16x8*)(lds + kb2 + (key * A_KS + d0) * 2) = kreg; *(LAS bf16x8*)(lds + vb2 + (key * A_VS + d0) * 2) = vreg; }
        __syncthreads();
        buf ^= 1; j = jn;
    }
    float lt = l_; lt += shx<16>(lt, lane); lt += shx<32>(lt, lane); const float inv = lt > 0.f ? C.gate[BR] / lt : 0.f;
#pragma unroll
    for (int dt = 0; dt < 4; ++dt) otot[dt] += oa[dt] * inv;
}

__device__ __forceinline__ void phase_nsa_attn(const bf16_t* PROJ, const bf16_t* KCMP, const bf16_t* VCMP, bf16_t* OATT, LAS unsigned char* lds) {
    int tid = threadIdx.x; asm volatile("" : "+v"(tid));
    const int wid = __builtin_amdgcn_readfirstlane(tid >> 6), lane = tid & 63, fr = lane & 15, fq = lane >> 4;
    LAS float* IMP = (LAS float*)(lds + A_OFF_IMP); LAS unsigned* SEL = (LAS unsigned*)(lds + A_OFF_SEL); LAS unsigned* SELP = (LAS unsigned*)(lds + A_OFF_SELP);
    for (int id = blockIdx.x; id < 4096; id += gridDim.x) {
        const int k8 = id & 255, ii = id >> 8, bg = k8 & 63, kk = k8 >> 6;
        const int qt32 = (ii & 1) ? 63 - (kk + 4 * (ii - 1)) : kk + 4 * ii;
        AttnCtx C; C.cur = qt32 >> 1; C.b = bg >> 2; C.g = bg & 3; C.hp = wid >> 1; C.head = C.g * 4 + C.hp; C.slope = exp2f(-0.5f * (float)(C.head + 1));
        const int qq = (wid & 1) * 16 + fr; C.t = qt32 * 32 + qq; const size_t trow = (size_t)C.b * SEQ + C.t;
        { const bf16_t* pr = PROJ + trow * 2816;
#pragma unroll
          for (int ks = 0; ks < 2; ++ks) C.qf[ks] = *(const bf16x8*)(pr + C.head * 64 + ks * 32 + fq * 8);
#pragma unroll
          for (int br = 0; br < 3; ++br) C.gate[br] = 1.0f / (1.0f + __expf(-bf2f(pr[2560 + C.head * 3 + br]))); }
        f32x4 otot[4];
#pragma unroll
        for (int dt = 0; dt < 4; ++dt) otot[dt] = (f32x4){0.f, 0.f, 0.f, 0.f};
        __syncthreads();
#pragma unroll
        for (int rep = 0; rep < 2; ++rep) { const int idx = tid + rep * NTHR, n = idx >> 3, d0 = (idx & 7) * 8, nc = n < 126 ? n : 126; const size_t src = ((size_t)(C.b * 127 + nc) * 4 + C.g) * 64 + d0;
            *(LAS bf16x8*)(lds + A_OFF_KC + (n * A_KCS + d0) * 2) = *(const bf16x8*)(KCMP + src);
            *(LAS bf16x8*)(lds + A_OFF_VCT + (n * A_VCS + d0) * 2) = *(const bf16x8*)(VCMP + src); }
        __syncthreads();
        {
            f32x4 sc[8]; float mx = -1e30f;
#pragma unroll
            for (int kt = 0; kt < 8; ++kt) { f32x4 acc = (f32x4){0.f, 0.f, 0.f, 0.f};
#pragma unroll
                for (int ks = 0; ks < 2; ++ks) acc = MFMA16(lds_rd16(lds, A_OFF_KC + ((kt * 16 + fr) * A_KCS + ks * 32 + fq * 8) * 2), C.qf[ks], acc);
#pragma unroll
                for (int jj = 0; jj < 4; ++jj) { const int n = kt * 16 + fq * 4 + jj, ce = n * 16 + 31; const bool ok = (n <= 126) && (ce <= C.t);
                    const float s = ok ? acc[jj] * 0.125f - C.slope * (float)(C.t - ce) : -1e30f; sc[kt][jj] = s; mx = fmaxf(mx, s); } }
            mx = fmaxf(mx, shx<16>(mx, lane)); mx = fmaxf(mx, shx<32>(mx, lane));
            float sum = 0.f;
#pragma unroll
            for (int kt = 0; kt < 8; ++kt)
#pragma unroll
                for (int jj = 0; jj < 4; ++jj) { const float pp = (sc[kt][jj] > -1e29f) ? __expf(sc[kt][jj] - mx) : 0.f; sc[kt][jj] = pp; sum += pp; }
            sum += shx<16>(sum, lane); sum += shx<32>(sum, lane);
            const float inv = sum > 0.f ? 1.0f / sum : 0.f;
#pragma unroll
            for (int kt = 0; kt < 8; ++kt) sc[kt] *= inv;
#pragma unroll
            for (int kt = 0; kt < 8; ++kt) { const float a = shi(sc[kt][3], (lane + 48) & 63); const float bp = kt > 0 ? shi(sc[kt > 0 ? kt - 1 : 0][3], (lane + 48) & 63) : 0.f;
                const float prev3 = fq > 0 ? a : bp;
                IMP[(C.hp * 32 + qq) * 33 + 4 * kt + fq] = sc[kt][0] + sc[kt][1] + sc[kt][2] + 0.5f * sc[kt][3] + 0.5f * prev3; }
            f32x4 oc[4];
#pragma unroll
            for (int dt = 0; dt < 4; ++dt) oc[dt] = (f32x4){0.f, 0.f, 0.f, 0.f};
#pragma unroll
            for (int ks2 = 0; ks2 < 4; ++ks2) { const bf16x8 pf = pack8(sc[2 * ks2], sc[2 * ks2 + 1]);
#pragma unroll
                for (int dt = 0; dt < 4; ++dt) oc[dt] = MFMA16(lds_tr8x2(lds, A_OFF_VCT + (ks2 * 32 + fq * 4 + ((lane & 15) >> 2)) * (A_VCS * 2) + dt * 32 + 8 * (lane & 3), 16 * A_VCS * 2), pf, oc[dt]); }
#pragma unroll
            for (int dt = 0; dt < 4; ++dt) otot[dt] += oc[dt] * C.gate[0];
        }
        __syncthreads();
        if (C.cur >= 16) {
            const int sq = tid & 31, jg = tid >> 5;
#pragma unroll
            for (int jj = 0; jj < 2; ++jj) { const int j = jg * 2 + jj; const float imp = IMP[(0 * 32 + sq) * 33 + j] + IMP[(1 * 32 + sq) * 33 + j] + IMP[(2 * 32 + sq) * 33 + j] + IMP[(3 * 32 + sq) * 33 + j];
                const bool valid = j <= C.cur, forced = (j == 0) || (j == C.cur) || (j == C.cur - 1);
                IMP[sq * 33 + j] = valid ? (forced ? 1e4f : imp) : -1.0f; }
            __syncthreads();
            unsigned bits = 0u;
#pragma unroll
            for (int jj = 0; jj < 2; ++jj) { const int j = jg * 2 + jj; const float sj = IMP[sq * 33 + j]; int cnt = 0;
                for (int j2 = 0; j2 < 32; ++j2) { const float s2 = IMP[sq * 33 + j2]; cnt += ((s2 > sj) || (s2 == sj && j2 < j)) ? 1 : 0; }
                if (cnt < 16) bits |= 1u << j; }
            SELP[jg * 32 + sq] = bits;
            __syncthreads();
            if (tid < 32) { unsigned m = 0u;
#pragma unroll
                for (int q = 0; q < 16; ++q) m |= SELP[q * 32 + tid];
                SEL[tid] = m; }
        } else { if (tid < 32) SEL[tid] = (2u << C.cur) - 1u; }
        __syncthreads();
        C.selq = SEL[qq];
        { unsigned m = SEL[lane & 31]; m |= shxu<16>(m, lane); m |= shxu<8>(m, lane); m |= shxu<4>(m, lane); m |= shxu<2>(m, lane); m |= shxu<1>(m, lane); C.anym = (unsigned)__builtin_amdgcn_readfirstlane((int)m); }
        attn_branch<1>(PROJ, lds, C, otot, tid);
        attn_branch<2>(PROJ, lds, C, otot, tid);
#pragma unroll
        for (int dt = 0; dt < 4; ++dt) *(u32x2*)(OATT + trow * 1024 + C.head * 64 + dt * 16 + fq * 4) = pack4(otot[dt]);
    }
}

#define XB_TMO      128
#define XB_XCNT(j)  (256  + 64 * (j))
#define XB_XSUB(j)  (1280 + 64 * (j))
#define XB_XGEN(j)  (2304 + 64 * (j))
#define XB_TOP      3328
#define XB_TOPGEN   3392
#define XCD_BAR_WORDS 3456
#define XB_SPIN_CAP (1u << 18)

__device__ __forceinline__ unsigned xb_ld(unsigned* p)              { return __hip_atomic_load(p, __ATOMIC_RELAXED, __HIP_MEMORY_SCOPE_AGENT); }
__device__ __forceinline__ unsigned xb_add(unsigned* p, unsigned v) { return __hip_atomic_fetch_add(p, v, __ATOMIC_RELAXED, __HIP_MEMORY_SCOPE_AGENT); }
__device__ __forceinline__ unsigned xb_xcc_id() { return (unsigned)__builtin_amdgcn_s_getreg((3 << 11) | 20) & 0xFu; }
#define XB_SPIN(cond, bar) do { unsigned _sp = 0; while (cond) { __builtin_amdgcn_s_sleep(1); \
    if ((++_sp & 255u) == 0u) { if (xb_ld(&(bar)[XB_TMO])) break; if (_sp > XB_SPIN_CAP) { atomicAdd(&(bar)[XB_TMO], 1u); break; } } } } while (0)

struct XcdBarrier {
    unsigned* bar; unsigned x;
    volatile LAS unsigned* st;
};

__device__ __forceinline__ XcdBarrier xcd_barrier_post(unsigned* bar, volatile LAS unsigned* st) {
    XcdBarrier b; b.bar = bar; b.x = xb_xcc_id(); b.st = st;
    if (threadIdx.x == 0) (void)xb_add(&bar[XB_XCNT(b.x)], 1u);
    return b;
}
__device__ __forceinline__ void xcd_barrier_complete(unsigned* bar, unsigned x, unsigned& nloc, unsigned& nx) {
    const unsigned G = gridDim.x * gridDim.y * gridDim.z;
    unsigned sum, cnt, mine, sp = 0u;
    for (;;) {
        sum = 0u; cnt = 0u; mine = 0u;
#pragma unroll
        for (unsigned j = 0; j < 16; ++j) { const unsigned c = xb_ld(&bar[XB_XCNT(j)]); sum += c; cnt += (c > 0u) ? 1u : 0u; mine = (j == x) ? c : mine; }
        if (sum == G) break;
        __builtin_amdgcn_s_sleep(1);
        if ((++sp & 255u) == 0u) { if (xb_ld(&bar[XB_TMO])) break; if (sp > XB_SPIN_CAP) { atomicAdd(&bar[XB_TMO], 1u); break; } }
    }
    nloc = mine > 0u ? mine : 1u; nx = cnt > 0u ? cnt : 1u;
}

__device__ __forceinline__ void xcd_barrier(const XcdBarrier& b) {
    asm volatile("s_waitcnt vmcnt(0)" ::: "memory");
    __syncthreads();
    if (threadIdx.x == 0) {
        unsigned* bar = b.bar;
        __builtin_amdgcn_s_waitcnt(0);
        unsigned nloc = b.st[0], nx = b.st[1];
        if (nloc == 0u) { xcd_barrier_complete(bar, b.x, nloc, nx); b.st[0] = nloc; b.st[1] = nx; }
        const unsigned old = xb_add(&bar[XB_XSUB(b.x)], 1u);
        const unsigned gen = old / nloc;
        if (old + 1u == (gen + 1u) * nloc) {
            __builtin_amdgcn_fence(__ATOMIC_RELEASE, "agent");
            asm volatile("s_waitcnt vmcnt(0)" ::: "memory");
            const unsigned og = xb_add(&bar[XB_TOP], 1u);
            const unsigned tg = og / nx;
            if (og + 1u == (tg + 1u) * nx) xb_add(&bar[XB_TOPGEN], 1u);
            else XB_SPIN(xb_ld(&bar[XB_TOPGEN]) == tg, bar);
            __builtin_amdgcn_fence(__ATOMIC_ACQUIRE, "agent");
            xb_add(&bar[XB_XGEN(b.x)], 1u);
            asm volatile("s_waitcnt vmcnt(0)" ::: "memory");
        } else {
            XB_SPIN(xb_ld(&bar[XB_XGEN(b.x)]) == gen, bar);
            __builtin_amdgcn_fence(__ATOMIC_ACQUIRE, "agent");
            asm volatile("s_waitcnt vmcnt(0)" ::: "memory");
        }
    }
    __syncthreads();
}


#ifndef R_CORE
#define R_CORE 1
#endif
#ifndef R_ATTN
#define R_ATTN 1
#endif
#ifndef R_GEMM
#define R_GEMM 1
#endif
#ifndef R_BAR
#define R_BAR 1
#endif
#ifndef R_PREP
#define R_PREP 1
#endif
#ifndef GEMM_ALIGN
#define GEMM_ALIGN true
#endif
#ifndef GEMM_SP2
#define GEMM_SP2 true
#endif
struct GemmDesc { const bf16_t* A; const bf16_t* Bt; bf16_t* O; int M, N, K, ldc, act, cshift; };
__device__ __forceinline__ void run_gemm(const GemmDesc& d, LAS unsigned char* lds) {
    pg8::Gemm g{d.A, d.Bt, d.M, d.N, d.K}; pg8::StaticOrder S; const int G = (int)gridDim.x; S.init(d.M, d.N, G, ((int)blockIdx.x + G - d.cshift % G) % G);
    if (d.act == 0) { pg8::Epi<0> E{d.O, d.ldc}; pg8::gemm_phase<pg8::Epi<0>, pg8::StaticOrder, GEMM_ALIGN, GEMM_SP2>(lds, g, S, E); }
    else if (d.act == 1) { pg8::Epi<1> E{d.O, d.ldc}; pg8::gemm_phase<pg8::Epi<1>, pg8::StaticOrder, GEMM_ALIGN, GEMM_SP2>(lds, g, S, E); }
    else { pg8::Epi<2> E{d.O, d.ldc}; pg8::gemm_phase<pg8::Epi<2>, pg8::StaticOrder, GEMM_ALIGN, GEMM_SP2>(lds, g, S, E); }
}

__global__ void __launch_bounds__(NTHR) fwd_megakernel(Params p) {
    extern __shared__ __attribute__((aligned(16))) unsigned char smem[];
    LAS unsigned char* lds = (LAS unsigned char*)smem;
    cg::grid_group grid = cg::this_grid();
    unsigned char* ws = p.ws; unsigned char* U = ws + OFF_U2;
    const float* mod = (const float*)(ws + OFF_MOD); bf16_t* H = (bf16_t*)(ws + OFF_H);
    if (threadIdx.x < 4) ((LAS unsigned*)(lds + XB_LDS_OFF))[threadIdx.x] = 0u;
    __syncthreads();
    XcdBarrier xbar = xcd_barrier_post((unsigned*)(ws + WS_END), (volatile LAS unsigned*)(lds + XB_LDS_OFF));
    grid.sync();

#if 0
    { const u32x4 pz = (u32x4){0xAAAAAAAAu, 0xAAAAAAAAu, 0xAAAAAAAAu, 0xAAAAAAAAu}; for (size_t i = (size_t)blockIdx.x * NTHR + threadIdx.x; i < WS_END / 16; i += (size_t)gridDim.x * NTHR) ((u32x4*)ws)[i] = pz; }
    xcd_barrier(xbar);
#endif
    for (int gs = 0; gs < 2 + DEPTH * 13; ++gs) {
        if (gs < 2) {
            if (gs == 0) { for (int rr = 0; rr < R_PREP; ++rr) phase_prep(p, lds); } else phase_init(p);
        } else {
        const int layer = (gs - 2) / 13, st = (gs - 2) % 13;
        const int jm = layer >> 1; const bool is_ret = (layer & 1) == 0;
        const float* modL = mod + (size_t)layer * 16 * MODW;
        {
            GemmDesc d[2]; int ng = 0;
            d[0].cshift = 0; d[1].cshift = 0;
            if (st == 0 || st == 10) {
                const int s = st == 0 ? 0 : 1;
                d[0] = GemmDesc{H, (const bf16_t*)(ws + OFF_FFN_IN + (size_t)(layer * 2 + s) * SZ_FFN_IN), (bf16_t*)(U + U_FFN_ACT), MTOK, 5632, 1024, DFF, 1, 0}; ng = 1;
            } else if (st == 1 || st == 11) {
                const int s = st == 1 ? 0 : 1;
                d[0] = GemmDesc{(const bf16_t*)(U + U_FFN_ACT), (const bf16_t*)(ws + OFF_FFN_OUT + (size_t)(layer * 2 + s) * SZ_FFN_OUT), (bf16_t*)(U + U_FFN_Y), MTOK, 1024, DFF, 1024, 0, 0}; ng = 1;
            } else if (st == 2 || st == 9 || st == 12) {
                const int sub = st == 2 ? 0 : (st == 9 ? 1 : 2);
                const bf16_t* y = (const bf16_t*)(U + (sub == 1 ? (is_ret ? U_RET_Y : U_NSA_Y) : U_FFN_Y));
                const float* modN = (sub == 2) ? (layer + 1 < DEPTH ? modL + (size_t)16 * MODW : modL) : modL;
                const int shc = (sub == 2) ? 0 : (sub + 1) * 3;
                phase_ln(p.out, p.out, y, modL + (sub * 3 + 2) * 1024, sub == 1 ? 1.0f : 0.5f, p.ln_g + (size_t)(layer * 3 + sub) * 1024, p.ln_b + (size_t)(layer * 3 + sub) * 1024,
                         modN + shc * 1024, modN + (shc + 1) * 1024, H);
            } else if (is_ret) {
                const bf16_t* Wi = (const bf16_t*)(ws + OFF_RET_IN + (size_t)jm * SZ_RET_IN);
                if (st == 3) { d[0] = GemmDesc{H, Wi, (bf16_t*)(U + U_RET_QKV), MTOK, 4096, 1024, 4096, 0, 0}; ng = 1; }
                else if (st == 4) { for (int rr = 0; rr < R_CORE; ++rr) phase_ret_core((const bf16_t*)(U + U_RET_QKV), (bf16_t*)(U + U_RET_O), lds); }
                else if (st == 5) { d[0] = GemmDesc{H, Wi + (size_t)4096 * 1024, (bf16_t*)(U + U_RET_G), MTOK, 2048, 1024, 2048, 0, 0}; ng = 1; }
                else if (st == 6) phase_ret_gate((bf16_t*)(U + U_RET_O), (const bf16_t*)(U + U_RET_G));
                else if (st == 7) { d[0] = GemmDesc{(const bf16_t*)(U + U_RET_O), (const bf16_t*)(ws + OFF_RET_OUT + (size_t)jm * SZ_RET_OUT), (bf16_t*)(U + U_RET_Y), MTOK, 1024, 2048, 1024, 0, 0}; ng = 1; }
                else continue;
            } else {
                if (st == 3) { d[0] = GemmDesc{H, (const bf16_t*)(ws + OFF_NSA_IN + (size_t)jm * SZ_NSA_IN), (bf16_t*)(U + U_NSA_PROJ), MTOK, 2816, 1024, 2816, 0, 0}; ng = 1; }
                else if (st == 4) phase_nsa_mat((const bf16_t*)(U + U_NSA_PROJ), p.pe_k + (size_t)jm * 2048, p.pe_v + (size_t)jm * 2048, (bf16_t*)(U + U_NSA_ACMPK), (bf16_t*)(U + U_NSA_ACMPV));
                else if (st == 5) {
                    d[0] = GemmDesc{(const bf16_t*)(U + U_NSA_ACMPK), (const bf16_t*)(ws + OFF_W1 + (size_t)(0 * 2 + jm) * SZ_W1), (bf16_t*)(U + U_NSA_HK), 8192, 256, 2048, 256, 2, 0};
                    d[1] = GemmDesc{(const bf16_t*)(U + U_NSA_ACMPV), (const bf16_t*)(ws + OFF_W1 + (size_t)(1 * 2 + jm) * SZ_W1), (bf16_t*)(U + U_NSA_HV), 8192, 256, 2048, 256, 2, 32}; ng = 2;
                } else if (st == 6) phase_nsa_cmp2((const bf16_t*)(U + U_NSA_HK), (const bf16_t*)(U + U_NSA_HV), (const bf16_t*)(ws + OFF_W2 + (size_t)(0 * 2 + jm) * SZ_W2), (const bf16_t*)(ws + OFF_W2 + (size_t)(1 * 2 + jm) * SZ_W2),
                                               (bf16_t*)(U + U_NSA_KCMP), (bf16_t*)(U + U_NSA_VCMP));
                else if (st == 7) { for (int rr = 0; rr < R_ATTN; ++rr) phase_nsa_attn((const bf16_t*)(U + U_NSA_PROJ), (const bf16_t*)(U + U_NSA_KCMP), (const bf16_t*)(U + U_NSA_VCMP), (bf16_t*)(U + U_NSA_OATT), lds); }
                else { d[0] = GemmDesc{(const bf16_t*)(U + U_NSA_OATT), (const bf16_t*)(ws + OFF_NSA_OUT + (size_t)jm * SZ_NSA_OUT), (bf16_t*)(U + U_NSA_Y), MTOK, 1024, 1024, 1024, 0, 0}; ng = 1; }
            }
            for (int rr = 0; rr < R_GEMM; ++rr) for (int r = 0; r < ng; ++r) { GemmDesc dd = d[0]; if (r == 1) dd = d[1]; run_gemm(dd, lds); }
        }
        }
        xcd_barrier(xbar);
    }
}

extern "C" void kernel_launch(void* const* d_in, const int* in_sizes, int n_in, void* d_out, int out_size, void* d_ws, size_t ws_size, hipStream_t stream) {
    static int grid_blocks = 0;
    if (grid_blocks == 0) {
        int dev = 0, cus = 0, per_cu = 0;
        hipGetDevice(&dev); hipDeviceGetAttribute(&cus, hipDeviceAttributeMultiprocessorCount, dev);
        if (hipFuncSetAttribute((const void*)fwd_megakernel, hipFuncAttributeMaxDynamicSharedMemorySize, LDS_BYTES) != hipSuccess) fprintf(stderr, "hipFuncSetAttribute failed\n");
        if (hipOccupancyMaxActiveBlocksPerMultiprocessor(&per_cu, (const void*)fwd_megakernel, NTHR, LDS_BYTES) != hipSuccess || per_cu < 1) { fprintf(stderr, "occupancy query: %d\n", per_cu); per_cu = 1; }
        (void)hipGetLastError();
        grid_blocks = cus * 1;
        if (ws_size < WS_END + 16384) fprintf(stderr, "workspace too small: %zu < %zu\n", ws_size, (size_t)WS_END);
    }
    Params p{};
    p.x = (const float*)d_in[0]; p.c = (const float*)d_in[1]; p.ada_w = (const float*)d_in[2]; p.ada_b = (const float*)d_in[3]; p.ln_g = (const float*)d_in[4]; p.ln_b = (const float*)d_in[5];
    p.pe_k = (const float*)d_in[12]; p.pe_v = (const float*)d_in[13]; p.out = (float*)d_out; p.ws = (unsigned char*)d_ws;
    unsigned char* ws = (unsigned char*)d_ws; int nj = 0, te = 0;
    auto add = [&](const float* src, size_t dst_off, int K, int N, int Np, int mode) { p.jobs[nj] = WJob{src, (bf16_t*)(ws + dst_off), K, N, Np, mode}; te += (Np / 64) * (K / 64); p.tile_end[nj] = te; ++nj; };
    const float* ffn_in = (const float*)d_in[6]; const float* ffn_out = (const float*)d_in[7]; const float* ret_in = (const float*)d_in[8]; const float* ret_out = (const float*)d_in[9];
    const float* nsa_in = (const float*)d_in[10]; const float* nsa_out = (const float*)d_in[11];
    const float* ck1 = (const float*)d_in[14]; const float* ck2 = (const float*)d_in[15]; const float* cv1 = (const float*)d_in[16]; const float* cv2 = (const float*)d_in[17];
    for (int i = 0; i < 8; ++i) add(ffn_in + (size_t)i * 1024 * 5632, OFF_FFN_IN + i * SZ_FFN_IN, 1024, 5632, 5632, 1);
    for (int i = 0; i < 8; ++i) add(ffn_out + (size_t)i * 2816 * 1024, OFF_FFN_OUT + i * SZ_FFN_OUT, 2816, 1024, 1024, 0);
    for (int i = 0; i < 2; ++i) add(ret_in + (size_t)i * 1024 * 6144, OFF_RET_IN + i * SZ_RET_IN, 1024, 6144, 6144, 0);
    for (int i = 0; i < 2; ++i) add(ret_out + (size_t)i * 2048 * 1024, OFF_RET_OUT + i * SZ_RET_OUT, 2048, 1024, 1024, 0);
    for (int i = 0; i < 2; ++i) add(nsa_in + (size_t)i * 1024 * 2608, OFF_NSA_IN + i * SZ_NSA_IN, 1024, 2608, 2816, 0);
    for (int i = 0; i < 2; ++i) add(nsa_out + (size_t)i * 1024 * 1024, OFF_NSA_OUT + i * SZ_NSA_OUT, 1024, 1024, 1024, 0);
    for (int i = 0; i < 2; ++i) add(ck1 + (size_t)i * 2048 * 256, OFF_W1 + (0 * 2 + i) * SZ_W1, 2048, 256, 256, 0);
    for (int i = 0; i < 2; ++i) add(cv1 + (size_t)i * 2048 * 256, OFF_W1 + (1 * 2 + i) * SZ_W1, 2048, 256, 256, 0);
    for (int i = 0; i < 2; ++i) add(ck2 + (size_t)i * 256 * 64, OFF_W2 + (0 * 2 + i) * SZ_W2, 256, 64, 64, 0);
    for (int i = 0; i < 2; ++i) add(cv2 + (size_t)i * 256 * 64, OFF_W2 + (1 * 2 + i) * SZ_W2, 256, 64, 64, 0);
    p.njobs = nj;
    if (hipMemsetAsync(ws + WS_END, 0, 16384, stream) != hipSuccess) fprintf(stderr, "barrier memset failed\n");
    void* args[] = {&p};
    hipError_t e = hipLaunchCooperativeKernel((const void*)fwd_megakernel, dim3(grid_blocks), dim3(NTHR), args, LDS_BYTES, stream);
    if (e != hipSuccess) fprintf(stderr, "cooperative launch failed: %s (grid %d)\n", hipGetErrorString(e), grid_blocks);
}
```

```cpp
#include <hip/hip_runtime.h>
#include <hip/hip_cooperative_groups.h>
#include <cstdio>
namespace cg = cooperative_groups;

namespace pg8 {
#define PG8_LAS __attribute__((address_space(3)))
typedef unsigned short bf16_t;
typedef short bf16x8 __attribute__((ext_vector_type(8)));
typedef float f32x4 __attribute__((ext_vector_type(4)));
typedef unsigned u32x4 __attribute__((ext_vector_type(4)));
constexpr int BM = 256, BK = 64, HALF = 128, HTB = HALF * BK * 2  , STAGE_BYTES = 8 * HTB, NXCD = 8, WGM = 8;

__host__ __device__ __forceinline__ int lds_byte(int r, int c) { const int st = (r >> 4) * 2 + (c >> 5), rr = r & 15, cc = c & 31, ob = rr * 64 + cc * 2; return st * 1024 + (ob ^ (((ob >> 9) & 1) << 5)); }
__host__ __device__ __forceinline__ void stage_rc(int b, int& R, int& C) { const int st = b / 1024, sb = b % 1024, swz = sb ^ (((sb >> 9) & 1) << 5); R = (st >> 1) * 16 + swz / 64; C = (st & 1) * 32 + (swz % 64) / 2; }
__host__ __device__ __forceinline__ int perm32(int rho) { const int n = rho >> 4, i = rho & 15; return 8 * (i >> 2) + 4 * n + (i & 3); }

struct Unit { int pm, pn; };
struct Gemm { const bf16_t* A; const bf16_t* Bt; int M, N, K; };

struct StaticOrder {
    int nM, nN, nwg, G, c;
    __host__ __device__ void init(int M, int N, int G_, int c_) { nM = M / BM; nN = N / BM; nwg = nM * nN; G = G_; c = c_; }
    __host__ __device__ bool next(int i, Unit& u) const {
        const long L = (long)i * G + c; if (L >= nwg) return false;
        int wgid = (int)L; { const int q = nwg / NXCD, r = nwg % NXCD, xcd = wgid % NXCD, off = wgid / NXCD; wgid = (xcd < r ? xcd * (q + 1) : r * (q + 1) + (xcd - r) * q) + off; }
        const int nig = WGM * nN, gid = wgid / nig, fm = gid * WGM, gsz = (nM - fm) < WGM ? (nM - fm) : WGM;
        u.pm = fm + ((wgid % nig) % gsz); u.pn = (wgid % nig) / gsz; return true;
    }
    __device__ __forceinline__ void a_ready(const Unit&) const {}
    __device__ __forceinline__ void done(const Unit&) const {}
};

typedef float f32x2_t __attribute__((ext_vector_type(2)));
typedef __bf16 bf16x2_t __attribute__((ext_vector_type(2)));
__device__ __forceinline__ unsigned cvt_pk_bf16(float lo, float hi) { const f32x2_t v = {lo, hi}; return __builtin_bit_cast(unsigned, __builtin_convertvector(v, bf16x2_t)); }
__device__ __forceinline__ float silu_f(float a) { return a * __builtin_amdgcn_rcpf(1.0f + __builtin_amdgcn_exp2f(-1.44269504089f * a)); }
__device__ __forceinline__ float gelu_tanh_f(float x) { const float u = 0.7978845608028654f * (x + 0.044715f * x * x * x); const float t = 1.0f - 2.0f * __builtin_amdgcn_rcpf(1.0f + __builtin_amdgcn_exp2f(2.88539008178f * u)); return 0.5f * x * (1.0f + t); }

template <int ACT> struct Epi {
    static constexpr bool PERM = true, AFTER_DRAIN = false;
    bf16_t* O; int ldc;
    __device__ __forceinline__ void operator()(const f32x4 (&acc)[2][2][4][2], const Unit& u, int wr, int wc, int fr, int fq) const {
        const int row0 = u.pm * BM + wr * 64 + fr;
        if (ACT == 1) {
            const int col0 = u.pn * HALF + wc * 32 + 8 * fq;
#pragma unroll
            for (int ai = 0; ai < 2; ++ai)
#pragma unroll
                for (int m = 0; m < 4; ++m) { bf16_t* rowp = O + (size_t)(row0 + ai * HALF + m * 16) * ldc + col0;
                    const f32x4 a0 = acc[ai][0][m][0], a1 = acc[ai][0][m][1], u0 = acc[ai][1][m][0], u1 = acc[ai][1][m][1];
                    u32x4 w; w.x = cvt_pk_bf16(silu_f(a0[0]) * u0[0], silu_f(a0[1]) * u0[1]); w.y = cvt_pk_bf16(silu_f(a0[2]) * u0[2], silu_f(a0[3]) * u0[3]);
                    w.z = cvt_pk_bf16(silu_f(a1[0]) * u1[0], silu_f(a1[1]) * u1[1]); w.w = cvt_pk_bf16(silu_f(a1[2]) * u1[2], silu_f(a1[3]) * u1[3]);
                    *(u32x4*)rowp = w; }
        } else {
            const int col0 = u.pn * BM + wc * 32 + 8 * fq;
#pragma unroll
            for (int ai = 0; ai < 2; ++ai)
#pragma unroll
                for (int m = 0; m < 4; ++m) { bf16_t* rowp = O + (size_t)(row0 + ai * HALF + m * 16) * ldc + col0;
#pragma unroll
                    for (int bj = 0; bj < 2; ++bj) { f32x4 v0 = acc[ai][bj][m][0], v1 = acc[ai][bj][m][1];
                        if (ACT == 2) {
#pragma unroll
                            for (int j = 0; j < 4; ++j) { v0[j] = gelu_tanh_f(v0[j]); v1[j] = gelu_tanh_f(v1[j]); } }
                        u32x4 w; w.x = cvt_pk_bf16(v0[0], v0[1]); w.y = cvt_pk_bf16(v0[2], v0[3]); w.z = cvt_pk_bf16(v1[0], v1[1]); w.w = cvt_pk_bf16(v1[2], v1[3]);
                        *(u32x4*)(rowp + bj * HALF) = w; } }
        }
    }
};

template <class Epi, class Sched, bool ALIGN_EPI = false, bool SP2 = false>
__device__ __forceinline__ void gemm_phase(PG8_LAS unsigned char* lds, const Gemm g, const Sched& S, const Epi& E) {
    const int tid = threadIdx.x, wid = __builtin_amdgcn_readfirstlane(tid >> 6), lane = tid & 63, wr = wid >> 2, wc = wid & 3, fr = lane & 15, fq = lane >> 4;
    const int K = g.K, nt = K / BK;
    unsigned voffA[2], voffB[2];
#pragma unroll
    for (int i = 0; i < 2; ++i) { int R, C; stage_rc(tid * 16 + i * 8192, R, C); const int Rb = Epi::PERM ? ((R & ~31) + perm32(R & 31)) : R;
        voffA[i] = (unsigned)(R * K + C) * 2u; voffB[i] = (unsigned)(Rb * K + C) * 2u; }
    const size_t kstep = (size_t)(BK * 2);
    const size_t hstep = (size_t)HALF * K * 2;
    const size_t tstep = 2 * hstep;
    const unsigned ldsw = (unsigned)wid * 1024u;
    const int aoff = lds_byte(wr * 64 + fr, fq * 8), boff = lds_byte(wc * 32 + fr, fq * 8);
#define PG8_SA(b, h) (((b) * 2 + (h)) * HTB)
#define PG8_SB(b, h) ((4 + (b) * 2 + (h)) * HTB)
#define PG8_STAGE(bufoff, gbase, voff) do { _Pragma("unroll") for (int _i = 0; _i < 2; ++_i) \
        __builtin_amdgcn_global_load_lds((const unsigned*)((const char*)(gbase) + (voff)[_i]), (PG8_LAS unsigned*)(lds + (bufoff) + ldsw + _i * 8192), 16, 0, 0); } while (0)
#define PG8_LDA(dst, b, h) do { _Pragma("unroll") for (int m = 0; m < 4; ++m) _Pragma("unroll") for (int k = 0; k < 2; ++k) dst[m][k] = *(const PG8_LAS bf16x8*)(lds + PG8_SA(b, h) + aoff + m * 2048 + k * 1024); } while (0)
#define PG8_LDB(dst, b, h) do { _Pragma("unroll") for (int n = 0; n < 2; ++n) _Pragma("unroll") for (int k = 0; k < 2; ++k) dst[n][k] = *(const PG8_LAS bf16x8*)(lds + PG8_SB(b, h) + boff + n * 2048 + k * 1024); } while (0)
#define PG8_MMA(ai, bj, At, Bt) do { __builtin_amdgcn_s_setprio(1); _Pragma("unroll") for (int m = 0; m < 4; ++m) _Pragma("unroll") for (int n = 0; n < 2; ++n) _Pragma("unroll") for (int k = 0; k < 2; ++k) \
        acc[ai][bj][m][n] = __builtin_amdgcn_mfma_f32_16x16x32_bf16(Bt[n][k], At[m][k], acc[ai][bj][m][n], 0, 0, 0); __builtin_amdgcn_s_setprio(0); } while (0)
#define PG8_WAIT_V(n) asm volatile("s_waitcnt vmcnt(" #n ")" ::: "memory")
#define PG8_WAIT_L(n) asm volatile("s_waitcnt lgkmcnt(" #n ")" ::: "memory")
#define PG8_BAR __builtin_amdgcn_s_barrier()
#define PG8_SCHED __builtin_amdgcn_sched_barrier(0)
    Unit cur, nxt; int ui = 0;
    if (!S.next(0, cur)) return;
    f32x4 acc[2][2][4][2];
#pragma unroll
    for (int a = 0; a < 2; ++a)
#pragma unroll
        for (int b = 0; b < 2; ++b)
#pragma unroll
            for (int m = 0; m < 4; ++m)
#pragma unroll
                for (int n = 0; n < 2; ++n) acc[a][b][m][n] = (f32x4){0.f, 0.f, 0.f, 0.f};
    bf16x8 At[4][2], B0[2][2], B1[2][2];
    const char* cA = (const char*)g.A + (size_t)cur.pm * tstep; const char* cB = (const char*)g.Bt + (size_t)cur.pn * tstep;
    S.a_ready(cur);
    if constexpr (SP2) {
        PG8_STAGE(PG8_SB(0, 0), cB, voffB); PG8_STAGE(PG8_SB(0, 1), cB + hstep, voffB); PG8_STAGE(PG8_SA(0, 0), cA, voffA); PG8_STAGE(PG8_SA(0, 1), cA + hstep, voffA);
        if (wr == 1) PG8_BAR;
        PG8_WAIT_V(2); PG8_BAR;
        PG8_STAGE(PG8_SB(1, 0), cB + kstep, voffB); PG8_STAGE(PG8_SA(1, 0), cA + kstep, voffA); PG8_STAGE(PG8_SB(1, 1), cB + hstep + kstep, voffB);
        PG8_WAIT_V(6); PG8_BAR;
    } else {
        PG8_STAGE(PG8_SB(0, 0), cB, voffB); PG8_STAGE(PG8_SA(0, 0), cA, voffA); PG8_STAGE(PG8_SB(0, 1), cB + hstep, voffB); PG8_STAGE(PG8_SA(0, 1), cA + hstep, voffA);
        if (wr == 1) PG8_BAR;
        PG8_WAIT_V(4); PG8_BAR;
        PG8_STAGE(PG8_SB(1, 0), cB + kstep, voffB); PG8_STAGE(PG8_SA(1, 0), cA + kstep, voffA); PG8_STAGE(PG8_SB(1, 1), cB + hstep + kstep, voffB);
        PG8_WAIT_V(6); PG8_BAR;
    }
    for (;;) {
        const bool has_next = S.next(ui + 1, nxt);
        const char* nA = has_next ? (const char*)g.A + (size_t)nxt.pm * tstep : cA; const char* nB = has_next ? (const char*)g.Bt + (size_t)nxt.pn * tstep : cB;
        for (int t = 0; t < nt; t += 2) {
            const bool last = (t == nt - 2);
            const char* a1 = cA + (size_t)(t + 1) * kstep;
            const char* a2 = last ? nA : cA + (size_t)(t + 2) * kstep; const char* b2 = last ? nB : cB + (size_t)(t + 2) * kstep;
            const char* a3 = a2 + kstep; const char* b3 = b2 + kstep;
            if (last && has_next) S.a_ready(nxt);
            if constexpr (SP2) {
            PG8_LDB(B0, 0, 0); PG8_LDB(B1, 0, 1); PG8_SCHED; PG8_LDA(At, 0, 0); PG8_STAGE(PG8_SA(1, 1), a1 + hstep, voffA);
            PG8_WAIT_V(8); PG8_WAIT_L(0); PG8_BAR; PG8_MMA(0, 0, At, B0); PG8_MMA(0, 1, At, B1); PG8_BAR; PG8_SCHED;
            PG8_LDA(At, 0, 1); PG8_STAGE(PG8_SB(0, 0), b2, voffB); PG8_STAGE(PG8_SB(0, 1), b2 + hstep, voffB); PG8_STAGE(PG8_SA(0, 0), a2, voffA);
            PG8_WAIT_V(8); PG8_WAIT_L(0); PG8_BAR; PG8_MMA(1, 0, At, B0); PG8_MMA(1, 1, At, B1); PG8_BAR; PG8_SCHED;
            PG8_LDB(B0, 1, 0); PG8_LDB(B1, 1, 1); PG8_SCHED; PG8_LDA(At, 1, 0); PG8_STAGE(PG8_SA(0, 1), a2 + hstep, voffA);
            PG8_WAIT_V(8); PG8_WAIT_L(0); PG8_BAR; PG8_MMA(0, 0, At, B0); PG8_MMA(0, 1, At, B1); PG8_BAR; PG8_SCHED;
            PG8_LDA(At, 1, 1); PG8_STAGE(PG8_SB(1, 0), b3, voffB); PG8_STAGE(PG8_SB(1, 1), b3 + hstep, voffB); PG8_STAGE(PG8_SA(1, 0), a3, voffA);
            PG8_WAIT_V(8); PG8_WAIT_L(0); PG8_BAR; PG8_MMA(1, 0, At, B0); PG8_MMA(1, 1, At, B1); PG8_BAR; PG8_SCHED;
            } else {
            PG8_LDB(B0, 0, 0); PG8_SCHED; PG8_LDA(At, 0, 0); PG8_STAGE(PG8_SA(1, 1), a1 + hstep, voffA);
            PG8_WAIT_L(8); PG8_BAR; PG8_WAIT_L(0); PG8_MMA(0, 0, At, B0); PG8_BAR; PG8_SCHED;
            PG8_LDB(B1, 0, 1); PG8_STAGE(PG8_SB(0, 0), b2, voffB);
            PG8_BAR; PG8_WAIT_L(0); PG8_MMA(0, 1, At, B1); PG8_BAR;
            PG8_LDA(At, 0, 1); PG8_STAGE(PG8_SA(0, 0), a2, voffA);
            PG8_BAR; PG8_WAIT_L(0); PG8_MMA(1, 0, At, B0); PG8_BAR; PG8_SCHED;
            PG8_STAGE(PG8_SB(0, 1), b2 + hstep, voffB);
            PG8_WAIT_V(6); PG8_BAR; PG8_MMA(1, 1, At, B1); PG8_BAR;
            PG8_LDB(B0, 1, 0); PG8_SCHED; PG8_LDA(At, 1, 0); PG8_STAGE(PG8_SA(0, 1), a2 + hstep, voffA);
            PG8_WAIT_L(8); PG8_BAR; PG8_WAIT_L(0); PG8_MMA(0, 0, At, B0); PG8_BAR; PG8_SCHED;
            PG8_LDB(B1, 1, 1); PG8_STAGE(PG8_SB(1, 0), b3, voffB);
            PG8_BAR; PG8_WAIT_L(0); PG8_MMA(0, 1, At, B1); PG8_BAR;
            PG8_LDA(At, 1, 1); PG8_STAGE(PG8_SA(1, 0), a3, voffA);
            PG8_BAR; PG8_WAIT_L(0); PG8_MMA(1, 0, At, B0); PG8_BAR; PG8_SCHED;
            PG8_STAGE(PG8_SB(1, 1), b3 + hstep, voffB);
            PG8_WAIT_V(6); PG8_BAR; PG8_MMA(1, 1, At, B1); PG8_BAR;
            }
        }
        if constexpr (ALIGN_EPI) { if (wr == 0) PG8_BAR; }
        if constexpr (!Epi::AFTER_DRAIN) { E(acc, cur, wr, wc, fr, fq); S.done(cur); }
        if (!has_next) break;
#pragma unroll
        for (int a = 0; a < 2; ++a)
#pragma unroll
            for (int b = 0; b < 2; ++b)
#pragma unroll
                for (int m = 0; m < 4; ++m)
#pragma unroll
                    for (int n = 0; n < 2; ++n) acc[a][b][m][n] = (f32x4){0.f, 0.f, 0.f, 0.f};
        cur = nxt; cA = nA; cB = nB; ++ui;
        if constexpr (ALIGN_EPI) { if (wr == 1) PG8_BAR; }
    }
    PG8_WAIT_V(0);
    if constexpr (!ALIGN_EPI) { if (wr == 0) PG8_BAR; }
    PG8_BAR;
    if constexpr (Epi::AFTER_DRAIN) { E.fused(acc, cur, wr, wc, fr, fq, lds, wid, lane); S.done(cur); }
#undef PG8_SA
#undef PG8_SB
#undef PG8_STAGE
#undef PG8_LDA
#undef PG8_LDB
#undef PG8_MMA
#undef PG8_WAIT_V
#undef PG8_WAIT_L
#undef PG8_BAR
#undef PG8_SCHED
}
}

using pg8::bf16_t; using pg8::bf16x8; using pg8::f32x4; using pg8::u32x4; using pg8::cvt_pk_bf16; using pg8::silu_f;
#define LAS __attribute__((address_space(3)))
typedef unsigned u32x2 __attribute__((ext_vector_type(2)));
typedef short s16x4 __attribute__((ext_vector_type(4)));
#define MFMA16(a, b, c) __builtin_amdgcn_mfma_f32_16x16x32_bf16((a), (b), (c), 0, 0, 0)

constexpr int NTHR = 512;
constexpr int MTOK = 32768, DM = 1024, SEQ = 2048, DFF = 2816, DEPTH = 4, MODW = 9216;
constexpr float DN_ALPHA = 1.6817928305074290861f;
constexpr size_t MiB = (size_t)1 << 20;
constexpr size_t SZ_FFN_IN = (size_t)5632 * 1024 * 2, SZ_FFN_OUT = (size_t)1024 * 2816 * 2, SZ_RET_IN = (size_t)6144 * 1024 * 2, SZ_RET_OUT = (size_t)1024 * 2048 * 2,
                 SZ_NSA_IN = (size_t)2816 * 1024 * 2, SZ_NSA_OUT = (size_t)1024 * 1024 * 2, SZ_W1 = (size_t)256 * 2048 * 2, SZ_W2 = (size_t)64 * 256 * 2;
constexpr size_t OFF_FFN_IN = 0, OFF_FFN_OUT = OFF_FFN_IN + 8 * SZ_FFN_IN, OFF_RET_IN = OFF_FFN_OUT + 8 * SZ_FFN_OUT, OFF_RET_OUT = OFF_RET_IN + 2 * SZ_RET_IN,
                 OFF_NSA_IN = OFF_RET_OUT + 2 * SZ_RET_OUT, OFF_NSA_OUT = OFF_NSA_IN + 2 * SZ_NSA_IN, OFF_W1 = OFF_NSA_OUT + 2 * SZ_NSA_OUT, OFF_W2 = OFF_W1 + 4 * SZ_W1,
                 OFF_MOD = OFF_W2 + 4 * SZ_W2, OFF_H = OFF_MOD + (size_t)DEPTH * 16 * MODW * 4, OFF_U2 = OFF_H + (size_t)MTOK * DM * 2, WS_END = OFF_U2 + 384 * MiB;
constexpr size_t U_FFN_ACT = 0, U_FFN_Y = 192 * MiB;
constexpr size_t U_RET_QKV = 0, U_RET_G = 0, U_RET_O = 256 * MiB, U_RET_Y = 128 * MiB;
constexpr size_t U_NSA_PROJ = 0, U_NSA_Y = 192 * MiB, U_NSA_ACMPK = 256 * MiB, U_NSA_ACMPV = 288 * MiB, U_NSA_HK = 320 * MiB, U_NSA_HV = 324 * MiB, U_NSA_KCMP = 328 * MiB, U_NSA_VCMP = 329 * MiB, U_NSA_OATT = 256 * MiB;
constexpr int XB_LDS_OFF = 152 * 1024, LDS_BYTES = 152 * 1024 + 16;

struct WJob { const float* src; bf16_t* dst; int K, N, Np, mode; };
struct Params {
    const float* x; const float* c; const float* ada_w; const float* ada_b; const float* ln_g; const float* ln_b; const float* pe_k; const float* pe_v;
    float* out; unsigned char* ws;
    WJob jobs[32]; int tile_end[32]; int njobs; int pad;
};

__device__ __forceinline__ float bf2f(unsigned short b) { return __uint_as_float(((unsigned)b) << 16); }
__device__ __forceinline__ float bflo(unsigned w) { return __uint_as_float(w << 16); }
__device__ __forceinline__ float bfhi(unsigned w) { return __uint_as_float(w & 0xffff0000u); }
__device__ __forceinline__ unsigned short f2bf(float f) { return (unsigned short)(cvt_pk_bf16(f, 0.f) & 0xffffu); }
__device__ __forceinline__ bf16x8 pack8(const f32x4& a, const f32x4& b) { u32x4 w; w.x = cvt_pk_bf16(a[0], a[1]); w.y = cvt_pk_bf16(a[2], a[3]); w.z = cvt_pk_bf16(b[0], b[1]); w.w = cvt_pk_bf16(b[2], b[3]); return __builtin_bit_cast(bf16x8, w); }
__device__ __forceinline__ u32x2 pack4(const f32x4& a) { u32x2 w; w.x = cvt_pk_bf16(a[0], a[1]); w.y = cvt_pk_bf16(a[2], a[3]); return w; }
__device__ __forceinline__ bf16x8 lds_rd16(LAS unsigned char* lds, int off) { return *(const LAS bf16x8*)(lds + off); }
__device__ __forceinline__ bf16x8 lds_rd8x2(LAS unsigned char* lds, int off) { const s16x4 lo = *(const LAS s16x4*)(lds + off), hi = *(const LAS s16x4*)(lds + off + 32); return __builtin_shufflevector(lo, hi, 0, 1, 2, 3, 4, 5, 6, 7); }
template <int M> __device__ __forceinline__ float shx(float v, int lane) {
    if (M < 32) return __int_as_float(__builtin_amdgcn_ds_swizzle(__float_as_int(v), (M << 10) | 0x1f));
    return __int_as_float(__builtin_amdgcn_ds_bpermute((lane ^ M) << 2, __float_as_int(v)));
}
template <int M> __device__ __forceinline__ unsigned shxu(unsigned v, int lane) {
    if (M < 32) return (unsigned)__builtin_amdgcn_ds_swizzle((int)v, (M << 10) | 0x1f);
    return (unsigned)__builtin_amdgcn_ds_bpermute((lane ^ M) << 2, (int)v);
}
__device__ __forceinline__ float shi(float v, int src_lane) { return __int_as_float(__builtin_amdgcn_ds_bpermute(src_lane << 2, __float_as_int(v))); }
__device__ __forceinline__ float wsum(float v, int lane) { v += shx<32>(v, lane); v += shx<16>(v, lane); v += shx<8>(v, lane); v += shx<4>(v, lane); v += shx<2>(v, lane); v += shx<1>(v, lane); return v; }

struct WTile { const float* src; bf16_t* dst; int N, K, sbase, n0, k0; };
__device__ __forceinline__ WTile wt_lookup(const Params& p, int t) {
    int j = 0; while (j < p.njobs - 1 && t >= p.tile_end[j]) ++j;
    const int tl = t - (j ? p.tile_end[j - 1] : 0);
    const WJob& J = p.jobs[j];
    const int ntn = J.Np >> 6; const int tn = tl % ntn, tk = tl / ntn; const int n0 = tn * 64, k0 = tk * 64;
    int sbase = n0; if (J.mode == 1) { const int pn = n0 >> 8, r = n0 & 255; sbase = (r >> 7) * DFF + pn * 128 + (r & 127); }
    return WTile{J.src, J.dst, J.N, J.K, sbase, n0, k0};
}
__device__ __forceinline__ void wt_load(const WTile& W, int tid, f32x4& v0, f32x4& v1) {
    const int kk = tid >> 4, nn = (tid & 15) * 4;
    v0 = (f32x4){0.f, 0.f, 0.f, 0.f}; v1 = v0;
    if (W.sbase + nn < W.N) { v0 = *(const f32x4*)(W.src + (size_t)(W.k0 + kk) * W.N + W.sbase + nn); v1 = *(const f32x4*)(W.src + (size_t)(W.k0 + kk + 32) * W.N + W.sbase + nn); }
}

__device__ __forceinline__ void phase_prep(const Params& p, LAS unsigned char* lds) {
    int tid = threadIdx.x; asm volatile("" : "+v"(tid));
    LAS float* T = (LAS float*)lds;
    const int ntiles = p.tile_end[p.njobs - 1];
    {
        int t = blockIdx.x;
        WTile cur = wt_lookup(p, t < ntiles ? t : 0); f32x4 v0, v1;
        if (t < ntiles) wt_load(cur, tid, v0, v1);
        while (t < ntiles) {
            const int tn = t + (int)gridDim.x; const bool more = tn < ntiles;
            WTile nx = wt_lookup(p, more ? tn : 0); f32x4 n0 = (f32x4){0.f, 0.f, 0.f, 0.f}, n1 = n0;
            if (more) wt_load(nx, tid, n0, n1);
            const int kk = tid >> 4, nn = (tid & 15) * 4;
            T[kk * 65 + nn] = v0[0]; T[kk * 65 + nn + 1] = v0[1]; T[kk * 65 + nn + 2] = v0[2]; T[kk * 65 + nn + 3] = v0[3];
            T[(kk + 32) * 65 + nn] = v1[0]; T[(kk + 32) * 65 + nn + 1] = v1[1]; T[(kk + 32) * 65 + nn + 2] = v1[2]; T[(kk + 32) * 65 + nn + 3] = v1[3];
            __syncthreads();
            const int n = tid >> 3, k8 = (tid & 7) * 8;
            f32x4 a, b;
            a[0] = T[(k8 + 0) * 65 + n]; a[1] = T[(k8 + 1) * 65 + n]; a[2] = T[(k8 + 2) * 65 + n]; a[3] = T[(k8 + 3) * 65 + n];
            b[0] = T[(k8 + 4) * 65 + n]; b[1] = T[(k8 + 5) * 65 + n]; b[2] = T[(k8 + 6) * 65 + n]; b[3] = T[(k8 + 7) * 65 + n];
            *(bf16x8*)(cur.dst + (size_t)(cur.n0 + n) * cur.K + cur.k0 + k8) = pack8(a, b);
            __syncthreads();
            cur = nx; v0 = n0; v1 = n1; t = tn;
        }
    }
    if (blockIdx.x < 288) {
        LAS float* cs = (LAS float*)lds;
        LAS float* red = (LAS float*)(lds + 65536);
        float* mod = (float*)(p.ws + OFF_MOD);
        __syncthreads();
        for (int idx = tid; idx < 16 * 1024; idx += NTHR) { const int b = idx >> 10, k = idx & 1023; const float cv = p.c[idx]; cs[k * 16 + b] = cv / (1.0f + expf(-cv)); }
        __syncthreads();
        for (int unit = blockIdx.x; unit < 288; unit += gridDim.x) {
            const int i = unit / 72, n0 = (unit % 72) * 128, col = tid & 127, kq = tid >> 7;
            f32x4 a0 = (f32x4){0.f, 0.f, 0.f, 0.f}, a1 = a0, a2 = a0, a3 = a0;
            const float* wp = p.ada_w + ((size_t)i * 1024 + kq * 256) * MODW + n0 + col;
#pragma unroll 4
            for (int k = 0; k < 256; ++k) { const float w = wp[(size_t)k * MODW]; const LAS f32x4* cp = (const LAS f32x4*)(cs + (kq * 256 + k) * 16);
                a0 += cp[0] * w; a1 += cp[1] * w; a2 += cp[2] * w; a3 += cp[3] * w; }
#pragma unroll
            for (int b = 0; b < 4; ++b) { red[(kq * 16 + b) * 128 + col] = a0[b]; red[(kq * 16 + 4 + b) * 128 + col] = a1[b]; red[(kq * 16 + 8 + b) * 128 + col] = a2[b]; red[(kq * 16 + 12 + b) * 128 + col] = a3[b]; }
            __syncthreads();
#pragma unroll
            for (int r = 0; r < 4; ++r) { const int o = tid + r * NTHR, b = o >> 7, cc = o & 127;
                const float s = red[(0 * 16 + b) * 128 + cc] + red[(1 * 16 + b) * 128 + cc] + red[(2 * 16 + b) * 128 + cc] + red[(3 * 16 + b) * 128 + cc] + p.ada_b[i * MODW + n0 + cc];
                mod[((size_t)i * 16 + b) * MODW + n0 + cc] = s; }
            __syncthreads();
        }
    }
}

__device__ __forceinline__ void phase_init(const Params& p) {
    const float* mod = (const float*)(p.ws + OFF_MOD); bf16_t* H = (bf16_t*)(p.ws + OFF_H);
    int tid = threadIdx.x; asm volatile("" : "+v"(tid));
    for (size_t i = (size_t)blockIdx.x * NTHR + tid; i < (size_t)MTOK * 256; i += (size_t)gridDim.x * NTHR) {
        const int row = (int)(i >> 8), c4 = (int)(i & 255) * 4, b = row >> 11;
        const f32x4 xv = *(const f32x4*)(p.x + i * 4); *(f32x4*)(p.out + i * 4) = xv;
        const float* m = mod + (size_t)b * MODW; const f32x4 sh = *(const f32x4*)(m + c4), sc = *(const f32x4*)(m + 1024 + c4);
        const f32x4 h = xv * (sc + 1.0f) + sh; *(u32x2*)(H + i * 4) = pack4(h);
    }
}

__device__ __forceinline__ void phase_ln(float* xio, float* xout, const bf16_t* y, const float* modG, float rw, const float* lng, const float* lnb, const float* modSh, const float* modSc, bf16_t* H) {
    int tid = threadIdx.x; asm volatile("" : "+v"(tid));
    const int wid = __builtin_amdgcn_readfirstlane(tid >> 6), lane = tid & 63;
    for (int row = blockIdx.x * 8 + wid; row < MTOK; row += gridDim.x * 8) {
        const int b = row >> 11; const size_t rb = (size_t)row * DM;
        f32x4 z[4]; float s = 0.f;
#pragma unroll
        for (int q = 0; q < 4; ++q) { const int c = q * 256 + lane * 4; const f32x4 xv = *(const f32x4*)(xio + rb + c); const u32x2 yv = *(const u32x2*)(y + rb + c);
            const f32x4 gt = *(const f32x4*)(modG + (size_t)b * MODW + c); const f32x4 yf = (f32x4){bflo(yv.x), bfhi(yv.x), bflo(yv.y), bfhi(yv.y)};
            z[q] = xv * DN_ALPHA + (gt + 1.0f) * yf * rw; s += (z[q][0] + z[q][1]) + (z[q][2] + z[q][3]); }
        const float mu = wsum(s, lane) * (1.0f / 1024.0f); float v = 0.f;
#pragma unroll
        for (int q = 0; q < 4; ++q) { const f32x4 d = z[q] - mu; v += (d[0] * d[0] + d[1] * d[1]) + (d[2] * d[2] + d[3] * d[3]); }
        const float rstd = rsqrtf(wsum(v, lane) * (1.0f / 1024.0f) + 1e-5f);
#pragma unroll
        for (int q = 0; q < 4; ++q) { const int c = q * 256 + lane * 4; const f32x4 g4 = *(const f32x4*)(lng + c), b4 = *(const f32x4*)(lnb + c);
            const f32x4 xn = (z[q] - mu) * rstd * g4 + b4; *(f32x4*)(xout + rb + c) = xn;
            const f32x4 sh = *(const f32x4*)(modSh + (size_t)b * MODW + c), sc = *(const f32x4*)(modSc + (size_t)b * MODW + c);
            *(u32x2*)(H + rb + c) = pack4(xn * (sc + 1.0f) + sh); }
    }
}

typedef short v4i16_t __attribute__((ext_vector_type(4)));
__device__ __forceinline__ s16x4 lds_tr8(LAS unsigned char* lds, int off) { return __builtin_bit_cast(s16x4, __builtin_amdgcn_ds_read_tr16_b64_v4i16((LAS v4i16_t*)(lds + off))); }

__device__ __forceinline__ bf16x8 lds_tr8x2(LAS unsigned char* lds, int off, int hi_off) { const s16x4 lo = lds_tr8(lds, off), hi = lds_tr8(lds, off + hi_off); return __builtin_shufflevector(lo, hi, 0, 1, 2, 3, 4, 5, 6, 7); }

__device__ __forceinline__ void phase_ret_core(const bf16_t* QKV, bf16_t* O, LAS unsigned char* lds) {
    constexpr int KSB = 528, PS = 136, STS = 264, OFF_K = 0, OFF_P = 67584, OFF_VT = 102400, OFF_ST = 119808;
    int tid = threadIdx.x; asm volatile("" : "+v"(tid));
    const int wid = __builtin_amdgcn_readfirstlane(tid >> 6), lane = tid & 63, fr = lane & 15, fq = lane >> 4;
    for (int item = blockIdx.x; item < 512; item += gridDim.x) {
        const int es = item & 7, bh = item >> 3, hh = bh & 3, b = bh >> 2, e0 = es * 64;
        const float log_g = logf(1.0f - exp2f(-5.0f - (float)hh));
        const float gN = expf(log_g * 128.0f);
        const float l2g = log_g * 1.44269504089f;
        __syncthreads();
        for (int i = tid; i < 64 * STS / 2; i += NTHR) ((LAS unsigned*)(lds + OFF_ST))[i] = 0u;
        f32x4 sacc[2][4];
#pragma unroll
        for (int dt = 0; dt < 2; ++dt)
#pragma unroll
            for (int et = 0; et < 4; ++et) sacc[dt][et] = (f32x4){0.f, 0.f, 0.f, 0.f};
        bf16x8 kst[8], vst[2];
        {   const bf16_t* kp = QKV + ((size_t)b * SEQ + (tid >> 5)) * 4096 + 1024 + hh * 256 + (tid & 31) * 8;
#pragma unroll
            for (int it = 0; it < 8; ++it) kst[it] = *(const bf16x8*)(kp + (size_t)it * 16 * 4096);
            const bf16_t* vrow = QKV + ((size_t)b * SEQ + 2 * (tid & 63)) * 4096 + 2048 + hh * 512 + e0 + (tid >> 6) * 8;
            vst[0] = *(const bf16x8*)(vrow); vst[1] = *(const bf16x8*)(vrow + 4096); }
        bf16x8 qf[8];
        { const bf16_t* qrow = QKV + ((size_t)b * SEQ + wid * 16 + fr) * 4096 + hh * 256 + fq * 8;
#pragma unroll
          for (int ks = 0; ks < 8; ++ks) qf[ks] = *(const bf16x8*)(qrow + ks * 32); }
        for (int n = 0; n < 16; ++n) {
            const size_t tok0 = (size_t)b * SEQ + n * 128;
            int t2 = tid; asm volatile("" : "+v"(t2));
            const int lane = t2 & 63, fr = lane & 15, fq = lane >> 4;
            {
#pragma unroll
                for (int it = 0; it < 8; ++it) *(LAS bf16x8*)(lds + OFF_K + ((t2 >> 5) + 16 * it) * KSB + (t2 & 31) * 16) = kst[it];
                const int cp_ = t2 & 63, q_ = t2 >> 6;
#pragma unroll
                for (int i = 0; i < 8; ++i) *(LAS unsigned*)(lds + OFF_VT + ((q_ * 8 + i) * PS + 2 * cp_) * 2) = (unsigned)(unsigned short)vst[0][i] | ((unsigned)(unsigned short)vst[1][i] << 16);
            }
            if (n < 15) {
                const bf16_t* kp = QKV + (tok0 + 128 + (t2 >> 5)) * 4096 + 1024 + hh * 256 + (t2 & 31) * 8;
#pragma unroll
                for (int it = 0; it < 8; ++it) kst[it] = *(const bf16x8*)(kp + (size_t)it * 16 * 4096);
                const bf16_t* vrow = QKV + (tok0 + 128 + 2 * (t2 & 63)) * 4096 + 2048 + hh * 512 + e0 + (t2 >> 6) * 8;
                vst[0] = *(const bf16x8*)(vrow); vst[1] = *(const bf16x8*)(vrow + 4096); }
            __syncthreads();
            const int cc = wid * 16 + fr;
            const int npair = (wid >> 1) + 1;
            for (int cp2 = 0; cp2 < npair; ++cp2) {
                const int kb0 = OFF_K + (cp2 * 32 + fr) * KSB + fq * 16;
                f32x4 acc0 = (f32x4){0.f, 0.f, 0.f, 0.f}, acc1 = acc0;
#pragma unroll
                for (int ks = 0; ks < 8; ++ks) { acc0 = MFMA16(lds_rd16(lds, kb0 + ks * 64), qf[ks], acc0); acc1 = MFMA16(lds_rd16(lds, kb0 + 16 * KSB + ks * 64), qf[ks], acc1); }
                f32x4 pv0, pv1;
#pragma unroll
                for (int j = 0; j < 4; ++j) { const int cp = cp2 * 32 + fq * 4 + j;
                    pv0[j] = (cc >= cp) ? acc0[j] * 0.0625f * __builtin_amdgcn_exp2f(l2g * (float)(cc - cp)) : 0.f;
                    pv1[j] = (cc >= cp + 16) ? acc1[j] * 0.0625f * __builtin_amdgcn_exp2f(l2g * (float)(cc - cp - 16)) : 0.f; }
                *(LAS u32x2*)(lds + OFF_P + (cc * PS + cp2 * 32 + fq * 4) * 2) = pack4(pv0);
                *(LAS u32x2*)(lds + OFF_P + (cc * PS + cp2 * 32 + 16 + fq * 4) * 2) = pack4(pv1);
            }
            __syncthreads();
            {
                f32x4 a1[4], a2[4];
#pragma unroll
                for (int et = 0; et < 4; ++et) { a1[et] = (f32x4){0.f, 0.f, 0.f, 0.f}; a2[et] = a1[et]; }
                const int ksmax = wid >> 1;
                for (int ks = 0; ks <= ksmax; ++ks) { const bf16x8 pf = lds_rd16(lds, OFF_P + (cc * PS + ks * 32 + fq * 8) * 2);
#pragma unroll
                    for (int et = 0; et < 4; ++et) a1[et] = MFMA16(lds_rd16(lds, OFF_VT + ((et * 16 + fr) * PS + ks * 32 + fq * 8) * 2), pf, a1[et]); }
#pragma unroll
                for (int ks = 0; ks < 8; ++ks)
#pragma unroll
                    for (int et = 0; et < 4; ++et) a2[et] = MFMA16(lds_rd16(lds, OFF_ST + ((et * 16 + fr) * STS + ks * 32 + fq * 8) * 2), qf[ks], a2[et]);
                const float dq = __builtin_amdgcn_exp2f(l2g * (float)(cc + 1));
                bf16_t* orow = O + (tok0 + cc) * 2048 + hh * 512 + e0 + fq * 4;
#pragma unroll
                for (int et = 0; et < 4; ++et) *(u32x2*)(orow + et * 16) = pack4(a1[et] + a2[et] * dq);
            }
            if (n < 15) {
                const bf16_t* qrow = QKV + (tok0 + 128 + cc) * 4096 + hh * 256 + fq * 8;
#pragma unroll
                for (int ks = 0; ks < 8; ++ks) qf[ks] = *(const bf16x8*)(qrow + ks * 32); }
            __syncthreads();
            if (n < 15) {
#pragma unroll
                for (int dt = 0; dt < 2; ++dt)
#pragma unroll
                    for (int et = 0; et < 4; ++et) sacc[dt][et] *= gN;
                const int q4 = (lane & 15) >> 2, p4 = lane & 3;
                const float fbase = 0.0625f * __builtin_amdgcn_exp2f(l2g * (float)(127 - 8 * fq));
#pragma unroll
                for (int ks = 0; ks < 4; ++ks) {
                    bf16x8 vf[4];
#pragma unroll
                    for (int et = 0; et < 4; ++et) vf[et] = lds_rd16(lds, OFF_VT + ((et * 16 + fr) * PS + ks * 32 + fq * 8) * 2);
                    const float fks = fbase * __builtin_amdgcn_exp2f(l2g * (float)(-32 * ks));
#pragma unroll
                    for (int dt = 0; dt < 2; ++dt) {
                        const int tb = OFF_K + (32 * ks + 8 * fq + q4) * KSB + (2 * wid + dt) * 32 + 8 * p4;
                        const s16x4 lo = lds_tr8(lds, tb), hi = lds_tr8(lds, tb + 4 * KSB);
                        f32x4 f0, f1;
#pragma unroll
                        for (int e = 0; e < 4; ++e) { f0[e] = bf2f((unsigned short)lo[e]) * (fks * __builtin_amdgcn_exp2f(l2g * (float)(-e))); f1[e] = bf2f((unsigned short)hi[e]) * (fks * __builtin_amdgcn_exp2f(l2g * (float)(-4 - e))); }
                        const bf16x8 kf = pack8(f0, f1);
#pragma unroll
                        for (int et = 0; et < 4; ++et) sacc[dt][et] = MFMA16(kf, vf[et], sacc[dt][et]); }
                }
#pragma unroll
                for (int dt = 0; dt < 2; ++dt)
#pragma unroll
                    for (int et = 0; et < 4; ++et) *(LAS u32x2*)(lds + OFF_ST + ((et * 16 + fr) * STS + (2 * wid + dt) * 16 + fq * 4) * 2) = pack4(sacc[dt][et]);
            }
            __syncthreads();
        }
    }
}

__device__ __forceinline__ void phase_ret_gate(bf16_t* O, const bf16_t* G) {
    int tid = threadIdx.x; asm volatile("" : "+v"(tid));
    const int wid = __builtin_amdgcn_readfirstlane(tid >> 6), lane = tid & 63;
    for (int idx = blockIdx.x * 8 + wid; idx < MTOK * 4; idx += gridDim.x * 8) {
        const size_t base = (size_t)(idx >> 2) * 2048 + (idx & 3) * 512 + lane * 8;
        const u32x4 ov = *(const u32x4*)(O + base), gv = *(const u32x4*)(G + base);
        float o[8] = {bflo(ov.x), bfhi(ov.x), bflo(ov.y), bfhi(ov.y), bflo(ov.z), bfhi(ov.z), bflo(ov.w), bfhi(ov.w)};
        const float g[8] = {bflo(gv.x), bfhi(gv.x), bflo(gv.y), bfhi(gv.y), bflo(gv.z), bfhi(gv.z), bflo(gv.w), bfhi(gv.w)};
        float s = 0.f;
#pragma unroll
        for (int i = 0; i < 8; ++i) s += o[i];
        const float mu = wsum(s, lane) * (1.0f / 512.0f); float v = 0.f;
#pragma unroll
        for (int i = 0; i < 8; ++i) { const float d = o[i] - mu; v += d * d; }
        const float rstd = rsqrtf(wsum(v, lane) * (1.0f / 512.0f) + 1e-6f);
#pragma unroll
        for (int i = 0; i < 8; ++i) o[i] = (o[i] - mu) * rstd * silu_f(g[i]);
        u32x4 w; w.x = cvt_pk_bf16(o[0], o[1]); w.y = cvt_pk_bf16(o[2], o[3]); w.z = cvt_pk_bf16(o[4], o[5]); w.w = cvt_pk_bf16(o[6], o[7]);
        *(u32x4*)(O + base) = w;
    }
}

__device__ __forceinline__ void phase_nsa_mat(const bf16_t* PROJ, const float* pek, const float* pev, bf16_t* AK, bf16_t* AV) {
    const size_t per = (size_t)8128 * 256;
    int tid = threadIdx.x; asm volatile("" : "+v"(tid));
    for (size_t i = (size_t)blockIdx.x * NTHR + tid; i < 2 * per; i += (size_t)gridDim.x * NTHR) {
        const int kv = i >= per; const size_t rem = kv ? i - per : i; const int r = (int)(rem >> 8), pp = (int)(rem & 255), l = pp >> 3, d0 = (pp & 7) * 8;
        const int g = r & 3, bn = r >> 2, b = bn / 127, n = bn % 127;
        const u32x4 v = *(const u32x4*)(PROJ + ((size_t)b * SEQ + n * 16 + l) * 2816 + 1024 + kv * 256 + g * 64 + d0);
        const float* pe = (kv ? pev : pek) + l * 64 + d0; const f32x4 p0 = *(const f32x4*)pe, p1 = *(const f32x4*)(pe + 4);
        u32x4 w; w.x = cvt_pk_bf16(bflo(v.x) + p0[0], bfhi(v.x) + p0[1]); w.y = cvt_pk_bf16(bflo(v.y) + p0[2], bfhi(v.y) + p0[3]);
        w.z = cvt_pk_bf16(bflo(v.z) + p1[0], bfhi(v.z) + p1[1]); w.w = cvt_pk_bf16(bflo(v.w) + p1[2], bfhi(v.w) + p1[3]);
        *(u32x4*)((kv ? AV : AK) + (size_t)r * 2048 + l * 64 + d0) = w;
    }
}
__device__ __forceinline__ void phase_nsa_cmp2(const bf16_t* HK, const bf16_t* HV, const bf16_t* W2K, const bf16_t* W2V, bf16_t* KC, bf16_t* VC) {
    int tid = threadIdx.x; asm volatile("" : "+v"(tid));
    const int wid = __builtin_amdgcn_readfirstlane(tid >> 6), lane = tid & 63, fr = lane & 15, fq = lane >> 4;
    for (int tt = blockIdx.x * 8 + wid; tt < 508 * 2; tt += gridDim.x * 8) {
        const int kv = tt >= 508, rt = kv ? tt - 508 : tt; const bf16_t* Hd = kv ? HV : HK; const bf16_t* W = kv ? W2V : W2K; bf16_t* Od = kv ? VC : KC;
        f32x4 acc[4];
#pragma unroll
        for (int nt = 0; nt < 4; ++nt) acc[nt] = (f32x4){0.f, 0.f, 0.f, 0.f};
#pragma unroll
        for (int ks = 0; ks < 8; ++ks) { const bf16x8 hf = *(const bf16x8*)(Hd + (size_t)(rt * 16 + fr) * 256 + ks * 32 + fq * 8);
#pragma unroll
            for (int nt = 0; nt < 4; ++nt) acc[nt] = MFMA16(*(const bf16x8*)(W + (size_t)(nt * 16 + fr) * 256 + ks * 32 + fq * 8), hf, acc[nt]); }
#pragma unroll
        for (int nt = 0; nt < 4; ++nt) *(u32x2*)(Od + (size_t)(rt * 16 + fr) * 64 + nt * 16 + fq * 4) = pack4(acc[nt]);
    }
}

struct AttnCtx { int b, g, cur, head, hp, t; float slope; bf16x8 qf[2]; float gate[3]; unsigned selq; unsigned anym; };
constexpr int A_KS = 72, A_VS = 72, A_KCS = 72, A_VCS = 72, A_KBYTES = 9216, A_VBYTES = 9216, A_OFF_K = 0, A_OFF_VT = 18432, A_OFF_KC = 36864, A_OFF_VCT = 55296, A_OFF_IMP = 73728, A_OFF_SEL = 90624, A_OFF_SELP = 90752;

template <int BR>
__device__ __forceinline__ void attn_branch(const bf16_t* PROJ, LAS unsigned char* lds, const AttnCtx& C, f32x4 (&otot)[4], int tid) {
    const int lane = tid & 63, fr = lane & 15, fq = lane >> 4;
    const float qs = 0.125f * 1.44269504089f, slope2 = C.slope * 1.44269504089f;
    f32x4 sl[4];
#pragma unroll
    for (int kt = 0; kt < 4; ++kt)
#pragma unroll
        for (int jj = 0; jj < 4; ++jj) sl[kt][jj] = slope2 * (float)(kt * 16 + jj);
    float m_ = -1e30f, l_ = 0.f;
    f32x4 oa[4];
#pragma unroll
    for (int dt = 0; dt < 4; ++dt) oa[dt] = (f32x4){0.f, 0.f, 0.f, 0.f};
    const int jlo = (BR == 1) ? 0 : (C.cur > 8 ? C.cur - 8 : 0);
    const int koff = (BR == 1 ? 1536 : 2048) + C.g * 64, voff = (BR == 1 ? 1792 : 2304) + C.g * 64;
    const int key = tid >> 3, d0 = (tid & 7) * 8;
    const bf16_t* srcb = PROJ + ((size_t)C.b * SEQ + key) * 2816 + d0;
    int j = jlo;
    if (BR == 1) { while (j <= C.cur && !((C.anym >> j) & 1u)) ++j; }
    bf16x8 kreg = *(const bf16x8*)(srcb + (size_t)j * 64 * 2816 + koff), vreg = *(const bf16x8*)(srcb + (size_t)j * 64 * 2816 + voff);
    __syncthreads();
    int buf = 0;
    { *(LAS bf16x8*)(lds + A_OFF_K + (key * A_KS + d0) * 2) = kreg; *(LAS bf16x8*)(lds + A_OFF_VT + (key * A_VS + d0) * 2) = vreg; }
    __syncthreads();
    while (j <= C.cur) {
        int jn = j + 1;
        if (BR == 1) { while (jn <= C.cur && !((C.anym >> jn) & 1u)) ++jn; }
        const bool more = jn <= C.cur;
        if (more) { kreg = *(const bf16x8*)(srcb + (size_t)jn * 64 * 2816 + koff); vreg = *(const bf16x8*)(srcb + (size_t)jn * 64 * 2816 + voff); }
        const int kb = A_OFF_K + buf * A_KBYTES, vb = A_OFF_VT + buf * A_VBYTES;
        bf16x8 vfr[2][4];
#pragma unroll
        for (int ks2 = 0; ks2 < 2; ++ks2)
#pragma unroll
            for (int dt = 0; dt < 4; ++dt) vfr[ks2][dt] = lds_tr8x2(lds, vb + (ks2 * 32 + fq * 4 + ((lane & 15) >> 2)) * (A_VS * 2) + dt * 32 + 8 * (lane & 3), 16 * A_VS * 2);
        f32x4 s4[4]; float alpha;
        const int dbase = C.t - j * 64 - fq * 4;
        const bool partial = (j == C.cur) || (BR == 2 && j + 8 <= C.cur);
        if (partial) {
            float tmax = -1e30f;
#pragma unroll
            for (int kt = 0; kt < 4; ++kt) { f32x4 acc = (f32x4){0.f, 0.f, 0.f, 0.f};
#pragma unroll
                for (int ks = 0; ks < 2; ++ks) acc = MFMA16(lds_rd16(lds, kb + ((kt * 16 + fr) * A_KS + ks * 32 + fq * 8) * 2), C.qf[ks], acc);
#pragma unroll
                for (int jj = 0; jj < 4; ++jj) { const int dist = dbase - (kt * 16 + jj);
                    const bool ok = (dist >= 0) && (BR == 1 ? (((C.selq >> j) & 1u) != 0u) : (dist < 512));
                    const float s = ok ? acc[jj] * qs - slope2 * (float)dist : -1e30f; s4[kt][jj] = s; tmax = fmaxf(tmax, s); } }
            tmax = fmaxf(tmax, shx<16>(tmax, lane)); tmax = fmaxf(tmax, shx<32>(tmax, lane));
            const float mnew = fmaxf(m_, tmax); alpha = __builtin_amdgcn_exp2f(m_ - mnew); m_ = mnew;
            float psum = 0.f;
#pragma unroll
            for (int kt = 0; kt < 4; ++kt)
#pragma unroll
                for (int jj = 0; jj < 4; ++jj) { const float pp = (s4[kt][jj] > -1e29f) ? __builtin_amdgcn_exp2f(s4[kt][jj] - mnew) : 0.f; s4[kt][jj] = pp; psum += pp; }
            l_ = l_ * alpha + psum;
        } else {
            float c0 = -slope2 * (float)dbase;
            if (BR == 1 && !((C.selq >> j) & 1u)) c0 = -1e30f;
            float tmax = -1e30f;
#pragma unroll
            for (int kt = 0; kt < 4; ++kt) { f32x4 acc = (f32x4){0.f, 0.f, 0.f, 0.f};
#pragma unroll
                for (int ks = 0; ks < 2; ++ks) acc = MFMA16(lds_rd16(lds, kb + ((kt * 16 + fr) * A_KS + ks * 32 + fq * 8) * 2), C.qf[ks], acc);
#pragma unroll
                for (int jj = 0; jj < 4; ++jj) { const float u = acc[jj] * qs + sl[kt][jj]; s4[kt][jj] = u; tmax = fmaxf(tmax, u); } }
            tmax += c0;
            tmax = fmaxf(tmax, shx<16>(tmax, lane)); tmax = fmaxf(tmax, shx<32>(tmax, lane));
            const float mnew = fmaxf(m_, tmax); alpha = __builtin_amdgcn_exp2f(m_ - mnew); m_ = mnew;
            const float sh = mnew - c0; float psum = 0.f;
#pragma unroll
            for (int kt = 0; kt < 4; ++kt)
#pragma unroll
                for (int jj = 0; jj < 4; ++jj) { const float pp = __builtin_amdgcn_exp2f(s4[kt][jj] - sh); s4[kt][jj] = pp; psum += pp; }
            l_ = l_ * alpha + psum;
        }
#pragma unroll
        for (int dt = 0; dt < 4; ++dt) oa[dt] *= alpha;
#pragma unroll
        for (int ks2 = 0; ks2 < 2; ++ks2) { const bf16x8 pf = pack8(s4[2 * ks2], s4[2 * ks2 + 1]);
#pragma unroll
            for (int dt = 0; dt < 4; ++dt) oa[dt] = MFMA16(vfr[ks2][dt], pf, oa[dt]); }
        if (more) { const int kb2 = A_OFF_K + (buf ^ 1) * A_KBYTES, vb2 = A_OFF_VT + (buf ^ 1) * A_VBYTES;
            *(LAS bf16x8*)(lds + kb2 + (key * A_KS + d0) * 2) = kreg; *(LAS bf16x8*)(lds + vb2 + (key * A_VS + d0) * 2) = vreg; }
        __syncthreads();
        buf ^= 1; j = jn;
    }
    float lt = l_; lt += shx<16>(lt, lane); lt += shx<32>(lt, lane); const float inv = lt > 0.f ? C.gate[BR] / lt : 0.f;
#pragma unroll
    for (int dt = 0; dt < 4; ++dt) otot[dt] += oa[dt] * inv;
}

__device__ __forceinline__ void phase_nsa_attn(const bf16_t* PROJ, const bf16_t* KCMP, const bf16_t* VCMP, bf16_t* OATT, LAS unsigned char* lds) {
    int tid0 = threadIdx.x; asm volatile("" : "+v"(tid0));
    const int wid = __builtin_amdgcn_readfirstlane(tid0 >> 6);
    LAS float* IMP = (LAS float*)(lds + A_OFF_IMP); LAS unsigned* SEL = (LAS unsigned*)(lds + A_OFF_SEL); LAS unsigned* SELP = (LAS unsigned*)(lds + A_OFF_SELP);
    for (int id = blockIdx.x; id < 4096; id += gridDim.x) {
        int tid = tid0; asm volatile("" : "+v"(tid));
        const int lane = tid & 63, fr = lane & 15, fq = lane >> 4;
        const int k8 = id & 255, ii = id >> 8, bg = k8 & 63, kk = k8 >> 6;
        const int qt32 = (ii & 1) ? 63 - (kk + 4 * (ii - 1)) : kk + 4 * ii;
        AttnCtx C; C.cur = qt32 >> 1; C.b = bg >> 2; C.g = bg & 3; C.hp = wid >> 1; C.head = C.g * 4 + C.hp; C.slope = exp2f(-0.5f * (float)(C.head + 1));
        const int qq = (wid & 1) * 16 + fr; C.t = qt32 * 32 + qq; const size_t trow = (size_t)C.b * SEQ + C.t;
        { const bf16_t* pr = PROJ + trow * 2816;
#pragma unroll
          for (int ks = 0; ks < 2; ++ks) C.qf[ks] = *(const bf16x8*)(pr + C.head * 64 + ks * 32 + fq * 8);
#pragma unroll
          for (int br = 0; br < 3; ++br) C.gate[br] = 1.0f / (1.0f + __expf(-bf2f(pr[2560 + C.head * 3 + br]))); }
        f32x4 otot[4];
#pragma unroll
        for (int dt = 0; dt < 4; ++dt) otot[dt] = (f32x4){0.f, 0.f, 0.f, 0.f};
        __syncthreads();
#pragma unroll
        for (int rep = 0; rep < 2; ++rep) { const int idx = tid + rep * NTHR, n = idx >> 3, d0 = (idx & 7) * 8, nc = n < 126 ? n : 126; const size_t src = ((size_t)(C.b * 127 + nc) * 4 + C.g) * 64 + d0;
            *(LAS bf16x8*)(lds + A_OFF_KC + (n * A_KCS + d0) * 2) = *(const bf16x8*)(KCMP + src);
            *(LAS bf16x8*)(lds + A_OFF_VCT + (n * A_VCS + d0) * 2) = *(const bf16x8*)(VCMP + src); }
        __syncthreads();
        {
            f32x4 sc[8]; float mx = -1e30f;
#pragma unroll
            for (int kt = 0; kt < 8; ++kt) { f32x4 acc = (f32x4){0.f, 0.f, 0.f, 0.f};
#pragma unroll
                for (int ks = 0; ks < 2; ++ks) acc = MFMA16(lds_rd16(lds, A_OFF_KC + ((kt * 16 + fr) * A_KCS + ks * 32 + fq * 8) * 2), C.qf[ks], acc);
#pragma unroll
                for (int jj = 0; jj < 4; ++jj) { const int n = kt * 16 + fq * 4 + jj, ce = n * 16 + 31; const bool ok = (n <= 126) && (ce <= C.t);
                    const float s = ok ? acc[jj] * 0.125f - C.slope * (float)(C.t - ce) : -1e30f; sc[kt][jj] = s; mx = fmaxf(mx, s); } }
            mx = fmaxf(mx, shx<16>(mx, lane)); mx = fmaxf(mx, shx<32>(mx, lane));
            float sum = 0.f;
#pragma unroll
            for (int kt = 0; kt < 8; ++kt)
#pragma unroll
                for (int jj = 0; jj < 4; ++jj) { const float pp = (sc[kt][jj] > -1e29f) ? __expf(sc[kt][jj] - mx) : 0.f; sc[kt][jj] = pp; sum += pp; }
            sum += shx<16>(sum, lane); sum += shx<32>(sum, lane);
            const float inv = sum > 0.f ? 1.0f / sum : 0.f;
#pragma unroll
            for (int kt = 0; kt < 8; ++kt) sc[kt] *= inv;
#pragma unroll
            for (int kt = 0; kt < 8; ++kt) { const float a = shi(sc[kt][3], (lane + 48) & 63); const float bp = kt > 0 ? shi(sc[kt > 0 ? kt - 1 : 0][3], (lane + 48) & 63) : 0.f;
                const float prev3 = fq > 0 ? a : bp;
                IMP[(C.hp * 32 + qq) * 33 + 4 * kt + fq] = sc[kt][0] + sc[kt][1] + sc[kt][2] + 0.5f * sc[kt][3] + 0.5f * prev3; }
            f32x4 oc[4];
#pragma unroll
            for (int dt = 0; dt < 4; ++dt) oc[dt] = (f32x4){0.f, 0.f, 0.f, 0.f};
#pragma unroll
            for (int ks2 = 0; ks2 < 4; ++ks2) { const bf16x8 pf = pack8(sc[2 * ks2], sc[2 * ks2 + 1]);
#pragma unroll
                for (int dt = 0; dt < 4; ++dt) oc[dt] = MFMA16(lds_tr8x2(lds, A_OFF_VCT + (ks2 * 32 + fq * 4 + ((lane & 15) >> 2)) * (A_VCS * 2) + dt * 32 + 8 * (lane & 3), 16 * A_VCS * 2), pf, oc[dt]); }
#pragma unroll
            for (int dt = 0; dt < 4; ++dt) otot[dt] += oc[dt] * C.gate[0];
        }
        __syncthreads();
        if (C.cur >= 16) {
            const int sq = tid & 31, jg = tid >> 5;
#pragma unroll
            for (int jj = 0; jj < 2; ++jj) { const int j = jg * 2 + jj; const float imp = IMP[(0 * 32 + sq) * 33 + j] + IMP[(1 * 32 + sq) * 33 + j] + IMP[(2 * 32 + sq) * 33 + j] + IMP[(3 * 32 + sq) * 33 + j];
                const bool valid = j <= C.cur, forced = (j == 0) || (j == C.cur) || (j == C.cur - 1);
                IMP[sq * 33 + j] = valid ? (forced ? 1e4f : imp) : -1.0f; }
            __syncthreads();
            unsigned bits = 0u;
#pragma unroll
            for (int jj = 0; jj < 2; ++jj) { const int j = jg * 2 + jj; const float sj = IMP[sq * 33 + j]; int cnt = 0;
                for (int j2 = 0; j2 < 32; ++j2) { const float s2 = IMP[sq * 33 + j2]; cnt += ((s2 > sj) || (s2 == sj && j2 < j)) ? 1 : 0; }
                if (cnt < 16) bits |= 1u << j; }
            SELP[jg * 32 + sq] = bits;
            __syncthreads();
            if (tid < 32) { unsigned m = 0u;
#pragma unroll
                for (int q = 0; q < 16; ++q) m |= SELP[q * 32 + tid];
                SEL[tid] = m; }
        } else { if (tid < 32) SEL[tid] = (2u << C.cur) - 1u; }
        __syncthreads();
        C.selq = SEL[qq];
        { unsigned m = SEL[lane & 31]; m |= shxu<16>(m, lane); m |= shxu<8>(m, lane); m |= shxu<4>(m, lane); m |= shxu<2>(m, lane); m |= shxu<1>(m, lane); C.anym = (unsigned)__builtin_amdgcn_readfirstlane((int)m); }
        attn_branch<1>(PROJ, lds, C, otot, tid);
        attn_branch<2>(PROJ, lds, C, otot, tid);
#pragma unroll
        for (int dt = 0; dt < 4; ++dt) *(u32x2*)(OATT + trow * 1024 + C.head * 64 + dt * 16 + fq * 4) = pack4(otot[dt]);
    }
}

#define XB_TMO      128
#define XB_XCNT(j)  (256  + 64 * (j))
#define XB_XSUB(j)  (1280 + 64 * (j))
#define XB_XGEN(j)  (2304 + 64 * (j))
#define XB_TOP      3328
#define XB_TOPGEN   3392
#define XCD_BAR_WORDS 3456
#define XB_SPIN_CAP (1u << 18)

__device__ __forceinline__ unsigned xb_ld(unsigned* p)              { return __hip_atomic_load(p, __ATOMIC_RELAXED, __HIP_MEMORY_SCOPE_AGENT); }
__device__ __forceinline__ unsigned xb_add(unsigned* p, unsigned v) { return __hip_atomic_fetch_add(p, v, __ATOMIC_RELAXED, __HIP_MEMORY_SCOPE_AGENT); }
__device__ __forceinline__ unsigned xb_xcc_id() { return (unsigned)__builtin_amdgcn_s_getreg((3 << 11) | 20) & 0xFu; }
#define XB_SPIN(cond, bar) do { unsigned _sp = 0; while (cond) { __builtin_amdgcn_s_sleep(1); \
    if ((++_sp & 255u) == 0u) { if (xb_ld(&(bar)[XB_TMO])) break; if (_sp > XB_SPIN_CAP) { atomicAdd(&(bar)[XB_TMO], 1u); break; } } } } while (0)

struct XcdBarrier {
    unsigned* bar; unsigned x;
    volatile LAS unsigned* st;
};

__device__ __forceinline__ XcdBarrier xcd_barrier_post(unsigned* bar, volatile LAS unsigned* st) {
    XcdBarrier b; b.bar = bar; b.x = xb_xcc_id(); b.st = st;
    if (threadIdx.x == 0) (void)xb_add(&bar[XB_XCNT(b.x)], 1u);
    return b;
}
__device__ __forceinline__ void xcd_barrier_complete(unsigned* bar, unsigned x, unsigned& nloc, unsigned& nx) {
    const unsigned G = gridDim.x * gridDim.y * gridDim.z;
    unsigned sum, cnt, mine, sp = 0u;
    for (;;) {
        sum = 0u; cnt = 0u; mine = 0u;
#pragma unroll
        for (unsigned j = 0; j < 16; ++j) { const unsigned c = xb_ld(&bar[XB_XCNT(j)]); sum += c; cnt += (c > 0u) ? 1u : 0u; mine = (j == x) ? c : mine; }
        if (sum == G) break;
        __builtin_amdgcn_s_sleep(1);
        if ((++sp & 255u) == 0u) { if (xb_ld(&bar[XB_TMO])) break; if (sp > XB_SPIN_CAP) { atomicAdd(&bar[XB_TMO], 1u); break; } }
    }
    nloc = mine > 0u ? mine : 1u; nx = cnt > 0u ? cnt : 1u;
}

__device__ __forceinline__ void xcd_barrier(const XcdBarrier& b) {
    asm volatile("s_waitcnt vmcnt(0)" ::: "memory");
    __syncthreads();
    if (threadIdx.x == 0) {
        unsigned* bar = b.bar;
        __builtin_amdgcn_s_waitcnt(0);
        unsigned nloc = b.st[0], nx = b.st[1];
        if (nloc == 0u) { xcd_barrier_complete(bar, b.x, nloc, nx); b.st[0] = nloc; b.st[1] = nx; }
        const unsigned old = xb_add(&bar[XB_XSUB(b.x)], 1u);
        const unsigned gen = old / nloc;
        if (old + 1u == (gen + 1u) * nloc) {
            __builtin_amdgcn_fence(__ATOMIC_RELEASE, "agent");
            asm volatile("s_waitcnt vmcnt(0)" ::: "memory");
            const unsigned og = xb_add(&bar[XB_TOP], 1u);
            const unsigned tg = og / nx;
            if (og + 1u == (tg + 1u) * nx) xb_add(&bar[XB_TOPGEN], 1u);
            else XB_SPIN(xb_ld(&bar[XB_TOPGEN]) == tg, bar);
            __builtin_amdgcn_fence(__ATOMIC_ACQUIRE, "agent");
            xb_add(&bar[XB_XGEN(b.x)], 1u);
            asm volatile("s_waitcnt vmcnt(0)" ::: "memory");
        } else {
            XB_SPIN(xb_ld(&bar[XB_XGEN(b.x)]) == gen, bar);
            __builtin_amdgcn_fence(__ATOMIC_ACQUIRE, "agent");
            asm volatile("s_waitcnt vmcnt(0)" ::: "memory");
        }
    }
    __syncthreads();
}


#ifndef R_CORE
#define R_CORE 1
#endif
#ifndef R_ATTN
#define R_ATTN 1
#endif
#ifndef R_GEMM
#define R_GEMM 1
#endif
#ifndef R_BAR
#define R_BAR 1
#endif
#ifndef R_PREP
#define R_PREP 1
#endif
#ifndef GEMM_ALIGN
#define GEMM_ALIGN true
#endif
#ifndef GEMM_SP2
#define GEMM_SP2 true
#endif
struct GemmDesc { const bf16_t* A; const bf16_t* Bt; bf16_t* O; int M, N, K, ldc, act, cshift; };
__device__ __forceinline__ void run_gemm(const GemmDesc& d, LAS unsigned char* lds) {
    pg8::Gemm g{d.A, d.Bt, d.M, d.N, d.K}; pg8::StaticOrder S; const int G = (int)gridDim.x; S.init(d.M, d.N, G, ((int)blockIdx.x + G - d.cshift % G) % G);
    if (d.act == 0) { pg8::Epi<0> E{d.O, d.ldc}; pg8::gemm_phase<pg8::Epi<0>, pg8::StaticOrder, GEMM_ALIGN, GEMM_SP2>(lds, g, S, E); }
    else if (d.act == 1) { pg8::Epi<1> E{d.O, d.ldc}; pg8::gemm_phase<pg8::Epi<1>, pg8::StaticOrder, GEMM_ALIGN, GEMM_SP2>(lds, g, S, E); }
    else { pg8::Epi<2> E{d.O, d.ldc}; pg8::gemm_phase<pg8::Epi<2>, pg8::StaticOrder, GEMM_ALIGN, GEMM_SP2>(lds, g, S, E); }
}

__global__ void __launch_bounds__(NTHR) fwd_megakernel(Params p) {
    extern __shared__ __attribute__((aligned(16))) unsigned char smem[];
    LAS unsigned char* lds = (LAS unsigned char*)smem;
    cg::grid_group grid = cg::this_grid();
    unsigned char* ws = p.ws; unsigned char* U = ws + OFF_U2;
    const float* mod = (const float*)(ws + OFF_MOD); bf16_t* H = (bf16_t*)(ws + OFF_H);
    if (threadIdx.x < 4) ((LAS unsigned*)(lds + XB_LDS_OFF))[threadIdx.x] = 0u;
    __syncthreads();
    XcdBarrier xbar = xcd_barrier_post((unsigned*)(ws + WS_END), (volatile LAS unsigned*)(lds + XB_LDS_OFF));
    grid.sync();

#if 0
    { const u32x4 pz = (u32x4){0xAAAAAAAAu, 0xAAAAAAAAu, 0xAAAAAAAAu, 0xAAAAAAAAu}; for (size_t i = (size_t)blockIdx.x * NTHR + threadIdx.x; i < WS_END / 16; i += (size_t)gridDim.x * NTHR) ((u32x4*)ws)[i] = pz; }
    xcd_barrier(xbar);
#endif
    for (int gs = 0; gs < 2 + DEPTH * 13; ++gs) {
        if (gs < 2) {
            if (gs == 0) { for (int rr = 0; rr < R_PREP; ++rr) phase_prep(p, lds); } else phase_init(p);
        } else {
        const int layer = (gs - 2) / 13, st = (gs - 2) % 13;
        const int jm = layer >> 1; const bool is_ret = (layer & 1) == 0;
        const float* modL = mod + (size_t)layer * 16 * MODW;
        {
            GemmDesc d[2]; int ng = 0;
            d[0].cshift = 0; d[1].cshift = 0;
            if (st == 0 || st == 10) {
                const int s = st == 0 ? 0 : 1;
                d[0] = GemmDesc{H, (const bf16_t*)(ws + OFF_FFN_IN + (size_t)(layer * 2 + s) * SZ_FFN_IN), (bf16_t*)(U + U_FFN_ACT), MTOK, 5632, 1024, DFF, 1, 0}; ng = 1;
            } else if (st == 1 || st == 11) {
                const int s = st == 1 ? 0 : 1;
                d[0] = GemmDesc{(const bf16_t*)(U + U_FFN_ACT), (const bf16_t*)(ws + OFF_FFN_OUT + (size_t)(layer * 2 + s) * SZ_FFN_OUT), (bf16_t*)(U + U_FFN_Y), MTOK, 1024, DFF, 1024, 0, 0}; ng = 1;
            } else if (st == 2 || st == 9 || st == 12) {
                const int sub = st == 2 ? 0 : (st == 9 ? 1 : 2);
                const bf16_t* y = (const bf16_t*)(U + (sub == 1 ? (is_ret ? U_RET_Y : U_NSA_Y) : U_FFN_Y));
                const float* modN = (sub == 2) ? (layer + 1 < DEPTH ? modL + (size_t)16 * MODW : modL) : modL;
                const int shc = (sub == 2) ? 0 : (sub + 1) * 3;
                phase_ln(p.out, p.out, y, modL + (sub * 3 + 2) * 1024, sub == 1 ? 1.0f : 0.5f, p.ln_g + (size_t)(layer * 3 + sub) * 1024, p.ln_b + (size_t)(layer * 3 + sub) * 1024,
                         modN + shc * 1024, modN + (shc + 1) * 1024, H);
            } else if (is_ret) {
                const bf16_t* Wi = (const bf16_t*)(ws + OFF_RET_IN + (size_t)jm * SZ_RET_IN);
                if (st == 3) { d[0] = GemmDesc{H, Wi, (bf16_t*)(U + U_RET_QKV), MTOK, 4096, 1024, 4096, 0, 0}; ng = 1; }
                else if (st == 4) { for (int rr = 0; rr < R_CORE; ++rr) phase_ret_core((const bf16_t*)(U + U_RET_QKV), (bf16_t*)(U + U_RET_O), lds); }
                else if (st == 5) { d[0] = GemmDesc{H, Wi + (size_t)4096 * 1024, (bf16_t*)(U + U_RET_G), MTOK, 2048, 1024, 2048, 0, 0}; ng = 1; }
                else if (st == 6) phase_ret_gate((bf16_t*)(U + U_RET_O), (const bf16_t*)(U + U_RET_G));
                else if (st == 7) { d[0] = GemmDesc{(const bf16_t*)(U + U_RET_O), (const bf16_t*)(ws + OFF_RET_OUT + (size_t)jm * SZ_RET_OUT), (bf16_t*)(U + U_RET_Y), MTOK, 1024, 2048, 1024, 0, 0}; ng = 1; }
                else continue;
            } else {
                if (st == 3) { d[0] = GemmDesc{H, (const bf16_t*)(ws + OFF_NSA_IN + (size_t)jm * SZ_NSA_IN), (bf16_t*)(U + U_NSA_PROJ), MTOK, 2816, 1024, 2816, 0, 0}; ng = 1; }
                else if (st == 4) phase_nsa_mat((const bf16_t*)(U + U_NSA_PROJ), p.pe_k + (size_t)jm * 2048, p.pe_v + (size_t)jm * 2048, (bf16_t*)(U + U_NSA_ACMPK), (bf16_t*)(U + U_NSA_ACMPV));
                else if (st == 5) {
                    d[0] = GemmDesc{(const bf16_t*)(U + U_NSA_ACMPK), (const bf16_t*)(ws + OFF_W1 + (size_t)(0 * 2 + jm) * SZ_W1), (bf16_t*)(U + U_NSA_HK), 8192, 256, 2048, 256, 2, 0};
                    d[1] = GemmDesc{(const bf16_t*)(U + U_NSA_ACMPV), (const bf16_t*)(ws + OFF_W1 + (size_t)(1 * 2 + jm) * SZ_W1), (bf16_t*)(U + U_NSA_HV), 8192, 256, 2048, 256, 2, 32}; ng = 2;
                } else if (st == 6) phase_nsa_cmp2((const bf16_t*)(U + U_NSA_HK), (const bf16_t*)(U + U_NSA_HV), (const bf16_t*)(ws + OFF_W2 + (size_t)(0 * 2 + jm) * SZ_W2), (const bf16_t*)(ws + OFF_W2 + (size_t)(1 * 2 + jm) * SZ_W2),
                                               (bf16_t*)(U + U_NSA_KCMP), (bf16_t*)(U + U_NSA_VCMP));
                else if (st == 7) { for (int rr = 0; rr < R_ATTN; ++rr) phase_nsa_attn((const bf16_t*)(U + U_NSA_PROJ), (const bf16_t*)(U + U_NSA_KCMP), (const bf16_t*)(U + U_NSA_VCMP), (bf16_t*)(U + U_NSA_OATT), lds); }
                else { d[0] = GemmDesc{(const bf16_t*)(U + U_NSA_OATT), (const bf16_t*)(ws + OFF_NSA_OUT + (size_t)jm * SZ_NSA_OUT), (bf16_t*)(U + U_NSA_Y), MTOK, 1024, 1024, 1024, 0, 0}; ng = 1; }
            }
            for (int rr = 0; rr < R_GEMM; ++rr) for (int r = 0; r < ng; ++r) { GemmDesc dd = d[0]; if (r == 1) dd = d[1]; run_gemm(dd, lds); }
        }
        }
        xcd_barrier(xbar);
    }
}

extern "C" void kernel_launch(void* const* d_in, const int* in_sizes, int n_in, void* d_out, int out_size, void* d_ws, size_t ws_size, hipStream_t stream) {
    static int grid_blocks = 0;
    if (grid_blocks == 0) {
        int dev = 0, cus = 0, per_cu = 0;
        hipGetDevice(&dev); hipDeviceGetAttribute(&cus, hipDeviceAttributeMultiprocessorCount, dev);
        if (hipFuncSetAttribute((const void*)fwd_megakernel, hipFuncAttributeMaxDynamicSharedMemorySize, LDS_BYTES) != hipSuccess) fprintf(stderr, "hipFuncSetAttribute failed\n");
        if (hipOccupancyMaxActiveBlocksPerMultiprocessor(&per_cu, (const void*)fwd_megakernel, NTHR, LDS_BYTES) != hipSuccess || per_cu < 1) { fprintf(stderr, "occupancy query: %d\n", per_cu); per_cu = 1; }
        (void)hipGetLastError();
        grid_blocks = cus * 1;
        if (ws_size < WS_END + 16384) fprintf(stderr, "workspace too small: %zu < %zu\n", ws_size, (size_t)WS_END);
    }
    Params p{};
    p.x = (const float*)d_in[0]; p.c = (const float*)d_in[1]; p.ada_w = (const float*)d_in[2]; p.ada_b = (const float*)d_in[3]; p.ln_g = (const float*)d_in[4]; p.ln_b = (const float*)d_in[5];
    p.pe_k = (const float*)d_in[12]; p.pe_v = (const float*)d_in[13]; p.out = (float*)d_out; p.ws = (unsigned char*)d_ws;
    unsigned char* ws = (unsigned char*)d_ws; int nj = 0, te = 0;
    auto add = [&](const float* src, size_t dst_off, int K, int N, int Np, int mode) { p.jobs[nj] = WJob{src, (bf16_t*)(ws + dst_off), K, N, Np, mode}; te += (Np / 64) * (K / 64); p.tile_end[nj] = te; ++nj; };
    const float* ffn_in = (const float*)d_in[6]; const float* ffn_out = (const float*)d_in[7]; const float* ret_in = (const float*)d_in[8]; const float* ret_out = (const float*)d_in[9];
    const float* nsa_in = (const float*)d_in[10]; const float* nsa_out = (const float*)d_in[11];
    const float* ck1 = (const float*)d_in[14]; const float* ck2 = (const float*)d_in[15]; const float* cv1 = (const float*)d_in[16]; const float* cv2 = (const float*)d_in[17];
    for (int i = 0; i < 8; ++i) add(ffn_in + (size_t)i * 1024 * 5632, OFF_FFN_IN + i * SZ_FFN_IN, 1024, 5632, 5632, 1);
    for (int i = 0; i < 8; ++i) add(ffn_out + (size_t)i * 2816 * 1024, OFF_FFN_OUT + i * SZ_FFN_OUT, 2816, 1024, 1024, 0);
    for (int i = 0; i < 2; ++i) add(ret_in + (size_t)i * 1024 * 6144, OFF_RET_IN + i * SZ_RET_IN, 1024, 6144, 6144, 0);
    for (int i = 0; i < 2; ++i) add(ret_out + (size_t)i * 2048 * 1024, OFF_RET_OUT + i * SZ_RET_OUT, 2048, 1024, 1024, 0);
    for (int i = 0; i < 2; ++i) add(nsa_in + (size_t)i * 1024 * 2608, OFF_NSA_IN + i * SZ_NSA_IN, 1024, 2608, 2816, 0);
    for (int i = 0; i < 2; ++i) add(nsa_out + (size_t)i * 1024 * 1024, OFF_NSA_OUT + i * SZ_NSA_OUT, 1024, 1024, 1024, 0);
    for (int i = 0; i < 2; ++i) add(ck1 + (size_t)i * 2048 * 256, OFF_W1 + (0 * 2 + i) * SZ_W1, 2048, 256, 256, 0);
    for (int i = 0; i < 2; ++i) add(cv1 + (size_t)i * 2048 * 256, OFF_W1 + (1 * 2 + i) * SZ_W1, 2048, 256, 256, 0);
    for (int i = 0; i < 2; ++i) add(ck2 + (size_t)i * 256 * 64, OFF_W2 + (0 * 2 + i) * SZ_W2, 256, 64, 64, 0);
    for (int i = 0; i < 2; ++i) add(cv2 + (size_t)i * 256 * 64, OFF_W2 + (1 * 2 + i) * SZ_W2, 256, 64, 64, 0);
    p.njobs = nj;
    if (hipMemsetAsync(ws + WS_END, 0, 16384, stream) != hipSuccess) fprintf(stderr, "barrier memset failed\n");
    void* args[] = {&p};
    hipError_t e = hipLaunchCooperativeKernel((const void*)fwd_megakernel, dim3(grid_blocks), dim3(NTHR), args, LDS_BYTES, stream);
    if (e != hipSuccess) fprintf(stderr, "cooperative launch failed: %s (grid %d)\n", hipGetErrorString(e), grid_blocks);
}
```

```cpp
#include <hip/hip_runtime.h>
#include <hip/hip_cooperative_groups.h>
#include <cstdio>
namespace cg = cooperative_groups;

namespace pg8 {
#define PG8_LAS __attribute__((address_space(3)))
typedef unsigned short bf16_t;
typedef short bf16x8 __attribute__((ext_vector_type(8)));
typedef float f32x4 __attribute__((ext_vector_type(4)));
typedef unsigned u32x4 __attribute__((ext_vector_type(4)));
constexpr int BM = 256, BK = 64, HALF = 128, HTB = HALF * BK * 2  , STAGE_BYTES = 8 * HTB, NXCD = 8, WGM = 8;

__host__ __device__ __forceinline__ int lds_byte(int r, int c) { const int st = (r >> 4) * 2 + (c >> 5), rr = r & 15, cc = c & 31, ob = rr * 64 + cc * 2; return st * 1024 + (ob ^ (((ob >> 9) & 1) << 5)); }
__host__ __device__ __forceinline__ void stage_rc(int b, int& R, int& C) { const int st = b / 1024, sb = b % 1024, swz = sb ^ (((sb >> 9) & 1) << 5); R = (st >> 1) * 16 + swz / 64; C = (st & 1) * 32 + (swz % 64) / 2; }
__host__ __device__ __forceinline__ int perm32(int rho) { const int n = rho >> 4, i = rho & 15; return 8 * (i >> 2) + 4 * n + (i & 3); }

struct Unit { int pm, pn; };
struct Gemm { const bf16_t* A; const bf16_t* Bt; int M, N, K; };

struct StaticOrder {
    int nM, nN, nwg, G, c;
    __host__ __device__ void init(int M, int N, int G_, int c_) { nM = M / BM; nN = N / BM; nwg = nM * nN; G = G_; c = c_; }
    __host__ __device__ bool next(int i, Unit& u) const {
        const long L = (long)i * G + c; if (L >= nwg) return false;
        int wgid = (int)L; { const int q = nwg / NXCD, r = nwg % NXCD, xcd = wgid % NXCD, off = wgid / NXCD; wgid = (xcd < r ? xcd * (q + 1) : r * (q + 1) + (xcd - r) * q) + off; }
        const int nig = WGM * nN, gid = wgid / nig, fm = gid * WGM, gsz = (nM - fm) < WGM ? (nM - fm) : WGM;
        u.pm = fm + ((wgid % nig) % gsz); u.pn = (wgid % nig) / gsz; return true;
    }
    __device__ __forceinline__ void a_ready(const Unit&) const {}
    __device__ __forceinline__ void done(const Unit&) const {}
};

typedef float f32x2_t __attribute__((ext_vector_type(2)));
typedef __bf16 bf16x2_t __attribute__((ext_vector_type(2)));
__device__ __forceinline__ unsigned cvt_pk_bf16(float lo, float hi) { const f32x2_t v = {lo, hi}; return __builtin_bit_cast(unsigned, __builtin_convertvector(v, bf16x2_t)); }
__device__ __forceinline__ float silu_f(float a) { return a * __builtin_amdgcn_rcpf(1.0f + __builtin_amdgcn_exp2f(-1.44269504089f * a)); }
__device__ __forceinline__ float gelu_tanh_f(float x) { const float u = 0.7978845608028654f * (x + 0.044715f * x * x * x); const float t = 1.0f - 2.0f * __builtin_amdgcn_rcpf(1.0f + __builtin_amdgcn_exp2f(2.88539008178f * u)); return 0.5f * x * (1.0f + t); }

template <int ACT> struct Epi {
    static constexpr bool PERM = true, AFTER_DRAIN = false;
    bf16_t* O; int ldc;
    __device__ __forceinline__ void operator()(const f32x4 (&acc)[2][2][4][2], const Unit& u, int wr, int wc, int fr, int fq) const {
        const int row0 = u.pm * BM + wr * 64 + fr;
        if (ACT == 1) {
            const int col0 = u.pn * HALF + wc * 32 + 8 * fq;
#pragma unroll
            for (int ai = 0; ai < 2; ++ai)
#pragma unroll
                for (int m = 0; m < 4; ++m) { bf16_t* rowp = O + (size_t)(row0 + ai * HALF + m * 16) * ldc + col0;
                    const f32x4 a0 = acc[ai][0][m][0], a1 = acc[ai][0][m][1], u0 = acc[ai][1][m][0], u1 = acc[ai][1][m][1];
                    u32x4 w; w.x = cvt_pk_bf16(silu_f(a0[0]) * u0[0], silu_f(a0[1]) * u0[1]); w.y = cvt_pk_bf16(silu_f(a0[2]) * u0[2], silu_f(a0[3]) * u0[3]);
                    w.z = cvt_pk_bf16(silu_f(a1[0]) * u1[0], silu_f(a1[1]) * u1[1]); w.w = cvt_pk_bf16(silu_f(a1[2]) * u1[2], silu_f(a1[3]) * u1[3]);
                    *(u32x4*)rowp = w; }
        } else {
            const int col0 = u.pn * BM + wc * 32 + 8 * fq;
#pragma unroll
            for (int ai = 0; ai < 2; ++ai)
#pragma unroll
                for (int m = 0; m < 4; ++m) { bf16_t* rowp = O + (size_t)(row0 + ai * HALF + m * 16) * ldc + col0;
#pragma unroll
                    for (int bj = 0; bj < 2; ++bj) { f32x4 v0 = acc[ai][bj][m][0], v1 = acc[ai][bj][m][1];
                        if (ACT == 2) {
#pragma unroll
                            for (int j = 0; j < 4; ++j) { v0[j] = gelu_tanh_f(v0[j]); v1[j] = gelu_tanh_f(v1[j]); } }
                        u32x4 w; w.x = cvt_pk_bf16(v0[0], v0[1]); w.y = cvt_pk_bf16(v0[2], v0[3]); w.z = cvt_pk_bf16(v1[0], v1[1]); w.w = cvt_pk_bf16(v1[2], v1[3]);
                        *(u32x4*)(rowp + bj * HALF) = w; } }
        }
    }
};

template <class Epi, class Sched, bool ALIGN_EPI = false, bool SP2 = false>
__device__ __forceinline__ void gemm_phase(PG8_LAS unsigned char* lds, const Gemm g, const Sched& S, const Epi& E) {
    const int tid = threadIdx.x, wid = __builtin_amdgcn_readfirstlane(tid >> 6), lane = tid & 63, wr = wid >> 2, wc = wid & 3, fr = lane & 15, fq = lane >> 4;
    const int K = g.K, nt = K / BK;
    unsigned voffA[2], voffB[2];
#pragma unroll
    for (int i = 0; i < 2; ++i) { int R, C; stage_rc(tid * 16 + i * 8192, R, C); const int Rb = Epi::PERM ? ((R & ~31) + perm32(R & 31)) : R;
        voffA[i] = (unsigned)(R * K + C) * 2u; voffB[i] = (unsigned)(Rb * K + C) * 2u; }
    const size_t kstep = (size_t)(BK * 2);
    const size_t hstep = (size_t)HALF * K * 2;
    const size_t tstep = 2 * hstep;
    const unsigned ldsw = (unsigned)wid * 1024u;
    const int aoff = lds_byte(wr * 64 + fr, fq * 8), boff = lds_byte(wc * 32 + fr, fq * 8);
#define PG8_SA(b, h) (((b) * 2 + (h)) * HTB)
#define PG8_SB(b, h) ((4 + (b) * 2 + (h)) * HTB)
#define PG8_STAGE(bufoff, gbase, voff) do { _Pragma("unroll") for (int _i = 0; _i < 2; ++_i) \
        __builtin_amdgcn_global_load_lds((const unsigned*)((const char*)(gbase) + (voff)[_i]), (PG8_LAS unsigned*)(lds + (bufoff) + ldsw + _i * 8192), 16, 0, 0); } while (0)
#define PG8_LDA(dst, b, h) do { _Pragma("unroll") for (int m = 0; m < 4; ++m) _Pragma("unroll") for (int k = 0; k < 2; ++k) dst[m][k] = *(const PG8_LAS bf16x8*)(lds + PG8_SA(b, h) + aoff + m * 2048 + k * 1024); } while (0)
#define PG8_LDB(dst, b, h) do { _Pragma("unroll") for (int n = 0; n < 2; ++n) _Pragma("unroll") for (int k = 0; k < 2; ++k) dst[n][k] = *(const PG8_LAS bf16x8*)(lds + PG8_SB(b, h) + boff + n * 2048 + k * 1024); } while (0)
#define PG8_MMA(ai, bj, At, Bt) do { __builtin_amdgcn_s_setprio(1); _Pragma("unroll") for (int m = 0; m < 4; ++m) _Pragma("unroll") for (int n = 0; n < 2; ++n) _Pragma("unroll") for (int k = 0; k < 2; ++k) \
        acc[ai][bj][m][n] = __builtin_amdgcn_mfma_f32_16x16x32_bf16(Bt[n][k], At[m][k], acc[ai][bj][m][n], 0, 0, 0); __builtin_amdgcn_s_setprio(0); } while (0)
#define PG8_WAIT_V(n) asm volatile("s_waitcnt vmcnt(" #n ")" ::: "memory")
#define PG8_WAIT_L(n) asm volatile("s_waitcnt lgkmcnt(" #n ")" ::: "memory")
#define PG8_BAR __builtin_amdgcn_s_barrier()
#define PG8_SCHED __builtin_amdgcn_sched_barrier(0)
    Unit cur, nxt; int ui = 0;
    if (!S.next(0, cur)) return;
    f32x4 acc[2][2][4][2];
#pragma unroll
    for (int a = 0; a < 2; ++a)
#pragma unroll
        for (int b = 0; b < 2; ++b)
#pragma unroll
            for (int m = 0; m < 4; ++m)
#pragma unroll
                for (int n = 0; n < 2; ++n) acc[a][b][m][n] = (f32x4){0.f, 0.f, 0.f, 0.f};
    bf16x8 At[4][2], B0[2][2], B1[2][2];
    const char* cA = (const char*)g.A + (size_t)cur.pm * tstep; const char* cB = (const char*)g.Bt + (size_t)cur.pn * tstep;
    S.a_ready(cur);
    if constexpr (SP2) {
        PG8_STAGE(PG8_SB(0, 0), cB, voffB); PG8_STAGE(PG8_SB(0, 1), cB + hstep, voffB); PG8_STAGE(PG8_SA(0, 0), cA, voffA); PG8_STAGE(PG8_SA(0, 1), cA + hstep, voffA);
        if (wr == 1) PG8_BAR;
        PG8_WAIT_V(2); PG8_BAR;
        PG8_STAGE(PG8_SB(1, 0), cB + kstep, voffB); PG8_STAGE(PG8_SA(1, 0), cA + kstep, voffA); PG8_STAGE(PG8_SB(1, 1), cB + hstep + kstep, voffB);
        PG8_WAIT_V(6); PG8_BAR;
    } else {
        PG8_STAGE(PG8_SB(0, 0), cB, voffB); PG8_STAGE(PG8_SA(0, 0), cA, voffA); PG8_STAGE(PG8_SB(0, 1), cB + hstep, voffB); PG8_STAGE(PG8_SA(0, 1), cA + hstep, voffA);
        if (wr == 1) PG8_BAR;
        PG8_WAIT_V(4); PG8_BAR;
        PG8_STAGE(PG8_SB(1, 0), cB + kstep, voffB); PG8_STAGE(PG8_SA(1, 0), cA + kstep, voffA); PG8_STAGE(PG8_SB(1, 1), cB + hstep + kstep, voffB);
        PG8_WAIT_V(6); PG8_BAR;
    }
    for (;;) {
        const bool has_next = S.next(ui + 1, nxt);
        const char* nA = has_next ? (const char*)g.A + (size_t)nxt.pm * tstep : cA; const char* nB = has_next ? (const char*)g.Bt + (size_t)nxt.pn * tstep : cB;
        for (int t = 0; t < nt; t += 2) {
            const bool last = (t == nt - 2);
            const char* a1 = cA + (size_t)(t + 1) * kstep;
            const char* a2 = last ? nA : cA + (size_t)(t + 2) * kstep; const char* b2 = last ? nB : cB + (size_t)(t + 2) * kstep;
            const char* a3 = a2 + kstep; const char* b3 = b2 + kstep;
            if (last && has_next) S.a_ready(nxt);
            if constexpr (SP2) {
            PG8_LDB(B0, 0, 0); PG8_LDB(B1, 0, 1); PG8_SCHED; PG8_LDA(At, 0, 0); PG8_STAGE(PG8_SA(1, 1), a1 + hstep, voffA);
            PG8_WAIT_V(8); PG8_WAIT_L(0); PG8_BAR; PG8_MMA(0, 0, At, B0); PG8_MMA(0, 1, At, B1); PG8_BAR; PG8_SCHED;
            PG8_LDA(At, 0, 1); PG8_STAGE(PG8_SB(0, 0), b2, voffB); PG8_STAGE(PG8_SB(0, 1), b2 + hstep, voffB); PG8_STAGE(PG8_SA(0, 0), a2, voffA);
            PG8_WAIT_V(8); PG8_WAIT_L(0); PG8_BAR; PG8_MMA(1, 0, At, B0); PG8_MMA(1, 1, At, B1); PG8_BAR; PG8_SCHED;
            PG8_LDB(B0, 1, 0); PG8_LDB(B1, 1, 1); PG8_SCHED; PG8_LDA(At, 1, 0); PG8_STAGE(PG8_SA(0, 1), a2 + hstep, voffA);
            PG8_WAIT_V(8); PG8_WAIT_L(0); PG8_BAR; PG8_MMA(0, 0, At, B0); PG8_MMA(0, 1, At, B1); PG8_BAR; PG8_SCHED;
            PG8_LDA(At, 1, 1); PG8_STAGE(PG8_SB(1, 0), b3, voffB); PG8_STAGE(PG8_SB(1, 1), b3 + hstep, voffB); PG8_STAGE(PG8_SA(1, 0), a3, voffA);
            PG8_WAIT_V(8); PG8_WAIT_L(0); PG8_BAR; PG8_MMA(1, 0, At, B0); PG8_MMA(1, 1, At, B1); PG8_BAR; PG8_SCHED;
            } else {
            PG8_LDB(B0, 0, 0); PG8_SCHED; PG8_LDA(At, 0, 0); PG8_STAGE(PG8_SA(1, 1), a1 + hstep, voffA);
            PG8_WAIT_L(8); PG8_BAR; PG8_WAIT_L(0); PG8_MMA(0, 0, At, B0); PG8_BAR; PG8_SCHED;
            PG8_LDB(B1, 0, 1); PG8_STAGE(PG8_SB(0, 0), b2, voffB);
            PG8_BAR; PG8_WAIT_L(0); PG8_MMA(0, 1, At, B1); PG8_BAR;
            PG8_LDA(At, 0, 1); PG8_STAGE(PG8_SA(0, 0), a2, voffA);
            PG8_BAR; PG8_WAIT_L(0); PG8_MMA(1, 0, At, B0); PG8_BAR; PG8_SCHED;
            PG8_STAGE(PG8_SB(0, 1), b2 + hstep, voffB);
            PG8_WAIT_V(6); PG8_BAR; PG8_MMA(1, 1, At, B1); PG8_BAR;
            PG8_LDB(B0, 1, 0); PG8_SCHED; PG8_LDA(At, 1, 0); PG8_STAGE(PG8_SA(0, 1), a2 + hstep, voffA);
            PG8_WAIT_L(8); PG8_BAR; PG8_WAIT_L(0); PG8_MMA(0, 0, At, B0); PG8_BAR; PG8_SCHED;
            PG8_LDB(B1, 1, 1); PG8_STAGE(PG8_SB(1, 0), b3, voffB);
            PG8_BAR; PG8_WAIT_L(0); PG8_MMA(0, 1, At, B1); PG8_BAR;
            PG8_LDA(At, 1, 1); PG8_STAGE(PG8_SA(1, 0), a3, voffA);
            PG8_BAR; PG8_WAIT_L(0); PG8_MMA(1, 0, At, B0); PG8_BAR; PG8_SCHED;
            PG8_STAGE(PG8_SB(1, 1), b3 + hstep, voffB);
            PG8_WAIT_V(6); PG8_BAR; PG8_MMA(1, 1, At, B1); PG8_BAR;
            }
        }
        if constexpr (ALIGN_EPI) { if (wr == 0) PG8_BAR; }
        if constexpr (!Epi::AFTER_DRAIN) { E(acc, cur, wr, wc, fr, fq); S.done(cur); }
        if (!has_next) break;
#pragma unroll
        for (int a = 0; a < 2; ++a)
#pragma unroll
            for (int b = 0; b < 2; ++b)
#pragma unroll
                for (int m = 0; m < 4; ++m)
#pragma unroll
                    for (int n = 0; n < 2; ++n) acc[a][b][m][n] = (f32x4){0.f, 0.f, 0.f, 0.f};
        cur = nxt; cA = nA; cB = nB; ++ui;
        if constexpr (ALIGN_EPI) { if (wr == 1) PG8_BAR; }
    }
    PG8_WAIT_V(0);
    if constexpr (!ALIGN_EPI) { if (wr == 0) PG8_BAR; }
    PG8_BAR;
    if constexpr (Epi::AFTER_DRAIN) { E.fused(acc, cur, wr, wc, fr, fq, lds, wid, lane); S.done(cur); }
#undef PG8_SA
#undef PG8_SB
#undef PG8_STAGE
#undef PG8_LDA
#undef PG8_LDB
#undef PG8_MMA
#undef PG8_WAIT_V
#undef PG8_WAIT_L
#undef PG8_BAR
#undef PG8_SCHED
}
}

using pg8::bf16_t; using pg8::bf16x8; using pg8::f32x4; using pg8::u32x4; using pg8::cvt_pk_bf16; using pg8::silu_f;
#define LAS __attribute__((address_space(3)))
typedef unsigned u32x2 __attribute__((ext_vector_type(2)));
typedef short s16x4 __attribute__((ext_vector_type(4)));
#define MFMA16(a, b, c) __builtin_amdgcn_mfma_f32_16x16x32_bf16((a), (b), (c), 0, 0, 0)

constexpr int NTHR = 512;
constexpr int MTOK = 32768, DM = 1024, SEQ = 2048, DFF = 2816, DEPTH = 4, MODW = 9216;
constexpr float DN_ALPHA = 1.6817928305074290861f;
constexpr size_t MiB = (size_t)1 << 20;
constexpr size_t SZ_FFN_IN = (size_t)5632 * 1024 * 2, SZ_FFN_OUT = (size_t)1024 * 2816 * 2, SZ_RET_IN = (size_t)6144 * 1024 * 2, SZ_RET_OUT = (size_t)1024 * 2048 * 2,
                 SZ_NSA_IN = (size_t)2816 * 1024 * 2, SZ_NSA_OUT = (size_t)1024 * 1024 * 2, SZ_W1 = (size_t)256 * 2048 * 2, SZ_W2 = (size_t)64 * 256 * 2;
constexpr size_t OFF_FFN_IN = 0, OFF_FFN_OUT = OFF_FFN_IN + 8 * SZ_FFN_IN, OFF_RET_IN = OFF_FFN_OUT + 8 * SZ_FFN_OUT, OFF_RET_OUT = OFF_RET_IN + 2 * SZ_RET_IN,
                 OFF_NSA_IN = OFF_RET_OUT + 2 * SZ_RET_OUT, OFF_NSA_OUT = OFF_NSA_IN + 2 * SZ_NSA_IN, OFF_W1 = OFF_NSA_OUT + 2 * SZ_NSA_OUT, OFF_W2 = OFF_W1 + 4 * SZ_W1,
                 OFF_MOD = OFF_W2 + 4 * SZ_W2, OFF_H = OFF_MOD + (size_t)DEPTH * 16 * MODW * 4, OFF_U2 = OFF_H + (size_t)MTOK * DM * 2, WS_END = OFF_U2 + 384 * MiB;
constexpr size_t U_FFN_ACT = 0, U_FFN_Y = 192 * MiB;
constexpr size_t U_RET_QKV = 0, U_RET_G = 0, U_RET_O = 256 * MiB, U_RET_Y = 128 * MiB;
constexpr size_t U_NSA_PROJ = 0, U_NSA_Y = 192 * MiB, U_NSA_ACMPK = 256 * MiB, U_NSA_ACMPV = 288 * MiB, U_NSA_HK = 320 * MiB, U_NSA_HV = 324 * MiB, U_NSA_KCMP = 328 * MiB, U_NSA_VCMP = 329 * MiB, U_NSA_OATT = 256 * MiB;
constexpr int XB_LDS_OFF = 152 * 1024, LDS_BYTES = 152 * 1024 + 16;

struct WJob { const float* src; bf16_t* dst; int K, N, Np, mode; };
struct Params {
    const float* x; const float* c; const float* ada_w; const float* ada_b; const float* ln_g; const float* ln_b; const float* pe_k; const float* pe_v;
    float* out; unsigned char* ws;
    WJob jobs[32]; int tile_end[32]; int njobs; int pad;
};

__device__ __forceinline__ float bf2f(unsigned short b) { return __uint_as_float(((unsigned)b) << 16); }
__device__ __forceinline__ float bflo(unsigned w) { return __uint_as_float(w << 16); }
__device__ __forceinline__ float bfhi(unsigned w) { return __uint_as_float(w & 0xffff0000u); }
__device__ __forceinline__ unsigned short f2bf(float f) { return (unsigned short)(cvt_pk_bf16(f, 0.f) & 0xffffu); }
__device__ __forceinline__ bf16x8 pack8(const f32x4& a, const f32x4& b) { u32x4 w; w.x = cvt_pk_bf16(a[0], a[1]); w.y = cvt_pk_bf16(a[2], a[3]); w.z = cvt_pk_bf16(b[0], b[1]); w.w = cvt_pk_bf16(b[2], b[3]); return __builtin_bit_cast(bf16x8, w); }
__device__ __forceinline__ u32x2 pack4(const f32x4& a) { u32x2 w; w.x = cvt_pk_bf16(a[0], a[1]); w.y = cvt_pk_bf16(a[2], a[3]); return w; }
__device__ __forceinline__ bf16x8 lds_rd16(LAS unsigned char* lds, int off) { return *(const LAS bf16x8*)(lds + off); }
__device__ __forceinline__ bf16x8 lds_rd8x2(LAS unsigned char* lds, int off) { const s16x4 lo = *(const LAS s16x4*)(lds + off), hi = *(const LAS s16x4*)(lds + off + 32); return __builtin_shufflevector(lo, hi, 0, 1, 2, 3, 4, 5, 6, 7); }
template <int M> __device__ __forceinline__ float shx(float v, int lane) {
    if (M < 32) return __int_as_float(__builtin_amdgcn_ds_swizzle(__float_as_int(v), (M << 10) | 0x1f));
    return __int_as_float(__builtin_amdgcn_ds_bpermute((lane ^ M) << 2, __float_as_int(v)));
}
template <int M> __device__ __forceinline__ unsigned shxu(unsigned v, int lane) {
    if (M < 32) return (unsigned)__builtin_amdgcn_ds_swizzle((int)v, (M << 10) | 0x1f);
    return (unsigned)__builtin_amdgcn_ds_bpermute((lane ^ M) << 2, (int)v);
}
__device__ __forceinline__ float shi(float v, int src_lane) { return __int_as_float(__builtin_amdgcn_ds_bpermute(src_lane << 2, __float_as_int(v))); }
__device__ __forceinline__ float wsum(float v, int lane) { v += shx<32>(v, lane); v += shx<16>(v, lane); v += shx<8>(v, lane); v += shx<4>(v, lane); v += shx<2>(v, lane); v += shx<1>(v, lane); return v; }

struct WTile { const float* src; bf16_t* dst; int N, K, sbase, n0, k0; };
__device__ __forceinline__ WTile wt_lookup(const Params& p, int t) {
    int j = 0; while (j < p.njobs - 1 && t >= p.tile_end[j]) ++j;
    const int tl = t - (j ? p.tile_end[j - 1] : 0);
    const WJob& J = p.jobs[j];
    const int ntn = J.Np >> 6; const int tn = tl % ntn, tk = tl / ntn; const int n0 = tn * 64, k0 = tk * 64;
    int sbase = n0; if (J.mode == 1) { const int pn = n0 >> 8, r = n0 & 255; sbase = (r >> 7) * DFF + pn * 128 + (r & 127); }
    return WTile{J.src, J.dst, J.N, J.K, sbase, n0, k0};
}
__device__ __forceinline__ void wt_load(const WTile& W, int tid, f32x4& v0, f32x4& v1) {
    const int kk = tid >> 4, nn = (tid & 15) * 4;
    v0 = (f32x4){0.f, 0.f, 0.f, 0.f}; v1 = v0;
    if (W.sbase + nn < W.N) { v0 = *(const f32x4*)(W.src + (size_t)(W.k0 + kk) * W.N + W.sbase + nn); v1 = *(const f32x4*)(W.src + (size_t)(W.k0 + kk + 32) * W.N + W.sbase + nn); }
}

__device__ __forceinline__ void phase_prep(const Params& p, LAS unsigned char* lds) {
    int tid = threadIdx.x; asm volatile("" : "+v"(tid));
    LAS float* T = (LAS float*)lds;
    const int ntiles = p.tile_end[p.njobs - 1];
    {
        int t = blockIdx.x;
        WTile cur = wt_lookup(p, t < ntiles ? t : 0); f32x4 v0, v1;
        if (t < ntiles) wt_load(cur, tid, v0, v1);
        while (t < ntiles) {
            const int tn = t + (int)gridDim.x; const bool more = tn < ntiles;
            WTile nx = wt_lookup(p, more ? tn : 0); f32x4 n0 = (f32x4){0.f, 0.f, 0.f, 0.f}, n1 = n0;
            if (more) wt_load(nx, tid, n0, n1);
            const int kk = tid >> 4, nn = (tid & 15) * 4;
            T[kk * 65 + nn] = v0[0]; T[kk * 65 + nn + 1] = v0[1]; T[kk * 65 + nn + 2] = v0[2]; T[kk * 65 + nn + 3] = v0[3];
            T[(kk + 32) * 65 + nn] = v1[0]; T[(kk + 32) * 65 + nn + 1] = v1[1]; T[(kk + 32) * 65 + nn + 2] = v1[2]; T[(kk + 32) * 65 + nn + 3] = v1[3];
            __syncthreads();
            const int n = tid >> 3, k8 = (tid & 7) * 8;
            f32x4 a, b;
            a[0] = T[(k8 + 0) * 65 + n]; a[1] = T[(k8 + 1) * 65 + n]; a[2] = T[(k8 + 2) * 65 + n]; a[3] = T[(k8 + 3) * 65 + n];
            b[0] = T[(k8 + 4) * 65 + n]; b[1] = T[(k8 + 5) * 65 + n]; b[2] = T[(k8 + 6) * 65 + n]; b[3] = T[(k8 + 7) * 65 + n];
            *(bf16x8*)(cur.dst + (size_t)(cur.n0 + n) * cur.K + cur.k0 + k8) = pack8(a, b);
            __syncthreads();
            cur = nx; v0 = n0; v1 = n1; t = tn;
        }
    }
    if (blockIdx.x < 288) {
        LAS float* cs = (LAS float*)lds;
        LAS float* red = (LAS float*)(lds + 65536);
        float* mod = (float*)(p.ws + OFF_MOD);
        __syncthreads();
        for (int idx = tid; idx < 16 * 1024; idx += NTHR) { const int b = idx >> 10, k = idx & 1023; const float cv = p.c[idx]; cs[k * 16 + b] = cv / (1.0f + expf(-cv)); }
        __syncthreads();
        for (int unit = blockIdx.x; unit < 288; unit += gridDim.x) {
            const int i = unit / 72, n0 = (unit % 72) * 128, col = tid & 127, kq = tid >> 7;
            f32x4 a0 = (f32x4){0.f, 0.f, 0.f, 0.f}, a1 = a0, a2 = a0, a3 = a0;
            const float* wp = p.ada_w + ((size_t)i * 1024 + kq * 256) * MODW + n0 + col;
#pragma unroll 4
            for (int k = 0; k < 256; ++k) { const float w = wp[(size_t)k * MODW]; const LAS f32x4* cp = (const LAS f32x4*)(cs + (kq * 256 + k) * 16);
                a0 += cp[0] * w; a1 += cp[1] * w; a2 += cp[2] * w; a3 += cp[3] * w; }
#pragma unroll
            for (int b = 0; b < 4; ++b) { red[(kq * 16 + b) * 128 + col] = a0[b]; red[(kq * 16 + 4 + b) * 128 + col] = a1[b]; red[(kq * 16 + 8 + b) * 128 + col] = a2[b]; red[(kq * 16 + 12 + b) * 128 + col] = a3[b]; }
            __syncthreads();
#pragma unroll
            for (int r = 0; r < 4; ++r) { const int o = tid + r * NTHR, b = o >> 7, cc = o & 127;
                const float s = red[(0 * 16 + b) * 128 + cc] + red[(1 * 16 + b) * 128 + cc] + red[(2 * 16 + b) * 128 + cc] + red[(3 * 16 + b) * 128 + cc] + p.ada_b[i * MODW + n0 + cc];
                mod[((size_t)i * 16 + b) * MODW + n0 + cc] = s; }
            __syncthreads();
        }
    }
}

__device__ __forceinline__ void phase_init(const Params& p) {
    const float* mod = (const float*)(p.ws + OFF_MOD); bf16_t* H = (bf16_t*)(p.ws + OFF_H);
    int tid = threadIdx.x; asm volatile("" : "+v"(tid));
    for (size_t i = (size_t)blockIdx.x * NTHR + tid; i < (size_t)MTOK * 256; i += (size_t)gridDim.x * NTHR) {
        const int row = (int)(i >> 8), c4 = (int)(i & 255) * 4, b = row >> 11;
        const f32x4 xv = *(const f32x4*)(p.x + i * 4); *(f32x4*)(p.out + i * 4) = xv;
        const float* m = mod + (size_t)b * MODW; const f32x4 sh = *(const f32x4*)(m + c4), sc = *(const f32x4*)(m + 1024 + c4);
        const f32x4 h = xv * (sc + 1.0f) + sh; *(u32x2*)(H + i * 4) = pack4(h);
    }
}

__device__ __forceinline__ void phase_ln(float* xio, float* xout, const bf16_t* y, const float* modG, float rw, const float* lng, const float* lnb, const float* modSh, const float* modSc, bf16_t* H) {
    int tid = threadIdx.x; asm volatile("" : "+v"(tid));
    const int wid = __builtin_amdgcn_readfirstlane(tid >> 6), lane = tid & 63;
    for (int row = blockIdx.x * 8 + wid; row < MTOK; row += gridDim.x * 8) {
        const int b = row >> 11; const size_t rb = (size_t)row * DM;
        f32x4 z[4]; float s = 0.f;
#pragma unroll
        for (int q = 0; q < 4; ++q) { const int c = q * 256 + lane * 4; const f32x4 xv = *(const f32x4*)(xio + rb + c); const u32x2 yv = *(const u32x2*)(y + rb + c);
            const f32x4 gt = *(const f32x4*)(modG + (size_t)b * MODW + c); const f32x4 yf = (f32x4){bflo(yv.x), bfhi(yv.x), bflo(yv.y), bfhi(yv.y)};
            z[q] = xv * DN_ALPHA + (gt + 1.0f) * yf * rw; s += (z[q][0] + z[q][1]) + (z[q][2] + z[q][3]); }
        const float mu = wsum(s, lane) * (1.0f / 1024.0f); float v = 0.f;
#pragma unroll
        for (int q = 0; q < 4; ++q) { const f32x4 d = z[q] - mu; v += (d[0] * d[0] + d[1] * d[1]) + (d[2] * d[2] + d[3] * d[3]); }
        const float rstd = rsqrtf(wsum(v, lane) * (1.0f / 1024.0f) + 1e-5f);
#pragma unroll
        for (int q = 0; q < 4; ++q) { const int c = q * 256 + lane * 4; const f32x4 g4 = *(const f32x4*)(lng + c), b4 = *(const f32x4*)(lnb + c);
            const f32x4 xn = (z[q] - mu) * rstd * g4 + b4; *(f32x4*)(xout + rb + c) = xn;
            const f32x4 sh = *(const f32x4*)(modSh + (size_t)b * MODW + c), sc = *(const f32x4*)(modSc + (size_t)b * MODW + c);
            *(u32x2*)(H + rb + c) = pack4(xn * (sc + 1.0f) + sh); }
    }
}

typedef short v4i16_t __attribute__((ext_vector_type(4)));
__device__ __forceinline__ s16x4 lds_tr8(LAS unsigned char* lds, int off) { return __builtin_bit_cast(s16x4, __builtin_amdgcn_ds_read_tr16_b64_v4i16((LAS v4i16_t*)(lds + off))); }

__device__ __forceinline__ bf16x8 lds_tr8x2(LAS unsigned char* lds, int off, int hi_off) { const s16x4 lo = lds_tr8(lds, off), hi = lds_tr8(lds, off + hi_off); return __builtin_shufflevector(lo, hi, 0, 1, 2, 3, 4, 5, 6, 7); }

__device__ __forceinline__ void phase_ret_core(const bf16_t* QKV, bf16_t* O, LAS unsigned char* lds) {
    constexpr int KSB = 528, PS = 136, STS = 264, OFF_K = 0, OFF_P = 67584, OFF_VT = 102400, OFF_ST = 119808;
    int tid = threadIdx.x; asm volatile("" : "+v"(tid));
    const int wid = __builtin_amdgcn_readfirstlane(tid >> 6), lane = tid & 63, fr = lane & 15, fq = lane >> 4;
    for (int item = blockIdx.x; item < 512; item += gridDim.x) {
        const int es = item & 7, bh = item >> 3, hh = bh & 3, b = bh >> 2, e0 = es * 64;
        const float log_g = logf(1.0f - exp2f(-5.0f - (float)hh));
        const float gN = expf(log_g * 128.0f);
        const float l2g = log_g * 1.44269504089f;
        __syncthreads();
        for (int i = tid; i < 64 * STS / 2; i += NTHR) ((LAS unsigned*)(lds + OFF_ST))[i] = 0u;
        f32x4 sacc[2][4];
#pragma unroll
        for (int dt = 0; dt < 2; ++dt)
#pragma unroll
            for (int et = 0; et < 4; ++et) sacc[dt][et] = (f32x4){0.f, 0.f, 0.f, 0.f};
        bf16x8 kst[8], vst[2];
        {   const bf16_t* kp = QKV + ((size_t)b * SEQ + (tid >> 5)) * 4096 + 1024 + hh * 256 + (tid & 31) * 8;
#pragma unroll
            for (int it = 0; it < 8; ++it) kst[it] = *(const bf16x8*)(kp + (size_t)it * 16 * 4096);
            const bf16_t* vrow = QKV + ((size_t)b * SEQ + 2 * (tid & 63)) * 4096 + 2048 + hh * 512 + e0 + (tid >> 6) * 8;
            vst[0] = *(const bf16x8*)(vrow); vst[1] = *(const bf16x8*)(vrow + 4096); }
        bf16x8 qf[8];
        { const bf16_t* qrow = QKV + ((size_t)b * SEQ + wid * 16 + fr) * 4096 + hh * 256 + fq * 8;
#pragma unroll
          for (int ks = 0; ks < 8; ++ks) qf[ks] = *(const bf16x8*)(qrow + ks * 32); }
        for (int n = 0; n < 16; ++n) {
            const size_t tok0 = (size_t)b * SEQ + n * 128;
            int t2 = tid; asm volatile("" : "+v"(t2));
            const int lane = t2 & 63, fr = lane & 15, fq = lane >> 4;
            {
#pragma unroll
                for (int it = 0; it < 8; ++it) *(LAS bf16x8*)(lds + OFF_K + ((t2 >> 5) + 16 * it) * KSB + (t2 & 31) * 16) = kst[it];
                const int cp_ = t2 & 63, q_ = t2 >> 6;
#pragma unroll
                for (int i = 0; i < 8; ++i) *(LAS unsigned*)(lds + OFF_VT + ((q_ * 8 + i) * PS + 2 * cp_) * 2) = (unsigned)(unsigned short)vst[0][i] | ((unsigned)(unsigned short)vst[1][i] << 16);
            }
            if (n < 15) {
                const bf16_t* kp = QKV + (tok0 + 128 + (t2 >> 5)) * 4096 + 1024 + hh * 256 + (t2 & 31) * 8;
#pragma unroll
                for (int it = 0; it < 8; ++it) kst[it] = *(const bf16x8*)(kp + (size_t)it * 16 * 4096);
                const bf16_t* vrow = QKV + (tok0 + 128 + 2 * (t2 & 63)) * 4096 + 2048 + hh * 512 + e0 + (t2 >> 6) * 8;
                vst[0] = *(const bf16x8*)(vrow); vst[1] = *(const bf16x8*)(vrow + 4096); }
            __syncthreads();
            const int cc = wid * 16 + fr;
            const int npair = (wid >> 1) + 1;
            for (int cp2 = 0; cp2 < npair; ++cp2) {
                const int kb0 = OFF_K + (cp2 * 32 + fr) * KSB + fq * 16;
                f32x4 acc0 = (f32x4){0.f, 0.f, 0.f, 0.f}, acc1 = acc0;
#pragma unroll
                for (int ks = 0; ks < 8; ++ks) { acc0 = MFMA16(lds_rd16(lds, kb0 + ks * 64), qf[ks], acc0); acc1 = MFMA16(lds_rd16(lds, kb0 + 16 * KSB + ks * 64), qf[ks], acc1); }
                f32x4 pv0, pv1;
#pragma unroll
                for (int j = 0; j < 4; ++j) { const int cp = cp2 * 32 + fq * 4 + j;
                    pv0[j] = (cc >= cp) ? acc0[j] * 0.0625f * __builtin_amdgcn_exp2f(l2g * (float)(cc - cp)) : 0.f;
                    pv1[j] = (cc >= cp + 16) ? acc1[j] * 0.0625f * __builtin_amdgcn_exp2f(l2g * (float)(cc - cp - 16)) : 0.f; }
                *(LAS u32x2*)(lds + OFF_P + (cc * PS + cp2 * 32 + fq * 4) * 2) = pack4(pv0);
                *(LAS u32x2*)(lds + OFF_P + (cc * PS + cp2 * 32 + 16 + fq * 4) * 2) = pack4(pv1);
            }
            __syncthreads();
            {
                f32x4 a1[4], a2[4];
#pragma unroll
                for (int et = 0; et < 4; ++et) { a1[et] = (f32x4){0.f, 0.f, 0.f, 0.f}; a2[et] = a1[et]; }
                const int ksmax = wid >> 1;
                for (int ks = 0; ks <= ksmax; ++ks) { const bf16x8 pf = lds_rd16(lds, OFF_P + (cc * PS + ks * 32 + fq * 8) * 2);
#pragma unroll
                    for (int et = 0; et < 4; ++et) a1[et] = MFMA16(lds_rd16(lds, OFF_VT + ((et * 16 + fr) * PS + ks * 32 + fq * 8) * 2), pf, a1[et]); }
#pragma unroll
                for (int ks = 0; ks < 8; ++ks)
#pragma unroll
                    for (int et = 0; et < 4; ++et) a2[et] = MFMA16(lds_rd16(lds, OFF_ST + ((et * 16 + fr) * STS + ks * 32 + fq * 8) * 2), qf[ks], a2[et]);
                const float dq = __builtin_amdgcn_exp2f(l2g * (float)(cc + 1));
                bf16_t* orow = O + (tok0 + cc) * 2048 + hh * 512 + e0 + fq * 4;
#pragma unroll
                for (int et = 0; et < 4; ++et) *(u32x2*)(orow + et * 16) = pack4(a1[et] + a2[et] * dq);
            }
            if (n < 15) {
                const bf16_t* qrow = QKV + (tok0 + 128 + cc) * 4096 + hh * 256 + fq * 8;
#pragma unroll
                for (int ks = 0; ks < 8; ++ks) qf[ks] = *(const bf16x8*)(qrow + ks * 32); }
            __syncthreads();
            if (n < 15) {
#pragma unroll
                for (int dt = 0; dt < 2; ++dt)
#pragma unroll
                    for (int et = 0; et < 4; ++et) sacc[dt][et] *= gN;
                const int q4 = (lane & 15) >> 2, p4 = lane & 3;
                const float fbase = 0.0625f * __builtin_amdgcn_exp2f(l2g * (float)(127 - 8 * fq));
#pragma unroll
                for (int ks = 0; ks < 4; ++ks) {
                    bf16x8 vf[4];
#pragma unroll
                    for (int et = 0; et < 4; ++et) vf[et] = lds_rd16(lds, OFF_VT + ((et * 16 + fr) * PS + ks * 32 + fq * 8) * 2);
                    const float fks = fbase * __builtin_amdgcn_exp2f(l2g * (float)(-32 * ks));
#pragma unroll
                    for (int dt = 0; dt < 2; ++dt) {
                        const int tb = OFF_K + (32 * ks + 8 * fq + q4) * KSB + (2 * wid + dt) * 32 + 8 * p4;
                        const s16x4 lo = lds_tr8(lds, tb), hi = lds_tr8(lds, tb + 4 * KSB);
                        f32x4 f0, f1;
#pragma unroll
                        for (int e = 0; e < 4; ++e) { f0[e] = bf2f((unsigned short)lo[e]) * (fks * __builtin_amdgcn_exp2f(l2g * (float)(-e))); f1[e] = bf2f((unsigned short)hi[e]) * (fks * __builtin_amdgcn_exp2f(l2g * (float)(-4 - e))); }
                        const bf16x8 kf = pack8(f0, f1);
#pragma unroll
                        for (int et = 0; et < 4; ++et) sacc[dt][et] = MFMA16(kf, vf[et], sacc[dt][et]); }
                }
#pragma unroll
                for (int dt = 0; dt < 2; ++dt)
#pragma unroll
                    for (int et = 0; et < 4; ++et) *(LAS u32x2*)(lds + OFF_ST + ((et * 16 + fr) * STS + (2 * wid + dt) * 16 + fq * 4) * 2) = pack4(sacc[dt][et]);
            }
            __syncthreads();
        }
    }
}

__device__ __forceinline__ void phase_ret_gate(bf16_t* O, const bf16_t* G) {
    int tid = threadIdx.x; asm volatile("" : "+v"(tid));
    const int wid = __builtin_amdgcn_readfirstlane(tid >> 6), lane = tid & 63;
    for (int idx = blockIdx.x * 8 + wid; idx < MTOK * 4; idx += gridDim.x * 8) {
        const size_t base = (size_t)(idx >> 2) * 2048 + (idx & 3) * 512 + lane * 8;
        const u32x4 ov = *(const u32x4*)(O + base), gv = *(const u32x4*)(G + base);
        float o[8] = {bflo(ov.x), bfhi(ov.x), bflo(ov.y), bfhi(ov.y), bflo(ov.z), bfhi(ov.z), bflo(ov.w), bfhi(ov.w)};
        const float g[8] = {bflo(gv.x), bfhi(gv.x), bflo(gv.y), bfhi(gv.y), bflo(gv.z), bfhi(gv.z), bflo(gv.w), bfhi(gv.w)};
        float s = 0.f;
#pragma unroll
        for (int i = 0; i < 8; ++i) s += o[i];
        const float mu = wsum(s, lane) * (1.0f / 512.0f); float v = 0.f;
#pragma unroll
        for (int i = 0; i < 8; ++i) { const float d = o[i] - mu; v += d * d; }
        const float rstd = rsqrtf(wsum(v, lane) * (1.0f / 512.0f) + 1e-6f);
#pragma unroll
        for (int i = 0; i < 8; ++i) o[i] = (o[i] - mu) * rstd * silu_f(g[i]);
        u32x4 w; w.x = cvt_pk_bf16(o[0], o[1]); w.y = cvt_pk_bf16(o[2], o[3]); w.z = cvt_pk_bf16(o[4], o[5]); w.w = cvt_pk_bf16(o[6], o[7]);
        *(u32x4*)(O + base) = w;
    }
}

__device__ __forceinline__ void phase_nsa_mat(const bf16_t* PROJ, const float* pek, const float* pev, bf16_t* AK, bf16_t* AV) {
    const size_t per = (size_t)8128 * 256;
    int tid = threadIdx.x; asm volatile("" : "+v"(tid));
    for (size_t i = (size_t)blockIdx.x * NTHR + tid; i < 2 * per; i += (size_t)gridDim.x * NTHR) {
        const int kv = i >= per; const size_t rem = kv ? i - per : i; const int r = (int)(rem >> 8), pp = (int)(rem & 255), l = pp >> 3, d0 = (pp & 7) * 8;
        const int g = r & 3, bn = r >> 2, b = bn / 127, n = bn % 127;
        const u32x4 v = *(const u32x4*)(PROJ + ((size_t)b * SEQ + n * 16 + l) * 2816 + 1024 + kv * 256 + g * 64 + d0);
        const float* pe = (kv ? pev : pek) + l * 64 + d0; const f32x4 p0 = *(const f32x4*)pe, p1 = *(const f32x4*)(pe + 4);
        u32x4 w; w.x = cvt_pk_bf16(bflo(v.x) + p0[0], bfhi(v.x) + p0[1]); w.y = cvt_pk_bf16(bflo(v.y) + p0[2], bfhi(v.y) + p0[3]);
        w.z = cvt_pk_bf16(bflo(v.z) + p1[0], bfhi(v.z) + p1[1]); w.w = cvt_pk_bf16(bflo(v.w) + p1[2], bfhi(v.w) + p1[3]);
        *(u32x4*)((kv ? AV : AK) + (size_t)r * 2048 + l * 64 + d0) = w;
    }
}
__device__ __forceinline__ void phase_nsa_cmp2(const bf16_t* HK, const bf16_t* HV, const bf16_t* W2K, const bf16_t* W2V, bf16_t* KC, bf16_t* VC) {
    int tid = threadIdx.x; asm volatile("" : "+v"(tid));
    const int wid = __builtin_amdgcn_readfirstlane(tid >> 6), lane = tid & 63, fr = lane & 15, fq = lane >> 4;
    for (int tt = blockIdx.x * 8 + wid; tt < 508 * 2; tt += gridDim.x * 8) {
        const int kv = tt >= 508, rt = kv ? tt - 508 : tt; const bf16_t* Hd = kv ? HV : HK; const bf16_t* W = kv ? W2V : W2K; bf16_t* Od = kv ? VC : KC;
        f32x4 acc[4];
#pragma unroll
        for (int nt = 0; nt < 4; ++nt) acc[nt] = (f32x4){0.f, 0.f, 0.f, 0.f};
#pragma unroll
        for (int ks = 0; ks < 8; ++ks) { const bf16x8 hf = *(const bf16x8*)(Hd + (size_t)(rt * 16 + fr) * 256 + ks * 32 + fq * 8);
#pragma unroll
            for (int nt = 0; nt < 4; ++nt) acc[nt] = MFMA16(*(const bf16x8*)(W + (size_t)(nt * 16 + fr) * 256 + ks * 32 + fq * 8), hf, acc[nt]); }
#pragma unroll
        for (int nt = 0; nt < 4; ++nt) *(u32x2*)(Od + (size_t)(rt * 16 + fr) * 64 + nt * 16 + fq * 4) = pack4(acc[nt]);
    }
}

constexpr int A_KS = 72, A_VS = 72, A_KCS = 72, A_VCS = 72, A_KBYTES = 9216, A_VBYTES = 9216;
struct AttnCtx2 { int b, g, cur, head, hp; int t[2]; float slope; bf16x8 qf[2][2]; float gate[2][3]; unsigned selq[2]; unsigned anym; };
constexpr int B_OFF_K = 0, B_OFF_VT = 18432, B_OFF_KC = 36864, B_OFF_VCT = 55296, B_OFF_IMP = 73728, B_OFF_SEL = 107520, B_OFF_SELP = 107776;

template <int BR>
__device__ __forceinline__ void attn_branch64(const bf16_t* PROJ, LAS unsigned char* lds, const AttnCtx2& C, f32x4 (&otot)[2][4], int tid) {
    const int lane = tid & 63, fr = lane & 15, fq = lane >> 4;
    const float qs = 0.125f * 1.44269504089f, slope2 = C.slope * 1.44269504089f;
    f32x4 sl[4];
#pragma unroll
    for (int kt = 0; kt < 4; ++kt)
#pragma unroll
        for (int jj = 0; jj < 4; ++jj) sl[kt][jj] = slope2 * (float)(kt * 16 + jj);
    float m_[2] = {-1e30f, -1e30f}, l_[2] = {0.f, 0.f};
    f32x4 oa[2][4];
#pragma unroll
    for (int qi = 0; qi < 2; ++qi)
#pragma unroll
        for (int dt = 0; dt < 4; ++dt) oa[qi][dt] = (f32x4){0.f, 0.f, 0.f, 0.f};
    const int jlo = (BR == 1) ? 0 : (C.cur > 8 ? C.cur - 8 : 0);
    const int koff = (BR == 1 ? 1536 : 2048) + C.g * 64, voff = (BR == 1 ? 1792 : 2304) + C.g * 64;
    const int key = tid >> 3, d0 = (tid & 7) * 8;
    const bf16_t* srcb = PROJ + ((size_t)C.b * SEQ + key) * 2816 + d0;
    const int wofs = (key * A_KS + d0) * 2;
    int j = jlo;
    if (BR == 1) { while (j <= C.cur && !((C.anym >> j) & 1u)) ++j; }
    bf16x8 kreg = *(const bf16x8*)(srcb + (size_t)j * 64 * 2816 + koff), vreg = *(const bf16x8*)(srcb + (size_t)j * 64 * 2816 + voff);
    __syncthreads();
    int buf = 0;
    *(LAS bf16x8*)(lds + B_OFF_K + wofs) = kreg; *(LAS bf16x8*)(lds + B_OFF_VT + wofs) = vreg;
    __syncthreads();
    while (j <= C.cur) {
        int jn = j + 1;
        if (BR == 1) { while (jn <= C.cur && !((C.anym >> jn) & 1u)) ++jn; }
        const bool more = jn <= C.cur;
        if (more) { kreg = *(const bf16x8*)(srcb + (size_t)jn * 64 * 2816 + koff); vreg = *(const bf16x8*)(srcb + (size_t)jn * 64 * 2816 + voff); }
        const int kb = B_OFF_K + buf * A_KBYTES, vb = B_OFF_VT + buf * A_VBYTES;
        const bool partial = (j == C.cur) || (BR == 2 && j + 8 <= C.cur);
        bf16x8 pf[2][2];
#pragma unroll
        for (int qi = 0; qi < 2; ++qi) {
            f32x4 s4[4]; float alpha;
            const int dbase = C.t[qi] - j * 64 - fq * 4;
            if (partial) {
                float tmax = -1e30f;
#pragma unroll
                for (int kt = 0; kt < 4; ++kt) { f32x4 acc = (f32x4){0.f, 0.f, 0.f, 0.f};
#pragma unroll
                    for (int ks = 0; ks < 2; ++ks) acc = MFMA16(lds_rd16(lds, kb + ((kt * 16 + fr) * A_KS + ks * 32 + fq * 8) * 2), C.qf[qi][ks], acc);
#pragma unroll
                    for (int jj = 0; jj < 4; ++jj) { const int dist = dbase - (kt * 16 + jj);
                        const bool ok = (dist >= 0) && (BR == 1 ? (((C.selq[qi] >> j) & 1u) != 0u) : (dist < 512));
                        const float sv = ok ? acc[jj] * qs - slope2 * (float)dist : -1e30f; s4[kt][jj] = sv; tmax = fmaxf(tmax, sv); } }
                tmax = fmaxf(tmax, shx<16>(tmax, lane)); tmax = fmaxf(tmax, shx<32>(tmax, lane));
                const float mnew = fmaxf(m_[qi], tmax); alpha = __builtin_amdgcn_exp2f(m_[qi] - mnew); m_[qi] = mnew;
                float psum = 0.f;
#pragma unroll
                for (int kt = 0; kt < 4; ++kt)
#pragma unroll
                    for (int jj = 0; jj < 4; ++jj) { const float pp = (s4[kt][jj] > -1e29f) ? __builtin_amdgcn_exp2f(s4[kt][jj] - mnew) : 0.f; s4[kt][jj] = pp; psum += pp; }
                l_[qi] = l_[qi] * alpha + psum;
            } else {
                float c0 = -slope2 * (float)dbase;
                if (BR == 1 && !((C.selq[qi] >> j) & 1u)) c0 = -1e30f;
                float tmax = -1e30f;
#pragma unroll
                for (int kt = 0; kt < 4; ++kt) { f32x4 acc = (f32x4){0.f, 0.f, 0.f, 0.f};
#pragma unroll
                    for (int ks = 0; ks < 2; ++ks) acc = MFMA16(lds_rd16(lds, kb + ((kt * 16 + fr) * A_KS + ks * 32 + fq * 8) * 2), C.qf[qi][ks], acc);
#pragma unroll
                    for (int jj = 0; jj < 4; ++jj) { const float u = acc[jj] * qs + sl[kt][jj]; s4[kt][jj] = u; tmax = fmaxf(tmax, u); } }
                tmax += c0;
                tmax = fmaxf(tmax, shx<16>(tmax, lane)); tmax = fmaxf(tmax, shx<32>(tmax, lane));
                const float mnew = fmaxf(m_[qi], tmax); alpha = __builtin_amdgcn_exp2f(m_[qi] - mnew); m_[qi] = mnew;
                const float sh = mnew - c0; float psum = 0.f;
#pragma unroll
                for (int kt = 0; kt < 4; ++kt)
#pragma unroll
                    for (int jj = 0; jj < 4; ++jj) { const float pp = __builtin_amdgcn_exp2f(s4[kt][jj] - sh); s4[kt][jj] = pp; psum += pp; }
                l_[qi] = l_[qi] * alpha + psum;
            }
#pragma unroll
            for (int dt = 0; dt < 4; ++dt) oa[qi][dt] *= alpha;
            pf[qi][0] = pack8(s4[0], s4[1]); pf[qi][1] = pack8(s4[2], s4[3]);
        }
#pragma unroll
        for (int ks2 = 0; ks2 < 2; ++ks2)
#pragma unroll
            for (int dt = 0; dt < 4; ++dt) { const bf16x8 vf = lds_tr8x2(lds, vb + (ks2 * 32 + fq * 4 + ((lane & 15) >> 2)) * (A_VS * 2) + dt * 32 + 8 * (lane & 3), 16 * A_VS * 2);
                oa[0][dt] = MFMA16(vf, pf[0][ks2], oa[0][dt]); oa[1][dt] = MFMA16(vf, pf[1][ks2], oa[1][dt]); }
        if (more) { *(LAS bf16x8*)(lds + B_OFF_K + (buf ^ 1) * A_KBYTES + wofs) = kreg; *(LAS bf16x8*)(lds + B_OFF_VT + (buf ^ 1) * A_VBYTES + wofs) = vreg; }
        __syncthreads();
        buf ^= 1; j = jn;
    }
#pragma unroll
    for (int qi = 0; qi < 2; ++qi) { float lt = l_[qi]; lt += shx<16>(lt, lane); lt += shx<32>(lt, lane); const float inv = lt > 0.f ? C.gate[qi][BR] / lt : 0.f;
#pragma unroll
        for (int dt = 0; dt < 4; ++dt) otot[qi][dt] += oa[qi][dt] * inv; }
}

__device__ __forceinline__ void phase_nsa_attn64(const bf16_t* PROJ, const bf16_t* KCMP, const bf16_t* VCMP, bf16_t* OATT, LAS unsigned char* lds) {
    int tid0 = threadIdx.x; asm volatile("" : "+v"(tid0));
    const int wid = __builtin_amdgcn_readfirstlane(tid0 >> 6);
    LAS float* IMP = (LAS float*)(lds + B_OFF_IMP); LAS unsigned* SEL = (LAS unsigned*)(lds + B_OFF_SEL); LAS unsigned* SELP = (LAS unsigned*)(lds + B_OFF_SELP);
    for (int id = blockIdx.x; id < 2048; id += gridDim.x) {
        int tid = tid0; asm volatile("" : "+v"(tid));
        const int lane = tid & 63, fr = lane & 15, fq = lane >> 4;
        const int k8 = id & 255, ii = id >> 8, bg = k8 & 63, kk = k8 >> 6;
        AttnCtx2 C; C.cur = (ii & 1) ? 31 - (kk + 4 * (ii - 1)) : kk + 4 * ii; C.b = bg >> 2; C.g = bg & 3; C.hp = wid >> 1; C.head = C.g * 4 + C.hp; C.slope = exp2f(-0.5f * (float)(C.head + 1));
        int qq[2]; size_t trow[2];
#pragma unroll
        for (int qi = 0; qi < 2; ++qi) { qq[qi] = (wid & 1) * 32 + qi * 16 + fr; C.t[qi] = C.cur * 64 + qq[qi]; trow[qi] = (size_t)C.b * SEQ + C.t[qi];
            const bf16_t* pr = PROJ + trow[qi] * 2816;
#pragma unroll
            for (int ks = 0; ks < 2; ++ks) C.qf[qi][ks] = *(const bf16x8*)(pr + C.head * 64 + ks * 32 + fq * 8);
#pragma unroll
            for (int br = 0; br < 3; ++br) C.gate[qi][br] = 1.0f / (1.0f + __expf(-bf2f(pr[2560 + C.head * 3 + br]))); }
        f32x4 otot[2][4];
#pragma unroll
        for (int qi = 0; qi < 2; ++qi)
#pragma unroll
            for (int dt = 0; dt < 4; ++dt) otot[qi][dt] = (f32x4){0.f, 0.f, 0.f, 0.f};
        __syncthreads();
#pragma unroll
        for (int rep = 0; rep < 2; ++rep) { const int idx = tid + rep * NTHR, n = idx >> 3, d0 = (idx & 7) * 8, nc = n < 126 ? n : 126; const size_t src = ((size_t)(C.b * 127 + nc) * 4 + C.g) * 64 + d0;
            *(LAS bf16x8*)(lds + B_OFF_KC + (n * A_KCS + d0) * 2) = *(const bf16x8*)(KCMP + src);
            *(LAS bf16x8*)(lds + B_OFF_VCT + (n * A_VCS + d0) * 2) = *(const bf16x8*)(VCMP + src); }
        __syncthreads();
#pragma unroll
        for (int qi = 0; qi < 2; ++qi) {
            f32x4 sc[8]; float mx = -1e30f;
#pragma unroll
            for (int kt = 0; kt < 8; ++kt) { f32x4 acc = (f32x4){0.f, 0.f, 0.f, 0.f};
#pragma unroll
                for (int ks = 0; ks < 2; ++ks) acc = MFMA16(lds_rd16(lds, B_OFF_KC + ((kt * 16 + fr) * A_KCS + ks * 32 + fq * 8) * 2), C.qf[qi][ks], acc);
#pragma unroll
                for (int jj = 0; jj < 4; ++jj) { const int n = kt * 16 + fq * 4 + jj, ce = n * 16 + 31; const bool ok = (n <= 126) && (ce <= C.t[qi]);
                    const float sv = ok ? acc[jj] * 0.125f - C.slope * (float)(C.t[qi] - ce) : -1e30f; sc[kt][jj] = sv; mx = fmaxf(mx, sv); } }
            mx = fmaxf(mx, shx<16>(mx, lane)); mx = fmaxf(mx, shx<32>(mx, lane));
            float sum = 0.f;
#pragma unroll
            for (int kt = 0; kt < 8; ++kt)
#pragma unroll
                for (int jj = 0; jj < 4; ++jj) { const float pp = (sc[kt][jj] > -1e29f) ? __expf(sc[kt][jj] - mx) : 0.f; sc[kt][jj] = pp; sum += pp; }
            sum += shx<16>(sum, lane); sum += shx<32>(sum, lane);
            const float inv = sum > 0.f ? 1.0f / sum : 0.f;
#pragma unroll
            for (int kt = 0; kt < 8; ++kt) sc[kt] *= inv;
#pragma unroll
            for (int kt = 0; kt < 8; ++kt) { const float a = shi(sc[kt][3], (lane + 48) & 63); const float bp = kt > 0 ? shi(sc[kt > 0 ? kt - 1 : 0][3], (lane + 48) & 63) : 0.f;
                const float prev3 = fq > 0 ? a : bp;
                IMP[(C.hp * 64 + qq[qi]) * 33 + 4 * kt + fq] = sc[kt][0] + sc[kt][1] + sc[kt][2] + 0.5f * sc[kt][3] + 0.5f * prev3; }
            f32x4 oc[4];
#pragma unroll
            for (int dt = 0; dt < 4; ++dt) oc[dt] = (f32x4){0.f, 0.f, 0.f, 0.f};
#pragma unroll
            for (int ks2 = 0; ks2 < 4; ++ks2) { const bf16x8 pfc = pack8(sc[2 * ks2], sc[2 * ks2 + 1]);
#pragma unroll
                for (int dt = 0; dt < 4; ++dt) oc[dt] = MFMA16(lds_tr8x2(lds, B_OFF_VCT + (ks2 * 32 + fq * 4 + ((lane & 15) >> 2)) * (A_VCS * 2) + dt * 32 + 8 * (lane & 3), 16 * A_VCS * 2), pfc, oc[dt]); }
#pragma unroll
            for (int dt = 0; dt < 4; ++dt) otot[qi][dt] += oc[dt] * C.gate[qi][0];
        }
        __syncthreads();
        if (C.cur >= 16) {
            const int sq = tid & 63, jg = tid >> 6;
#pragma unroll
            for (int jj = 0; jj < 4; ++jj) { const int j = jg * 4 + jj; const float imp = IMP[(0 * 64 + sq) * 33 + j] + IMP[(1 * 64 + sq) * 33 + j] + IMP[(2 * 64 + sq) * 33 + j] + IMP[(3 * 64 + sq) * 33 + j];
                const bool valid = j <= C.cur, forced = (j == 0) || (j == C.cur) || (j == C.cur - 1);
                IMP[sq * 33 + j] = valid ? (forced ? 1e4f : imp) : -1.0f; }
            __syncthreads();
            unsigned bits = 0u;
#pragma unroll
            for (int jj = 0; jj < 4; ++jj) { const int j = jg * 4 + jj; const float sj = IMP[sq * 33 + j]; int cnt = 0;
                for (int j2 = 0; j2 < 32; ++j2) { const float s2 = IMP[sq * 33 + j2]; cnt += ((s2 > sj) || (s2 == sj && j2 < j)) ? 1 : 0; }
                if (cnt < 16) bits |= 1u << j; }
            SELP[jg * 64 + sq] = bits;
            __syncthreads();
            if (tid < 64) { unsigned m = 0u;
#pragma unroll
                for (int q = 0; q < 8; ++q) m |= SELP[q * 64 + tid];
                SEL[tid] = m; }
        } else { if (tid < 64) SEL[tid] = (2u << C.cur) - 1u; }
        __syncthreads();
        C.selq[0] = SEL[qq[0]]; C.selq[1] = SEL[qq[1]];
        { unsigned m = SEL[lane]; m |= shxu<32>(m, lane); m |= shxu<16>(m, lane); m |= shxu<8>(m, lane); m |= shxu<4>(m, lane); m |= shxu<2>(m, lane); m |= shxu<1>(m, lane); C.anym = (unsigned)__builtin_amdgcn_readfirstlane((int)m); }
        attn_branch64<1>(PROJ, lds, C, otot, tid);
        attn_branch64<2>(PROJ, lds, C, otot, tid);
#pragma unroll
        for (int qi = 0; qi < 2; ++qi)
#pragma unroll
            for (int dt = 0; dt < 4; ++dt) *(u32x2*)(OATT + trow[qi] * 1024 + C.head * 64 + dt * 16 + fq * 4) = pack4(otot[qi][dt]);
    }
}

#define XB_TMO      128
#define XB_XCNT(j)  (256  + 64 * (j))
#define XB_XSUB(j)  (1280 + 64 * (j))
#define XB_XGEN(j)  (2304 + 64 * (j))
#define XB_TOP      3328
#define XB_TOPGEN   3392
#define XCD_BAR_WORDS 3456
#define XB_SPIN_CAP (1u << 18)

__device__ __forceinline__ unsigned xb_ld(unsigned* p)              { return __hip_atomic_load(p, __ATOMIC_RELAXED, __HIP_MEMORY_SCOPE_AGENT); }
__device__ __forceinline__ unsigned xb_add(unsigned* p, unsigned v) { return __hip_atomic_fetch_add(p, v, __ATOMIC_RELAXED, __HIP_MEMORY_SCOPE_AGENT); }
__device__ __forceinline__ unsigned xb_xcc_id() { return (unsigned)__builtin_amdgcn_s_getreg((3 << 11) | 20) & 0xFu; }
#define XB_SPIN(cond, bar) do { unsigned _sp = 0; while (cond) { __builtin_amdgcn_s_sleep(1); \
    if ((++_sp & 255u) == 0u) { if (xb_ld(&(bar)[XB_TMO])) break; if (_sp > XB_SPIN_CAP) { atomicAdd(&(bar)[XB_TMO], 1u); break; } } } } while (0)

struct XcdBarrier {
    unsigned* bar; unsigned x;
    volatile LAS unsigned* st;
};

__device__ __forceinline__ XcdBarrier xcd_barrier_post(unsigned* bar, volatile LAS unsigned* st) {
    XcdBarrier b; b.bar = bar; b.x = xb_xcc_id(); b.st = st;
    if (threadIdx.x == 0) (void)xb_add(&bar[XB_XCNT(b.x)], 1u);
    return b;
}
__device__ __forceinline__ void xcd_barrier_complete(unsigned* bar, unsigned x, unsigned& nloc, unsigned& nx) {
    const unsigned G = gridDim.x * gridDim.y * gridDim.z;
    unsigned sum, cnt, mine, sp = 0u;
    for (;;) {
        sum = 0u; cnt = 0u; mine = 0u;
#pragma unroll
        for (unsigned j = 0; j < 16; ++j) { const unsigned c = xb_ld(&bar[XB_XCNT(j)]); sum += c; cnt += (c > 0u) ? 1u : 0u; mine = (j == x) ? c : mine; }
        if (sum == G) break;
        __builtin_amdgcn_s_sleep(1);
        if ((++sp & 255u) == 0u) { if (xb_ld(&bar[XB_TMO])) break; if (sp > XB_SPIN_CAP) { atomicAdd(&bar[XB_TMO], 1u); break; } }
    }
    nloc = mine > 0u ? mine : 1u; nx = cnt > 0u ? cnt : 1u;
}

__device__ __forceinline__ void xcd_barrier(const XcdBarrier& b) {
    asm volatile("s_waitcnt vmcnt(0)" ::: "memory");
    __syncthreads();
    if (threadIdx.x == 0) {
        unsigned* bar = b.bar;
        __builtin_amdgcn_s_waitcnt(0);
        unsigned nloc = b.st[0], nx = b.st[1];
        if (nloc == 0u) { xcd_barrier_complete(bar, b.x, nloc, nx); b.st[0] = nloc; b.st[1] = nx; }
        const unsigned old = xb_add(&bar[XB_XSUB(b.x)], 1u);
        const unsigned gen = old / nloc;
        if (old + 1u == (gen + 1u) * nloc) {
            __builtin_amdgcn_fence(__ATOMIC_RELEASE, "agent");
            asm volatile("s_waitcnt vmcnt(0)" ::: "memory");
            const unsigned og = xb_add(&bar[XB_TOP], 1u);
            const unsigned tg = og / nx;
            if (og + 1u == (tg + 1u) * nx) xb_add(&bar[XB_TOPGEN], 1u);
            else XB_SPIN(xb_ld(&bar[XB_TOPGEN]) == tg, bar);
            __builtin_amdgcn_fence(__ATOMIC_ACQUIRE, "agent");
            xb_add(&bar[XB_XGEN(b.x)], 1u);
            asm volatile("s_waitcnt vmcnt(0)" ::: "memory");
        } else {
            XB_SPIN(xb_ld(&bar[XB_XGEN(b.x)]) == gen, bar);
            __builtin_amdgcn_fence(__ATOMIC_ACQUIRE, "agent");
            asm volatile("s_waitcnt vmcnt(0)" ::: "memory");
        }
    }
    __syncthreads();
}


#ifndef R_CORE
#define R_CORE 1
#endif
#ifndef R_ATTN
#define R_ATTN 1
#endif
#ifndef R_GEMM
#define R_GEMM 1
#endif
#ifndef R_BAR
#define R_BAR 1
#endif
#ifndef R_PREP
#define R_PREP 1
#endif
#ifndef GEMM_ALIGN
#define GEMM_ALIGN true
#endif
#ifndef GEMM_SP2
#define GEMM_SP2 true
#endif
struct GemmDesc { const bf16_t* A; const bf16_t* Bt; bf16_t* O; int M, N, K, ldc, act, cshift; };
__device__ __forceinline__ void run_gemm(const GemmDesc& d, LAS unsigned char* lds) {
    pg8::Gemm g{d.A, d.Bt, d.M, d.N, d.K}; pg8::StaticOrder S; const int G = (int)gridDim.x; S.init(d.M, d.N, G, ((int)blockIdx.x + G - d.cshift % G) % G);
    if (d.act == 0) { pg8::Epi<0> E{d.O, d.ldc}; pg8::gemm_phase<pg8::Epi<0>, pg8::StaticOrder, GEMM_ALIGN, GEMM_SP2>(lds, g, S, E); }
    else if (d.act == 1) { pg8::Epi<1> E{d.O, d.ldc}; pg8::gemm_phase<pg8::Epi<1>, pg8::StaticOrder, GEMM_ALIGN, GEMM_SP2>(lds, g, S, E); }
    else { pg8::Epi<2> E{d.O, d.ldc}; pg8::gemm_phase<pg8::Epi<2>, pg8::StaticOrder, GEMM_ALIGN, GEMM_SP2>(lds, g, S, E); }
}

__global__ void __launch_bounds__(NTHR) fwd_megakernel(Params p) {
    extern __shared__ __attribute__((aligned(16))) unsigned char smem[];
    LAS unsigned char* lds = (LAS unsigned char*)smem;
    cg::grid_group grid = cg::this_grid();
    unsigned char* ws = p.ws; unsigned char* U = ws + OFF_U2;
    const float* mod = (const float*)(ws + OFF_MOD); bf16_t* H = (bf16_t*)(ws + OFF_H);
    if (threadIdx.x < 4) ((LAS unsigned*)(lds + XB_LDS_OFF))[threadIdx.x] = 0u;
    __syncthreads();
    XcdBarrier xbar = xcd_barrier_post((unsigned*)(ws + WS_END), (volatile LAS unsigned*)(lds + XB_LDS_OFF));
    grid.sync();

#if 0
    { const u32x4 pz = (u32x4){0xAAAAAAAAu, 0xAAAAAAAAu, 0xAAAAAAAAu, 0xAAAAAAAAu}; for (size_t i = (size_t)blockIdx.x * NTHR + threadIdx.x; i < WS_END / 16; i += (size_t)gridDim.x * NTHR) ((u32x4*)ws)[i] = pz; }
    xcd_barrier(xbar);
#endif
    for (int gs = 0; gs < 2 + DEPTH * 13; ++gs) {
        if (gs < 2) {
            if (gs == 0) { for (int rr = 0; rr < R_PREP; ++rr) phase_prep(p, lds); } else phase_init(p);
        } else {
        const int layer = (gs - 2) / 13, st = (gs - 2) % 13;
        const int jm = layer >> 1; const bool is_ret = (layer & 1) == 0;
        const float* modL = mod + (size_t)layer * 16 * MODW;
        {
            GemmDesc d[2]; int ng = 0;
            d[0].cshift = 0; d[1].cshift = 0;
            if (st == 0 || st == 10) {
                const int s = st == 0 ? 0 : 1;
                d[0] = GemmDesc{H, (const bf16_t*)(ws + OFF_FFN_IN + (size_t)(layer * 2 + s) * SZ_FFN_IN), (bf16_t*)(U + U_FFN_ACT), MTOK, 5632, 1024, DFF, 1, 0}; ng = 1;
            } else if (st == 1 || st == 11) {
                const int s = st == 1 ? 0 : 1;
                d[0] = GemmDesc{(const bf16_t*)(U + U_FFN_ACT), (const bf16_t*)(ws + OFF_FFN_OUT + (size_t)(layer * 2 + s) * SZ_FFN_OUT), (bf16_t*)(U + U_FFN_Y), MTOK, 1024, DFF, 1024, 0, 0}; ng = 1;
            } else if (st == 2 || st == 9 || st == 12) {
                const int sub = st == 2 ? 0 : (st == 9 ? 1 : 2);
                const bf16_t* y = (const bf16_t*)(U + (sub == 1 ? (is_ret ? U_RET_Y : U_NSA_Y) : U_FFN_Y));
                const float* modN = (sub == 2) ? (layer + 1 < DEPTH ? modL + (size_t)16 * MODW : modL) : modL;
                const int shc = (sub == 2) ? 0 : (sub + 1) * 3;
                phase_ln(p.out, p.out, y, modL + (sub * 3 + 2) * 1024, sub == 1 ? 1.0f : 0.5f, p.ln_g + (size_t)(layer * 3 + sub) * 1024, p.ln_b + (size_t)(layer * 3 + sub) * 1024,
                         modN + shc * 1024, modN + (shc + 1) * 1024, H);
            } else if (is_ret) {
                const bf16_t* Wi = (const bf16_t*)(ws + OFF_RET_IN + (size_t)jm * SZ_RET_IN);
                if (st == 3) { d[0] = GemmDesc{H, Wi, (bf16_t*)(U + U_RET_QKV), MTOK, 4096, 1024, 4096, 0, 0}; ng = 1; }
                else if (st == 4) { for (int rr = 0; rr < R_CORE; ++rr) phase_ret_core((const bf16_t*)(U + U_RET_QKV), (bf16_t*)(U + U_RET_O), lds); }
                else if (st == 5) { d[0] = GemmDesc{H, Wi + (size_t)4096 * 1024, (bf16_t*)(U + U_RET_G), MTOK, 2048, 1024, 2048, 0, 0}; ng = 1; }
                else if (st == 6) phase_ret_gate((bf16_t*)(U + U_RET_O), (const bf16_t*)(U + U_RET_G));
                else if (st == 7) { d[0] = GemmDesc{(const bf16_t*)(U + U_RET_O), (const bf16_t*)(ws + OFF_RET_OUT + (size_t)jm * SZ_RET_OUT), (bf16_t*)(U + U_RET_Y), MTOK, 1024, 2048, 1024, 0, 0}; ng = 1; }
                else continue;
            } else {
                if (st == 3) { d[0] = GemmDesc{H, (const bf16_t*)(ws + OFF_NSA_IN + (size_t)jm * SZ_NSA_IN), (bf16_t*)(U + U_NSA_PROJ), MTOK, 2816, 1024, 2816, 0, 0}; ng = 1; }
                else if (st == 4) phase_nsa_mat((const bf16_t*)(U + U_NSA_PROJ), p.pe_k + (size_t)jm * 2048, p.pe_v + (size_t)jm * 2048, (bf16_t*)(U + U_NSA_ACMPK), (bf16_t*)(U + U_NSA_ACMPV));
                else if (st == 5) {
                    d[0] = GemmDesc{(const bf16_t*)(U + U_NSA_ACMPK), (const bf16_t*)(ws + OFF_W1 + (size_t)(0 * 2 + jm) * SZ_W1), (bf16_t*)(U + U_NSA_HK), 8192, 256, 2048, 256, 2, 0};
                    d[1] = GemmDesc{(const bf16_t*)(U + U_NSA_ACMPV), (const bf16_t*)(ws + OFF_W1 + (size_t)(1 * 2 + jm) * SZ_W1), (bf16_t*)(U + U_NSA_HV), 8192, 256, 2048, 256, 2, 32}; ng = 2;
                } else if (st == 6) phase_nsa_cmp2((const bf16_t*)(U + U_NSA_HK), (const bf16_t*)(U + U_NSA_HV), (const bf16_t*)(ws + OFF_W2 + (size_t)(0 * 2 + jm) * SZ_W2), (const bf16_t*)(ws + OFF_W2 + (size_t)(1 * 2 + jm) * SZ_W2),
                                               (bf16_t*)(U + U_NSA_KCMP), (bf16_t*)(U + U_NSA_VCMP));
                else if (st == 7) { for (int rr = 0; rr < R_ATTN; ++rr) phase_nsa_attn64((const bf16_t*)(U + U_NSA_PROJ), (const bf16_t*)(U + U_NSA_KCMP), (const bf16_t*)(U + U_NSA_VCMP), (bf16_t*)(U + U_NSA_OATT), lds); }
                else { d[0] = GemmDesc{(const bf16_t*)(U + U_NSA_OATT), (const bf16_t*)(ws + OFF_NSA_OUT + (size_t)jm * SZ_NSA_OUT), (bf16_t*)(U + U_NSA_Y), MTOK, 1024, 1024, 1024, 0, 0}; ng = 1; }
            }
            for (int rr = 0; rr < R_GEMM; ++rr) for (int r = 0; r < ng; ++r) { GemmDesc dd = d[0]; if (r == 1) dd = d[1]; run_gemm(dd, lds); }
        }
        }
        xcd_barrier(xbar);
    }
}

extern "C" void kernel_launch(void* const* d_in, const int* in_sizes, int n_in, void* d_out, int out_size, void* d_ws, size_t ws_size, hipStream_t stream) {
    static int grid_blocks = 0;
    if (grid_blocks == 0) {
        int dev = 0, cus = 0, per_cu = 0;
        hipGetDevice(&dev); hipDeviceGetAttribute(&cus, hipDeviceAttributeMultiprocessorCount, dev);
        if (hipFuncSetAttribute((const void*)fwd_megakernel, hipFuncAttributeMaxDynamicSharedMemorySize, LDS_BYTES) != hipSuccess) fprintf(stderr, "hipFuncSetAttribute failed\n");
        if (hipOccupancyMaxActiveBlocksPerMultiprocessor(&per_cu, (const void*)fwd_megakernel, NTHR, LDS_BYTES) != hipSuccess || per_cu < 1) { fprintf(stderr, "occupancy query: %d\n", per_cu); per_cu = 1; }
        (void)hipGetLastError();
        grid_blocks = cus * 1;
        if (ws_size < WS_END + 16384) fprintf(stderr, "workspace too small: %zu < %zu\n", ws_size, (size_t)WS_END);
    }
    Params p{};
    p.x = (const float*)d_in[0]; p.c = (const float*)d_in[1]; p.ada_w = (const float*)d_in[2]; p.ada_b = (const float*)d_in[3]; p.ln_g = (const float*)d_in[4]; p.ln_b = (const float*)d_in[5];
    p.pe_k = (const float*)d_in[12]; p.pe_v = (const float*)d_in[13]; p.out = (float*)d_out; p.ws = (unsigned char*)d_ws;
    unsigned char* ws = (unsigned char*)d_ws; int nj = 0, te = 0;
    auto add = [&](const float* src, size_t dst_off, int K, int N, int Np, int mode) { p.jobs[nj] = WJob{src, (bf16_t*)(ws + dst_off), K, N, Np, mode}; te += (Np / 64) * (K / 64); p.tile_end[nj] = te; ++nj; };
    const float* ffn_in = (const float*)d_in[6]; const float* ffn_out = (const float*)d_in[7]; const float* ret_in = (const float*)d_in[8]; const float* ret_out = (const float*)d_in[9];
    const float* nsa_in = (const float*)d_in[10]; const float* nsa_out = (const float*)d_in[11];
    const float* ck1 = (const float*)d_in[14]; const float* ck2 = (const float*)d_in[15]; const float* cv1 = (const float*)d_in[16]; const float* cv2 = (const float*)d_in[17];
    for (int i = 0; i < 8; ++i) add(ffn_in + (size_t)i * 1024 * 5632, OFF_FFN_IN + i * SZ_FFN_IN, 1024, 5632, 5632, 1);
    for (int i = 0; i < 8; ++i) add(ffn_out + (size_t)i * 2816 * 1024, OFF_FFN_OUT + i * SZ_FFN_OUT, 2816, 1024, 1024, 0);
    for (int i = 0; i < 2; ++i) add(ret_in + (size_t)i * 1024 * 6144, OFF_RET_IN + i * SZ_RET_IN, 1024, 6144, 6144, 0);
    for (int i = 0; i < 2; ++i) add(ret_out + (size_t)i * 2048 * 1024, OFF_RET_OUT + i * SZ_RET_OUT, 2048, 1024, 1024, 0);
    for (int i = 0; i < 2; ++i) add(nsa_in + (size_t)i * 1024 * 2608, OFF_NSA_IN + i * SZ_NSA_IN, 1024, 2608, 2816, 0);
    for (int i = 0; i < 2; ++i) add(nsa_out + (size_t)i * 1024 * 1024, OFF_NSA_OUT + i * SZ_NSA_OUT, 1024, 1024, 1024, 0);
    for (int i = 0; i < 2; ++i) add(ck1 + (size_t)i * 2048 * 256, OFF_W1 + (0 * 2 + i) * SZ_W1, 2048, 256, 256, 0);
    for (int i = 0; i < 2; ++i) add(cv1 + (size_t)i * 2048 * 256, OFF_W1 + (1 * 2 + i) * SZ_W1, 2048, 256, 256, 0);
    for (int i = 0; i < 2; ++i) add(ck2 + (size_t)i * 256 * 64, OFF_W2 + (0 * 2 + i) * SZ_W2, 256, 64, 64, 0);
    for (int i = 0; i < 2; ++i) add(cv2 + (size_t)i * 256 * 64, OFF_W2 + (1 * 2 + i) * SZ_W2, 256, 64, 64, 0);
    p.njobs = nj;
    if (hipMemsetAsync(ws + WS_END, 0, 16384, stream) != hipSuccess) fprintf(stderr, "barrier memset failed\n");
    void* args[] = {&p};
    hipError_t e = hipLaunchCooperativeKernel((const void*)fwd_megakernel, dim3(grid_blocks), dim3(NTHR), args, LDS_BYTES, stream);
    if (e != hipSuccess) fprintf(stderr, "cooperative launch failed: %s (grid %d)\n", hipGetErrorString(e), grid_blocks);
}
```

```cpp
#include <hip/hip_runtime.h>
#include <hip/hip_cooperative_groups.h>
#include <cstdio>
namespace cg = cooperative_groups;

namespace pg8 {
#define PG8_LAS __attribute__((address_space(3)))
typedef unsigned short bf16_t;
typedef short bf16x8 __attribute__((ext_vector_type(8)));
typedef float f32x4 __attribute__((ext_vector_type(4)));
typedef unsigned u32x4 __attribute__((ext_vector_type(4)));
constexpr int BM = 256, BK = 64, HALF = 128, HTB = HALF * BK * 2  , STAGE_BYTES = 8 * HTB, NXCD = 8, WGM = 8;

__host__ __device__ __forceinline__ int lds_byte(int r, int c) { const int st = (r >> 4) * 2 + (c >> 5), rr = r & 15, cc = c & 31, ob = rr * 64 + cc * 2; return st * 1024 + (ob ^ (((ob >> 9) & 1) << 5)); }
__host__ __device__ __forceinline__ void stage_rc(int b, int& R, int& C) { const int st = b / 1024, sb = b % 1024, swz = sb ^ (((sb >> 9) & 1) << 5); R = (st >> 1) * 16 + swz / 64; C = (st & 1) * 32 + (swz % 64) / 2; }
__host__ __device__ __forceinline__ int perm32(int rho) { const int n = rho >> 4, i = rho & 15; return 8 * (i >> 2) + 4 * n + (i & 3); }

struct Unit { int pm, pn; };
struct Gemm { const bf16_t* A; const bf16_t* Bt; int M, N, K; };

struct StaticOrder {
    int nM, nN, nwg, G, c;
    __host__ __device__ void init(int M, int N, int G_, int c_) { nM = M / BM; nN = N / BM; nwg = nM * nN; G = G_; c = c_; }
    __host__ __device__ bool next(int i, Unit& u) const {
        const long L = (long)i * G + c; if (L >= nwg) return false;
        int wgid = (int)L; { const int q = nwg / NXCD, r = nwg % NXCD, xcd = wgid % NXCD, off = wgid / NXCD; wgid = (xcd < r ? xcd * (q + 1) : r * (q + 1) + (xcd - r) * q) + off; }
        const int nig = WGM * nN, gid = wgid / nig, fm = gid * WGM, gsz = (nM - fm) < WGM ? (nM - fm) : WGM;
        u.pm = fm + ((wgid % nig) % gsz); u.pn = (wgid % nig) / gsz; return true;
    }
    __device__ __forceinline__ void a_ready(const Unit&) const {}
    __device__ __forceinline__ void done(const Unit&) const {}
};

typedef float f32x2_t __attribute__((ext_vector_type(2)));
typedef __bf16 bf16x2_t __attribute__((ext_vector_type(2)));
__device__ __forceinline__ unsigned cvt_pk_bf16(float lo, float hi) { const f32x2_t v = {lo, hi}; return __builtin_bit_cast(unsigned, __builtin_convertvector(v, bf16x2_t)); }
__device__ __forceinline__ float silu_f(float a) { return a * __builtin_amdgcn_rcpf(1.0f + __builtin_amdgcn_exp2f(-1.44269504089f * a)); }
__device__ __forceinline__ float gelu_tanh_f(float x) { const float u = 0.7978845608028654f * (x + 0.044715f * x * x * x); const float t = 1.0f - 2.0f * __builtin_amdgcn_rcpf(1.0f + __builtin_amdgcn_exp2f(2.88539008178f * u)); return 0.5f * x * (1.0f + t); }

template <int ACT> struct Epi {
    static constexpr bool PERM = true, AFTER_DRAIN = false;
    bf16_t* O; int ldc;
    __device__ __forceinline__ void operator()(const f32x4 (&acc)[2][2][4][2], const Unit& u, int wr, int wc, int fr, int fq) const {
        const int row0 = u.pm * BM + wr * 64 + fr;
        if (ACT == 1) {
            const int col0 = u.pn * HALF + wc * 32 + 8 * fq;
#pragma unroll
            for (int ai = 0; ai < 2; ++ai)
#pragma unroll
                for (int m = 0; m < 4; ++m) { bf16_t* rowp = O + (size_t)(row0 + ai * HALF + m * 16) * ldc + col0;
                    const f32x4 a0 = acc[ai][0][m][0], a1 = acc[ai][0][m][1], u0 = acc[ai][1][m][0], u1 = acc[ai][1][m][1];
                    u32x4 w; w.x = cvt_pk_bf16(silu_f(a0[0]) * u0[0], silu_f(a0[1]) * u0[1]); w.y = cvt_pk_bf16(silu_f(a0[2]) * u0[2], silu_f(a0[3]) * u0[3]);
                    w.z = cvt_pk_bf16(silu_f(a1[0]) * u1[0], silu_f(a1[1]) * u1[1]); w.w = cvt_pk_bf16(silu_f(a1[2]) * u1[2], silu_f(a1[3]) * u1[3]);
                    *(u32x4*)rowp = w; }
        } else {
            const int col0 = u.pn * BM + wc * 32 + 8 * fq;
#pragma unroll
            for (int ai = 0; ai < 2; ++ai)
#pragma unroll
                for (int m = 0; m < 4; ++m) { bf16_t* rowp = O + (size_t)(row0 + ai * HALF + m * 16) * ldc + col0;
#pragma unroll
                    for (int bj = 0; bj < 2; ++bj) { f32x4 v0 = acc[ai][bj][m][0], v1 = acc[ai][bj][m][1];
                        if (ACT == 2) {
#pragma unroll
                            for (int j = 0; j < 4; ++j) { v0[j] = gelu_tanh_f(v0[j]); v1[j] = gelu_tanh_f(v1[j]); } }
                        u32x4 w; w.x = cvt_pk_bf16(v0[0], v0[1]); w.y = cvt_pk_bf16(v0[2], v0[3]); w.z = cvt_pk_bf16(v1[0], v1[1]); w.w = cvt_pk_bf16(v1[2], v1[3]);
                        *(u32x4*)(rowp + bj * HALF) = w; } }
        }
    }
};

template <class Epi, class Sched, bool ALIGN_EPI = false, bool SP2 = false>
__device__ __forceinline__ void gemm_phase(PG8_LAS unsigned char* lds, const Gemm g, const Sched& S, const Epi& E) {
    const int tid = threadIdx.x, wid = __builtin_amdgcn_readfirstlane(tid >> 6), lane = tid & 63, wr = wid >> 2, wc = wid & 3, fr = lane & 15, fq = lane >> 4;
    const int K = g.K, nt = K / BK;
    unsigned voffA[2], voffB[2];
#pragma unroll
    for (int i = 0; i < 2; ++i) { int R, C; stage_rc(tid * 16 + i * 8192, R, C); const int Rb = Epi::PERM ? ((R & ~31) + perm32(R & 31)) : R;
        voffA[i] = (unsigned)(R * K + C) * 2u; voffB[i] = (unsigned)(Rb * K + C) * 2u; }
    const size_t kstep = (size_t)(BK * 2);
    const size_t hstep = (size_t)HALF * K * 2;
    const size_t tstep = 2 * hstep;
    const unsigned ldsw = (unsigned)wid * 1024u;
    const int aoff = lds_byte(wr * 64 + fr, fq * 8), boff = lds_byte(wc * 32 + fr, fq * 8);
#define PG8_SA(b, h) (((b) * 2 + (h)) * HTB)
#define PG8_SB(b, h) ((4 + (b) * 2 + (h)) * HTB)
#define PG8_STAGE(bufoff, gbase, voff) do { _Pragma("unroll") for (int _i = 0; _i < 2; ++_i) \
        __builtin_amdgcn_global_load_lds((const unsigned*)((const char*)(gbase) + (voff)[_i]), (PG8_LAS unsigned*)(lds + (bufoff) + ldsw + _i * 8192), 16, 0, 0); } while (0)
#define PG8_LDA(dst, b, h) do { _Pragma("unroll") for (int m = 0; m < 4; ++m) _Pragma("unroll") for (int k = 0; k < 2; ++k) dst[m][k] = *(const PG8_LAS bf16x8*)(lds + PG8_SA(b, h) + aoff + m * 2048 + k * 1024); } while (0)
#define PG8_LDB(dst, b, h) do { _Pragma("unroll") for (int n = 0; n < 2; ++n) _Pragma("unroll") for (int k = 0; k < 2; ++k) dst[n][k] = *(const PG8_LAS bf16x8*)(lds + PG8_SB(b, h) + boff + n * 2048 + k * 1024); } while (0)
#define PG8_MMA(ai, bj, At, Bt) do { __builtin_amdgcn_s_setprio(1); _Pragma("unroll") for (int m = 0; m < 4; ++m) _Pragma("unroll") for (int n = 0; n < 2; ++n) _Pragma("unroll") for (int k = 0; k < 2; ++k) \
        acc[ai][bj][m][n] = __builtin_amdgcn_mfma_f32_16x16x32_bf16(Bt[n][k], At[m][k], acc[ai][bj][m][n], 0, 0, 0); __builtin_amdgcn_s_setprio(0); } while (0)
#define PG8_WAIT_V(n) asm volatile("s_waitcnt vmcnt(" #n ")" ::: "memory")
#define PG8_WAIT_L(n) asm volatile("s_waitcnt lgkmcnt(" #n ")" ::: "memory")
#define PG8_BAR __builtin_amdgcn_s_barrier()
#define PG8_SCHED __builtin_amdgcn_sched_barrier(0)
    Unit cur, nxt; int ui = 0;
    if (!S.next(0, cur)) return;
    f32x4 acc[2][2][4][2];
#pragma unroll
    for (int a = 0; a < 2; ++a)
#pragma unroll
        for (int b = 0; b < 2; ++b)
#pragma unroll
            for (int m = 0; m < 4; ++m)
#pragma unroll
                for (int n = 0; n < 2; ++n) acc[a][b][m][n] = (f32x4){0.f, 0.f, 0.f, 0.f};
    bf16x8 At[4][2], B0[2][2], B1[2][2];
    const char* cA = (const char*)g.A + (size_t)cur.pm * tstep; const char* cB = (const char*)g.Bt + (size_t)cur.pn * tstep;
    S.a_ready(cur);
    if constexpr (SP2) {
        PG8_STAGE(PG8_SB(0, 0), cB, voffB); PG8_STAGE(PG8_SB(0, 1), cB + hstep, voffB); PG8_STAGE(PG8_SA(0, 0), cA, voffA); PG8_STAGE(PG8_SA(0, 1), cA + hstep, voffA);
        if (wr == 1) PG8_BAR;
        PG8_WAIT_V(2); PG8_BAR;
        PG8_STAGE(PG8_SB(1, 0), cB + kstep, voffB); PG8_STAGE(PG8_SA(1, 0), cA + kstep, voffA); PG8_STAGE(PG8_SB(1, 1), cB + hstep + kstep, voffB);
        PG8_WAIT_V(6); PG8_BAR;
    } else {
        PG8_STAGE(PG8_SB(0, 0), cB, voffB); PG8_STAGE(PG8_SA(0, 0), cA, voffA); PG8_STAGE(PG8_SB(0, 1), cB + hstep, voffB); PG8_STAGE(PG8_SA(0, 1), cA + hstep, voffA);
        if (wr == 1) PG8_BAR;
        PG8_WAIT_V(4); PG8_BAR;
        PG8_STAGE(PG8_SB(1, 0), cB + kstep, voffB); PG8_STAGE(PG8_SA(1, 0), cA + kstep, voffA); PG8_STAGE(PG8_SB(1, 1), cB + hstep + kstep, voffB);
        PG8_WAIT_V(6); PG8_BAR;
    }
    for (;;) {
        const bool has_next = S.next(ui + 1, nxt);
        const char* nA = has_next ? (const char*)g.A + (size_t)nxt.pm * tstep : cA; const char* nB = has_next ? (const char*)g.Bt + (size_t)nxt.pn * tstep : cB;
        for (int t = 0; t < nt; t += 2) {
            const bool last = (t == nt - 2);
            const char* a1 = cA + (size_t)(t + 1) * kstep;
            const char* a2 = last ? nA : cA + (size_t)(t + 2) * kstep; const char* b2 = last ? nB : cB + (size_t)(t + 2) * kstep;
            const char* a3 = a2 + kstep; const char* b3 = b2 + kstep;
            if (last && has_next) S.a_ready(nxt);
            if constexpr (SP2) {
            PG8_LDB(B0, 0, 0); PG8_LDB(B1, 0, 1); PG8_SCHED; PG8_LDA(At, 0, 0); PG8_STAGE(PG8_SA(1, 1), a1 + hstep, voffA);
            PG8_WAIT_V(8); PG8_WAIT_L(0); PG8_BAR; PG8_MMA(0, 0, At, B0); PG8_MMA(0, 1, At, B1); PG8_BAR; PG8_SCHED;
            PG8_LDA(At, 0, 1); PG8_STAGE(PG8_SB(0, 0), b2, voffB); PG8_STAGE(PG8_SB(0, 1), b2 + hstep, voffB); PG8_STAGE(PG8_SA(0, 0), a2, voffA);
            PG8_WAIT_V(8); PG8_WAIT_L(0); PG8_BAR; PG8_MMA(1, 0, At, B0); PG8_MMA(1, 1, At, B1); PG8_BAR; PG8_SCHED;
            PG8_LDB(B0, 1, 0); PG8_LDB(B1, 1, 1); PG8_SCHED; PG8_LDA(At, 1, 0); PG8_STAGE(PG8_SA(0, 1), a2 + hstep, voffA);
            PG8_WAIT_V(8); PG8_WAIT_L(0); PG8_BAR; PG8_MMA(0, 0, At, B0); PG8_MMA(0, 1, At, B1); PG8_BAR; PG8_SCHED;
            PG8_LDA(At, 1, 1); PG8_STAGE(PG8_SB(1, 0), b3, voffB); PG8_STAGE(PG8_SB(1, 1), b3 + hstep, voffB); PG8_STAGE(PG8_SA(1, 0), a3, voffA);
            PG8_WAIT_V(8); PG8_WAIT_L(0); PG8_BAR; PG8_MMA(1, 0, At, B0); PG8_MMA(1, 1, At, B1); PG8_BAR; PG8_SCHED;
            } else {
            PG8_LDB(B0, 0, 0); PG8_SCHED; PG8_LDA(At, 0, 0); PG8_STAGE(PG8_SA(1, 1), a1 + hstep, voffA);
            PG8_WAIT_L(8); PG8_BAR; PG8_WAIT_L(0); PG8_MMA(0, 0, At, B0); PG8_BAR; PG8_SCHED;
            PG8_LDB(B1, 0, 1); PG8_STAGE(PG8_SB(0, 0), b2, voffB);
            PG8_BAR; PG8_WAIT_L(0); PG8_MMA(0, 1, At, B1); PG8_BAR;
            PG8_LDA(At, 0, 1); PG8_STAGE(PG8_SA(0, 0), a2, voffA);
            PG8_BAR; PG8_WAIT_L(0); PG8_MMA(1, 0, At, B0); PG8_BAR; PG8_SCHED;
            PG8_STAGE(PG8_SB(0, 1), b2 + hstep, voffB);
            PG8_WAIT_V(6); PG8_BAR; PG8_MMA(1, 1, At, B1); PG8_BAR;
            PG8_LDB(B0, 1, 0); PG8_SCHED; PG8_LDA(At, 1, 0); PG8_STAGE(PG8_SA(0, 1), a2 + hstep, voffA);
            PG8_WAIT_L(8); PG8_BAR; PG8_WAIT_L(0); PG8_MMA(0, 0, At, B0); PG8_BAR; PG8_SCHED;
            PG8_LDB(B1, 1, 1); PG8_STAGE(PG8_SB(1, 0), b3, voffB);
            PG8_BAR; PG8_WAIT_L(0); PG8_MMA(0, 1, At, B1); PG8_BAR;
            PG8_LDA(At, 1, 1); PG8_STAGE(PG8_SA(1, 0), a3, voffA);
            PG8_BAR; PG8_WAIT_L(0); PG8_MMA(1, 0, At, B0); PG8_BAR; PG8_SCHED;
            PG8_STAGE(PG8_SB(1, 1), b3 + hstep, voffB);
            PG8_WAIT_V(6); PG8_BAR; PG8_MMA(1, 1, At, B1); PG8_BAR;
            }
        }
        if constexpr (ALIGN_EPI) { if (wr == 0) PG8_BAR; }
        if constexpr (!Epi::AFTER_DRAIN) { E(acc, cur, wr, wc, fr, fq); S.done(cur); }
        if (!has_next) break;
#pragma unroll
        for (int a = 0; a < 2; ++a)
#pragma unroll
            for (int b = 0; b < 2; ++b)
#pragma unroll
                for (int m = 0; m < 4; ++m)
#pragma unroll
                    for (int n = 0; n < 2; ++n) acc[a][b][m][n] = (f32x4){0.f, 0.f, 0.f, 0.f};
        cur = nxt; cA = nA; cB = nB; ++ui;
        if constexpr (ALIGN_EPI) { if (wr == 1) PG8_BAR; }
    }
    PG8_WAIT_V(0);
    if constexpr (!ALIGN_EPI) { if (wr == 0) PG8_BAR; }
    PG8_BAR;
    if constexpr (Epi::AFTER_DRAIN) { E.fused(acc, cur, wr, wc, fr, fq, lds, wid, lane); S.done(cur); }
#undef PG8_SA
#undef PG8_SB
#undef PG8_STAGE
#undef PG8_LDA
#undef PG8_LDB
#undef PG8_MMA
#undef PG8_WAIT_V
#undef PG8_WAIT_L
#undef PG8_BAR
#undef PG8_SCHED
}
}

using pg8::bf16_t; using pg8::bf16x8; using pg8::f32x4; using pg8::u32x4; using pg8::cvt_pk_bf16; using pg8::silu_f;
#define LAS __attribute__((address_space(3)))
typedef unsigned u32x2 __attribute__((ext_vector_type(2)));
typedef short s16x4 __attribute__((ext_vector_type(4)));
#define MFMA16(a, b, c) __builtin_amdgcn_mfma_f32_16x16x32_bf16((a), (b), (c), 0, 0, 0)

constexpr int NTHR = 512;
constexpr int MTOK = 32768, DM = 1024, SEQ = 2048, DFF = 2816, DEPTH = 4, MODW = 9216;
constexpr float DN_ALPHA = 1.6817928305074290861f;
constexpr size_t MiB = (size_t)1 << 20;
constexpr size_t SZ_FFN_IN = (size_t)5632 * 1024 * 2, SZ_FFN_OUT = (size_t)1024 * 2816 * 2, SZ_RET_IN = (size_t)6144 * 1024 * 2, SZ_RET_OUT = (size_t)1024 * 2048 * 2,
                 SZ_NSA_IN = (size_t)2816 * 1024 * 2, SZ_NSA_OUT = (size_t)1024 * 1024 * 2, SZ_W1 = (size_t)256 * 2048 * 2, SZ_W2 = (size_t)64 * 256 * 2;
constexpr size_t OFF_FFN_IN = 0, OFF_FFN_OUT = OFF_FFN_IN + 8 * SZ_FFN_IN, OFF_RET_IN = OFF_FFN_OUT + 8 * SZ_FFN_OUT, OFF_RET_OUT = OFF_RET_IN + 2 * SZ_RET_IN,
                 OFF_NSA_IN = OFF_RET_OUT + 2 * SZ_RET_OUT, OFF_NSA_OUT = OFF_NSA_IN + 2 * SZ_NSA_IN, OFF_W1 = OFF_NSA_OUT + 2 * SZ_NSA_OUT, OFF_W2 = OFF_W1 + 4 * SZ_W1,
                 OFF_MOD = OFF_W2 + 4 * SZ_W2, OFF_H = OFF_MOD + (size_t)DEPTH * 16 * MODW * 4, OFF_U2 = OFF_H + (size_t)MTOK * DM * 2, WS_END = OFF_U2 + 384 * MiB;
constexpr size_t U_FFN_ACT = 0, U_FFN_Y = 192 * MiB;
constexpr size_t U_RET_QKV = 0, U_RET_G = 0, U_RET_O = 256 * MiB, U_RET_Y = 128 * MiB;
constexpr size_t U_NSA_PROJ = 0, U_NSA_Y = 192 * MiB, U_NSA_ACMPK = 256 * MiB, U_NSA_ACMPV = 288 * MiB, U_NSA_HK = 320 * MiB, U_NSA_HV = 324 * MiB, U_NSA_KCMP = 328 * MiB, U_NSA_VCMP = 329 * MiB, U_NSA_OATT = 256 * MiB;
constexpr int XB_LDS_OFF = 152 * 1024, LDS_BYTES = 152 * 1024 + 16;

struct WJob { const float* src; bf16_t* dst; int K, N, Np, mode; };
struct Params {
    const float* x; const float* c; const float* ada_w; const float* ada_b; const float* ln_g; const float* ln_b; const float* pe_k; const float* pe_v;
    float* out; unsigned char* ws;
    WJob jobs[32]; int tile_end[32]; int njobs; int pad;
};

__device__ __forceinline__ float bf2f(unsigned short b) { return __uint_as_float(((unsigned)b) << 16); }
__device__ __forceinline__ float bflo(unsigned w) { return __uint_as_float(w << 16); }
__device__ __forceinline__ float bfhi(unsigned w) { return __uint_as_float(w & 0xffff0000u); }
__device__ __forceinline__ unsigned short f2bf(float f) { return (unsigned short)(cvt_pk_bf16(f, 0.f) & 0xffffu); }
__device__ __forceinline__ bf16x8 pack8(const f32x4& a, const f32x4& b) { u32x4 w; w.x = cvt_pk_bf16(a[0], a[1]); w.y = cvt_pk_bf16(a[2], a[3]); w.z = cvt_pk_bf16(b[0], b[1]); w.w = cvt_pk_bf16(b[2], b[3]); return __builtin_bit_cast(bf16x8, w); }
__device__ __forceinline__ u32x2 pack4(const f32x4& a) { u32x2 w; w.x = cvt_pk_bf16(a[0], a[1]); w.y = cvt_pk_bf16(a[2], a[3]); return w; }
__device__ __forceinline__ bf16x8 lds_rd16(LAS unsigned char* lds, int off) { return *(const LAS bf16x8*)(lds + off); }
__device__ __forceinline__ bf16x8 lds_rd8x2(LAS unsigned char* lds, int off) { const s16x4 lo = *(const LAS s16x4*)(lds + off), hi = *(const LAS s16x4*)(lds + off + 32); return __builtin_shufflevector(lo, hi, 0, 1, 2, 3, 4, 5, 6, 7); }
template <int M> __device__ __forceinline__ float shx(float v, int lane) {
    if (M < 32) return __int_as_float(__builtin_amdgcn_ds_swizzle(__float_as_int(v), (M << 10) | 0x1f));
    return __int_as_float(__builtin_amdgcn_ds_bpermute((lane ^ M) << 2, __float_as_int(v)));
}
template <int M> __device__ __forceinline__ unsigned shxu(unsigned v, int lane) {
    if (M < 32) return (unsigned)__builtin_amdgcn_ds_swizzle((int)v, (M << 10) | 0x1f);
    return (unsigned)__builtin_amdgcn_ds_bpermute((lane ^ M) << 2, (int)v);
}
__device__ __forceinline__ float shi(float v, int src_lane) { return __int_as_float(__builtin_amdgcn_ds_bpermute(src_lane << 2, __float_as_int(v))); }
__device__ __forceinline__ float wsum(float v, int lane) { v += shx<32>(v, lane); v += shx<16>(v, lane); v += shx<8>(v, lane); v += shx<4>(v, lane); v += shx<2>(v, lane); v += shx<1>(v, lane); return v; }

struct WTile { const float* src; bf16_t* dst; int N, K, sbase, n0, k0; };
__device__ __forceinline__ WTile wt_lookup(const Params& p, int t) {
    int j = 0; while (j < p.njobs - 1 && t >= p.tile_end[j]) ++j;
    const int tl = t - (j ? p.tile_end[j - 1] : 0);
    const WJob& J = p.jobs[j];
    const int ntn = J.Np >> 6; const int tn = tl % ntn, tk = tl / ntn; const int n0 = tn * 64, k0 = tk * 64;
    int sbase = n0; if (J.mode == 1) { const int pn = n0 >> 8, r = n0 & 255; sbase = (r >> 7) * DFF + pn * 128 + (r & 127); }
    return WTile{J.src, J.dst, J.N, J.K, sbase, n0, k0};
}
__device__ __forceinline__ void wt_load(const WTile& W, int tid, f32x4& v0, f32x4& v1) {
    const int kk = tid >> 4, nn = (tid & 15) * 4;
    v0 = (f32x4){0.f, 0.f, 0.f, 0.f}; v1 = v0;
    if (W.sbase + nn < W.N) { v0 = *(const f32x4*)(W.src + (size_t)(W.k0 + kk) * W.N + W.sbase + nn); v1 = *(const f32x4*)(W.src + (size_t)(W.k0 + kk + 32) * W.N + W.sbase + nn); }
}

__device__ __forceinline__ void phase_prep(const Params& p, LAS unsigned char* lds) {
    int tid = threadIdx.x; asm volatile("" : "+v"(tid));
    LAS float* T = (LAS float*)lds;
    const int ntiles = p.tile_end[p.njobs - 1];
    {
        int t = blockIdx.x;
        WTile cur = wt_lookup(p, t < ntiles ? t : 0); f32x4 v0, v1;
        if (t < ntiles) wt_load(cur, tid, v0, v1);
        while (t < ntiles) {
            const int tn = t + (int)gridDim.x; const bool more = tn < ntiles;
            WTile nx = wt_lookup(p, more ? tn : 0); f32x4 n0 = (f32x4){0.f, 0.f, 0.f, 0.f}, n1 = n0;
            if (more) wt_load(nx, tid, n0, n1);
            const int kk = tid >> 4, nn = (tid & 15) * 4;
            T[kk * 65 + nn] = v0[0]; T[kk * 65 + nn + 1] = v0[1]; T[kk * 65 + nn + 2] = v0[2]; T[kk * 65 + nn + 3] = v0[3];
            T[(kk + 32) * 65 + nn] = v1[0]; T[(kk + 32) * 65 + nn + 1] = v1[1]; T[(kk + 32) * 65 + nn + 2] = v1[2]; T[(kk + 32) * 65 + nn + 3] = v1[3];
            __syncthreads();
            const int n = tid >> 3, k8 = (tid & 7) * 8;
            f32x4 a, b;
            a[0] = T[(k8 + 0) * 65 + n]; a[1] = T[(k8 + 1) * 65 + n]; a[2] = T[(k8 + 2) * 65 + n]; a[3] = T[(k8 + 3) * 65 + n];
            b[0] = T[(k8 + 4) * 65 + n]; b[1] = T[(k8 + 5) * 65 + n]; b[2] = T[(k8 + 6) * 65 + n]; b[3] = T[(k8 + 7) * 65 + n];
            *(bf16x8*)(cur.dst + (size_t)(cur.n0 + n) * cur.K + cur.k0 + k8) = pack8(a, b);
            __syncthreads();
            cur = nx; v0 = n0; v1 = n1; t = tn;
        }
    }
    if (blockIdx.x < 288) {
        LAS float* cs = (LAS float*)lds;
        LAS float* red = (LAS float*)(lds + 65536);
        float* mod = (float*)(p.ws + OFF_MOD);
        __syncthreads();
        for (int idx = tid; idx < 16 * 1024; idx += NTHR) { const int b = idx >> 10, k = idx & 1023; const float cv = p.c[idx]; cs[k * 16 + b] = cv / (1.0f + expf(-cv)); }
        __syncthreads();
        for (int unit = blockIdx.x; unit < 288; unit += gridDim.x) {
            const int i = unit / 72, n0 = (unit % 72) * 128, col = tid & 127, kq = tid >> 7;
            f32x4 a0 = (f32x4){0.f, 0.f, 0.f, 0.f}, a1 = a0, a2 = a0, a3 = a0;
            const float* wp = p.ada_w + ((size_t)i * 1024 + kq * 256) * MODW + n0 + col;
#pragma unroll 4
            for (int k = 0; k < 256; ++k) { const float w = wp[(size_t)k * MODW]; const LAS f32x4* cp = (const LAS f32x4*)(cs + (kq * 256 + k) * 16);
                a0 += cp[0] * w; a1 += cp[1] * w; a2 += cp[2] * w; a3 += cp[3] * w; }
#pragma unroll
            for (int b = 0; b < 4; ++b) { red[(kq * 16 + b) * 128 + col] = a0[b]; red[(kq * 16 + 4 + b) * 128 + col] = a1[b]; red[(kq * 16 + 8 + b) * 128 + col] = a2[b]; red[(kq * 16 + 12 + b) * 128 + col] = a3[b]; }
            __syncthreads();
#pragma unroll
            for (int r = 0; r < 4; ++r) { const int o = tid + r * NTHR, b = o >> 7, cc = o & 127;
                const float s = red[(0 * 16 + b) * 128 + cc] + red[(1 * 16 + b) * 128 + cc] + red[(2 * 16 + b) * 128 + cc] + red[(3 * 16 + b) * 128 + cc] + p.ada_b[i * MODW + n0 + cc];
                mod[((size_t)i * 16 + b) * MODW + n0 + cc] = s; }
            __syncthreads();
        }
    }
}

__device__ __forceinline__ void phase_init(const Params& p) {
    const float* mod = (const float*)(p.ws + OFF_MOD); bf16_t* H = (bf16_t*)(p.ws + OFF_H);
    int tid = threadIdx.x; asm volatile("" : "+v"(tid));
    for (size_t i = (size_t)blockIdx.x * NTHR + tid; i < (size_t)MTOK * 256; i += (size_t)gridDim.x * NTHR) {
        const int row = (int)(i >> 8), c4 = (int)(i & 255) * 4, b = row >> 11;
        const f32x4 xv = *(const f32x4*)(p.x + i * 4); *(f32x4*)(p.out + i * 4) = xv;
        const float* m = mod + (size_t)b * MODW; const f32x4 sh = *(const f32x4*)(m + c4), sc = *(const f32x4*)(m + 1024 + c4);
        const f32x4 h = xv * (sc + 1.0f) + sh; *(u32x2*)(H + i * 4) = pack4(h);
    }
}

__device__ __forceinline__ void phase_ln(float* xio, float* xout, const bf16_t* y, const float* modG, float rw, const float* lng, const float* lnb, const float* modSh, const float* modSc, bf16_t* H) {
    int tid = threadIdx.x; asm volatile("" : "+v"(tid));
    const int wid = __builtin_amdgcn_readfirstlane(tid >> 6), lane = tid & 63;
    for (int row = blockIdx.x * 8 + wid; row < MTOK; row += gridDim.x * 8) {
        const int b = row >> 11; const size_t rb = (size_t)row * DM;
        f32x4 z[4]; float s = 0.f;
#pragma unroll
        for (int q = 0; q < 4; ++q) { const int c = q * 256 + lane * 4; const f32x4 xv = *(const f32x4*)(xio + rb + c); const u32x2 yv = *(const u32x2*)(y + rb + c);
            const f32x4 gt = *(const f32x4*)(modG + (size_t)b * MODW + c); const f32x4 yf = (f32x4){bflo(yv.x), bfhi(yv.x), bflo(yv.y), bfhi(yv.y)};
            z[q] = xv * DN_ALPHA + (gt + 1.0f) * yf * rw; s += (z[q][0] + z[q][1]) + (z[q][2] + z[q][3]); }
        const float mu = wsum(s, lane) * (1.0f / 1024.0f); float v = 0.f;
#pragma unroll
        for (int q = 0; q < 4; ++q) { const f32x4 d = z[q] - mu; v += (d[0] * d[0] + d[1] * d[1]) + (d[2] * d[2] + d[3] * d[3]); }
        const float rstd = rsqrtf(wsum(v, lane) * (1.0f / 1024.0f) + 1e-5f);
#pragma unroll
        for (int q = 0; q < 4; ++q) { const int c = q * 256 + lane * 4; const f32x4 g4 = *(const f32x4*)(lng + c), b4 = *(const f32x4*)(lnb + c);
            const f32x4 xn = (z[q] - mu) * rstd * g4 + b4; *(f32x4*)(xout + rb + c) = xn;
            const f32x4 sh = *(const f32x4*)(modSh + (size_t)b * MODW + c), sc = *(const f32x4*)(modSc + (size_t)b * MODW + c);
            *(u32x2*)(H + rb + c) = pack4(xn * (sc + 1.0f) + sh); }
    }
}

typedef short v4i16_t __attribute__((ext_vector_type(4)));
__device__ __forceinline__ s16x4 lds_tr8(LAS unsigned char* lds, int off) { return __builtin_bit_cast(s16x4, __builtin_amdgcn_ds_read_tr16_b64_v4i16((LAS v4i16_t*)(lds + off))); }

__device__ __forceinline__ bf16x8 lds_tr8x2(LAS unsigned char* lds, int off, int hi_off) { const s16x4 lo = lds_tr8(lds, off), hi = lds_tr8(lds, off + hi_off); return __builtin_shufflevector(lo, hi, 0, 1, 2, 3, 4, 5, 6, 7); }

__device__ __forceinline__ void phase_ret_core(const bf16_t* QKV, bf16_t* O, LAS unsigned char* lds) {
    constexpr int KSB = 528, PS = 136, STS = 264, OFF_K = 0, OFF_P = 67584, OFF_VT = 102400, OFF_ST = 119808;
    int tid = threadIdx.x; asm volatile("" : "+v"(tid));
    const int wid = __builtin_amdgcn_readfirstlane(tid >> 6), lane = tid & 63, fr = lane & 15, fq = lane >> 4;
    for (int item = blockIdx.x; item < 512; item += gridDim.x) {
        const int es = item & 7, bh = item >> 3, hh = bh & 3, b = bh >> 2, e0 = es * 64;
        const float log_g = logf(1.0f - exp2f(-5.0f - (float)hh));
        const float gN = expf(log_g * 128.0f);
        const float l2g = log_g * 1.44269504089f;
        __syncthreads();
        for (int i = tid; i < 64 * STS / 2; i += NTHR) ((LAS unsigned*)(lds + OFF_ST))[i] = 0u;
        f32x4 sacc[2][4];
#pragma unroll
        for (int dt = 0; dt < 2; ++dt)
#pragma unroll
            for (int et = 0; et < 4; ++et) sacc[dt][et] = (f32x4){0.f, 0.f, 0.f, 0.f};
        bf16x8 kst[8], vst[2];
        {   const bf16_t* kp = QKV + ((size_t)b * SEQ + (tid >> 5)) * 4096 + 1024 + hh * 256 + (tid & 31) * 8;
#pragma unroll
            for (int it = 0; it < 8; ++it) kst[it] = *(const bf16x8*)(kp + (size_t)it * 16 * 4096);
            const bf16_t* vrow = QKV + ((size_t)b * SEQ + 2 * (tid & 63)) * 4096 + 2048 + hh * 512 + e0 + (tid >> 6) * 8;
            vst[0] = *(const bf16x8*)(vrow); vst[1] = *(const bf16x8*)(vrow + 4096); }
        bf16x8 qf[8];
        { const bf16_t* qrow = QKV + ((size_t)b * SEQ + wid * 16 + fr) * 4096 + hh * 256 + fq * 8;
#pragma unroll
          for (int ks = 0; ks < 8; ++ks) qf[ks] = *(const bf16x8*)(qrow + ks * 32); }
        for (int n = 0; n < 16; ++n) {
            const size_t tok0 = (size_t)b * SEQ + n * 128;
            int t2 = tid; asm volatile("" : "+v"(t2));
            const int lane = t2 & 63, fr = lane & 15, fq = lane >> 4;
            {
#pragma unroll
                for (int it = 0; it < 8; ++it) *(LAS bf16x8*)(lds + OFF_K + ((t2 >> 5) + 16 * it) * KSB + (t2 & 31) * 16) = kst[it];
                const int cp_ = t2 & 63, q_ = t2 >> 6;
#pragma unroll
                for (int i = 0; i < 8; ++i) *(LAS unsigned*)(lds + OFF_VT + ((q_ * 8 + i) * PS + 2 * cp_) * 2) = (unsigned)(unsigned short)vst[0][i] | ((unsigned)(unsigned short)vst[1][i] << 16);
            }
            if (n < 15) {
                const bf16_t* kp = QKV + (tok0 + 128 + (t2 >> 5)) * 4096 + 1024 + hh * 256 + (t2 & 31) * 8;
#pragma unroll
                for (int it = 0; it < 8; ++it) kst[it] = *(const bf16x8*)(kp + (size_t)it * 16 * 4096);
                const bf16_t* vrow = QKV + (tok0 + 128 + 2 * (t2 & 63)) * 4096 + 2048 + hh * 512 + e0 + (t2 >> 6) * 8;
                vst[0] = *(const bf16x8*)(vrow); vst[1] = *(const bf16x8*)(vrow + 4096); }
            __syncthreads();
            const int cc = wid * 16 + fr;
            const int npair = (wid >> 1) + 1;
            f32x4 a1[4], a2[4];
#pragma unroll
            for (int et = 0; et < 4; ++et) { a1[et] = (f32x4){0.f, 0.f, 0.f, 0.f}; a2[et] = a1[et]; }
            for (int cp2 = 0; cp2 < npair; ++cp2) {
                const int kb0 = OFF_K + (cp2 * 32 + fr) * KSB + fq * 16;
                f32x4 acc0 = (f32x4){0.f, 0.f, 0.f, 0.f}, acc1 = acc0;
#pragma unroll
                for (int ks = 0; ks < 8; ++ks) { acc0 = MFMA16(lds_rd16(lds, kb0 + ks * 64), qf[ks], acc0); acc1 = MFMA16(lds_rd16(lds, kb0 + 16 * KSB + ks * 64), qf[ks], acc1); }
                f32x4 pv0, pv1;
#pragma unroll
                for (int j = 0; j < 4; ++j) { const int cp = cp2 * 32 + fq * 4 + j;
                    pv0[j] = (cc >= cp) ? acc0[j] * 0.0625f * __builtin_amdgcn_exp2f(l2g * (float)(cc - cp)) : 0.f;
                    pv1[j] = (cc >= cp + 16) ? acc1[j] * 0.0625f * __builtin_amdgcn_exp2f(l2g * (float)(cc - cp - 16)) : 0.f; }
                const bf16x8 pf = pack8(pv0, pv1);
#pragma unroll
                for (int et = 0; et < 4; ++et) a1[et] = MFMA16(lds_rd8x2(lds, OFF_VT + ((et * 16 + fr) * PS + cp2 * 32 + fq * 4) * 2), pf, a1[et]);
            }
            {
#pragma unroll
                for (int ks = 0; ks < 8; ++ks)
#pragma unroll
                    for (int et = 0; et < 4; ++et) a2[et] = MFMA16(lds_rd16(lds, OFF_ST + ((et * 16 + fr) * STS + ks * 32 + fq * 8) * 2), qf[ks], a2[et]);
                const float dq = __builtin_amdgcn_exp2f(l2g * (float)(cc + 1));
                bf16_t* orow = O + (tok0 + cc) * 2048 + hh * 512 + e0 + fq * 4;
#pragma unroll
                for (int et = 0; et < 4; ++et) *(u32x2*)(orow + et * 16) = pack4(a1[et] + a2[et] * dq);
            }
            if (n < 15) {
                const bf16_t* qrow = QKV + (tok0 + 128 + cc) * 4096 + hh * 256 + fq * 8;
#pragma unroll
                for (int ks = 0; ks < 8; ++ks) qf[ks] = *(const bf16x8*)(qrow + ks * 32); }
            __syncthreads();
            if (n < 15) {
#pragma unroll
                for (int dt = 0; dt < 2; ++dt)
#pragma unroll
                    for (int et = 0; et < 4; ++et) sacc[dt][et] *= gN;
                const int q4 = (lane & 15) >> 2, p4 = lane & 3;
                const float fbase = 0.0625f * __builtin_amdgcn_exp2f(l2g * (float)(127 - 8 * fq));
#pragma unroll
                for (int ks = 0; ks < 4; ++ks) {
                    bf16x8 vf[4];
#pragma unroll
                    for (int et = 0; et < 4; ++et) vf[et] = lds_rd16(lds, OFF_VT + ((et * 16 + fr) * PS + ks * 32 + fq * 8) * 2);
                    const float fks = fbase * __builtin_amdgcn_exp2f(l2g * (float)(-32 * ks));
#pragma unroll
                    for (int dt = 0; dt < 2; ++dt) {
                        const int tb = OFF_K + (32 * ks + 8 * fq + q4) * KSB + (2 * wid + dt) * 32 + 8 * p4;
                        const s16x4 lo = lds_tr8(lds, tb), hi = lds_tr8(lds, tb + 4 * KSB);
                        f32x4 f0, f1;
#pragma unroll
                        for (int e = 0; e < 4; ++e) { f0[e] = bf2f((unsigned short)lo[e]) * (fks * __builtin_amdgcn_exp2f(l2g * (float)(-e))); f1[e] = bf2f((unsigned short)hi[e]) * (fks * __builtin_amdgcn_exp2f(l2g * (float)(-4 - e))); }
                        const bf16x8 kf = pack8(f0, f1);
#pragma unroll
                        for (int et = 0; et < 4; ++et) sacc[dt][et] = MFMA16(kf, vf[et], sacc[dt][et]); }
                }
#pragma unroll
                for (int dt = 0; dt < 2; ++dt)
#pragma unroll
                    for (int et = 0; et < 4; ++et) *(LAS u32x2*)(lds + OFF_ST + ((et * 16 + fr) * STS + (2 * wid + dt) * 16 + fq * 4) * 2) = pack4(sacc[dt][et]);
            }
            __syncthreads();
        }
    }
}

__device__ __forceinline__ void phase_ret_gate(bf16_t* O, const bf16_t* G) {
    int tid = threadIdx.x; asm volatile("" : "+v"(tid));
    const int wid = __builtin_amdgcn_readfirstlane(tid >> 6), lane = tid & 63;
    for (int idx = blockIdx.x * 8 + wid; idx < MTOK * 4; idx += gridDim.x * 8) {
        const size_t base = (size_t)(idx >> 2) * 2048 + (idx & 3) * 512 + lane * 8;
        const u32x4 ov = *(const u32x4*)(O + base), gv = *(const u32x4*)(G + base);
        float o[8] = {bflo(ov.x), bfhi(ov.x), bflo(ov.y), bfhi(ov.y), bflo(ov.z), bfhi(ov.z), bflo(ov.w), bfhi(ov.w)};
        const float g[8] = {bflo(gv.x), bfhi(gv.x), bflo(gv.y), bfhi(gv.y), bflo(gv.z), bfhi(gv.z), bflo(gv.w), bfhi(gv.w)};
        float s = 0.f;
#pragma unroll
        for (int i = 0; i < 8; ++i) s += o[i];
        const float mu = wsum(s, lane) * (1.0f / 512.0f); float v = 0.f;
#pragma unroll
        for (int i = 0; i < 8; ++i) { const float d = o[i] - mu; v += d * d; }
        const float rstd = rsqrtf(wsum(v, lane) * (1.0f / 512.0f) + 1e-6f);
#pragma unroll
        for (int i = 0; i < 8; ++i) o[i] = (o[i] - mu) * rstd * silu_f(g[i]);
        u32x4 w; w.x = cvt_pk_bf16(o[0], o[1]); w.y = cvt_pk_bf16(o[2], o[3]); w.z = cvt_pk_bf16(o[4], o[5]); w.w = cvt_pk_bf16(o[6], o[7]);
        *(u32x4*)(O + base) = w;
    }
}

__device__ __forceinline__ void phase_nsa_mat(const bf16_t* PROJ, const float* pek, const float* pev, bf16_t* AK, bf16_t* AV) {
    const size_t per = (size_t)8128 * 256;
    int tid = threadIdx.x; asm volatile("" : "+v"(tid));
    for (size_t i = (size_t)blockIdx.x * NTHR + tid; i < 2 * per; i += (size_t)gridDim.x * NTHR) {
        const int kv = i >= per; const size_t rem = kv ? i - per : i; const int r = (int)(rem >> 8), pp = (int)(rem & 255), l = pp >> 3, d0 = (pp & 7) * 8;
        const int g = r & 3, bn = r >> 2, b = bn / 127, n = bn % 127;
        const u32x4 v = *(const u32x4*)(PROJ + ((size_t)b * SEQ + n * 16 + l) * 2816 + 1024 + kv * 256 + g * 64 + d0);
        const float* pe = (kv ? pev : pek) + l * 64 + d0; const f32x4 p0 = *(const f32x4*)pe, p1 = *(const f32x4*)(pe + 4);
        u32x4 w; w.x = cvt_pk_bf16(bflo(v.x) + p0[0], bfhi(v.x) + p0[1]); w.y = cvt_pk_bf16(bflo(v.y) + p0[2], bfhi(v.y) + p0[3]);
        w.z = cvt_pk_bf16(bflo(v.z) + p1[0], bfhi(v.z) + p1[1]); w.w = cvt_pk_bf16(bflo(v.w) + p1[2], bfhi(v.w) + p1[3]);
        *(u32x4*)((kv ? AV : AK) + (size_t)r * 2048 + l * 64 + d0) = w;
    }
}
__device__ __forceinline__ void phase_nsa_cmp2(const bf16_t* HK, const bf16_t* HV, const bf16_t* W2K, const bf16_t* W2V, bf16_t* KC, bf16_t* VC) {
    int tid = threadIdx.x; asm volatile("" : "+v"(tid));
    const int wid = __builtin_amdgcn_readfirstlane(tid >> 6), lane = tid & 63, fr = lane & 15, fq = lane >> 4;
    for (int tt = blockIdx.x * 8 + wid; tt < 508 * 2; tt += gridDim.x * 8) {
        const int kv = tt >= 508, rt = kv ? tt - 508 : tt; const bf16_t* Hd = kv ? HV : HK; const bf16_t* W = kv ? W2V : W2K; bf16_t* Od = kv ? VC : KC;
        f32x4 acc[4];
#pragma unroll
        for (int nt = 0; nt < 4; ++nt) acc[nt] = (f32x4){0.f, 0.f, 0.f, 0.f};
#pragma unroll
        for (int ks = 0; ks < 8; ++ks) { const bf16x8 hf = *(const bf16x8*)(Hd + (size_t)(rt * 16 + fr) * 256 + ks * 32 + fq * 8);
#pragma unroll
            for (int nt = 0; nt < 4; ++nt) acc[nt] = MFMA16(*(const bf16x8*)(W + (size_t)(nt * 16 + fr) * 256 + ks * 32 + fq * 8), hf, acc[nt]); }
#pragma unroll
        for (int nt = 0; nt < 4; ++nt) *(u32x2*)(Od + (size_t)(rt * 16 + fr) * 64 + nt * 16 + fq * 4) = pack4(acc[nt]);
    }
}

constexpr int A_KS = 72, A_VS = 72, A_KCS = 72, A_VCS = 72, A_KBYTES = 9216, A_VBYTES = 9216;
struct AttnCtx2 { int b, g, cur, head, hp; int t[2]; float slope; bf16x8 qf[2][2]; float gate[2][3]; unsigned selq[2]; unsigned anym; };
constexpr int B_OFF_K = 0, B_OFF_VT = 18432, B_OFF_KC = 36864, B_OFF_VCT = 55296, B_OFF_IMP = 73728, B_OFF_SEL = 107520, B_OFF_SELP = 107776;

template <int BR>
__device__ __forceinline__ void attn_branch64(const bf16_t* PROJ, LAS unsigned char* lds, const AttnCtx2& C, f32x4 (&otot)[2][4], int tid) {
    const int lane = tid & 63, fr = lane & 15, fq = lane >> 4;
    const float qs = 0.125f * 1.44269504089f, slope2 = C.slope * 1.44269504089f;
    f32x4 sl[4];
#pragma unroll
    for (int kt = 0; kt < 4; ++kt)
#pragma unroll
        for (int jj = 0; jj < 4; ++jj) sl[kt][jj] = slope2 * (float)(kt * 16 + jj);
    float m_[2] = {-1e30f, -1e30f}, l_[2] = {0.f, 0.f};
    f32x4 oa[2][4];
#pragma unroll
    for (int qi = 0; qi < 2; ++qi)
#pragma unroll
        for (int dt = 0; dt < 4; ++dt) oa[qi][dt] = (f32x4){0.f, 0.f, 0.f, 0.f};
    const int jlo = (BR == 1) ? 0 : (C.cur > 8 ? C.cur - 8 : 0);
    const int koff = (BR == 1 ? 1536 : 2048) + C.g * 64, voff = (BR == 1 ? 1792 : 2304) + C.g * 64;
    const int key = tid >> 3, d0 = (tid & 7) * 8;
    const bf16_t* srcb = PROJ + ((size_t)C.b * SEQ + key) * 2816 + d0;
    const int wofs = (key * A_KS + d0) * 2;
    int j = jlo;
    if (BR == 1) { while (j <= C.cur && !((C.anym >> j) & 1u)) ++j; }
    bf16x8 kreg = *(const bf16x8*)(srcb + (size_t)j * 64 * 2816 + koff), vreg = *(const bf16x8*)(srcb + (size_t)j * 64 * 2816 + voff);
    __syncthreads();
    int buf = 0;
    *(LAS bf16x8*)(lds + B_OFF_K + wofs) = kreg; *(LAS bf16x8*)(lds + B_OFF_VT + wofs) = vreg;
    __syncthreads();
    while (j <= C.cur) {
        int jn = j + 1;
        if (BR == 1) { while (jn <= C.cur && !((C.anym >> jn) & 1u)) ++jn; }
        const bool more = jn <= C.cur;
        if (more) { kreg = *(const bf16x8*)(srcb + (size_t)jn * 64 * 2816 + koff); vreg = *(const bf16x8*)(srcb + (size_t)jn * 64 * 2816 + voff); }
        const int kb = B_OFF_K + buf * A_KBYTES, vb = B_OFF_VT + buf * A_VBYTES;
        const bool partial = (j == C.cur) || (BR == 2 && j + 8 <= C.cur);
        bf16x8 pf[2][2];
#pragma unroll
        for (int qi = 0; qi < 2; ++qi) {
            f32x4 s4[4]; float alpha;
            const int dbase = C.t[qi] - j * 64 - fq * 4;
            if (partial) {
                float tmax = -1e30f;
#pragma unroll
                for (int kt = 0; kt < 4; ++kt) { f32x4 acc = (f32x4){0.f, 0.f, 0.f, 0.f};
#pragma unroll
                    for (int ks = 0; ks < 2; ++ks) acc = MFMA16(lds_rd16(lds, kb + ((kt * 16 + fr) * A_KS + ks * 32 + fq * 8) * 2), C.qf[qi][ks], acc);
#pragma unroll
                    for (int jj = 0; jj < 4; ++jj) { const int dist = dbase - (kt * 16 + jj);
                        const bool ok = (dist >= 0) && (BR == 1 ? (((C.selq[qi] >> j) & 1u) != 0u) : (dist < 512));
                        const float sv = ok ? acc[jj] * qs - slope2 * (float)dist : -1e30f; s4[kt][jj] = sv; tmax = fmaxf(tmax, sv); } }
                tmax = fmaxf(tmax, shx<16>(tmax, lane)); tmax = fmaxf(tmax, shx<32>(tmax, lane));
                const float mnew = fmaxf(m_[qi], tmax); alpha = __builtin_amdgcn_exp2f(m_[qi] - mnew); m_[qi] = mnew;
                float psum = 0.f;
#pragma unroll
                for (int kt = 0; kt < 4; ++kt)
#pragma unroll
                    for (int jj = 0; jj < 4; ++jj) { const float pp = (s4[kt][jj] > -1e29f) ? __builtin_amdgcn_exp2f(s4[kt][jj] - mnew) : 0.f; s4[kt][jj] = pp; psum += pp; }
                l_[qi] = l_[qi] * alpha + psum;
            } else {
                float c0 = -slope2 * (float)dbase;
                if (BR == 1 && !((C.selq[qi] >> j) & 1u)) c0 = -1e30f;
                float tmax = -1e30f;
#pragma unroll
                for (int kt = 0; kt < 4; ++kt) { f32x4 acc = (f32x4){0.f, 0.f, 0.f, 0.f};
#pragma unroll
                    for (int ks = 0; ks < 2; ++ks) acc = MFMA16(lds_rd16(lds, kb + ((kt * 16 + fr) * A_KS + ks * 32 + fq * 8) * 2), C.qf[qi][ks], acc);
#pragma unroll
                    for (int jj = 0; jj < 4; ++jj) { const float u = acc[jj] * qs + sl[kt][jj]; s4[kt][jj] = u; tmax = fmaxf(tmax, u); } }
                tmax += c0;
                tmax = fmaxf(tmax, shx<16>(tmax, lane)); tmax = fmaxf(tmax, shx<32>(tmax, lane));
                const float mnew = fmaxf(m_[qi], tmax); alpha = __builtin_amdgcn_exp2f(m_[qi] - mnew); m_[qi] = mnew;
                const float sh = mnew - c0; float psum = 0.f;
#pragma unroll
                for (int kt = 0; kt < 4; ++kt)
#pragma unroll
                    for (int jj = 0; jj < 4; ++jj) { const float pp = __builtin_amdgcn_exp2f(s4[kt][jj] - sh); s4[kt][jj] = pp; psum += pp; }
                l_[qi] = l_[qi] * alpha + psum;
            }
#pragma unroll
            for (int dt = 0; dt < 4; ++dt) oa[qi][dt] *= alpha;
            pf[qi][0] = pack8(s4[0], s4[1]); pf[qi][1] = pack8(s4[2], s4[3]);
        }
#pragma unroll
        for (int ks2 = 0; ks2 < 2; ++ks2)
#pragma unroll
            for (int dt = 0; dt < 4; ++dt) { const bf16x8 vf = lds_tr8x2(lds, vb + (ks2 * 32 + fq * 4 + ((lane & 15) >> 2)) * (A_VS * 2) + dt * 32 + 8 * (lane & 3), 16 * A_VS * 2);
                oa[0][dt] = MFMA16(vf, pf[0][ks2], oa[0][dt]); oa[1][dt] = MFMA16(vf, pf[1][ks2], oa[1][dt]); }
        if (more) { *(LAS bf16x8*)(lds + B_OFF_K + (buf ^ 1) * A_KBYTES + wofs) = kreg; *(LAS bf16x8*)(lds + B_OFF_VT + (buf ^ 1) * A_VBYTES + wofs) = vreg; }
        __syncthreads();
        buf ^= 1; j = jn;
    }
#pragma unroll
    for (int qi = 0; qi < 2; ++qi) { float lt = l_[qi]; lt += shx<16>(lt, lane); lt += shx<32>(lt, lane); const float inv = lt > 0.f ? C.gate[qi][BR] / lt : 0.f;
#pragma unroll
        for (int dt = 0; dt < 4; ++dt) otot[qi][dt] += oa[qi][dt] * inv; }
}

__device__ __forceinline__ void phase_nsa_attn64(const bf16_t* PROJ, const bf16_t* KCMP, const bf16_t* VCMP, bf16_t* OATT, LAS unsigned char* lds) {
    int tid0 = threadIdx.x; asm volatile("" : "+v"(tid0));
    const int wid = __builtin_amdgcn_readfirstlane(tid0 >> 6);
    LAS float* IMP = (LAS float*)(lds + B_OFF_IMP); LAS unsigned* SEL = (LAS unsigned*)(lds + B_OFF_SEL); LAS unsigned* SELP = (LAS unsigned*)(lds + B_OFF_SELP);
    for (int id = blockIdx.x; id < 2048; id += gridDim.x) {
        int tid = tid0; asm volatile("" : "+v"(tid));
        const int lane = tid & 63, fr = lane & 15, fq = lane >> 4;
        const int k8 = id & 255, ii = id >> 8, bg = k8 & 63, kk = k8 >> 6;
        AttnCtx2 C; C.cur = (ii & 1) ? 31 - (kk + 4 * (ii - 1)) : kk + 4 * ii; C.b = bg >> 2; C.g = bg & 3; C.hp = wid >> 1; C.head = C.g * 4 + C.hp; C.slope = exp2f(-0.5f * (float)(C.head + 1));
        int qq[2]; size_t trow[2];
#pragma unroll
        for (int qi = 0; qi < 2; ++qi) { qq[qi] = (wid & 1) * 32 + qi * 16 + fr; C.t[qi] = C.cur * 64 + qq[qi]; trow[qi] = (size_t)C.b * SEQ + C.t[qi];
            const bf16_t* pr = PROJ + trow[qi] * 2816;
#pragma unroll
            for (int ks = 0; ks < 2; ++ks) C.qf[qi][ks] = *(const bf16x8*)(pr + C.head * 64 + ks * 32 + fq * 8);
#pragma unroll
            for (int br = 0; br < 3; ++br) C.gate[qi][br] = 1.0f / (1.0f + __expf(-bf2f(pr[2560 + C.head * 3 + br]))); }
        f32x4 otot[2][4];
#pragma unroll
        for (int qi = 0; qi < 2; ++qi)
#pragma unroll
            for (int dt = 0; dt < 4; ++dt) otot[qi][dt] = (f32x4){0.f, 0.f, 0.f, 0.f};
        __syncthreads();
#pragma unroll
        for (int rep = 0; rep < 2; ++rep) { const int idx = tid + rep * NTHR, n = idx >> 3, d0 = (idx & 7) * 8, nc = n < 126 ? n : 126; const size_t src = ((size_t)(C.b * 127 + nc) * 4 + C.g) * 64 + d0;
            *(LAS bf16x8*)(lds + B_OFF_KC + (n * A_KCS + d0) * 2) = *(const bf16x8*)(KCMP + src);
            *(LAS bf16x8*)(lds + B_OFF_VCT + (n * A_VCS + d0) * 2) = *(const bf16x8*)(VCMP + src); }
        __syncthreads();
#pragma unroll
        for (int qi = 0; qi < 2; ++qi) {
            f32x4 sc[8]; float mx = -1e30f;
#pragma unroll
            for (int kt = 0; kt < 8; ++kt) { f32x4 acc = (f32x4){0.f, 0.f, 0.f, 0.f};
#pragma unroll
                for (int ks = 0; ks < 2; ++ks) acc = MFMA16(lds_rd16(lds, B_OFF_KC + ((kt * 16 + fr) * A_KCS + ks * 32 + fq * 8) * 2), C.qf[qi][ks], acc);
#pragma unroll
                for (int jj = 0; jj < 4; ++jj) { const int n = kt * 16 + fq * 4 + jj, ce = n * 16 + 31; const bool ok = (n <= 126) && (ce <= C.t[qi]);
                    const float sv = ok ? acc[jj] * 0.125f - C.slope * (float)(C.t[qi] - ce) : -1e30f; sc[kt][jj] = sv; mx = fmaxf(mx, sv); } }
            mx = fmaxf(mx, shx<16>(mx, lane)); mx = fmaxf(mx, shx<32>(mx, lane));
            float sum = 0.f;
#pragma unroll
            for (int kt = 0; kt < 8; ++kt)
#pragma unroll
                for (int jj = 0; jj < 4; ++jj) { const float pp = (sc[kt][jj] > -1e29f) ? __expf(sc[kt][jj] - mx) : 0.f; sc[kt][jj] = pp; sum += pp; }
            sum += shx<16>(sum, lane); sum += shx<32>(sum, lane);
            const float inv = sum > 0.f ? 1.0f / sum : 0.f;
#pragma unroll
            for (int kt = 0; kt < 8; ++kt) sc[kt] *= inv;
#pragma unroll
            for (int kt = 0; kt < 8; ++kt) { const float a = shi(sc[kt][3], (lane + 48) & 63); const float bp = kt > 0 ? shi(sc[kt > 0 ? kt - 1 : 0][3], (lane + 48) & 63) : 0.f;
                const float prev3 = fq > 0 ? a : bp;
                IMP[(C.hp * 64 + qq[qi]) * 33 + 4 * kt + fq] = sc[kt][0] + sc[kt][1] + sc[kt][2] + 0.5f * sc[kt][3] + 0.5f * prev3; }
            f32x4 oc[4];
#pragma unroll
            for (int dt = 0; dt < 4; ++dt) oc[dt] = (f32x4){0.f, 0.f, 0.f, 0.f};
#pragma unroll
            for (int ks2 = 0; ks2 < 4; ++ks2) { const bf16x8 pfc = pack8(sc[2 * ks2], sc[2 * ks2 + 1]);
#pragma unroll
                for (int dt = 0; dt < 4; ++dt) oc[dt] = MFMA16(lds_tr8x2(lds, B_OFF_VCT + (ks2 * 32 + fq * 4 + ((lane & 15) >> 2)) * (A_VCS * 2) + dt * 32 + 8 * (lane & 3), 16 * A_VCS * 2), pfc, oc[dt]); }
#pragma unroll
            for (int dt = 0; dt < 4; ++dt) otot[qi][dt] += oc[dt] * C.gate[qi][0];
        }
        __syncthreads();
        if (C.cur >= 16) {
            const int sq = tid & 63, jg = tid >> 6;
#pragma unroll
            for (int jj = 0; jj < 4; ++jj) { const int j = jg * 4 + jj; const float imp = IMP[(0 * 64 + sq) * 33 + j] + IMP[(1 * 64 + sq) * 33 + j] + IMP[(2 * 64 + sq) * 33 + j] + IMP[(3 * 64 + sq) * 33 + j];
                const bool valid = j <= C.cur, forced = (j == 0) || (j == C.cur) || (j == C.cur - 1);
                IMP[sq * 33 + j] = valid ? (forced ? 1e4f : imp) : -1.0f; }
            __syncthreads();
            unsigned bits = 0u;
#pragma unroll
            for (int jj = 0; jj < 4; ++jj) { const int j = jg * 4 + jj; const float sj = IMP[sq * 33 + j]; int cnt = 0;
                for (int j2 = 0; j2 < 32; ++j2) { const float s2 = IMP[sq * 33 + j2]; cnt += ((s2 > sj) || (s2 == sj && j2 < j)) ? 1 : 0; }
                if (cnt < 16) bits |= 1u << j; }
            SELP[jg * 64 + sq] = bits;
            __syncthreads();
            if (tid < 64) { unsigned m = 0u;
#pragma unroll
                for (int q = 0; q < 8; ++q) m |= SELP[q * 64 + tid];
                SEL[tid] = m; }
        } else { if (tid < 64) SEL[tid] = (2u << C.cur) - 1u; }
        __syncthreads();
        C.selq[0] = SEL[qq[0]]; C.selq[1] = SEL[qq[1]];
        { unsigned m = SEL[lane]; m |= shxu<32>(m, lane); m |= shxu<16>(m, lane); m |= shxu<8>(m, lane); m |= shxu<4>(m, lane); m |= shxu<2>(m, lane); m |= shxu<1>(m, lane); C.anym = (unsigned)__builtin_amdgcn_readfirstlane((int)m); }
        attn_branch64<1>(PROJ, lds, C, otot, tid);
        attn_branch64<2>(PROJ, lds, C, otot, tid);
#pragma unroll
        for (int qi = 0; qi < 2; ++qi)
#pragma unroll
            for (int dt = 0; dt < 4; ++dt) *(u32x2*)(OATT + trow[qi] * 1024 + C.head * 64 + dt * 16 + fq * 4) = pack4(otot[qi][dt]);
    }
}

#define XB_TMO      128
#define XB_XCNT(j)  (256  + 64 * (j))
#define XB_XSUB(j)  (1280 + 64 * (j))
#define XB_XGEN(j)  (2304 + 64 * (j))
#define XB_TOP      3328
#define XB_TOPGEN   3392
#define XCD_BAR_WORDS 3456
#define XB_SPIN_CAP (1u << 18)

__device__ __forceinline__ unsigned xb_ld(unsigned* p)              { return __hip_atomic_load(p, __ATOMIC_RELAXED, __HIP_MEMORY_SCOPE_AGENT); }
__device__ __forceinline__ unsigned xb_add(unsigned* p, unsigned v) { return __hip_atomic_fetch_add(p, v, __ATOMIC_RELAXED, __HIP_MEMORY_SCOPE_AGENT); }
__device__ __forceinline__ unsigned xb_xcc_id() { return (unsigned)__builtin_amdgcn_s_getreg((3 << 11) | 20) & 0xFu; }
#define XB_SPIN(cond, bar) do { unsigned _sp = 0; while (cond) { __builtin_amdgcn_s_sleep(1); \
    if ((++_sp & 255u) == 0u) { if (xb_ld(&(bar)[XB_TMO])) break; if (_sp > XB_SPIN_CAP) { atomicAdd(&(bar)[XB_TMO], 1u); break; } } } } while (0)

struct XcdBarrier {
    unsigned* bar; unsigned x;
    volatile LAS unsigned* st;
};

__device__ __forceinline__ XcdBarrier xcd_barrier_post(unsigned* bar, volatile LAS unsigned* st) {
    XcdBarrier b; b.bar = bar; b.x = xb_xcc_id(); b.st = st;
    if (threadIdx.x == 0) (void)xb_add(&bar[XB_XCNT(b.x)], 1u);
    return b;
}
__device__ __forceinline__ void xcd_barrier_complete(unsigned* bar, unsigned x, unsigned& nloc, unsigned& nx) {
    const unsigned G = gridDim.x * gridDim.y * gridDim.z;
    unsigned sum, cnt, mine, sp = 0u;
    for (;;) {
        sum = 0u; cnt = 0u; mine = 0u;
#pragma unroll
        for (unsigned j = 0; j < 16; ++j) { const unsigned c = xb_ld(&bar[XB_XCNT(j)]); sum += c; cnt += (c > 0u) ? 1u : 0u; mine = (j == x) ? c : mine; }
        if (sum == G) break;
        __builtin_amdgcn_s_sleep(1);
        if ((++sp & 255u) == 0u) { if (xb_ld(&bar[XB_TMO])) break; if (sp > XB_SPIN_CAP) { atomicAdd(&bar[XB_TMO], 1u); break; } }
    }
    nloc = mine > 0u ? mine : 1u; nx = cnt > 0u ? cnt : 1u;
}

__device__ __forceinline__ void xcd_barrier(const XcdBarrier& b) {
    asm volatile("s_waitcnt vmcnt(0)" ::: "memory");
    __syncthreads();
    if (threadIdx.x == 0) {
        unsigned* bar = b.bar;
        __builtin_amdgcn_s_waitcnt(0);
        unsigned nloc = b.st[0], nx = b.st[1];
        if (nloc == 0u) { xcd_barrier_complete(bar, b.x, nloc, nx); b.st[0] = nloc; b.st[1] = nx; }
        const unsigned old = xb_add(&bar[XB_XSUB(b.x)], 1u);
        const unsigned gen = old / nloc;
        if (old + 1u == (gen + 1u) * nloc) {
            __builtin_amdgcn_fence(__ATOMIC_RELEASE, "agent");
            asm volatile("s_waitcnt vmcnt(0)" ::: "memory");
            const unsigned og = xb_add(&bar[XB_TOP], 1u);
            const unsigned tg = og / nx;
            if (og + 1u == (tg + 1u) * nx) xb_add(&bar[XB_TOPGEN], 1u);
            else XB_SPIN(xb_ld(&bar[XB_TOPGEN]) == tg, bar);
            __builtin_amdgcn_fence(__ATOMIC_ACQUIRE, "agent");
            xb_add(&bar[XB_XGEN(b.x)], 1u);
            asm volatile("s_waitcnt vmcnt(0)" ::: "memory");
        } else {
            XB_SPIN(xb_ld(&bar[XB_XGEN(b.x)]) == gen, bar);
            __builtin_amdgcn_fence(__ATOMIC_ACQUIRE, "agent");
            asm volatile("s_waitcnt vmcnt(0)" ::: "memory");
        }
    }
    __syncthreads();
}


#ifndef R_CORE
#define R_CORE 1
#endif
#ifndef R_ATTN
#define R_ATTN 1
#endif
#ifndef R_GEMM
#define R_GEMM 1
#endif
#ifndef R_BAR
#define R_BAR 1
#endif
#ifndef R_PREP
#define R_PREP 1
#endif
#ifndef GEMM_ALIGN
#define GEMM_ALIGN true
#endif
#ifndef GEMM_SP2
#define GEMM_SP2 true
#endif
struct GemmDesc { const bf16_t* A; const bf16_t* Bt; bf16_t* O; int M, N, K, ldc, act, cshift; };
__device__ __forceinline__ void run_gemm(const GemmDesc& d, LAS unsigned char* lds) {
    pg8::Gemm g{d.A, d.Bt, d.M, d.N, d.K}; pg8::StaticOrder S; const int G = (int)gridDim.x; S.init(d.M, d.N, G, ((int)blockIdx.x + G - d.cshift % G) % G);
    if (d.act == 0) { pg8::Epi<0> E{d.O, d.ldc}; pg8::gemm_phase<pg8::Epi<0>, pg8::StaticOrder, GEMM_ALIGN, GEMM_SP2>(lds, g, S, E); }
    else if (d.act == 1) { pg8::Epi<1> E{d.O, d.ldc}; pg8::gemm_phase<pg8::Epi<1>, pg8::StaticOrder, GEMM_ALIGN, GEMM_SP2>(lds, g, S, E); }
    else { pg8::Epi<2> E{d.O, d.ldc}; pg8::gemm_phase<pg8::Epi<2>, pg8::StaticOrder, GEMM_ALIGN, GEMM_SP2>(lds, g, S, E); }
}

__global__ void __launch_bounds__(NTHR) fwd_megakernel(Params p) {
    extern __shared__ __attribute__((aligned(16))) unsigned char smem[];
    LAS unsigned char* lds = (LAS unsigned char*)smem;
    cg::grid_group grid = cg::this_grid();
    unsigned char* ws = p.ws; unsigned char* U = ws + OFF_U2;
    const float* mod = (const float*)(ws + OFF_MOD); bf16_t* H = (bf16_t*)(ws + OFF_H);
    if (threadIdx.x < 4) ((LAS unsigned*)(lds + XB_LDS_OFF))[threadIdx.x] = 0u;
    __syncthreads();
    XcdBarrier xbar = xcd_barrier_post((unsigned*)(ws + WS_END), (volatile LAS unsigned*)(lds + XB_LDS_OFF));
    grid.sync();

#if 0
    { const u32x4 pz = (u32x4){0xAAAAAAAAu, 0xAAAAAAAAu, 0xAAAAAAAAu, 0xAAAAAAAAu}; for (size_t i = (size_t)blockIdx.x * NTHR + threadIdx.x; i < WS_END / 16; i += (size_t)gridDim.x * NTHR) ((u32x4*)ws)[i] = pz; }
    xcd_barrier(xbar);
#endif
    for (int gs = 0; gs < 2 + DEPTH * 13; ++gs) {
        if (gs < 2) {
            if (gs == 0) { for (int rr = 0; rr < R_PREP; ++rr) phase_prep(p, lds); } else phase_init(p);
        } else {
        const int layer = (gs - 2) / 13, st = (gs - 2) % 13;
        const int jm = layer >> 1; const bool is_ret = (layer & 1) == 0;
        const float* modL = mod + (size_t)layer * 16 * MODW;
        {
            GemmDesc d[2]; int ng = 0;
            d[0].cshift = 0; d[1].cshift = 0;
            if (st == 0 || st == 10) {
                const int s = st == 0 ? 0 : 1;
                d[0] = GemmDesc{H, (const bf16_t*)(ws + OFF_FFN_IN + (size_t)(layer * 2 + s) * SZ_FFN_IN), (bf16_t*)(U + U_FFN_ACT), MTOK, 5632, 1024, DFF, 1, 0}; ng = 1;
            } else if (st == 1 || st == 11) {
                const int s = st == 1 ? 0 : 1;
                d[0] = GemmDesc{(const bf16_t*)(U + U_FFN_ACT), (const bf16_t*)(ws + OFF_FFN_OUT + (size_t)(layer * 2 + s) * SZ_FFN_OUT), (bf16_t*)(U + U_FFN_Y), MTOK, 1024, DFF, 1024, 0, 0}; ng = 1;
            } else if (st == 2 || st == 9 || st == 12) {
                const int sub = st == 2 ? 0 : (st == 9 ? 1 : 2);
                const bf16_t* y = (const bf16_t*)(U + (sub == 1 ? (is_ret ? U_RET_Y : U_NSA_Y) : U_FFN_Y));
                const float* modN = (sub == 2) ? (layer + 1 < DEPTH ? modL + (size_t)16 * MODW : modL) : modL;
                const int shc = (sub == 2) ? 0 : (sub + 1) * 3;
                phase_ln(p.out, p.out, y, modL + (sub * 3 + 2) * 1024, sub == 1 ? 1.0f : 0.5f, p.ln_g + (size_t)(layer * 3 + sub) * 1024, p.ln_b + (size_t)(layer * 3 + sub) * 1024,
                         modN + shc * 1024, modN + (shc + 1) * 1024, H);
            } else if (is_ret) {
                const bf16_t* Wi = (const bf16_t*)(ws + OFF_RET_IN + (size_t)jm * SZ_RET_IN);
                if (st == 3) { d[0] = GemmDesc{H, Wi, (bf16_t*)(U + U_RET_QKV), MTOK, 4096, 1024, 4096, 0, 0}; ng = 1; }
                else if (st == 4) { for (int rr = 0; rr < R_CORE; ++rr) phase_ret_core((const bf16_t*)(U + U_RET_QKV), (bf16_t*)(U + U_RET_O), lds); }
                else if (st == 5) { d[0] = GemmDesc{H, Wi + (size_t)4096 * 1024, (bf16_t*)(U + U_RET_G), MTOK, 2048, 1024, 2048, 0, 0}; ng = 1; }
                else if (st == 6) phase_ret_gate((bf16_t*)(U + U_RET_O), (const bf16_t*)(U + U_RET_G));
                else if (st == 7) { d[0] = GemmDesc{(const bf16_t*)(U + U_RET_O), (const bf16_t*)(ws + OFF_RET_OUT + (size_t)jm * SZ_RET_OUT), (bf16_t*)(U + U_RET_Y), MTOK, 1024, 2048, 1024, 0, 0}; ng = 1; }
                else continue;
            } else {
                if (st == 3) { d[0] = GemmDesc{H, (const bf16_t*)(ws + OFF_NSA_IN + (size_t)jm * SZ_NSA_IN), (bf16_t*)(U + U_NSA_PROJ), MTOK, 2816, 1024, 2816, 0, 0}; ng = 1; }
                else if (st == 4) phase_nsa_mat((const bf16_t*)(U + U_NSA_PROJ), p.pe_k + (size_t)jm * 2048, p.pe_v + (size_t)jm * 2048, (bf16_t*)(U + U_NSA_ACMPK), (bf16_t*)(U + U_NSA_ACMPV));
                else if (st == 5) {
                    d[0] = GemmDesc{(const bf16_t*)(U + U_NSA_ACMPK), (const bf16_t*)(ws + OFF_W1 + (size_t)(0 * 2 + jm) * SZ_W1), (bf16_t*)(U + U_NSA_HK), 8192, 256, 2048, 256, 2, 0};
                    d[1] = GemmDesc{(const bf16_t*)(U + U_NSA_ACMPV), (const bf16_t*)(ws + OFF_W1 + (size_t)(1 * 2 + jm) * SZ_W1), (bf16_t*)(U + U_NSA_HV), 8192, 256, 2048, 256, 2, 32}; ng = 2;
                } else if (st == 6) phase_nsa_cmp2((const bf16_t*)(U + U_NSA_HK), (const bf16_t*)(U + U_NSA_HV), (const bf16_t*)(ws + OFF_W2 + (size_t)(0 * 2 + jm) * SZ_W2), (const bf16_t*)(ws + OFF_W2 + (size_t)(1 * 2 + jm) * SZ_W2),
                                               (bf16_t*)(U + U_NSA_KCMP), (bf16_t*)(U + U_NSA_VCMP));
                else if (st == 7) { for (int rr = 0; rr < R_ATTN; ++rr) phase_nsa_attn64((const bf16_t*)(U + U_NSA_PROJ), (const bf16_t*)(U + U_NSA_KCMP), (const bf16_t*)(U + U_NSA_VCMP), (bf16_t*)(U + U_NSA_OATT), lds); }
                else { d[0] = GemmDesc{(const bf16_t*)(U + U_NSA_OATT), (const bf16_t*)(ws + OFF_NSA_OUT + (size_t)jm * SZ_NSA_OUT), (bf16_t*)(U + U_NSA_Y), MTOK, 1024, 1024, 1024, 0, 0}; ng = 1; }
            }
            for (int rr = 0; rr < R_GEMM; ++rr) for (int r = 0; r < ng; ++r) { GemmDesc dd = d[0]; if (r == 1) dd = d[1]; run_gemm(dd, lds); }
        }
        }
        xcd_barrier(xbar);
    }
}

extern "C" void kernel_launch(void* const* d_in, const int* in_sizes, int n_in, void* d_out, int out_size, void* d_ws, size_t ws_size, hipStream_t stream) {
    static int grid_blocks = 0;
    if (grid_blocks == 0) {
        int dev = 0, cus = 0, per_cu = 0;
        hipGetDevice(&dev); hipDeviceGetAttribute(&cus, hipDeviceAttributeMultiprocessorCount, dev);
        if (hipFuncSetAttribute((const void*)fwd_megakernel, hipFuncAttributeMaxDynamicSharedMemorySize, LDS_BYTES) != hipSuccess) fprintf(stderr, "hipFuncSetAttribute failed\n");
        if (hipOccupancyMaxActiveBlocksPerMultiprocessor(&per_cu, (const void*)fwd_megakernel, NTHR, LDS_BYTES) != hipSuccess || per_cu < 1) { fprintf(stderr, "occupancy query: %d\n", per_cu); per_cu = 1; }
        (void)hipGetLastError();
        grid_blocks = cus * 1;
        if (ws_size < WS_END + 16384) fprintf(stderr, "workspace too small: %zu < %zu\n", ws_size, (size_t)WS_END);
    }
    Params p{};
    p.x = (const float*)d_in[0]; p.c = (const float*)d_in[1]; p.ada_w = (const float*)d_in[2]; p.ada_b = (const float*)d_in[3]; p.ln_g = (const float*)d_in[4]; p.ln_b = (const float*)d_in[5];
    p.pe_k = (const float*)d_in[12]; p.pe_v = (const float*)d_in[13]; p.out = (float*)d_out; p.ws = (unsigned char*)d_ws;
    unsigned char* ws = (unsigned char*)d_ws; int nj = 0, te = 0;
    auto add = [&](const float* src, size_t dst_off, int K, int N, int Np, int mode) { p.jobs[nj] = WJob{src, (bf16_t*)(ws + dst_off), K, N, Np, mode}; te += (Np / 64) * (K / 64); p.tile_end[nj] = te; ++nj; };
    const float* ffn_in = (const float*)d_in[6]; const float* ffn_out = (const float*)d_in[7]; const float* ret_in = (const float*)d_in[8]; const float* ret_out = (const float*)d_in[9];
    const float* nsa_in = (const float*)d_in[10]; const float* nsa_out = (const float*)d_in[11];
    const float* ck1 = (const float*)d_in[14]; const float* ck2 = (const float*)d_in[15]; const float* cv1 = (const float*)d_in[16]; const float* cv2 = (const float*)d_in[17];
    for (int i = 0; i < 8; ++i) add(ffn_in + (size_t)i * 1024 * 5632, OFF_FFN_IN + i * SZ_FFN_IN, 1024, 5632, 5632, 1);
    for (int i = 0; i < 8; ++i) add(ffn_out + (size_t)i * 2816 * 1024, OFF_FFN_OUT + i * SZ_FFN_OUT, 2816, 1024, 1024, 0);
    for (int i = 0; i < 2; ++i) add(ret_in + (size_t)i * 1024 * 6144, OFF_RET_IN + i * SZ_RET_IN, 1024, 6144, 6144, 0);
    for (int i = 0; i < 2; ++i) add(ret_out + (size_t)i * 2048 * 1024, OFF_RET_OUT + i * SZ_RET_OUT, 2048, 1024, 1024, 0);
    for (int i = 0; i < 2; ++i) add(nsa_in + (size_t)i * 1024 * 2608, OFF_NSA_IN + i * SZ_NSA_IN, 1024, 2608, 2816, 0);
    for (int i = 0; i < 2; ++i) add(nsa_out + (size_t)i * 1024 * 1024, OFF_NSA_OUT + i * SZ_NSA_OUT, 1024, 1024, 1024, 0);
    for (int i = 0; i < 2; ++i) add(ck1 + (size_t)i * 2048 * 256, OFF_W1 + (0 * 2 + i) * SZ_W1, 2048, 256, 256, 0);
    for (int i = 0; i < 2; ++i) add(cv1 + (size_t)i * 2048 * 256, OFF_W1 + (1 * 2 + i) * SZ_W1, 2048, 256, 256, 0);
    for (int i = 0; i < 2; ++i) add(ck2 + (size_t)i * 256 * 64, OFF_W2 + (0 * 2 + i) * SZ_W2, 256, 64, 64, 0);
    for (int i = 0; i < 2; ++i) add(cv2 + (size_t)i * 256 * 64, OFF_W2 + (1 * 2 + i) * SZ_W2, 256, 64, 64, 0);
    p.njobs = nj;
    if (hipMemsetAsync(ws + WS_END, 0, 16384, stream) != hipSuccess) fprintf(stderr, "barrier memset failed\n");
    void* args[] = {&p};
    hipError_t e = hipLaunchCooperativeKernel((const void*)fwd_megakernel, dim3(grid_blocks), dim3(NTHR), args, LDS_BYTES, stream);
    if (e != hipSuccess) fprintf(stderr, "cooperative launch failed: %s (grid %d)\n", hipGetErrorString(e), grid_blocks);
}
```

```cpp
#include <hip/hip_runtime.h>
#include <hip/hip_cooperative_groups.h>
#include <cstdio>
namespace cg = cooperative_groups;

namespace pg8 {
#define PG8_LAS __attribute__((address_space(3)))
typedef unsigned short bf16_t;
typedef short bf16x8 __attribute__((ext_vector_type(8)));
typedef float f32x4 __attribute__((ext_vector_type(4)));
typedef unsigned u32x4 __attribute__((ext_vector_type(4)));
constexpr int BM = 256, BK = 64, HALF = 128, HTB = HALF * BK * 2  , STAGE_BYTES = 8 * HTB, NXCD = 8, WGM = 8;

__host__ __device__ __forceinline__ int lds_byte(int r, int c) { const int st = (r >> 4) * 2 + (c >> 5), rr = r & 15, cc = c & 31, ob = rr * 64 + cc * 2; return st * 1024 + (ob ^ (((ob >> 9) & 1) << 5)); }
__host__ __device__ __forceinline__ void stage_rc(int b, int& R, int& C) { const int st = b / 1024, sb = b % 1024, swz = sb ^ (((sb >> 9) & 1) << 5); R = (st >> 1) * 16 + swz / 64; C = (st & 1) * 32 + (swz % 64) / 2; }
__host__ __device__ __forceinline__ int perm32(int rho) { const int n = rho >> 4, i = rho & 15; return 8 * (i >> 2) + 4 * n + (i & 3); }

struct Unit { int pm, pn; };
struct Gemm { const bf16_t* A; const bf16_t* Bt; int M, N, K; };

struct StaticOrder {
    int nM, nN, nwg, G, c;
    __host__ __device__ void init(int M, int N, int G_, int c_) { nM = M / BM; nN = N / BM; nwg = nM * nN; G = G_; c = c_; }
    __host__ __device__ bool next(int i, Unit& u) const {
        const long L = (long)i * G + c; if (L >= nwg) return false;
        int wgid = (int)L; { const int q = nwg / NXCD, r = nwg % NXCD, xcd = wgid % NXCD, off = wgid / NXCD; wgid = (xcd < r ? xcd * (q + 1) : r * (q + 1) + (xcd - r) * q) + off; }
        const int nig = WGM * nN, gid = wgid / nig, fm = gid * WGM, gsz = (nM - fm) < WGM ? (nM - fm) : WGM;
        u.pm = fm + ((wgid % nig) % gsz); u.pn = (wgid % nig) / gsz; return true;
    }
    __device__ __forceinline__ void a_ready(const Unit&) const {}
    __device__ __forceinline__ void done(const Unit&) const {}
};

typedef float f32x2_t __attribute__((ext_vector_type(2)));
typedef __bf16 bf16x2_t __attribute__((ext_vector_type(2)));
__device__ __forceinline__ unsigned cvt_pk_bf16(float lo, float hi) { const f32x2_t v = {lo, hi}; return __builtin_bit_cast(unsigned, __builtin_convertvector(v, bf16x2_t)); }
__device__ __forceinline__ float silu_f(float a) { return a * __builtin_amdgcn_rcpf(1.0f + __builtin_amdgcn_exp2f(-1.44269504089f * a)); }
__device__ __forceinline__ float gelu_tanh_f(float x) { const float u = 0.7978845608028654f * (x + 0.044715f * x * x * x); const float t = 1.0f - 2.0f * __builtin_amdgcn_rcpf(1.0f + __builtin_amdgcn_exp2f(2.88539008178f * u)); return 0.5f * x * (1.0f + t); }

template <int ACT> struct Epi {
    static constexpr bool PERM = true, AFTER_DRAIN = false;
    bf16_t* O; int ldc; const float* stats;
    __device__ __forceinline__ void operator()(const f32x4 (&acc)[2][2][4][2], const Unit& u, int wr, int wc, int fr, int fq) const {
        const int row0 = u.pm * BM + wr * 64 + fr;
        if (ACT == 3) {
            const int hh = u.pn >> 1, col0 = u.pn * BM + wc * 32 + 8 * fq;
#pragma unroll
            for (int ai = 0; ai < 2; ++ai)
#pragma unroll
                for (int m = 0; m < 4; ++m) { const int r = row0 + ai * HALF + m * 16;
                    const f32x4* sp = (const f32x4*)(stats + ((size_t)r * 4 + hh) * 16);
                    const f32x4 s0 = sp[0], s1 = sp[1], s2 = sp[2], s3 = sp[3];
                    const float sm = ((s0[0] + s0[2]) + (s1[0] + s1[2])) + ((s2[0] + s2[2]) + (s3[0] + s3[2])), sq = ((s0[1] + s0[3]) + (s1[1] + s1[3])) + ((s2[1] + s2[3]) + (s3[1] + s3[3]));
                    const float mu = sm * (1.0f / 512.0f), rstd = rsqrtf(fmaxf(sq * (1.0f / 512.0f) - mu * mu, 0.f) + 1e-6f);
                    bf16_t* rowp = O + (size_t)r * ldc + col0;
#pragma unroll
                    for (int bj = 0; bj < 2; ++bj) { const u32x4 ov = *(const u32x4*)(rowp + bj * HALF); const f32x4 g0 = acc[ai][bj][m][0], g1 = acc[ai][bj][m][1];
                        u32x4 w;
                        w.x = cvt_pk_bf16((__uint_as_float(ov.x << 16) - mu) * rstd * silu_f(g0[0]), (__uint_as_float(ov.x & 0xffff0000u) - mu) * rstd * silu_f(g0[1]));
                        w.y = cvt_pk_bf16((__uint_as_float(ov.y << 16) - mu) * rstd * silu_f(g0[2]), (__uint_as_float(ov.y & 0xffff0000u) - mu) * rstd * silu_f(g0[3]));
                        w.z = cvt_pk_bf16((__uint_as_float(ov.z << 16) - mu) * rstd * silu_f(g1[0]), (__uint_as_float(ov.z & 0xffff0000u) - mu) * rstd * silu_f(g1[1]));
                        w.w = cvt_pk_bf16((__uint_as_float(ov.w << 16) - mu) * rstd * silu_f(g1[2]), (__uint_as_float(ov.w & 0xffff0000u) - mu) * rstd * silu_f(g1[3]));
                        *(u32x4*)(rowp + bj * HALF) = w; } }
            return;
        }
        if (ACT == 1) {
            const int col0 = u.pn * HALF + wc * 32 + 8 * fq;
#pragma unroll
            for (int ai = 0; ai < 2; ++ai)
#pragma unroll
                for (int m = 0; m < 4; ++m) { bf16_t* rowp = O + (size_t)(row0 + ai * HALF + m * 16) * ldc + col0;
                    const f32x4 a0 = acc[ai][0][m][0], a1 = acc[ai][0][m][1], u0 = acc[ai][1][m][0], u1 = acc[ai][1][m][1];
                    u32x4 w; w.x = cvt_pk_bf16(silu_f(a0[0]) * u0[0], silu_f(a0[1]) * u0[1]); w.y = cvt_pk_bf16(silu_f(a0[2]) * u0[2], silu_f(a0[3]) * u0[3]);
                    w.z = cvt_pk_bf16(silu_f(a1[0]) * u1[0], silu_f(a1[1]) * u1[1]); w.w = cvt_pk_bf16(silu_f(a1[2]) * u1[2], silu_f(a1[3]) * u1[3]);
                    *(u32x4*)rowp = w; }
        } else {
            const int col0 = u.pn * BM + wc * 32 + 8 * fq;
#pragma unroll
            for (int ai = 0; ai < 2; ++ai)
#pragma unroll
                for (int m = 0; m < 4; ++m) { bf16_t* rowp = O + (size_t)(row0 + ai * HALF + m * 16) * ldc + col0;
#pragma unroll
                    for (int bj = 0; bj < 2; ++bj) { f32x4 v0 = acc[ai][bj][m][0], v1 = acc[ai][bj][m][1];
                        if (ACT == 2) {
#pragma unroll
                            for (int j = 0; j < 4; ++j) { v0[j] = gelu_tanh_f(v0[j]); v1[j] = gelu_tanh_f(v1[j]); } }
                        u32x4 w; w.x = cvt_pk_bf16(v0[0], v0[1]); w.y = cvt_pk_bf16(v0[2], v0[3]); w.z = cvt_pk_bf16(v1[0], v1[1]); w.w = cvt_pk_bf16(v1[2], v1[3]);
                        *(u32x4*)(rowp + bj * HALF) = w; } }
        }
    }
};

template <class Epi, class Sched, bool ALIGN_EPI = false, bool SP2 = false>
__device__ __forceinline__ void gemm_phase(PG8_LAS unsigned char* lds, const Gemm g, const Sched& S, const Epi& E) {
    const int tid = threadIdx.x, wid = __builtin_amdgcn_readfirstlane(tid >> 6), lane = tid & 63, wr = wid >> 2, wc = wid & 3, fr = lane & 15, fq = lane >> 4;
    const int K = g.K, nt = K / BK;
    unsigned voffA[2], voffB[2];
#pragma unroll
    for (int i = 0; i < 2; ++i) { int R, C; stage_rc(tid * 16 + i * 8192, R, C); const int Rb = Epi::PERM ? ((R & ~31) + perm32(R & 31)) : R;
        voffA[i] = (unsigned)(R * K + C) * 2u; voffB[i] = (unsigned)(Rb * K + C) * 2u; }
    const size_t kstep = (size_t)(BK * 2);
    const size_t hstep = (size_t)HALF * K * 2;
    const size_t tstep = 2 * hstep;
    const unsigned ldsw = (unsigned)wid * 1024u;
    const int aoff = lds_byte(wr * 64 + fr, fq * 8), boff = lds_byte(wc * 32 + fr, fq * 8);
#define PG8_SA(b, h) (((b) * 2 + (h)) * HTB)
#define PG8_SB(b, h) ((4 + (b) * 2 + (h)) * HTB)
#define PG8_STAGE(bufoff, gbase, voff) do { _Pragma("unroll") for (int _i = 0; _i < 2; ++_i) \
        __builtin_amdgcn_global_load_lds((const unsigned*)((const char*)(gbase) + (voff)[_i]), (PG8_LAS unsigned*)(lds + (bufoff) + ldsw + _i * 8192), 16, 0, 0); } while (0)
#define PG8_LDA(dst, b, h) do { _Pragma("unroll") for (int m = 0; m < 4; ++m) _Pragma("unroll") for (int k = 0; k < 2; ++k) dst[m][k] = *(const PG8_LAS bf16x8*)(lds + PG8_SA(b, h) + aoff + m * 2048 + k * 1024); } while (0)
#define PG8_LDB(dst, b, h) do { _Pragma("unroll") for (int n = 0; n < 2; ++n) _Pragma("unroll") for (int k = 0; k < 2; ++k) dst[n][k] = *(const PG8_LAS bf16x8*)(lds + PG8_SB(b, h) + boff + n * 2048 + k * 1024); } while (0)
#define PG8_MMA(ai, bj, At, Bt) do { __builtin_amdgcn_s_setprio(1); _Pragma("unroll") for (int m = 0; m < 4; ++m) _Pragma("unroll") for (int n = 0; n < 2; ++n) _Pragma("unroll") for (int k = 0; k < 2; ++k) \
        acc[ai][bj][m][n] = __builtin_amdgcn_mfma_f32_16x16x32_bf16(Bt[n][k], At[m][k], acc[ai][bj][m][n], 0, 0, 0); __builtin_amdgcn_s_setprio(0); } while (0)
#define PG8_WAIT_V(n) asm volatile("s_waitcnt vmcnt(" #n ")" ::: "memory")
#define PG8_WAIT_L(n) asm volatile("s_waitcnt lgkmcnt(" #n ")" ::: "memory")
#define PG8_BAR __builtin_amdgcn_s_barrier()
#define PG8_SCHED __builtin_amdgcn_sched_barrier(0)
    Unit cur, nxt; int ui = 0;
    if (!S.next(0, cur)) return;
    f32x4 acc[2][2][4][2];
#pragma unroll
    for (int a = 0; a < 2; ++a)
#pragma unroll
        for (int b = 0; b < 2; ++b)
#pragma unroll
            for (int m = 0; m < 4; ++m)
#pragma unroll
                for (int n = 0; n < 2; ++n) acc[a][b][m][n] = (f32x4){0.f, 0.f, 0.f, 0.f};
    bf16x8 At[4][2], B0[2][2], B1[2][2];
    const char* cA = (const char*)g.A + (size_t)cur.pm * tstep; const char* cB = (const char*)g.Bt + (size_t)cur.pn * tstep;
    S.a_ready(cur);
    if constexpr (SP2) {
        PG8_STAGE(PG8_SB(0, 0), cB, voffB); PG8_STAGE(PG8_SB(0, 1), cB + hstep, voffB); PG8_STAGE(PG8_SA(0, 0), cA, voffA); PG8_STAGE(PG8_SA(0, 1), cA + hstep, voffA);
        if (wr == 1) PG8_BAR;
        PG8_WAIT_V(2); PG8_BAR;
        PG8_STAGE(PG8_SB(1, 0), cB + kstep, voffB); PG8_STAGE(PG8_SA(1, 0), cA + kstep, voffA); PG8_STAGE(PG8_SB(1, 1), cB + hstep + kstep, voffB);
        PG8_WAIT_V(6); PG8_BAR;
    } else {
        PG8_STAGE(PG8_SB(0, 0), cB, voffB); PG8_STAGE(PG8_SA(0, 0), cA, voffA); PG8_STAGE(PG8_SB(0, 1), cB + hstep, voffB); PG8_STAGE(PG8_SA(0, 1), cA + hstep, voffA);
        if (wr == 1) PG8_BAR;
        PG8_WAIT_V(4); PG8_BAR;
        PG8_STAGE(PG8_SB(1, 0), cB + kstep, voffB); PG8_STAGE(PG8_SA(1, 0), cA + kstep, voffA); PG8_STAGE(PG8_SB(1, 1), cB + hstep + kstep, voffB);
        PG8_WAIT_V(6); PG8_BAR;
    }
    for (;;) {
        const bool has_next = S.next(ui + 1, nxt);
        const char* nA = has_next ? (const char*)g.A + (size_t)nxt.pm * tstep : cA; const char* nB = has_next ? (const char*)g.Bt + (size_t)nxt.pn * tstep : cB;
        for (int t = 0; t < nt; t += 2) {
            const bool last = (t == nt - 2);
            const char* a1 = cA + (size_t)(t + 1) * kstep;
            const char* a2 = last ? nA : cA + (size_t)(t + 2) * kstep; const char* b2 = last ? nB : cB + (size_t)(t + 2) * kstep;
            const char* a3 = a2 + kstep; const char* b3 = b2 + kstep;
            if (last && has_next) S.a_ready(nxt);
            if constexpr (SP2) {
            PG8_LDB(B0, 0, 0); PG8_LDB(B1, 0, 1); PG8_SCHED; PG8_LDA(At, 0, 0); PG8_STAGE(PG8_SA(1, 1), a1 + hstep, voffA);
            PG8_WAIT_V(8); PG8_WAIT_L(0); PG8_BAR; PG8_MMA(0, 0, At, B0); PG8_MMA(0, 1, At, B1); PG8_BAR; PG8_SCHED;
            PG8_LDA(At, 0, 1); PG8_STAGE(PG8_SB(0, 0), b2, voffB); PG8_STAGE(PG8_SB(0, 1), b2 + hstep, voffB); PG8_STAGE(PG8_SA(0, 0), a2, voffA);
            PG8_WAIT_V(8); PG8_WAIT_L(0); PG8_BAR; PG8_MMA(1, 0, At, B0); PG8_MMA(1, 1, At, B1); PG8_BAR; PG8_SCHED;
            PG8_LDB(B0, 1, 0); PG8_LDB(B1, 1, 1); PG8_SCHED; PG8_LDA(At, 1, 0); PG8_STAGE(PG8_SA(0, 1), a2 + hstep, voffA);
            PG8_WAIT_V(8); PG8_WAIT_L(0); PG8_BAR; PG8_MMA(0, 0, At, B0); PG8_MMA(0, 1, At, B1); PG8_BAR; PG8_SCHED;
            PG8_LDA(At, 1, 1); PG8_STAGE(PG8_SB(1, 0), b3, voffB); PG8_STAGE(PG8_SB(1, 1), b3 + hstep, voffB); PG8_STAGE(PG8_SA(1, 0), a3, voffA);
            PG8_WAIT_V(8); PG8_WAIT_L(0); PG8_BAR; PG8_MMA(1, 0, At, B0); PG8_MMA(1, 1, At, B1); PG8_BAR; PG8_SCHED;
            } else {
            PG8_LDB(B0, 0, 0); PG8_SCHED; PG8_LDA(At, 0, 0); PG8_STAGE(PG8_SA(1, 1), a1 + hstep, voffA);
            PG8_WAIT_L(8); PG8_BAR; PG8_WAIT_L(0); PG8_MMA(0, 0, At, B0); PG8_BAR; PG8_SCHED;
            PG8_LDB(B1, 0, 1); PG8_STAGE(PG8_SB(0, 0), b2, voffB);
            PG8_BAR; PG8_WAIT_L(0); PG8_MMA(0, 1, At, B1); PG8_BAR;
            PG8_LDA(At, 0, 1); PG8_STAGE(PG8_SA(0, 0), a2, voffA);
            PG8_BAR; PG8_WAIT_L(0); PG8_MMA(1, 0, At, B0); PG8_BAR; PG8_SCHED;
            PG8_STAGE(PG8_SB(0, 1), b2 + hstep, voffB);
            PG8_WAIT_V(6); PG8_BAR; PG8_MMA(1, 1, At, B1); PG8_BAR;
            PG8_LDB(B0, 1, 0); PG8_SCHED; PG8_LDA(At, 1, 0); PG8_STAGE(PG8_SA(0, 1), a2 + hstep, voffA);
            PG8_WAIT_L(8); PG8_BAR; PG8_WAIT_L(0); PG8_MMA(0, 0, At, B0); PG8_BAR; PG8_SCHED;
            PG8_LDB(B1, 1, 1); PG8_STAGE(PG8_SB(1, 0), b3, voffB);
            PG8_BAR; PG8_WAIT_L(0); PG8_MMA(0, 1, At, B1); PG8_BAR;
            PG8_LDA(At, 1, 1); PG8_STAGE(PG8_SA(1, 0), a3, voffA);
            PG8_BAR; PG8_WAIT_L(0); PG8_MMA(1, 0, At, B0); PG8_BAR; PG8_SCHED;
            PG8_STAGE(PG8_SB(1, 1), b3 + hstep, voffB);
            PG8_WAIT_V(6); PG8_BAR; PG8_MMA(1, 1, At, B1); PG8_BAR;
            }
        }
        if constexpr (ALIGN_EPI) { if (wr == 0) PG8_BAR; }
        if constexpr (!Epi::AFTER_DRAIN) { E(acc, cur, wr, wc, fr, fq); S.done(cur); }
        if (!has_next) break;
#pragma unroll
        for (int a = 0; a < 2; ++a)
#pragma unroll
            for (int b = 0; b < 2; ++b)
#pragma unroll
                for (int m = 0; m < 4; ++m)
#pragma unroll
                    for (int n = 0; n < 2; ++n) acc[a][b][m][n] = (f32x4){0.f, 0.f, 0.f, 0.f};
        cur = nxt; cA = nA; cB = nB; ++ui;
        if constexpr (ALIGN_EPI) { if (wr == 1) PG8_BAR; }
    }
    PG8_WAIT_V(0);
    if constexpr (!ALIGN_EPI) { if (wr == 0) PG8_BAR; }
    PG8_BAR;
    if constexpr (Epi::AFTER_DRAIN) { E.fused(acc, cur, wr, wc, fr, fq, lds, wid, lane); S.done(cur); }
#undef PG8_SA
#undef PG8_SB
#undef PG8_STAGE
#undef PG8_LDA
#undef PG8_LDB
#undef PG8_MMA
#undef PG8_WAIT_V
#undef PG8_WAIT_L
#undef PG8_BAR
#undef PG8_SCHED
}
}

using pg8::bf16_t; using pg8::bf16x8; using pg8::f32x4; using pg8::u32x4; using pg8::cvt_pk_bf16; using pg8::silu_f;
#define LAS __attribute__((address_space(3)))
typedef unsigned u32x2 __attribute__((ext_vector_type(2)));
typedef short s16x4 __attribute__((ext_vector_type(4)));
#define MFMA16(a, b, c) __builtin_amdgcn_mfma_f32_16x16x32_bf16((a), (b), (c), 0, 0, 0)

constexpr int NTHR = 512;
constexpr int MTOK = 32768, DM = 1024, SEQ = 2048, DFF = 2816, DEPTH = 4, MODW = 9216;
constexpr float DN_ALPHA = 1.6817928305074290861f;
constexpr size_t MiB = (size_t)1 << 20;
constexpr size_t SZ_FFN_IN = (size_t)5632 * 1024 * 2, SZ_FFN_OUT = (size_t)1024 * 2816 * 2, SZ_RET_IN = (size_t)6144 * 1024 * 2, SZ_RET_OUT = (size_t)1024 * 2048 * 2,
                 SZ_NSA_IN = (size_t)2816 * 1024 * 2, SZ_NSA_OUT = (size_t)1024 * 1024 * 2, SZ_W1 = (size_t)256 * 2048 * 2, SZ_W2 = (size_t)64 * 256 * 2;
constexpr size_t OFF_FFN_IN = 0, OFF_FFN_OUT = OFF_FFN_IN + 8 * SZ_FFN_IN, OFF_RET_IN = OFF_FFN_OUT + 8 * SZ_FFN_OUT, OFF_RET_OUT = OFF_RET_IN + 2 * SZ_RET_IN,
                 OFF_NSA_IN = OFF_RET_OUT + 2 * SZ_RET_OUT, OFF_NSA_OUT = OFF_NSA_IN + 2 * SZ_NSA_IN, OFF_W1 = OFF_NSA_OUT + 2 * SZ_NSA_OUT, OFF_W2 = OFF_W1 + 4 * SZ_W1,
                 OFF_MOD = OFF_W2 + 4 * SZ_W2, OFF_H = OFF_MOD + (size_t)DEPTH * 16 * MODW * 4, OFF_U2 = OFF_H + (size_t)MTOK * DM * 2, WS_END = OFF_U2 + 384 * MiB;
constexpr size_t U_FFN_ACT = 0, U_FFN_Y = 192 * MiB;
constexpr size_t U_RET_QKV = 0, U_RET_G = 0, U_RET_O = 256 * MiB, U_RET_Y = 128 * MiB;
constexpr size_t U_NSA_PROJ = 0, U_NSA_Y = 192 * MiB, U_NSA_ACMPK = 256 * MiB, U_NSA_ACMPV = 288 * MiB, U_NSA_HK = 320 * MiB, U_NSA_HV = 324 * MiB, U_NSA_KCMP = 328 * MiB, U_NSA_VCMP = 329 * MiB, U_NSA_OATT = 256 * MiB;
constexpr int XB_LDS_OFF = 152 * 1024, LDS_BYTES = 152 * 1024 + 16;

struct WJob { const float* src; bf16_t* dst; int K, N, Np, mode; };
struct Params {
    const float* x; const float* c; const float* ada_w; const float* ada_b; const float* ln_g; const float* ln_b; const float* pe_k; const float* pe_v;
    float* out; unsigned char* ws;
    WJob jobs[32]; int tile_end[32]; int njobs; int pad;
};

__device__ __forceinline__ float bf2f(unsigned short b) { return __uint_as_float(((unsigned)b) << 16); }
__device__ __forceinline__ float bflo(unsigned w) { return __uint_as_float(w << 16); }
__device__ __forceinline__ float bfhi(unsigned w) { return __uint_as_float(w & 0xffff0000u); }
__device__ __forceinline__ unsigned short f2bf(float f) { return (unsigned short)(cvt_pk_bf16(f, 0.f) & 0xffffu); }
__device__ __forceinline__ bf16x8 pack8(const f32x4& a, const f32x4& b) { u32x4 w; w.x = cvt_pk_bf16(a[0], a[1]); w.y = cvt_pk_bf16(a[2], a[3]); w.z = cvt_pk_bf16(b[0], b[1]); w.w = cvt_pk_bf16(b[2], b[3]); return __builtin_bit_cast(bf16x8, w); }
__device__ __forceinline__ u32x2 pack4(const f32x4& a) { u32x2 w; w.x = cvt_pk_bf16(a[0], a[1]); w.y = cvt_pk_bf16(a[2], a[3]); return w; }
__device__ __forceinline__ bf16x8 lds_rd16(LAS unsigned char* lds, int off) { return *(const LAS bf16x8*)(lds + off); }
__device__ __forceinline__ bf16x8 lds_rd8x2(LAS unsigned char* lds, int off) { const s16x4 lo = *(const LAS s16x4*)(lds + off), hi = *(const LAS s16x4*)(lds + off + 32); return __builtin_shufflevector(lo, hi, 0, 1, 2, 3, 4, 5, 6, 7); }
template <int M> __device__ __forceinline__ float shx(float v, int lane) {
    if (M < 32) return __int_as_float(__builtin_amdgcn_ds_swizzle(__float_as_int(v), (M << 10) | 0x1f));
    return __int_as_float(__builtin_amdgcn_ds_bpermute((lane ^ M) << 2, __float_as_int(v)));
}
template <int M> __device__ __forceinline__ unsigned shxu(unsigned v, int lane) {
    if (M < 32) return (unsigned)__builtin_amdgcn_ds_swizzle((int)v, (M << 10) | 0x1f);
    return (unsigned)__builtin_amdgcn_ds_bpermute((lane ^ M) << 2, (int)v);
}
__device__ __forceinline__ float shi(float v, int src_lane) { return __int_as_float(__builtin_amdgcn_ds_bpermute(src_lane << 2, __float_as_int(v))); }
__device__ __forceinline__ float wsum(float v, int lane) { v += shx<32>(v, lane); v += shx<16>(v, lane); v += shx<8>(v, lane); v += shx<4>(v, lane); v += shx<2>(v, lane); v += shx<1>(v, lane); return v; }

struct WTile { const float* src; bf16_t* dst; int N, K, sbase, n0, k0; };
__device__ __forceinline__ WTile wt_lookup(const Params& p, int t) {
    int j = 0; while (j < p.njobs - 1 && t >= p.tile_end[j]) ++j;
    const int tl = t - (j ? p.tile_end[j - 1] : 0);
    const WJob& J = p.jobs[j];
    const int ntn = J.Np >> 6; const int tn = tl % ntn, tk = tl / ntn; const int n0 = tn * 64, k0 = tk * 64;
    int sbase = n0; if (J.mode == 1) { const int pn = n0 >> 8, r = n0 & 255; sbase = (r >> 7) * DFF + pn * 128 + (r & 127); }
    return WTile{J.src, J.dst, J.N, J.K, sbase, n0, k0};
}
__device__ __forceinline__ void wt_load(const WTile& W, int tid, f32x4& v0, f32x4& v1) {
    const int kk = tid >> 4, nn = (tid & 15) * 4;
    v0 = (f32x4){0.f, 0.f, 0.f, 0.f}; v1 = v0;
    if (W.sbase + nn < W.N) { v0 = *(const f32x4*)(W.src + (size_t)(W.k0 + kk) * W.N + W.sbase + nn); v1 = *(const f32x4*)(W.src + (size_t)(W.k0 + kk + 32) * W.N + W.sbase + nn); }
}

__device__ __forceinline__ void phase_prep(const Params& p, LAS unsigned char* lds) {
    int tid = threadIdx.x; asm volatile("" : "+v"(tid));
    LAS float* T = (LAS float*)lds;
    const int ntiles = p.tile_end[p.njobs - 1];
    {
        int t = blockIdx.x;
        WTile cur = wt_lookup(p, t < ntiles ? t : 0); f32x4 v0, v1;
        if (t < ntiles) wt_load(cur, tid, v0, v1);
        while (t < ntiles) {
            const int tn = t + (int)gridDim.x; const bool more = tn < ntiles;
            WTile nx = wt_lookup(p, more ? tn : 0); f32x4 n0 = (f32x4){0.f, 0.f, 0.f, 0.f}, n1 = n0;
            if (more) wt_load(nx, tid, n0, n1);
            const int kk = tid >> 4, nn = (tid & 15) * 4;
            T[kk * 65 + nn] = v0[0]; T[kk * 65 + nn + 1] = v0[1]; T[kk * 65 + nn + 2] = v0[2]; T[kk * 65 + nn + 3] = v0[3];
            T[(kk + 32) * 65 + nn] = v1[0]; T[(kk + 32) * 65 + nn + 1] = v1[1]; T[(kk + 32) * 65 + nn + 2] = v1[2]; T[(kk + 32) * 65 + nn + 3] = v1[3];
            __syncthreads();
            const int n = tid >> 3, k8 = (tid & 7) * 8;
            f32x4 a, b;
            a[0] = T[(k8 + 0) * 65 + n]; a[1] = T[(k8 + 1) * 65 + n]; a[2] = T[(k8 + 2) * 65 + n]; a[3] = T[(k8 + 3) * 65 + n];
            b[0] = T[(k8 + 4) * 65 + n]; b[1] = T[(k8 + 5) * 65 + n]; b[2] = T[(k8 + 6) * 65 + n]; b[3] = T[(k8 + 7) * 65 + n];
            *(bf16x8*)(cur.dst + (size_t)(cur.n0 + n) * cur.K + cur.k0 + k8) = pack8(a, b);
            __syncthreads();
            cur = nx; v0 = n0; v1 = n1; t = tn;
        }
    }
    if (blockIdx.x < 288) {
        LAS float* cs = (LAS float*)lds;
        LAS float* red = (LAS float*)(lds + 65536);
        float* mod = (float*)(p.ws + OFF_MOD);
        __syncthreads();
        for (int idx = tid; idx < 16 * 1024; idx += NTHR) { const int b = idx >> 10, k = idx & 1023; const float cv = p.c[idx]; cs[k * 16 + b] = cv / (1.0f + expf(-cv)); }
        __syncthreads();
        for (int unit = blockIdx.x; unit < 288; unit += gridDim.x) {
            const int i = unit / 72, n0 = (unit % 72) * 128, col = tid & 127, kq = tid >> 7;
            f32x4 a0 = (f32x4){0.f, 0.f, 0.f, 0.f}, a1 = a0, a2 = a0, a3 = a0;
            const float* wp = p.ada_w + ((size_t)i * 1024 + kq * 256) * MODW + n0 + col;
#pragma unroll 4
            for (int k = 0; k < 256; ++k) { const float w = wp[(size_t)k * MODW]; const LAS f32x4* cp = (const LAS f32x4*)(cs + (kq * 256 + k) * 16);
                a0 += cp[0] * w; a1 += cp[1] * w; a2 += cp[2] * w; a3 += cp[3] * w; }
#pragma unroll
            for (int b = 0; b < 4; ++b) { red[(kq * 16 + b) * 128 + col] = a0[b]; red[(kq * 16 + 4 + b) * 128 + col] = a1[b]; red[(kq * 16 + 8 + b) * 128 + col] = a2[b]; red[(kq * 16 + 12 + b) * 128 + col] = a3[b]; }
            __syncthreads();
#pragma unroll
            for (int r = 0; r < 4; ++r) { const int o = tid + r * NTHR, b = o >> 7, cc = o & 127;
                const float s = red[(0 * 16 + b) * 128 + cc] + red[(1 * 16 + b) * 128 + cc] + red[(2 * 16 + b) * 128 + cc] + red[(3 * 16 + b) * 128 + cc] + p.ada_b[i * MODW + n0 + cc];
                mod[((size_t)i * 16 + b) * MODW + n0 + cc] = s; }
            __syncthreads();
        }
    }
}

__device__ __forceinline__ void phase_init(const Params& p) {
    const float* mod = (const float*)(p.ws + OFF_MOD); bf16_t* H = (bf16_t*)(p.ws + OFF_H);
    int tid = threadIdx.x; asm volatile("" : "+v"(tid));
    for (size_t i = (size_t)blockIdx.x * NTHR + tid; i < (size_t)MTOK * 256; i += (size_t)gridDim.x * NTHR) {
        const int row = (int)(i >> 8), c4 = (int)(i & 255) * 4, b = row >> 11;
        const f32x4 xv = *(const f32x4*)(p.x + i * 4); *(f32x4*)(p.out + i * 4) = xv;
        const float* m = mod + (size_t)b * MODW; const f32x4 sh = *(const f32x4*)(m + c4), sc = *(const f32x4*)(m + 1024 + c4);
        const f32x4 h = xv * (sc + 1.0f) + sh; *(u32x2*)(H + i * 4) = pack4(h);
    }
}

__device__ __forceinline__ void phase_ln(float* xio, float* xout, const bf16_t* y, const float* modG, float rw, const float* lng, const float* lnb, const float* modSh, const float* modSc, bf16_t* H) {
    int tid = threadIdx.x; asm volatile("" : "+v"(tid));
    const int wid = __builtin_amdgcn_readfirstlane(tid >> 6), lane = tid & 63;
    for (int row = blockIdx.x * 8 + wid; row < MTOK; row += gridDim.x * 8) {
        const int b = row >> 11; const size_t rb = (size_t)row * DM;
        f32x4 z[4]; float s = 0.f;
#pragma unroll
        for (int q = 0; q < 4; ++q) { const int c = q * 256 + lane * 4; const f32x4 xv = *(const f32x4*)(xio + rb + c); const u32x2 yv = *(const u32x2*)(y + rb + c);
            const f32x4 gt = *(const f32x4*)(modG + (size_t)b * MODW + c); const f32x4 yf = (f32x4){bflo(yv.x), bfhi(yv.x), bflo(yv.y), bfhi(yv.y)};
            z[q] = xv * DN_ALPHA + (gt + 1.0f) * yf * rw; s += (z[q][0] + z[q][1]) + (z[q][2] + z[q][3]); }
        const float mu = wsum(s, lane) * (1.0f / 1024.0f); float v = 0.f;
#pragma unroll
        for (int q = 0; q < 4; ++q) { const f32x4 d = z[q] - mu; v += (d[0] * d[0] + d[1] * d[1]) + (d[2] * d[2] + d[3] * d[3]); }
        const float rstd = rsqrtf(wsum(v, lane) * (1.0f / 1024.0f) + 1e-5f);
#pragma unroll
        for (int q = 0; q < 4; ++q) { const int c = q * 256 + lane * 4; const f32x4 g4 = *(const f32x4*)(lng + c), b4 = *(const f32x4*)(lnb + c);
            const f32x4 xn = (z[q] - mu) * rstd * g4 + b4; *(f32x4*)(xout + rb + c) = xn;
            const f32x4 sh = *(const f32x4*)(modSh + (size_t)b * MODW + c), sc = *(const f32x4*)(modSc + (size_t)b * MODW + c);
            *(u32x2*)(H + rb + c) = pack4(xn * (sc + 1.0f) + sh); }
    }
}

typedef short v4i16_t __attribute__((ext_vector_type(4)));
__device__ __forceinline__ s16x4 lds_tr8(LAS unsigned char* lds, int off) { return __builtin_bit_cast(s16x4, __builtin_amdgcn_ds_read_tr16_b64_v4i16((LAS v4i16_t*)(lds + off))); }

__device__ __forceinline__ bf16x8 lds_tr8x2(LAS unsigned char* lds, int off, int hi_off) { const s16x4 lo = lds_tr8(lds, off), hi = lds_tr8(lds, off + hi_off); return __builtin_shufflevector(lo, hi, 0, 1, 2, 3, 4, 5, 6, 7); }

__device__ __forceinline__ void phase_ret_core(const bf16_t* QKV, bf16_t* O, float* stats, LAS unsigned char* lds) {
    constexpr int KSB = 528, PS = 136, STS = 264, OFF_K = 0, OFF_P = 67584, OFF_VT = 102400, OFF_ST = 119808;
    int tid = threadIdx.x; asm volatile("" : "+v"(tid));
    const int wid = __builtin_amdgcn_readfirstlane(tid >> 6), lane = tid & 63, fr = lane & 15, fq = lane >> 4;
    for (int item = blockIdx.x; item < 512; item += gridDim.x) {
        const int es = item & 7, bh = item >> 3, hh = bh & 3, b = bh >> 2, e0 = es * 64;
        const float log_g = logf(1.0f - exp2f(-5.0f - (float)hh));
        const float gN = expf(log_g * 128.0f);
        const float l2g = log_g * 1.44269504089f;
        __syncthreads();
        for (int i = tid; i < 64 * STS / 2; i += NTHR) ((LAS unsigned*)(lds + OFF_ST))[i] = 0u;
        f32x4 sacc[2][4];
#pragma unroll
        for (int dt = 0; dt < 2; ++dt)
#pragma unroll
            for (int et = 0; et < 4; ++et) sacc[dt][et] = (f32x4){0.f, 0.f, 0.f, 0.f};
        bf16x8 kst[8], vst[2];
        {   const bf16_t* kp = QKV + ((size_t)b * SEQ + (tid >> 5)) * 4096 + 1024 + hh * 256 + (tid & 31) * 8;
#pragma unroll
            for (int it = 0; it < 8; ++it) kst[it] = *(const bf16x8*)(kp + (size_t)it * 16 * 4096);
            const bf16_t* vrow = QKV + ((size_t)b * SEQ + 2 * (tid & 63)) * 4096 + 2048 + hh * 512 + e0 + (tid >> 6) * 8;
            vst[0] = *(const bf16x8*)(vrow); vst[1] = *(const bf16x8*)(vrow + 4096); }
        bf16x8 qf[8];
        { const bf16_t* qrow = QKV + ((size_t)b * SEQ + wid * 16 + fr) * 4096 + hh * 256 + fq * 8;
#pragma unroll
          for (int ks = 0; ks < 8; ++ks) qf[ks] = *(const bf16x8*)(qrow + ks * 32); }
        for (int n = 0; n < 16; ++n) {
            const size_t tok0 = (size_t)b * SEQ + n * 128;
            int t2 = tid; asm volatile("" : "+v"(t2));
            const int lane = t2 & 63, fr = lane & 15, fq = lane >> 4;
            {
#pragma unroll
                for (int it = 0; it < 8; ++it) *(LAS bf16x8*)(lds + OFF_K + ((t2 >> 5) + 16 * it) * KSB + (t2 & 31) * 16) = kst[it];
                const int cp_ = t2 & 63, q_ = t2 >> 6;
#pragma unroll
                for (int i = 0; i < 8; ++i) *(LAS unsigned*)(lds + OFF_VT + ((q_ * 8 + i) * PS + 2 * cp_) * 2) = (unsigned)(unsigned short)vst[0][i] | ((unsigned)(unsigned short)vst[1][i] << 16);
            }
            if (n < 15) {
                const bf16_t* kp = QKV + (tok0 + 128 + (t2 >> 5)) * 4096 + 1024 + hh * 256 + (t2 & 31) * 8;
#pragma unroll
                for (int it = 0; it < 8; ++it) kst[it] = *(const bf16x8*)(kp + (size_t)it * 16 * 4096);
                const bf16_t* vrow = QKV + (tok0 + 128 + 2 * (t2 & 63)) * 4096 + 2048 + hh * 512 + e0 + (t2 >> 6) * 8;
                vst[0] = *(const bf16x8*)(vrow); vst[1] = *(const bf16x8*)(vrow + 4096); }
            __syncthreads();
            const int cc = wid * 16 + fr;
            const int npair = (wid >> 1) + 1;
            f32x4 a1[4], a2[4];
#pragma unroll
            for (int et = 0; et < 4; ++et) { a1[et] = (f32x4){0.f, 0.f, 0.f, 0.f}; a2[et] = a1[et]; }
            for (int cp2 = 0; cp2 < npair; ++cp2) {
                const int kb0 = OFF_K + (cp2 * 32 + fr) * KSB + fq * 16;
                f32x4 acc0 = (f32x4){0.f, 0.f, 0.f, 0.f}, acc1 = acc0;
#pragma unroll
                for (int ks = 0; ks < 8; ++ks) { acc0 = MFMA16(lds_rd16(lds, kb0 + ks * 64), qf[ks], acc0); acc1 = MFMA16(lds_rd16(lds, kb0 + 16 * KSB + ks * 64), qf[ks], acc1); }
                f32x4 pv0, pv1;
#pragma unroll
                for (int j = 0; j < 4; ++j) { const int cp = cp2 * 32 + fq * 4 + j;
                    pv0[j] = (cc >= cp) ? acc0[j] * 0.0625f * __builtin_amdgcn_exp2f(l2g * (float)(cc - cp)) : 0.f;
                    pv1[j] = (cc >= cp + 16) ? acc1[j] * 0.0625f * __builtin_amdgcn_exp2f(l2g * (float)(cc - cp - 16)) : 0.f; }
                const bf16x8 pf = pack8(pv0, pv1);
#pragma unroll
                for (int et = 0; et < 4; ++et) a1[et] = MFMA16(lds_rd8x2(lds, OFF_VT + ((et * 16 + fr) * PS + cp2 * 32 + fq * 4) * 2), pf, a1[et]);
            }
            {
#pragma unroll
                for (int ks = 0; ks < 8; ++ks)
#pragma unroll
                    for (int et = 0; et < 4; ++et) a2[et] = MFMA16(lds_rd16(lds, OFF_ST + ((et * 16 + fr) * STS + ks * 32 + fq * 8) * 2), qf[ks], a2[et]);
                const float dq = __builtin_amdgcn_exp2f(l2g * (float)(cc + 1));
                bf16_t* orow = O + (tok0 + cc) * 2048 + hh * 512 + e0 + fq * 4;
                float ssum = 0.f, ssq = 0.f;
#pragma unroll
                for (int et = 0; et < 4; ++et) { const f32x4 ov = a1[et] + a2[et] * dq; *(u32x2*)(orow + et * 16) = pack4(ov);
                    ssum += (ov[0] + ov[1]) + (ov[2] + ov[3]); ssq += (ov[0] * ov[0] + ov[1] * ov[1]) + (ov[2] * ov[2] + ov[3] * ov[3]); }
                ssum += shx<16>(ssum, lane); ssum += shx<32>(ssum, lane); ssq += shx<16>(ssq, lane); ssq += shx<32>(ssq, lane);
                if (fq == 0) { float* sp = stats + (((tok0 + cc) * 4 + hh) * 8 + es) * 2; sp[0] = ssum; sp[1] = ssq; }
            }
            if (n < 15) {
                const bf16_t* qrow = QKV + (tok0 + 128 + cc) * 4096 + hh * 256 + fq * 8;
#pragma unroll
                for (int ks = 0; ks < 8; ++ks) qf[ks] = *(const bf16x8*)(qrow + ks * 32); }
            __syncthreads();
            if (n < 15) {
#pragma unroll
                for (int dt = 0; dt < 2; ++dt)
#pragma unroll
                    for (int et = 0; et < 4; ++et) sacc[dt][et] *= gN;
                const int q4 = (lane & 15) >> 2, p4 = lane & 3;
                const float fbase = 0.0625f * __builtin_amdgcn_exp2f(l2g * (float)(127 - 8 * fq));
#pragma unroll
                for (int ks = 0; ks < 4; ++ks) {
                    bf16x8 vf[4];
#pragma unroll
                    for (int et = 0; et < 4; ++et) vf[et] = lds_rd16(lds, OFF_VT + ((et * 16 + fr) * PS + ks * 32 + fq * 8) * 2);
                    const float fks = fbase * __builtin_amdgcn_exp2f(l2g * (float)(-32 * ks));
#pragma unroll
                    for (int dt = 0; dt < 2; ++dt) {
                        const int tb = OFF_K + (32 * ks + 8 * fq + q4) * KSB + (2 * wid + dt) * 32 + 8 * p4;
                        const s16x4 lo = lds_tr8(lds, tb), hi = lds_tr8(lds, tb + 4 * KSB);
                        f32x4 f0, f1;
#pragma unroll
                        for (int e = 0; e < 4; ++e) { f0[e] = bf2f((unsigned short)lo[e]) * (fks * __builtin_amdgcn_exp2f(l2g * (float)(-e))); f1[e] = bf2f((unsigned short)hi[e]) * (fks * __builtin_amdgcn_exp2f(l2g * (float)(-4 - e))); }
                        const bf16x8 kf = pack8(f0, f1);
#pragma unroll
                        for (int et = 0; et < 4; ++et) sacc[dt][et] = MFMA16(kf, vf[et], sacc[dt][et]); }
                }
#pragma unroll
                for (int dt = 0; dt < 2; ++dt)
#pragma unroll
                    for (int et = 0; et < 4; ++et) *(LAS u32x2*)(lds + OFF_ST + ((et * 16 + fr) * STS + (2 * wid + dt) * 16 + fq * 4) * 2) = pack4(sacc[dt][et]);
            }
            __syncthreads();
        }
    }
}

__device__ __forceinline__ void phase_ret_gate(bf16_t* O, const bf16_t* G) {
    int tid = threadIdx.x; asm volatile("" : "+v"(tid));
    const int wid = __builtin_amdgcn_readfirstlane(tid >> 6), lane = tid & 63;
    for (int idx = blockIdx.x * 8 + wid; idx < MTOK * 4; idx += gridDim.x * 8) {
        const size_t base = (size_t)(idx >> 2) * 2048 + (idx & 3) * 512 + lane * 8;
        const u32x4 ov = *(const u32x4*)(O + base), gv = *(const u32x4*)(G + base);
        float o[8] = {bflo(ov.x), bfhi(ov.x), bflo(ov.y), bfhi(ov.y), bflo(ov.z), bfhi(ov.z), bflo(ov.w), bfhi(ov.w)};
        const float g[8] = {bflo(gv.x), bfhi(gv.x), bflo(gv.y), bfhi(gv.y), bflo(gv.z), bfhi(gv.z), bflo(gv.w), bfhi(gv.w)};
        float s = 0.f;
#pragma unroll
        for (int i = 0; i < 8; ++i) s += o[i];
        const float mu = wsum(s, lane) * (1.0f / 512.0f); float v = 0.f;
#pragma unroll
        for (int i = 0; i < 8; ++i) { const float d = o[i] - mu; v += d * d; }
        const float rstd = rsqrtf(wsum(v, lane) * (1.0f / 512.0f) + 1e-6f);
#pragma unroll
        for (int i = 0; i < 8; ++i) o[i] = (o[i] - mu) * rstd * silu_f(g[i]);
        u32x4 w; w.x = cvt_pk_bf16(o[0], o[1]); w.y = cvt_pk_bf16(o[2], o[3]); w.z = cvt_pk_bf16(o[4], o[5]); w.w = cvt_pk_bf16(o[6], o[7]);
        *(u32x4*)(O + base) = w;
    }
}

__device__ __forceinline__ void phase_nsa_mat(const bf16_t* PROJ, const float* pek, const float* pev, bf16_t* AK, bf16_t* AV) {
    const size_t per = (size_t)8128 * 256;
    int tid = threadIdx.x; asm volatile("" : "+v"(tid));
    for (size_t i = (size_t)blockIdx.x * NTHR + tid; i < 2 * per; i += (size_t)gridDim.x * NTHR) {
        const int kv = i >= per; const size_t rem = kv ? i - per : i; const int r = (int)(rem >> 8), pp = (int)(rem & 255), l = pp >> 3, d0 = (pp & 7) * 8;
        const int g = r & 3, bn = r >> 2, b = bn / 127, n = bn % 127;
        const u32x4 v = *(const u32x4*)(PROJ + ((size_t)b * SEQ + n * 16 + l) * 2816 + 1024 + kv * 256 + g * 64 + d0);
        const float* pe = (kv ? pev : pek) + l * 64 + d0; const f32x4 p0 = *(const f32x4*)pe, p1 = *(const f32x4*)(pe + 4);
        u32x4 w; w.x = cvt_pk_bf16(bflo(v.x) + p0[0], bfhi(v.x) + p0[1]); w.y = cvt_pk_bf16(bflo(v.y) + p0[2], bfhi(v.y) + p0[3]);
        w.z = cvt_pk_bf16(bflo(v.z) + p1[0], bfhi(v.z) + p1[1]); w.w = cvt_pk_bf16(bflo(v.w) + p1[2], bfhi(v.w) + p1[3]);
        *(u32x4*)((kv ? AV : AK) + (size_t)r * 2048 + l * 64 + d0) = w;
    }
}
__device__ __forceinline__ void phase_nsa_cmp2(const bf16_t* HK, const bf16_t* HV, const bf16_t* W2K, const bf16_t* W2V, bf16_t* KC, bf16_t* VC) {
    int tid = threadIdx.x; asm volatile("" : "+v"(tid));
    const int wid = __builtin_amdgcn_readfirstlane(tid >> 6), lane = tid & 63, fr = lane & 15, fq = lane >> 4;
    for (int tt = blockIdx.x * 8 + wid; tt < 508 * 2; tt += gridDim.x * 8) {
        const int kv = tt >= 508, rt = kv ? tt - 508 : tt; const bf16_t* Hd = kv ? HV : HK; const bf16_t* W = kv ? W2V : W2K; bf16_t* Od = kv ? VC : KC;
        f32x4 acc[4];
#pragma unroll
        for (int nt = 0; nt < 4; ++nt) acc[nt] = (f32x4){0.f, 0.f, 0.f, 0.f};
#pragma unroll
        for (int ks = 0; ks < 8; ++ks) { const bf16x8 hf = *(const bf16x8*)(Hd + (size_t)(rt * 16 + fr) * 256 + ks * 32 + fq * 8);
#pragma unroll
            for (int nt = 0; nt < 4; ++nt) acc[nt] = MFMA16(*(const bf16x8*)(W + (size_t)(nt * 16 + fr) * 256 + ks * 32 + fq * 8), hf, acc[nt]); }
#pragma unroll
        for (int nt = 0; nt < 4; ++nt) *(u32x2*)(Od + (size_t)(rt * 16 + fr) * 64 + nt * 16 + fq * 4) = pack4(acc[nt]);
    }
}

constexpr int A_KS = 72, A_VS = 72, A_KCS = 72, A_VCS = 72, A_KBYTES = 9216, A_VBYTES = 9216;
struct AttnCtx2 { int b, g, cur, head, hp; int t[2]; float slope; bf16x8 qf[2][2]; float gate[2][3]; unsigned selq[2]; unsigned anym; };
constexpr int B_OFF_K = 0, B_OFF_VT = 18432, B_OFF_KC = 36864, B_OFF_VCT = 55296, B_OFF_IMP = 73728, B_OFF_SEL = 107520, B_OFF_SELP = 107776;

template <int BR>
__device__ __forceinline__ void attn_branch64(const bf16_t* PROJ, LAS unsigned char* lds, const AttnCtx2& C, f32x4 (&otot)[2][4], int tid) {
    const int lane = tid & 63, fr = lane & 15, fq = lane >> 4;
    const float qs = 0.125f * 1.44269504089f, slope2 = C.slope * 1.44269504089f;
    f32x4 sl[4];
#pragma unroll
    for (int kt = 0; kt < 4; ++kt)
#pragma unroll
        for (int jj = 0; jj < 4; ++jj) sl[kt][jj] = slope2 * (float)(kt * 16 + jj);
    float m_[2] = {-1e30f, -1e30f}, l_[2] = {0.f, 0.f};
    f32x4 oa[2][4];
#pragma unroll
    for (int qi = 0; qi < 2; ++qi)
#pragma unroll
        for (int dt = 0; dt < 4; ++dt) oa[qi][dt] = (f32x4){0.f, 0.f, 0.f, 0.f};
    const int jlo = (BR == 1) ? 0 : (C.cur > 8 ? C.cur - 8 : 0);
    const int koff = (BR == 1 ? 1536 : 2048) + C.g * 64, voff = (BR == 1 ? 1792 : 2304) + C.g * 64;
    const int key = tid >> 3, d0 = (tid & 7) * 8;
    const bf16_t* srcb = PROJ + ((size_t)C.b * SEQ + key) * 2816 + d0;
    const int wofs = (key * A_KS + d0) * 2;
    int j = jlo;
    if (BR == 1) { while (j <= C.cur && !((C.anym >> j) & 1u)) ++j; }
    bf16x8 kreg = *(const bf16x8*)(srcb + (size_t)j * 64 * 2816 + koff), vreg = *(const bf16x8*)(srcb + (size_t)j * 64 * 2816 + voff);
    __syncthreads();
    int buf = 0;
    *(LAS bf16x8*)(lds + B_OFF_K + wofs) = kreg; *(LAS bf16x8*)(lds + B_OFF_VT + wofs) = vreg;
    __syncthreads();
    while (j <= C.cur) {
        int jn = j + 1;
        if (BR == 1) { while (jn <= C.cur && !((C.anym >> jn) & 1u)) ++jn; }
        const bool more = jn <= C.cur;
        if (more) { kreg = *(const bf16x8*)(srcb + (size_t)jn * 64 * 2816 + koff); vreg = *(const bf16x8*)(srcb + (size_t)jn * 64 * 2816 + voff); }
        const int kb = B_OFF_K + buf * A_KBYTES, vb = B_OFF_VT + buf * A_VBYTES;
        const bool partial = (j == C.cur) || (BR == 2 && j + 8 <= C.cur);
        bf16x8 pf[2][2];
#pragma unroll
        for (int qi = 0; qi < 2; ++qi) {
            f32x4 s4[4]; float alpha;
            const int dbase = C.t[qi] - j * 64 - fq * 4;
            if (partial) {
                float tmax = -1e30f;
#pragma unroll
                for (int kt = 0; kt < 4; ++kt) { f32x4 acc = (f32x4){0.f, 0.f, 0.f, 0.f};
#pragma unroll
                    for (int ks = 0; ks < 2; ++ks) acc = MFMA16(lds_rd16(lds, kb + ((kt * 16 + fr) * A_KS + ks * 32 + fq * 8) * 2), C.qf[qi][ks], acc);
#pragma unroll
                    for (int jj = 0; jj < 4; ++jj) { const int dist = dbase - (kt * 16 + jj);
                        const bool ok = (dist >= 0) && (BR == 1 ? (((C.selq[qi] >> j) & 1u) != 0u) : (dist < 512));
                        const float sv = ok ? acc[jj] * qs - slope2 * (float)dist : -1e30f; s4[kt][jj] = sv; tmax = fmaxf(tmax, sv); } }
                tmax = fmaxf(tmax, shx<16>(tmax, lane)); tmax = fmaxf(tmax, shx<32>(tmax, lane));
                const float mnew = fmaxf(m_[qi], tmax); alpha = __builtin_amdgcn_exp2f(m_[qi] - mnew); m_[qi] = mnew;
                float psum = 0.f;
#pragma unroll
                for (int kt = 0; kt < 4; ++kt)
#pragma unroll
                    for (int jj = 0; jj < 4; ++jj) { const float pp = (s4[kt][jj] > -1e29f) ? __builtin_amdgcn_exp2f(s4[kt][jj] - mnew) : 0.f; s4[kt][jj] = pp; psum += pp; }
                l_[qi] = l_[qi] * alpha + psum;
            } else {
                float c0 = -slope2 * (float)dbase;
                if (BR == 1 && !((C.selq[qi] >> j) & 1u)) c0 = -1e30f;
                float tmax = -1e30f;
#pragma unroll
                for (int kt = 0; kt < 4; ++kt) { f32x4 acc = (f32x4){0.f, 0.f, 0.f, 0.f};
#pragma unroll
                    for (int ks = 0; ks < 2; ++ks) acc = MFMA16(lds_rd16(lds, kb + ((kt * 16 + fr) * A_KS + ks * 32 + fq * 8) * 2), C.qf[qi][ks], acc);
#pragma unroll
                    for (int jj = 0; jj < 4; ++jj) { const float u = acc[jj] * qs + sl[kt][jj]; s4[kt][jj] = u; tmax = fmaxf(tmax, u); } }
                tmax += c0;
                tmax = fmaxf(tmax, shx<16>(tmax, lane)); tmax = fmaxf(tmax, shx<32>(tmax, lane));
                const float mnew = fmaxf(m_[qi], tmax); alpha = __builtin_amdgcn_exp2f(m_[qi] - mnew); m_[qi] = mnew;
                const float sh = mnew - c0; float psum = 0.f;
#pragma unroll
                for (int kt = 0; kt < 4; ++kt)
#pragma unroll
                    for (int jj = 0; jj < 4; ++jj) { const float pp = __builtin_amdgcn_exp2f(s4[kt][jj] - sh); s4[kt][jj] = pp; psum += pp; }
                l_[qi] = l_[qi] * alpha + psum;
            }
#pragma unroll
            for (int dt = 0; dt < 4; ++dt) oa[qi][dt] *= alpha;
            pf[qi][0] = pack8(s4[0], s4[1]); pf[qi][1] = pack8(s4[2], s4[3]);
        }
#pragma unroll
        for (int ks2 = 0; ks2 < 2; ++ks2)
#pragma unroll
            for (int dt = 0; dt < 4; ++dt) { const bf16x8 vf = lds_tr8x2(lds, vb + (ks2 * 32 + fq * 4 + ((lane & 15) >> 2)) * (A_VS * 2) + dt * 32 + 8 * (lane & 3), 16 * A_VS * 2);
                oa[0][dt] = MFMA16(vf, pf[0][ks2], oa[0][dt]); oa[1][dt] = MFMA16(vf, pf[1][ks2], oa[1][dt]); }
        if (more) { *(LAS bf16x8*)(lds + B_OFF_K + (buf ^ 1) * A_KBYTES + wofs) = kreg; *(LAS bf16x8*)(lds + B_OFF_VT + (buf ^ 1) * A_VBYTES + wofs) = vreg; }
        __syncthreads();
        buf ^= 1; j = jn;
    }
#pragma unroll
    for (int qi = 0; qi < 2; ++qi) { float lt = l_[qi]; lt += shx<16>(lt, lane); lt += shx<32>(lt, lane); const float inv = lt > 0.f ? C.gate[qi][BR] / lt : 0.f;
#pragma unroll
        for (int dt = 0; dt < 4; ++dt) otot[qi][dt] += oa[qi][dt] * inv; }
}

__device__ __forceinline__ void phase_nsa_attn64(const bf16_t* PROJ, const bf16_t* KCMP, const bf16_t* VCMP, bf16_t* OATT, LAS unsigned char* lds) {
    int tid0 = threadIdx.x; asm volatile("" : "+v"(tid0));
    const int wid = __builtin_amdgcn_readfirstlane(tid0 >> 6);
    LAS float* IMP = (LAS float*)(lds + B_OFF_IMP); LAS unsigned* SEL = (LAS unsigned*)(lds + B_OFF_SEL); LAS unsigned* SELP = (LAS unsigned*)(lds + B_OFF_SELP);
    for (int id = blockIdx.x; id < 2048; id += gridDim.x) {
        int tid = tid0; asm volatile("" : "+v"(tid));
        const int lane = tid & 63, fr = lane & 15, fq = lane >> 4;
        const int k8 = id & 255, ii = id >> 8, bg = k8 & 63, kk = k8 >> 6;
        AttnCtx2 C; C.cur = (ii & 1) ? 31 - (kk + 4 * (ii - 1)) : kk + 4 * ii; C.b = bg >> 2; C.g = bg & 3; C.hp = wid >> 1; C.head = C.g * 4 + C.hp; C.slope = exp2f(-0.5f * (float)(C.head + 1));
        int qq[2]; size_t trow[2];
#pragma unroll
        for (int qi = 0; qi < 2; ++qi) { qq[qi] = (wid & 1) * 32 + qi * 16 + fr; C.t[qi] = C.cur * 64 + qq[qi]; trow[qi] = (size_t)C.b * SEQ + C.t[qi];
            const bf16_t* pr = PROJ + trow[qi] * 2816;
#pragma unroll
            for (int ks = 0; ks < 2; ++ks) C.qf[qi][ks] = *(const bf16x8*)(pr + C.head * 64 + ks * 32 + fq * 8);
#pragma unroll
            for (int br = 0; br < 3; ++br) C.gate[qi][br] = 1.0f / (1.0f + __expf(-bf2f(pr[2560 + C.head * 3 + br]))); }
        f32x4 otot[2][4];
#pragma unroll
        for (int qi = 0; qi < 2; ++qi)
#pragma unroll
            for (int dt = 0; dt < 4; ++dt) otot[qi][dt] = (f32x4){0.f, 0.f, 0.f, 0.f};
        __syncthreads();
#pragma unroll
        for (int rep = 0; rep < 2; ++rep) { const int idx = tid + rep * NTHR, n = idx >> 3, d0 = (idx & 7) * 8, nc = n < 126 ? n : 126; const size_t src = ((size_t)(C.b * 127 + nc) * 4 + C.g) * 64 + d0;
            *(LAS bf16x8*)(lds + B_OFF_KC + (n * A_KCS + d0) * 2) = *(const bf16x8*)(KCMP + src);
            *(LAS bf16x8*)(lds + B_OFF_VCT + (n * A_VCS + d0) * 2) = *(const bf16x8*)(VCMP + src); }
        __syncthreads();
#pragma unroll
        for (int qi = 0; qi < 2; ++qi) {
            f32x4 sc[8]; float mx = -1e30f;
#pragma unroll
            for (int kt = 0; kt < 8; ++kt) { f32x4 acc = (f32x4){0.f, 0.f, 0.f, 0.f};
#pragma unroll
                for (int ks = 0; ks < 2; ++ks) acc = MFMA16(lds_rd16(lds, B_OFF_KC + ((kt * 16 + fr) * A_KCS + ks * 32 + fq * 8) * 2), C.qf[qi][ks], acc);
#pragma unroll
                for (int jj = 0; jj < 4; ++jj) { const int n = kt * 16 + fq * 4 + jj, ce = n * 16 + 31; const bool ok = (n <= 126) && (ce <= C.t[qi]);
                    const float sv = ok ? acc[jj] * 0.125f - C.slope * (float)(C.t[qi] - ce) : -1e30f; sc[kt][jj] = sv; mx = fmaxf(mx, sv); } }
            mx = fmaxf(mx, shx<16>(mx, lane)); mx = fmaxf(mx, shx<32>(mx, lane));
            float sum = 0.f;
#pragma unroll
            for (int kt = 0; kt < 8; ++kt)
#pragma unroll
                for (int jj = 0; jj < 4; ++jj) { const float pp = (sc[kt][jj] > -1e29f) ? __expf(sc[kt][jj] - mx) : 0.f; sc[kt][jj] = pp; sum += pp; }
            sum += shx<16>(sum, lane); sum += shx<32>(sum, lane);
            const float inv = sum > 0.f ? 1.0f / sum : 0.f;
#pragma unroll
            for (int kt = 0; kt < 8; ++kt) sc[kt] *= inv;
#pragma unroll
            for (int kt = 0; kt < 8; ++kt) { const float a = shi(sc[kt][3], (lane + 48) & 63); const float bp = kt > 0 ? shi(sc[kt > 0 ? kt - 1 : 0][3], (lane + 48) & 63) : 0.f;
                const float prev3 = fq > 0 ? a : bp;
                IMP[(C.hp * 64 + qq[qi]) * 33 + 4 * kt + fq] = sc[kt][0] + sc[kt][1] + sc[kt][2] + 0.5f * sc[kt][3] + 0.5f * prev3; }
            f32x4 oc[4];
#pragma unroll
            for (int dt = 0; dt < 4; ++dt) oc[dt] = (f32x4){0.f, 0.f, 0.f, 0.f};
#pragma unroll
            for (int ks2 = 0; ks2 < 4; ++ks2) { const bf16x8 pfc = pack8(sc[2 * ks2], sc[2 * ks2 + 1]);
#pragma unroll
                for (int dt = 0; dt < 4; ++dt) oc[dt] = MFMA16(lds_tr8x2(lds, B_OFF_VCT + (ks2 * 32 + fq * 4 + ((lane & 15) >> 2)) * (A_VCS * 2) + dt * 32 + 8 * (lane & 3), 16 * A_VCS * 2), pfc, oc[dt]); }
#pragma unroll
            for (int dt = 0; dt < 4; ++dt) otot[qi][dt] += oc[dt] * C.gate[qi][0];
        }
        __syncthreads();
        if (C.cur >= 16) {
            const int sq = tid & 63, jg = tid >> 6;
#pragma unroll
            for (int jj = 0; jj < 4; ++jj) { const int j = jg * 4 + jj; const float imp = IMP[(0 * 64 + sq) * 33 + j] + IMP[(1 * 64 + sq) * 33 + j] + IMP[(2 * 64 + sq) * 33 + j] + IMP[(3 * 64 + sq) * 33 + j];
                const bool valid = j <= C.cur, forced = (j == 0) || (j == C.cur) || (j == C.cur - 1);
                IMP[sq * 33 + j] = valid ? (forced ? 1e4f : imp) : -1.0f; }
            __syncthreads();
            unsigned bits = 0u;
#pragma unroll
            for (int jj = 0; jj < 4; ++jj) { const int j = jg * 4 + jj; const float sj = IMP[sq * 33 + j]; int cnt = 0;
                for (int j2 = 0; j2 < 32; ++j2) { const float s2 = IMP[sq * 33 + j2]; cnt += ((s2 > sj) || (s2 == sj && j2 < j)) ? 1 : 0; }
                if (cnt < 16) bits |= 1u << j; }
            SELP[jg * 64 + sq] = bits;
            __syncthreads();
            if (tid < 64) { unsigned m = 0u;
#pragma unroll
                for (int q = 0; q < 8; ++q) m |= SELP[q * 64 + tid];
                SEL[tid] = m; }
        } else { if (tid < 64) SEL[tid] = (2u << C.cur) - 1u; }
        __syncthreads();
        C.selq[0] = SEL[qq[0]]; C.selq[1] = SEL[qq[1]];
        { unsigned m = SEL[lane]; m |= shxu<32>(m, lane); m |= shxu<16>(m, lane); m |= shxu<8>(m, lane); m |= shxu<4>(m, lane); m |= shxu<2>(m, lane); m |= shxu<1>(m, lane); C.anym = (unsigned)__builtin_amdgcn_readfirstlane((int)m); }
        attn_branch64<1>(PROJ, lds, C, otot, tid);
        attn_branch64<2>(PROJ, lds, C, otot, tid);
#pragma unroll
        for (int qi = 0; qi < 2; ++qi)
#pragma unroll
            for (int dt = 0; dt < 4; ++dt) *(u32x2*)(OATT + trow[qi] * 1024 + C.head * 64 + dt * 16 + fq * 4) = pack4(otot[qi][dt]);
    }
}

#define XB_TMO      128
#define XB_XCNT(j)  (256  + 64 * (j))
#define XB_XSUB(j)  (1280 + 64 * (j))
#define XB_XGEN(j)  (2304 + 64 * (j))
#define XB_TOP      3328
#define XB_TOPGEN   3392
#define XCD_BAR_WORDS 3456
#define XB_SPIN_CAP (1u << 18)

__device__ __forceinline__ unsigned xb_ld(unsigned* p)              { return __hip_atomic_load(p, __ATOMIC_RELAXED, __HIP_MEMORY_SCOPE_AGENT); }
__device__ __forceinline__ unsigned xb_add(unsigned* p, unsigned v) { return __hip_atomic_fetch_add(p, v, __ATOMIC_RELAXED, __HIP_MEMORY_SCOPE_AGENT); }
__device__ __forceinline__ unsigned xb_xcc_id() { return (unsigned)__builtin_amdgcn_s_getreg((3 << 11) | 20) & 0xFu; }
#define XB_SPIN(cond, bar) do { unsigned _sp = 0; while (cond) { __builtin_amdgcn_s_sleep(1); \
    if ((++_sp & 255u) == 0u) { if (xb_ld(&(bar)[XB_TMO])) break; if (_sp > XB_SPIN_CAP) { atomicAdd(&(bar)[XB_TMO], 1u); break; } } } } while (0)

struct XcdBarrier {
    unsigned* bar; unsigned x;
    volatile LAS unsigned* st;
};

__device__ __forceinline__ XcdBarrier xcd_barrier_post(unsigned* bar, volatile LAS unsigned* st) {
    XcdBarrier b; b.bar = bar; b.x = xb_xcc_id(); b.st = st;
    if (threadIdx.x == 0) (void)xb_add(&bar[XB_XCNT(b.x)], 1u);
    return b;
}
__device__ __forceinline__ void xcd_barrier_complete(unsigned* bar, unsigned x, unsigned& nloc, unsigned& nx) {
    const unsigned G = gridDim.x * gridDim.y * gridDim.z;
    unsigned sum, cnt, mine, sp = 0u;
    for (;;) {
        sum = 0u; cnt = 0u; mine = 0u;
#pragma unroll
        for (unsigned j = 0; j < 16; ++j) { const unsigned c = xb_ld(&bar[XB_XCNT(j)]); sum += c; cnt += (c > 0u) ? 1u : 0u; mine = (j == x) ? c : mine; }
        if (sum == G) break;
        __builtin_amdgcn_s_sleep(1);
        if ((++sp & 255u) == 0u) { if (xb_ld(&bar[XB_TMO])) break; if (sp > XB_SPIN_CAP) { atomicAdd(&bar[XB_TMO], 1u); break; } }
    }
    nloc = mine > 0u ? mine : 1u; nx = cnt > 0u ? cnt : 1u;
}

__device__ __forceinline__ void xcd_barrier(const XcdBarrier& b) {
    asm volatile("s_waitcnt vmcnt(0)" ::: "memory");
    __syncthreads();
    if (threadIdx.x == 0) {
        unsigned* bar = b.bar;
        __builtin_amdgcn_s_waitcnt(0);
        unsigned nloc = b.st[0], nx = b.st[1];
        if (nloc == 0u) { xcd_barrier_complete(bar, b.x, nloc, nx); b.st[0] = nloc; b.st[1] = nx; }
        const unsigned old = xb_add(&bar[XB_XSUB(b.x)], 1u);
        const unsigned gen = old / nloc;
        if (old + 1u == (gen + 1u) * nloc) {
            __builtin_amdgcn_fence(__ATOMIC_RELEASE, "agent");
            asm volatile("s_waitcnt vmcnt(0)" ::: "memory");
            const unsigned og = xb_add(&bar[XB_TOP], 1u);
            const unsigned tg = og / nx;
            if (og + 1u == (tg + 1u) * nx) xb_add(&bar[XB_TOPGEN], 1u);
            else XB_SPIN(xb_ld(&bar[XB_TOPGEN]) == tg, bar);
            __builtin_amdgcn_fence(__ATOMIC_ACQUIRE, "agent");
            xb_add(&bar[XB_XGEN(b.x)], 1u);
            asm volatile("s_waitcnt vmcnt(0)" ::: "memory");
        } else {
            XB_SPIN(xb_ld(&bar[XB_XGEN(b.x)]) == gen, bar);
            __builtin_amdgcn_fence(__ATOMIC_ACQUIRE, "agent");
            asm volatile("s_waitcnt vmcnt(0)" ::: "memory");
        }
    }
    __syncthreads();
}


#ifndef R_CORE
#define R_CORE 1
#endif
#ifndef R_ATTN
#define R_ATTN 1
#endif
#ifndef R_GEMM
#define R_GEMM 1
#endif
#ifndef R_BAR
#define R_BAR 1
#endif
#ifndef R_PREP
#define R_PREP 1
#endif
#ifndef GEMM_ALIGN
#define GEMM_ALIGN true
#endif
#ifndef GEMM_SP2
#define GEMM_SP2 true
#endif
struct GemmDesc { const bf16_t* A; const bf16_t* Bt; bf16_t* O; int M, N, K, ldc, act, cshift; const float* stats; };
__device__ __forceinline__ void run_gemm(const GemmDesc& d, LAS unsigned char* lds) {
    pg8::Gemm g{d.A, d.Bt, d.M, d.N, d.K}; pg8::StaticOrder S; const int G = (int)gridDim.x; S.init(d.M, d.N, G, ((int)blockIdx.x + G - d.cshift % G) % G);
    if (d.act == 0) { pg8::Epi<0> E{d.O, d.ldc, nullptr}; pg8::gemm_phase<pg8::Epi<0>, pg8::StaticOrder, GEMM_ALIGN, GEMM_SP2>(lds, g, S, E); }
    else if (d.act == 1) { pg8::Epi<1> E{d.O, d.ldc, nullptr}; pg8::gemm_phase<pg8::Epi<1>, pg8::StaticOrder, GEMM_ALIGN, GEMM_SP2>(lds, g, S, E); }
    else if (d.act == 3) { pg8::Epi<3> E{d.O, d.ldc, d.stats}; pg8::gemm_phase<pg8::Epi<3>, pg8::StaticOrder, GEMM_ALIGN, GEMM_SP2>(lds, g, S, E); }
    else { pg8::Epi<2> E{d.O, d.ldc, nullptr}; pg8::gemm_phase<pg8::Epi<2>, pg8::StaticOrder, GEMM_ALIGN, GEMM_SP2>(lds, g, S, E); }
}

__global__ void __launch_bounds__(NTHR) fwd_megakernel(Params p) {
    extern __shared__ __attribute__((aligned(16))) unsigned char smem[];
    LAS unsigned char* lds = (LAS unsigned char*)smem;
    cg::grid_group grid = cg::this_grid();
    unsigned char* ws = p.ws; unsigned char* U = ws + OFF_U2;
    const float* mod = (const float*)(ws + OFF_MOD); bf16_t* H = (bf16_t*)(ws + OFF_H);
    if (threadIdx.x < 4) ((LAS unsigned*)(lds + XB_LDS_OFF))[threadIdx.x] = 0u;
    __syncthreads();
    XcdBarrier xbar = xcd_barrier_post((unsigned*)(ws + WS_END), (volatile LAS unsigned*)(lds + XB_LDS_OFF));
    grid.sync();

#if 0
    { const u32x4 pz = (u32x4){0xAAAAAAAAu, 0xAAAAAAAAu, 0xAAAAAAAAu, 0xAAAAAAAAu}; for (size_t i = (size_t)blockIdx.x * NTHR + threadIdx.x; i < WS_END / 16; i += (size_t)gridDim.x * NTHR) ((u32x4*)ws)[i] = pz; }
    xcd_barrier(xbar);
#endif
    for (int gs = 0; gs < 2 + DEPTH * 13; ++gs) {
        if (gs < 2) {
            if (gs == 0) { for (int rr = 0; rr < R_PREP; ++rr) phase_prep(p, lds); } else phase_init(p);
        } else {
        const int layer = (gs - 2) / 13, st = (gs - 2) % 13;
        const int jm = layer >> 1; const bool is_ret = (layer & 1) == 0;
        const float* modL = mod + (size_t)layer * 16 * MODW;
        {
            GemmDesc d[2]; int ng = 0;
            d[0].cshift = 0; d[1].cshift = 0;
            if (st == 0 || st == 10) {
                const int s = st == 0 ? 0 : 1;
                d[0] = GemmDesc{H, (const bf16_t*)(ws + OFF_FFN_IN + (size_t)(layer * 2 + s) * SZ_FFN_IN), (bf16_t*)(U + U_FFN_ACT), MTOK, 5632, 1024, DFF, 1, 0, nullptr}; ng = 1;
            } else if (st == 1 || st == 11) {
                const int s = st == 1 ? 0 : 1;
                d[0] = GemmDesc{(const bf16_t*)(U + U_FFN_ACT), (const bf16_t*)(ws + OFF_FFN_OUT + (size_t)(layer * 2 + s) * SZ_FFN_OUT), (bf16_t*)(U + U_FFN_Y), MTOK, 1024, DFF, 1024, 0, 0, nullptr}; ng = 1;
            } else if (st == 2 || st == 9 || st == 12) {
                const int sub = st == 2 ? 0 : (st == 9 ? 1 : 2);
                const bf16_t* y = (const bf16_t*)(U + (sub == 1 ? (is_ret ? U_RET_Y : U_NSA_Y) : U_FFN_Y));
                const float* modN = (sub == 2) ? (layer + 1 < DEPTH ? modL + (size_t)16 * MODW : modL) : modL;
                const int shc = (sub == 2) ? 0 : (sub + 1) * 3;
                phase_ln(p.out, p.out, y, modL + (sub * 3 + 2) * 1024, sub == 1 ? 1.0f : 0.5f, p.ln_g + (size_t)(layer * 3 + sub) * 1024, p.ln_b + (size_t)(layer * 3 + sub) * 1024,
                         modN + shc * 1024, modN + (shc + 1) * 1024, H);
            } else if (is_ret) {
                const bf16_t* Wi = (const bf16_t*)(ws + OFF_RET_IN + (size_t)jm * SZ_RET_IN);
                if (st == 3) { d[0] = GemmDesc{H, Wi, (bf16_t*)(U + U_RET_QKV), MTOK, 4096, 1024, 4096, 0, 0, nullptr}; ng = 1; }
                else if (st == 4) { for (int rr = 0; rr < R_CORE; ++rr) phase_ret_core((const bf16_t*)(U + U_RET_QKV), (bf16_t*)(U + U_RET_O), (float*)(ws + OFF_FFN_IN + (size_t)(layer * 2) * SZ_FFN_IN), lds); }
                else if (st == 5) { d[0] = GemmDesc{H, Wi + (size_t)4096 * 1024, (bf16_t*)(U + U_RET_O), MTOK, 2048, 1024, 2048, 3, 0, (const float*)(ws + OFF_FFN_IN + (size_t)(layer * 2) * SZ_FFN_IN)}; ng = 1; }
                else if (st == 6) continue;
                else if (st == 7) { d[0] = GemmDesc{(const bf16_t*)(U + U_RET_O), (const bf16_t*)(ws + OFF_RET_OUT + (size_t)jm * SZ_RET_OUT), (bf16_t*)(U + U_RET_Y), MTOK, 1024, 2048, 1024, 0, 0, nullptr}; ng = 1; }
                else continue;
            } else {
                if (st == 3) { d[0] = GemmDesc{H, (const bf16_t*)(ws + OFF_NSA_IN + (size_t)jm * SZ_NSA_IN), (bf16_t*)(U + U_NSA_PROJ), MTOK, 2816, 1024, 2816, 0, 0, nullptr}; ng = 1; }
                else if (st == 4) phase_nsa_mat((const bf16_t*)(U + U_NSA_PROJ), p.pe_k + (size_t)jm * 2048, p.pe_v + (size_t)jm * 2048, (bf16_t*)(U + U_NSA_ACMPK), (bf16_t*)(U + U_NSA_ACMPV));
                else if (st == 5) {
                    d[0] = GemmDesc{(const bf16_t*)(U + U_NSA_ACMPK), (const bf16_t*)(ws + OFF_W1 + (size_t)(0 * 2 + jm) * SZ_W1), (bf16_t*)(U + U_NSA_HK), 8192, 256, 2048, 256, 2, 0, nullptr};
                    d[1] = GemmDesc{(const bf16_t*)(U + U_NSA_ACMPV), (const bf16_t*)(ws + OFF_W1 + (size_t)(1 * 2 + jm) * SZ_W1), (bf16_t*)(U + U_NSA_HV), 8192, 256, 2048, 256, 2, 32, nullptr}; ng = 2;
                } else if (st == 6) phase_nsa_cmp2((const bf16_t*)(U + U_NSA_HK), (const bf16_t*)(U + U_NSA_HV), (const bf16_t*)(ws + OFF_W2 + (size_t)(0 * 2 + jm) * SZ_W2), (const bf16_t*)(ws + OFF_W2 + (size_t)(1 * 2 + jm) * SZ_W2),
                                               (bf16_t*)(U + U_NSA_KCMP), (bf16_t*)(U + U_NSA_VCMP));
                else if (st == 7) { for (int rr = 0; rr < R_ATTN; ++rr) phase_nsa_attn64((const bf16_t*)(U + U_NSA_PROJ), (const bf16_t*)(U + U_NSA_KCMP), (const bf16_t*)(U + U_NSA_VCMP), (bf16_t*)(U + U_NSA_OATT), lds); }
                else { d[0] = GemmDesc{(const bf16_t*)(U + U_NSA_OATT), (const bf16_t*)(ws + OFF_NSA_OUT + (size_t)jm * SZ_NSA_OUT), (bf16_t*)(U + U_NSA_Y), MTOK, 1024, 1024, 1024, 0, 0, nullptr}; ng = 1; }
            }
            for (int rr = 0; rr < R_GEMM; ++rr) for (int r = 0; r < ng; ++r) { GemmDesc dd = d[0]; if (r == 1) dd = d[1]; run_gemm(dd, lds); }
        }
        }
        xcd_barrier(xbar);
    }
}

extern "C" void kernel_launch(void* const* d_in, const int* in_sizes, int n_in, void* d_out, int out_size, void* d_ws, size_t ws_size, hipStream_t stream) {
    static int grid_blocks = 0;
    if (grid_blocks == 0) {
        int dev = 0, cus = 0, per_cu = 0;
        hipGetDevice(&dev); hipDeviceGetAttribute(&cus, hipDeviceAttributeMultiprocessorCount, dev);
        if (hipFuncSetAttribute((const void*)fwd_megakernel, hipFuncAttributeMaxDynamicSharedMemorySize, LDS_BYTES) != hipSuccess) fprintf(stderr, "hipFuncSetAttribute failed\n");
        if (hipOccupancyMaxActiveBlocksPerMultiprocessor(&per_cu, (const void*)fwd_megakernel, NTHR, LDS_BYTES) != hipSuccess || per_cu < 1) { fprintf(stderr, "occupancy query: %d\n", per_cu); per_cu = 1; }
        (void)hipGetLastError();
        grid_blocks = cus * 1;
        if (ws_size < WS_END + 16384) fprintf(stderr, "workspace too small: %zu < %zu\n", ws_size, (size_t)WS_END);
    }
    Params p{};
    p.x = (const float*)d_in[0]; p.c = (const float*)d_in[1]; p.ada_w = (const float*)d_in[2]; p.ada_b = (const float*)d_in[3]; p.ln_g = (const float*)d_in[4]; p.ln_b = (const float*)d_in[5];
    p.pe_k = (const float*)d_in[12]; p.pe_v = (const float*)d_in[13]; p.out = (float*)d_out; p.ws = (unsigned char*)d_ws;
    unsigned char* ws = (unsigned char*)d_ws; int nj = 0, te = 0;
    auto add = [&](const float* src, size_t dst_off, int K, int N, int Np, int mode) { p.jobs[nj] = WJob{src, (bf16_t*)(ws + dst_off), K, N, Np, mode}; te += (Np / 64) * (K / 64); p.tile_end[nj] = te; ++nj; };
    const float* ffn_in = (const float*)d_in[6]; const float* ffn_out = (const float*)d_in[7]; const float* ret_in = (const float*)d_in[8]; const float* ret_out = (const float*)d_in[9];
    const float* nsa_in = (const float*)d_in[10]; const float* nsa_out = (const float*)d_in[11];
    const float* ck1 = (const float*)d_in[14]; const float* ck2 = (const float*)d_in[15]; const float* cv1 = (const float*)d_in[16]; const float* cv2 = (const float*)d_in[17];
    for (int i = 0; i < 8; ++i) add(ffn_in + (size_t)i * 1024 * 5632, OFF_FFN_IN + i * SZ_FFN_IN, 1024, 5632, 5632, 1);
    for (int i = 0; i < 8; ++i) add(ffn_out + (size_t)i * 2816 * 1024, OFF_FFN_OUT + i * SZ_FFN_OUT, 2816, 1024, 1024, 0);
    for (int i = 0; i < 2; ++i) add(ret_in + (size_t)i * 1024 * 6144, OFF_RET_IN + i * SZ_RET_IN, 1024, 6144, 6144, 0);
    for (int i = 0; i < 2; ++i) add(ret_out + (size_t)i * 2048 * 1024, OFF_RET_OUT + i * SZ_RET_OUT, 2048, 1024, 1024, 0);
    for (int i = 0; i < 2; ++i) add(nsa_in + (size_t)i * 1024 * 2608, OFF_NSA_IN + i * SZ_NSA_IN, 1024, 2608, 2816, 0);
    for (int i = 0; i < 2; ++i) add(nsa_out + (size_t)i * 1024 * 1024, OFF_NSA_OUT + i * SZ_NSA_OUT, 1024, 1024, 1024, 0);
    for (int i = 0; i < 2; ++i) add(ck1 + (size_t)i * 2048 * 256, OFF_W1 + (0 * 2 + i) * SZ_W1, 2048, 256, 256, 0);
    for (int i = 0; i < 2; ++i) add(cv1 + (size_t)i * 2048 * 256, OFF_W1 + (1 * 2 + i) * SZ_W1, 2048, 256, 256, 0);
    for (int i = 0; i < 2; ++i) add(ck2 + (size_t)i * 256 * 64, OFF_W2 + (0 * 2 + i) * SZ_W2, 256, 64, 64, 0);
    for (int i = 0; i < 2; ++i) add(cv2 + (size_t)i * 256 * 64, OFF_W2 + (1 * 2 + i) * SZ_W2, 256, 64, 64, 0);
    p.njobs = nj;
    if (hipMemsetAsync(ws + WS_END, 0, 16384, stream) != hipSuccess) fprintf(stderr, "barrier memset failed\n");
    void* args[] = {&p};
    hipError_t e = hipLaunchCooperativeKernel((const void*)fwd_megakernel, dim3(grid_blocks), dim3(NTHR), args, LDS_BYTES, stream);
    if (e != hipSuccess) fprintf(stderr, "cooperative launch failed: %s (grid %d)\n", hipGetErrorString(e), grid_blocks);
}
```

```cpp
#include <hip/hip_runtime.h>
#include <hip/hip_cooperative_groups.h>
#include <cstdio>
namespace cg = cooperative_groups;

namespace pg8 {
#define PG8_LAS __attribute__((address_space(3)))
typedef unsigned short bf16_t;
typedef short bf16x8 __attribute__((ext_vector_type(8)));
typedef float f32x4 __attribute__((ext_vector_type(4)));
typedef unsigned u32x4 __attribute__((ext_vector_type(4)));
constexpr int BM = 256, BK = 64, HALF = 128, HTB = HALF * BK * 2  , STAGE_BYTES = 8 * HTB, NXCD = 8, WGM = 8;

__host__ __device__ __forceinline__ int lds_byte(int r, int c) { const int st = (r >> 4) * 2 + (c >> 5), rr = r & 15, cc = c & 31, ob = rr * 64 + cc * 2; return st * 1024 + (ob ^ (((ob >> 9) & 1) << 5)); }
__host__ __device__ __forceinline__ void stage_rc(int b, int& R, int& C) { const int st = b / 1024, sb = b % 1024, swz = sb ^ (((sb >> 9) & 1) << 5); R = (st >> 1) * 16 + swz / 64; C = (st & 1) * 32 + (swz % 64) / 2; }
__host__ __device__ __forceinline__ int perm32(int rho) { const int n = rho >> 4, i = rho & 15; return 8 * (i >> 2) + 4 * n + (i & 3); }

struct Unit { int pm, pn; };
struct Gemm { const bf16_t* A; const bf16_t* Bt; int M, N, K; };

struct StaticOrder {
    int nM, nN, nwg, G, c;
    __host__ __device__ void init(int M, int N, int G_, int c_) { nM = M / BM; nN = N / BM; nwg = nM * nN; G = G_; c = c_; }
    __host__ __device__ bool next(int i, Unit& u) const {
        const long L = (long)i * G + c; if (L >= nwg) return false;
        int wgid = (int)L; { const int q = nwg / NXCD, r = nwg % NXCD, xcd = wgid % NXCD, off = wgid / NXCD; wgid = (xcd < r ? xcd * (q + 1) : r * (q + 1) + (xcd - r) * q) + off; }
        const int nig = WGM * nN, gid = wgid / nig, fm = gid * WGM, gsz = (nM - fm) < WGM ? (nM - fm) : WGM;
        u.pm = fm + ((wgid % nig) % gsz); u.pn = (wgid % nig) / gsz; return true;
    }
    __device__ __forceinline__ void a_ready(const Unit&) const {}
    __device__ __forceinline__ void done(const Unit&) const {}
};

typedef float f32x2_t __attribute__((ext_vector_type(2)));
typedef __bf16 bf16x2_t __attribute__((ext_vector_type(2)));
__device__ __forceinline__ unsigned cvt_pk_bf16(float lo, float hi) { const f32x2_t v = {lo, hi}; return __builtin_bit_cast(unsigned, __builtin_convertvector(v, bf16x2_t)); }
__device__ __forceinline__ float silu_f(float a) { return a * __builtin_amdgcn_rcpf(1.0f + __builtin_amdgcn_exp2f(-1.44269504089f * a)); }
__device__ __forceinline__ float gelu_tanh_f(float x) { const float u = 0.7978845608028654f * (x + 0.044715f * x * x * x); const float t = 1.0f - 2.0f * __builtin_amdgcn_rcpf(1.0f + __builtin_amdgcn_exp2f(2.88539008178f * u)); return 0.5f * x * (1.0f + t); }

template <int ACT> struct Epi {
    static constexpr bool PERM = true, AFTER_DRAIN = false;
    bf16_t* O; int ldc; const float* stats;
    __device__ __forceinline__ void operator()(const f32x4 (&acc)[2][2][4][2], const Unit& u, int wr, int wc, int fr, int fq) const {
        const int row0 = u.pm * BM + wr * 64 + fr;
        if (ACT == 3) {
            const int hh = u.pn >> 1, col0 = u.pn * BM + wc * 32 + 8 * fq;
#pragma unroll
            for (int ai = 0; ai < 2; ++ai)
#pragma unroll
                for (int m = 0; m < 4; ++m) { const int r = row0 + ai * HALF + m * 16;
                    const f32x4* sp = (const f32x4*)(stats + ((size_t)r * 4 + hh) * 16);
                    const f32x4 s0 = sp[0], s1 = sp[1], s2 = sp[2], s3 = sp[3];
                    const float sm = ((s0[0] + s0[2]) + (s1[0] + s1[2])) + ((s2[0] + s2[2]) + (s3[0] + s3[2])), sq = ((s0[1] + s0[3]) + (s1[1] + s1[3])) + ((s2[1] + s2[3]) + (s3[1] + s3[3]));
                    const float mu = sm * (1.0f / 512.0f), rstd = rsqrtf(fmaxf(sq * (1.0f / 512.0f) - mu * mu, 0.f) + 1e-6f);
                    bf16_t* rowp = O + (size_t)r * ldc + col0;
#pragma unroll
                    for (int bj = 0; bj < 2; ++bj) { const u32x4 ov = *(const u32x4*)(rowp + bj * HALF); const f32x4 g0 = acc[ai][bj][m][0], g1 = acc[ai][bj][m][1];
                        u32x4 w;
                        w.x = cvt_pk_bf16((__uint_as_float(ov.x << 16) - mu) * rstd * silu_f(g0[0]), (__uint_as_float(ov.x & 0xffff0000u) - mu) * rstd * silu_f(g0[1]));
                        w.y = cvt_pk_bf16((__uint_as_float(ov.y << 16) - mu) * rstd * silu_f(g0[2]), (__uint_as_float(ov.y & 0xffff0000u) - mu) * rstd * silu_f(g0[3]));
                        w.z = cvt_pk_bf16((__uint_as_float(ov.z << 16) - mu) * rstd * silu_f(g1[0]), (__uint_as_float(ov.z & 0xffff0000u) - mu) * rstd * silu_f(g1[1]));
                        w.w = cvt_pk_bf16((__uint_as_float(ov.w << 16) - mu) * rstd * silu_f(g1[2]), (__uint_as_float(ov.w & 0xffff0000u) - mu) * rstd * silu_f(g1[3]));
                        *(u32x4*)(rowp + bj * HALF) = w; } }
            return;
        }
        if (ACT == 1) {
            const int col0 = u.pn * HALF + wc * 32 + 8 * fq;
#pragma unroll
            for (int ai = 0; ai < 2; ++ai)
#pragma unroll
                for (int m = 0; m < 4; ++m) { bf16_t* rowp = O + (size_t)(row0 + ai * HALF + m * 16) * ldc + col0;
                    const f32x4 a0 = acc[ai][0][m][0], a1 = acc[ai][0][m][1], u0 = acc[ai][1][m][0], u1 = acc[ai][1][m][1];
                    u32x4 w; w.x = cvt_pk_bf16(silu_f(a0[0]) * u0[0], silu_f(a0[1]) * u0[1]); w.y = cvt_pk_bf16(silu_f(a0[2]) * u0[2], silu_f(a0[3]) * u0[3]);
                    w.z = cvt_pk_bf16(silu_f(a1[0]) * u1[0], silu_f(a1[1]) * u1[1]); w.w = cvt_pk_bf16(silu_f(a1[2]) * u1[2], silu_f(a1[3]) * u1[3]);
                    *(u32x4*)rowp = w; }
        } else {
            const int col0 = u.pn * BM + wc * 32 + 8 * fq;
#pragma unroll
            for (int ai = 0; ai < 2; ++ai)
#pragma unroll
                for (int m = 0; m < 4; ++m) { bf16_t* rowp = O + (size_t)(row0 + ai * HALF + m * 16) * ldc + col0;
#pragma unroll
                    for (int bj = 0; bj < 2; ++bj) { f32x4 v0 = acc[ai][bj][m][0], v1 = acc[ai][bj][m][1];
                        if (ACT == 2) {
#pragma unroll
                            for (int j = 0; j < 4; ++j) { v0[j] = gelu_tanh_f(v0[j]); v1[j] = gelu_tanh_f(v1[j]); } }
                        u32x4 w; w.x = cvt_pk_bf16(v0[0], v0[1]); w.y = cvt_pk_bf16(v0[2], v0[3]); w.z = cvt_pk_bf16(v1[0], v1[1]); w.w = cvt_pk_bf16(v1[2], v1[3]);
                        *(u32x4*)(rowp + bj * HALF) = w; } }
        }
    }
};

template <class Epi, class Sched, bool ALIGN_EPI = false, bool SP2 = false>
__device__ __forceinline__ void gemm_phase(PG8_LAS unsigned char* lds, const Gemm g, const Sched& S, const Epi& E) {
    const int tid = threadIdx.x, wid = __builtin_amdgcn_readfirstlane(tid >> 6), lane = tid & 63, wr = wid >> 2, wc = wid & 3, fr = lane & 15, fq = lane >> 4;
    const int K = g.K, nt = K / BK;
    unsigned voffA[2], voffB[2];
#pragma unroll
    for (int i = 0; i < 2; ++i) { int R, C; stage_rc(tid * 16 + i * 8192, R, C); const int Rb = Epi::PERM ? ((R & ~31) + perm32(R & 31)) : R;
        voffA[i] = (unsigned)(R * K + C) * 2u; voffB[i] = (unsigned)(Rb * K + C) * 2u; }
    const size_t kstep = (size_t)(BK * 2);
    const size_t hstep = (size_t)HALF * K * 2;
    const size_t tstep = 2 * hstep;
    const unsigned ldsw = (unsigned)wid * 1024u;
    const int aoff = lds_byte(wr * 64 + fr, fq * 8), boff = lds_byte(wc * 32 + fr, fq * 8);
#define PG8_SA(b, h) (((b) * 2 + (h)) * HTB)
#define PG8_SB(b, h) ((4 + (b) * 2 + (h)) * HTB)
#define PG8_STAGE(bufoff, gbase, voff) do { _Pragma("unroll") for (int _i = 0; _i < 2; ++_i) \
        __builtin_amdgcn_global_load_lds((const unsigned*)((const char*)(gbase) + (voff)[_i]), (PG8_LAS unsigned*)(lds + (bufoff) + ldsw + _i * 8192), 16, 0, 0); } while (0)
#define PG8_LDA(dst, b, h) do { _Pragma("unroll") for (int m = 0; m < 4; ++m) _Pragma("unroll") for (int k = 0; k < 2; ++k) dst[m][k] = *(const PG8_LAS bf16x8*)(lds + PG8_SA(b, h) + aoff + m * 2048 + k * 1024); } while (0)
#define PG8_LDB(dst, b, h) do { _Pragma("unroll") for (int n = 0; n < 2; ++n) _Pragma("unroll") for (int k = 0; k < 2; ++k) dst[n][k] = *(const PG8_LAS bf16x8*)(lds + PG8_SB(b, h) + boff + n * 2048 + k * 1024); } while (0)
#define PG8_MMA(ai, bj, At, Bt) do { __builtin_amdgcn_s_setprio(1); _Pragma("unroll") for (int m = 0; m < 4; ++m) _Pragma("unroll") for (int n = 0; n < 2; ++n) _Pragma("unroll") for (int k = 0; k < 2; ++k) \
        acc[ai][bj][m][n] = __builtin_amdgcn_mfma_f32_16x16x32_bf16(Bt[n][k], At[m][k], acc[ai][bj][m][n], 0, 0, 0); __builtin_amdgcn_s_setprio(0); } while (0)
#define PG8_WAIT_V(n) asm volatile("s_waitcnt vmcnt(" #n ")" ::: "memory")
#define PG8_WAIT_L(n) asm volatile("s_waitcnt lgkmcnt(" #n ")" ::: "memory")
#define PG8_BAR __builtin_amdgcn_s_barrier()
#define PG8_SCHED __builtin_amdgcn_sched_barrier(0)
    Unit cur, nxt; int ui = 0;
    if (!S.next(0, cur)) return;
    f32x4 acc[2][2][4][2];
#pragma unroll
    for (int a = 0; a < 2; ++a)
#pragma unroll
        for (int b = 0; b < 2; ++b)
#pragma unroll
            for (int m = 0; m < 4; ++m)
#pragma unroll
                for (int n = 0; n < 2; ++n) acc[a][b][m][n] = (f32x4){0.f, 0.f, 0.f, 0.f};
    bf16x8 At[4][2], B0[2][2], B1[2][2];
    const char* cA = (const char*)g.A + (size_t)cur.pm * tstep; const char* cB = (const char*)g.Bt + (size_t)cur.pn * tstep;
    S.a_ready(cur);
    if constexpr (SP2) {
        PG8_STAGE(PG8_SB(0, 0), cB, voffB); PG8_STAGE(PG8_SB(0, 1), cB + hstep, voffB); PG8_STAGE(PG8_SA(0, 0), cA, voffA); PG8_STAGE(PG8_SA(0, 1), cA + hstep, voffA);
        if (wr == 1) PG8_BAR;
        PG8_WAIT_V(2); PG8_BAR;
        PG8_STAGE(PG8_SB(1, 0), cB + kstep, voffB); PG8_STAGE(PG8_SA(1, 0), cA + kstep, voffA); PG8_STAGE(PG8_SB(1, 1), cB + hstep + kstep, voffB);
        PG8_WAIT_V(6); PG8_BAR;
    } else {
        PG8_STAGE(PG8_SB(0, 0), cB, voffB); PG8_STAGE(PG8_SA(0, 0), cA, voffA); PG8_STAGE(PG8_SB(0, 1), cB + hstep, voffB); PG8_STAGE(PG8_SA(0, 1), cA + hstep, voffA);
        if (wr == 1) PG8_BAR;
        PG8_WAIT_V(4); PG8_BAR;
        PG8_STAGE(PG8_SB(1, 0), cB + kstep, voffB); PG8_STAGE(PG8_SA(1, 0), cA + kstep, voffA); PG8_STAGE(PG8_SB(1, 1), cB + hstep + kstep, voffB);
        PG8_WAIT_V(6); PG8_BAR;
    }
    for (;;) {
        const bool has_next = S.next(ui + 1, nxt);
        const char* nA = has_next ? (const char*)g.A + (size_t)nxt.pm * tstep : cA; const char* nB = has_next ? (const char*)g.Bt + (size_t)nxt.pn * tstep : cB;
        for (int t = 0; t < nt; t += 2) {
            const bool last = (t == nt - 2);
            const char* a1 = cA + (size_t)(t + 1) * kstep;
            const char* a2 = last ? nA : cA + (size_t)(t + 2) * kstep; const char* b2 = last ? nB : cB + (size_t)(t + 2) * kstep;
            const char* a3 = a2 + kstep; const char* b3 = b2 + kstep;
            if (last && has_next) S.a_ready(nxt);
            if constexpr (SP2) {
            PG8_LDB(B0, 0, 0); PG8_LDB(B1, 0, 1); PG8_SCHED; PG8_LDA(At, 0, 0); PG8_STAGE(PG8_SA(1, 1), a1 + hstep, voffA);
            PG8_WAIT_V(8); PG8_WAIT_L(0); PG8_BAR; PG8_MMA(0, 0, At, B0); PG8_MMA(0, 1, At, B1); PG8_BAR; PG8_SCHED;
            PG8_LDA(At, 0, 1); PG8_STAGE(PG8_SB(0, 0), b2, voffB); PG8_STAGE(PG8_SB(0, 1), b2 + hstep, voffB); PG8_STAGE(PG8_SA(0, 0), a2, voffA);
            PG8_WAIT_V(8); PG8_WAIT_L(0); PG8_BAR; PG8_MMA(1, 0, At, B0); PG8_MMA(1, 1, At, B1); PG8_BAR; PG8_SCHED;
            PG8_LDB(B0, 1, 0); PG8_LDB(B1, 1, 1); PG8_SCHED; PG8_LDA(At, 1, 0); PG8_STAGE(PG8_SA(0, 1), a2 + hstep, voffA);
            PG8_WAIT_V(8); PG8_WAIT_L(0); PG8_BAR; PG8_MMA(0, 0, At, B0); PG8_MMA(0, 1, At, B1); PG8_BAR; PG8_SCHED;
            PG8_LDA(At, 1, 1); PG8_STAGE(PG8_SB(1, 0), b3, voffB); PG8_STAGE(PG8_SB(1, 1), b3 + hstep, voffB); PG8_STAGE(PG8_SA(1, 0), a3, voffA);
            PG8_WAIT_V(8); PG8_WAIT_L(0); PG8_BAR; PG8_MMA(1, 0, At, B0); PG8_MMA(1, 1, At, B1); PG8_BAR; PG8_SCHED;
            } else {
            PG8_LDB(B0, 0, 0); PG8_SCHED; PG8_LDA(At, 0, 0); PG8_STAGE(PG8_SA(1, 1), a1 + hstep, voffA);
            PG8_WAIT_L(8); PG8_BAR; PG8_WAIT_L(0); PG8_MMA(0, 0, At, B0); PG8_BAR; PG8_SCHED;
            PG8_LDB(B1, 0, 1); PG8_STAGE(PG8_SB(0, 0), b2, voffB);
            PG8_BAR; PG8_WAIT_L(0); PG8_MMA(0, 1, At, B1); PG8_BAR;
            PG8_LDA(At, 0, 1); PG8_STAGE(PG8_SA(0, 0), a2, voffA);
            PG8_BAR; PG8_WAIT_L(0); PG8_MMA(1, 0, At, B0); PG8_BAR; PG8_SCHED;
            PG8_STAGE(PG8_SB(0, 1), b2 + hstep, voffB);
            PG8_WAIT_V(6); PG8_BAR; PG8_MMA(1, 1, At, B1); PG8_BAR;
            PG8_LDB(B0, 1, 0); PG8_SCHED; PG8_LDA(At, 1, 0); PG8_STAGE(PG8_SA(0, 1), a2 + hstep, voffA);
            PG8_WAIT_L(8); PG8_BAR; PG8_WAIT_L(0); PG8_MMA(0, 0, At, B0); PG8_BAR; PG8_SCHED;
            PG8_LDB(B1, 1, 1); PG8_STAGE(PG8_SB(1, 0), b3, voffB);
            PG8_BAR; PG8_WAIT_L(0); PG8_MMA(0, 1, At, B1); PG8_BAR;
            PG8_LDA(At, 1, 1); PG8_STAGE(PG8_SA(1, 0), a3, voffA);
            PG8_BAR; PG8_WAIT_L(0); PG8_MMA(1, 0, At, B0); PG8_BAR; PG8_SCHED;
            PG8_STAGE(PG8_SB(1, 1), b3 + hstep, voffB);
            PG8_WAIT_V(6); PG8_BAR; PG8_MMA(1, 1, At, B1); PG8_BAR;
            }
        }
        if constexpr (ALIGN_EPI) { if (wr == 0) PG8_BAR; }
        if constexpr (!Epi::AFTER_DRAIN) { E(acc, cur, wr, wc, fr, fq); S.done(cur); }
        if (!has_next) break;
#pragma unroll
        for (int a = 0; a < 2; ++a)
#pragma unroll
            for (int b = 0; b < 2; ++b)
#pragma unroll
                for (int m = 0; m < 4; ++m)
#pragma unroll
                    for (int n = 0; n < 2; ++n) acc[a][b][m][n] = (f32x4){0.f, 0.f, 0.f, 0.f};
        cur = nxt; cA = nA; cB = nB; ++ui;
        if constexpr (ALIGN_EPI) { if (wr == 1) PG8_BAR; }
    }
    PG8_WAIT_V(0);
    if constexpr (!ALIGN_EPI) { if (wr == 0) PG8_BAR; }
    PG8_BAR;
    if constexpr (Epi::AFTER_DRAIN) { E.fused(acc, cur, wr, wc, fr, fq, lds, wid, lane); S.done(cur); }
#undef PG8_SA
#undef PG8_SB
#undef PG8_STAGE
#undef PG8_LDA
#undef PG8_LDB
#undef PG8_MMA
#undef PG8_WAIT_V
#undef PG8_WAIT_L
#undef PG8_BAR
#undef PG8_SCHED
}
}

using pg8::bf16_t; using pg8::bf16x8; using pg8::f32x4; using pg8::u32x4; using pg8::cvt_pk_bf16; using pg8::silu_f;
#define LAS __attribute__((address_space(3)))
typedef unsigned u32x2 __attribute__((ext_vector_type(2)));
typedef short s16x4 __attribute__((ext_vector_type(4)));
#define MFMA16(a, b, c) __builtin_amdgcn_mfma_f32_16x16x32_bf16((a), (b), (c), 0, 0, 0)

constexpr int NTHR = 512;
constexpr int MTOK = 32768, DM = 1024, SEQ = 2048, DFF = 2816, DEPTH = 4, MODW = 9216;
constexpr float DN_ALPHA = 1.6817928305074290861f;
constexpr size_t MiB = (size_t)1 << 20;
constexpr size_t SZ_FFN_IN = (size_t)5632 * 1024 * 2, SZ_FFN_OUT = (size_t)1024 * 2816 * 2, SZ_RET_IN = (size_t)6144 * 1024 * 2, SZ_RET_OUT = (size_t)1024 * 2048 * 2,
                 SZ_NSA_IN = (size_t)2816 * 1024 * 2, SZ_NSA_OUT = (size_t)1024 * 1024 * 2, SZ_W1 = (size_t)256 * 2048 * 2, SZ_W2 = (size_t)64 * 256 * 2;
constexpr size_t OFF_FFN_IN = 0, OFF_FFN_OUT = OFF_FFN_IN + 8 * SZ_FFN_IN, OFF_RET_IN = OFF_FFN_OUT + 8 * SZ_FFN_OUT, OFF_RET_OUT = OFF_RET_IN + 2 * SZ_RET_IN,
                 OFF_NSA_IN = OFF_RET_OUT + 2 * SZ_RET_OUT, OFF_NSA_OUT = OFF_NSA_IN + 2 * SZ_NSA_IN, OFF_W1 = OFF_NSA_OUT + 2 * SZ_NSA_OUT, OFF_W2 = OFF_W1 + 4 * SZ_W1,
                 OFF_MOD = OFF_W2 + 4 * SZ_W2, OFF_H = OFF_MOD + (size_t)DEPTH * 16 * MODW * 4, OFF_U2 = OFF_H + (size_t)MTOK * DM * 2, WS_END = OFF_U2 + 384 * MiB;
constexpr size_t U_FFN_ACT = 0, U_FFN_Y = 192 * MiB;
constexpr size_t U_RET_QKV = 0, U_RET_G = 0, U_RET_O = 256 * MiB, U_RET_Y = 128 * MiB;
constexpr size_t U_NSA_PROJ = 0, U_NSA_Y = 192 * MiB, U_NSA_ACMPK = 256 * MiB, U_NSA_ACMPV = 288 * MiB, U_NSA_HK = 320 * MiB, U_NSA_HV = 324 * MiB, U_NSA_KCMP = 328 * MiB, U_NSA_VCMP = 329 * MiB, U_NSA_OATT = 256 * MiB;
constexpr int XB_LDS_OFF = 152 * 1024, LDS_BYTES = 152 * 1024 + 16;

struct WJob { const float* src; bf16_t* dst; int K, N, Np, mode; };
struct Params {
    const float* x; const float* c; const float* ada_w; const float* ada_b; const float* ln_g; const float* ln_b; const float* pe_k; const float* pe_v;
    float* out; unsigned char* ws;
    WJob jobs[32]; int tile_end[32]; int njobs; int pad;
};

__device__ __forceinline__ float bf2f(unsigned short b) { return __uint_as_float(((unsigned)b) << 16); }
__device__ __forceinline__ float bflo(unsigned w) { return __uint_as_float(w << 16); }
__device__ __forceinline__ float bfhi(unsigned w) { return __uint_as_float(w & 0xffff0000u); }
__device__ __forceinline__ unsigned short f2bf(float f) { return (unsigned short)(cvt_pk_bf16(f, 0.f) & 0xffffu); }
__device__ __forceinline__ bf16x8 pack8(const f32x4& a, const f32x4& b) { u32x4 w; w.x = cvt_pk_bf16(a[0], a[1]); w.y = cvt_pk_bf16(a[2], a[3]); w.z = cvt_pk_bf16(b[0], b[1]); w.w = cvt_pk_bf16(b[2], b[3]); return __builtin_bit_cast(bf16x8, w); }
__device__ __forceinline__ u32x2 pack4(const f32x4& a) { u32x2 w; w.x = cvt_pk_bf16(a[0], a[1]); w.y = cvt_pk_bf16(a[2], a[3]); return w; }
__device__ __forceinline__ bf16x8 lds_rd16(LAS unsigned char* lds, int off) { return *(const LAS bf16x8*)(lds + off); }
__device__ __forceinline__ bf16x8 lds_rd8x2(LAS unsigned char* lds, int off) { const s16x4 lo = *(const LAS s16x4*)(lds + off), hi = *(const LAS s16x4*)(lds + off + 32); return __builtin_shufflevector(lo, hi, 0, 1, 2, 3, 4, 5, 6, 7); }
template <int M> __device__ __forceinline__ float shx(float v, int lane) {
    if (M < 32) return __int_as_float(__builtin_amdgcn_ds_swizzle(__float_as_int(v), (M << 10) | 0x1f));
    return __int_as_float(__builtin_amdgcn_ds_bpermute((lane ^ M) << 2, __float_as_int(v)));
}
template <int M> __device__ __forceinline__ unsigned shxu(unsigned v, int lane) {
    if (M < 32) return (unsigned)__builtin_amdgcn_ds_swizzle((int)v, (M << 10) | 0x1f);
    return (unsigned)__builtin_amdgcn_ds_bpermute((lane ^ M) << 2, (int)v);
}
__device__ __forceinline__ float shi(float v, int src_lane) { return __int_as_float(__builtin_amdgcn_ds_bpermute(src_lane << 2, __float_as_int(v))); }
__device__ __forceinline__ float wsum(float v, int lane) { v += shx<32>(v, lane); v += shx<16>(v, lane); v += shx<8>(v, lane); v += shx<4>(v, lane); v += shx<2>(v, lane); v += shx<1>(v, lane); return v; }

struct WTile { const float* src; bf16_t* dst; int N, K, sbase, n0, k0; };
__device__ __forceinline__ WTile wt_lookup(const Params& p, int t) {
    int j = 0; while (j < p.njobs - 1 && t >= p.tile_end[j]) ++j;
    const int tl = t - (j ? p.tile_end[j - 1] : 0);
    const WJob& J = p.jobs[j];
    const int ntn = J.Np >> 6; const int tn = tl % ntn, tk = tl / ntn; const int n0 = tn * 64, k0 = tk * 64;
    int sbase = n0; if (J.mode == 1) { const int pn = n0 >> 8, r = n0 & 255; sbase = (r >> 7) * DFF + pn * 128 + (r & 127); }
    return WTile{J.src, J.dst, J.N, J.K, sbase, n0, k0};
}
__device__ __forceinline__ void wt_load(const WTile& W, int tid, f32x4& v0, f32x4& v1) {
    const int kk = tid >> 4, nn = (tid & 15) * 4;
    v0 = (f32x4){0.f, 0.f, 0.f, 0.f}; v1 = v0;
    if (W.sbase + nn < W.N) { v0 = __builtin_nontemporal_load((const f32x4*)(W.src + (size_t)(W.k0 + kk) * W.N + W.sbase + nn)); v1 = __builtin_nontemporal_load((const f32x4*)(W.src + (size_t)(W.k0 + kk + 32) * W.N + W.sbase + nn)); }
}

__device__ __forceinline__ void phase_prep(const Params& p, LAS unsigned char* lds) {
    int tid = threadIdx.x; asm volatile("" : "+v"(tid));
    LAS float* T = (LAS float*)lds;
    const int ntiles = p.tile_end[p.njobs - 1];
    {
        int t = blockIdx.x;
        WTile cur = wt_lookup(p, t < ntiles ? t : 0); f32x4 v0, v1;
        if (t < ntiles) wt_load(cur, tid, v0, v1);
        while (t < ntiles) {
            const int tn = t + (int)gridDim.x; const bool more = tn < ntiles;
            WTile nx = wt_lookup(p, more ? tn : 0); f32x4 n0 = (f32x4){0.f, 0.f, 0.f, 0.f}, n1 = n0;
            if (more) wt_load(nx, tid, n0, n1);
            const int kk = tid >> 4, nn = (tid & 15) * 4;
            T[kk * 65 + nn] = v0[0]; T[kk * 65 + nn + 1] = v0[1]; T[kk * 65 + nn + 2] = v0[2]; T[kk * 65 + nn + 3] = v0[3];
            T[(kk + 32) * 65 + nn] = v1[0]; T[(kk + 32) * 65 + nn + 1] = v1[1]; T[(kk + 32) * 65 + nn + 2] = v1[2]; T[(kk + 32) * 65 + nn + 3] = v1[3];
            __syncthreads();
            const int n = tid >> 3, k8 = (tid & 7) * 8;
            f32x4 a, b;
            a[0] = T[(k8 + 0) * 65 + n]; a[1] = T[(k8 + 1) * 65 + n]; a[2] = T[(k8 + 2) * 65 + n]; a[3] = T[(k8 + 3) * 65 + n];
            b[0] = T[(k8 + 4) * 65 + n]; b[1] = T[(k8 + 5) * 65 + n]; b[2] = T[(k8 + 6) * 65 + n]; b[3] = T[(k8 + 7) * 65 + n];
            *(bf16x8*)(cur.dst + (size_t)(cur.n0 + n) * cur.K + cur.k0 + k8) = pack8(a, b);
            __syncthreads();
            cur = nx; v0 = n0; v1 = n1; t = tn;
        }
    }
    if (blockIdx.x < 288) {
        LAS float* cs = (LAS float*)lds;
        LAS float* red = (LAS float*)(lds + 65536);
        float* mod = (float*)(p.ws + OFF_MOD);
        __syncthreads();
        for (int idx = tid; idx < 16 * 1024; idx += NTHR) { const int b = idx >> 10, k = idx & 1023; const float cv = p.c[idx]; cs[k * 16 + b] = cv / (1.0f + expf(-cv)); }
        __syncthreads();
        for (int unit = blockIdx.x; unit < 288; unit += gridDim.x) {
            const int i = unit / 72, n0 = (unit % 72) * 128, col = tid & 127, kq = tid >> 7;
            f32x4 a0 = (f32x4){0.f, 0.f, 0.f, 0.f}, a1 = a0, a2 = a0, a3 = a0;
            const float* wp = p.ada_w + ((size_t)i * 1024 + kq * 256) * MODW + n0 + col;
#pragma unroll 4
            for (int k = 0; k < 256; ++k) { const float w = __builtin_nontemporal_load(wp + (size_t)k * MODW); const LAS f32x4* cp = (const LAS f32x4*)(cs + (kq * 256 + k) * 16);
                a0 += cp[0] * w; a1 += cp[1] * w; a2 += cp[2] * w; a3 += cp[3] * w; }
#pragma unroll
            for (int b = 0; b < 4; ++b) { red[(kq * 16 + b) * 128 + col] = a0[b]; red[(kq * 16 + 4 + b) * 128 + col] = a1[b]; red[(kq * 16 + 8 + b) * 128 + col] = a2[b]; red[(kq * 16 + 12 + b) * 128 + col] = a3[b]; }
            __syncthreads();
#pragma unroll
            for (int r = 0; r < 4; ++r) { const int o = tid + r * NTHR, b = o >> 7, cc = o & 127;
                const float s = red[(0 * 16 + b) * 128 + cc] + red[(1 * 16 + b) * 128 + cc] + red[(2 * 16 + b) * 128 + cc] + red[(3 * 16 + b) * 128 + cc] + p.ada_b[i * MODW + n0 + cc];
                mod[((size_t)i * 16 + b) * MODW + n0 + cc] = s; }
            __syncthreads();
        }
    }
}

__device__ __forceinline__ void phase_init(const Params& p) {
    const float* mod = (const float*)(p.ws + OFF_MOD); bf16_t* H = (bf16_t*)(p.ws + OFF_H);
    int tid = threadIdx.x; asm volatile("" : "+v"(tid));
    for (size_t i = (size_t)blockIdx.x * NTHR + tid; i < (size_t)MTOK * 256; i += (size_t)gridDim.x * NTHR) {
        const int row = (int)(i >> 8), c4 = (int)(i & 255) * 4, b = row >> 11;
        const f32x4 xv = __builtin_nontemporal_load((const f32x4*)(p.x + i * 4)); *(f32x4*)(p.out + i * 4) = xv;
        const float* m = mod + (size_t)b * MODW; const f32x4 sh = *(const f32x4*)(m + c4), sc = *(const f32x4*)(m + 1024 + c4);
        const f32x4 h = xv * (sc + 1.0f) + sh; *(u32x2*)(H + i * 4) = pack4(h);
    }
}

__device__ __forceinline__ void phase_ln(float* xio, float* xout, const bf16_t* y, const float* modG, float rw, const float* lng, const float* lnb, const float* modSh, const float* modSc, bf16_t* H) {
    int tid = threadIdx.x; asm volatile("" : "+v"(tid));
    const int wid = __builtin_amdgcn_readfirstlane(tid >> 6), lane = tid & 63;
    for (int row = blockIdx.x * 8 + wid; row < MTOK; row += gridDim.x * 8) {
        const int b = row >> 11; const size_t rb = (size_t)row * DM;
        f32x4 z[4]; float s = 0.f;
#pragma unroll
        for (int q = 0; q < 4; ++q) { const int c = q * 256 + lane * 4; const f32x4 xv = __builtin_nontemporal_load((const f32x4*)(xio + rb + c)); const u32x2 yv = __builtin_nontemporal_load((const u32x2*)(y + rb + c));
            const f32x4 gt = *(const f32x4*)(modG + (size_t)b * MODW + c); const f32x4 yf = (f32x4){bflo(yv.x), bfhi(yv.x), bflo(yv.y), bfhi(yv.y)};
            z[q] = xv * DN_ALPHA + (gt + 1.0f) * yf * rw; s += (z[q][0] + z[q][1]) + (z[q][2] + z[q][3]); }
        const float mu = wsum(s, lane) * (1.0f / 1024.0f); float v = 0.f;
#pragma unroll
        for (int q = 0; q < 4; ++q) { const f32x4 d = z[q] - mu; v += (d[0] * d[0] + d[1] * d[1]) + (d[2] * d[2] + d[3] * d[3]); }
        const float rstd = rsqrtf(wsum(v, lane) * (1.0f / 1024.0f) + 1e-5f);
#pragma unroll
        for (int q = 0; q < 4; ++q) { const int c = q * 256 + lane * 4; const f32x4 g4 = *(const f32x4*)(lng + c), b4 = *(const f32x4*)(lnb + c);
            const f32x4 xn = (z[q] - mu) * rstd * g4 + b4; __builtin_nontemporal_store(xn, (f32x4*)(xout + rb + c));
            const f32x4 sh = *(const f32x4*)(modSh + (size_t)b * MODW + c), sc = *(const f32x4*)(modSc + (size_t)b * MODW + c);
            *(u32x2*)(H + rb + c) = pack4(xn * (sc + 1.0f) + sh); }
    }
}

typedef short v4i16_t __attribute__((ext_vector_type(4)));
__device__ __forceinline__ s16x4 lds_tr8(LAS unsigned char* lds, int off) { return __builtin_bit_cast(s16x4, __builtin_amdgcn_ds_read_tr16_b64_v4i16((LAS v4i16_t*)(lds + off))); }

__device__ __forceinline__ bf16x8 lds_tr8x2(LAS unsigned char* lds, int off, int hi_off) { const s16x4 lo = lds_tr8(lds, off), hi = lds_tr8(lds, off + hi_off); return __builtin_shufflevector(lo, hi, 0, 1, 2, 3, 4, 5, 6, 7); }

__device__ __forceinline__ void phase_ret_core(const bf16_t* QKV, bf16_t* O, float* stats, LAS unsigned char* lds) {
    constexpr int KSB = 528, PS = 136, STS = 264, OFF_K = 0, OFF_P = 67584, OFF_VT = 102400, OFF_ST = 119808;
    int tid = threadIdx.x; asm volatile("" : "+v"(tid));
    const int wid = __builtin_amdgcn_readfirstlane(tid >> 6), lane = tid & 63, fr = lane & 15, fq = lane >> 4;
    for (int item = blockIdx.x; item < 512; item += gridDim.x) {
        const int es = item & 7, bh = item >> 3, hh = bh & 3, b = bh >> 2, e0 = es * 64;
        const float log_g = logf(1.0f - exp2f(-5.0f - (float)hh));
        const float gN = expf(log_g * 128.0f);
        const float l2g = log_g * 1.44269504089f;
        __syncthreads();
        for (int i = tid; i < 64 * STS / 2; i += NTHR) ((LAS unsigned*)(lds + OFF_ST))[i] = 0u;
        f32x4 sacc[2][4];
#pragma unroll
        for (int dt = 0; dt < 2; ++dt)
#pragma unroll
            for (int et = 0; et < 4; ++et) sacc[dt][et] = (f32x4){0.f, 0.f, 0.f, 0.f};
        bf16x8 kst[8], vst[2];
        {   const bf16_t* kp = QKV + ((size_t)b * SEQ + (tid >> 5)) * 4096 + 1024 + hh * 256 + (tid & 31) * 8;
#pragma unroll
            for (int it = 0; it < 8; ++it) kst[it] = *(const bf16x8*)(kp + (size_t)it * 16 * 4096);
            const bf16_t* vrow = QKV + ((size_t)b * SEQ + 2 * (tid & 63)) * 4096 + 2048 + hh * 512 + e0 + (tid >> 6) * 8;
            vst[0] = *(const bf16x8*)(vrow); vst[1] = *(const bf16x8*)(vrow + 4096); }
        bf16x8 qf[8];
        { const bf16_t* qrow = QKV + ((size_t)b * SEQ + wid * 16 + fr) * 4096 + hh * 256 + fq * 8;
#pragma unroll
          for (int ks = 0; ks < 8; ++ks) qf[ks] = *(const bf16x8*)(qrow + ks * 32); }
        for (int n = 0; n < 16; ++n) {
            const size_t tok0 = (size_t)b * SEQ + n * 128;
            int t2 = tid; asm volatile("" : "+v"(t2));
            const int lane = t2 & 63, fr = lane & 15, fq = lane >> 4;
            {
#pragma unroll
                for (int it = 0; it < 8; ++it) *(LAS bf16x8*)(lds + OFF_K + ((t2 >> 5) + 16 * it) * KSB + (t2 & 31) * 16) = kst[it];
                const int cp_ = t2 & 63, q_ = t2 >> 6;
#pragma unroll
                for (int i = 0; i < 8; ++i) *(LAS unsigned*)(lds + OFF_VT + ((q_ * 8 + i) * PS + 2 * cp_) * 2) = (unsigned)(unsigned short)vst[0][i] | ((unsigned)(unsigned short)vst[1][i] << 16);
            }
            if (n < 15) {
                const bf16_t* kp = QKV + (tok0 + 128 + (t2 >> 5)) * 4096 + 1024 + hh * 256 + (t2 & 31) * 8;
#pragma unroll
                for (int it = 0; it < 8; ++it) kst[it] = *(const bf16x8*)(kp + (size_t)it * 16 * 4096);
                const bf16_t* vrow = QKV + (tok0 + 128 + 2 * (t2 & 63)) * 4096 + 2048 + hh * 512 + e0 + (t2 >> 6) * 8;
                vst[0] = *(const bf16x8*)(vrow); vst[1] = *(const bf16x8*)(vrow + 4096); }
            __syncthreads();
            const int cc = wid * 16 + fr;
            const int npair = (wid >> 1) + 1;
            f32x4 a1[4], a2[4];
#pragma unroll
            for (int et = 0; et < 4; ++et) { a1[et] = (f32x4){0.f, 0.f, 0.f, 0.f}; a2[et] = a1[et]; }
            for (int cp2 = 0; cp2 < npair; ++cp2) {
                const int kb0 = OFF_K + (cp2 * 32 + fr) * KSB + fq * 16;
                f32x4 acc0 = (f32x4){0.f, 0.f, 0.f, 0.f}, acc1 = acc0;
#pragma unroll
                for (int ks = 0; ks < 8; ++ks) { acc0 = MFMA16(lds_rd16(lds, kb0 + ks * 64), qf[ks], acc0); acc1 = MFMA16(lds_rd16(lds, kb0 + 16 * KSB + ks * 64), qf[ks], acc1); }
                f32x4 pv0, pv1;
#pragma unroll
                for (int j = 0; j < 4; ++j) { const int cp = cp2 * 32 + fq * 4 + j;
                    pv0[j] = (cc >= cp) ? acc0[j] * 0.0625f * __builtin_amdgcn_exp2f(l2g * (float)(cc - cp)) : 0.f;
                    pv1[j] = (cc >= cp + 16) ? acc1[j] * 0.0625f * __builtin_amdgcn_exp2f(l2g * (float)(cc - cp - 16)) : 0.f; }
                const bf16x8 pf = pack8(pv0, pv1);
#pragma unroll
                for (int et = 0; et < 4; ++et) a1[et] = MFMA16(lds_rd8x2(lds, OFF_VT + ((et * 16 + fr) * PS + cp2 * 32 + fq * 4) * 2), pf, a1[et]);
            }
            {
#pragma unroll
                for (int ks = 0; ks < 8; ++ks)
#pragma unroll
                    for (int et = 0; et < 4; ++et) a2[et] = MFMA16(lds_rd16(lds, OFF_ST + ((et * 16 + fr) * STS + ks * 32 + fq * 8) * 2), qf[ks], a2[et]);
                const float dq = __builtin_amdgcn_exp2f(l2g * (float)(cc + 1));
                bf16_t* orow = O + (tok0 + cc) * 2048 + hh * 512 + e0 + fq * 4;
                float ssum = 0.f, ssq = 0.f;
#pragma unroll
                for (int et = 0; et < 4; ++et) { const f32x4 ov = a1[et] + a2[et] * dq; *(u32x2*)(orow + et * 16) = pack4(ov);
                    ssum += (ov[0] + ov[1]) + (ov[2] + ov[3]); ssq += (ov[0] * ov[0] + ov[1] * ov[1]) + (ov[2] * ov[2] + ov[3] * ov[3]); }
                ssum += shx<16>(ssum, lane); ssum += shx<32>(ssum, lane); ssq += shx<16>(ssq, lane); ssq += shx<32>(ssq, lane);
                if (fq == 0) { float* sp = stats + (((tok0 + cc) * 4 + hh) * 8 + es) * 2; sp[0] = ssum; sp[1] = ssq; }
            }
            if (n < 15) {
                const bf16_t* qrow = QKV + (tok0 + 128 + cc) * 4096 + hh * 256 + fq * 8;
#pragma unroll
                for (int ks = 0; ks < 8; ++ks) qf[ks] = *(const bf16x8*)(qrow + ks * 32); }
            __syncthreads();
            if (n < 15) {
#pragma unroll
                for (int dt = 0; dt < 2; ++dt)
#pragma unroll
                    for (int et = 0; et < 4; ++et) sacc[dt][et] *= gN;
                const int q4 = (lane & 15) >> 2, p4 = lane & 3;
                const float fbase = 0.0625f * __builtin_amdgcn_exp2f(l2g * (float)(127 - 8 * fq));
#pragma unroll
                for (int ks = 0; ks < 4; ++ks) {
                    bf16x8 vf[4];
#pragma unroll
                    for (int et = 0; et < 4; ++et) vf[et] = lds_rd16(lds, OFF_VT + ((et * 16 + fr) * PS + ks * 32 + fq * 8) * 2);
                    const float fks = fbase * __builtin_amdgcn_exp2f(l2g * (float)(-32 * ks));
#pragma unroll
                    for (int dt = 0; dt < 2; ++dt) {
                        const int tb = OFF_K + (32 * ks + 8 * fq + q4) * KSB + (2 * wid + dt) * 32 + 8 * p4;
                        const s16x4 lo = lds_tr8(lds, tb), hi = lds_tr8(lds, tb + 4 * KSB);
                        f32x4 f0, f1;
#pragma unroll
                        for (int e = 0; e < 4; ++e) { f0[e] = bf2f((unsigned short)lo[e]) * (fks * __builtin_amdgcn_exp2f(l2g * (float)(-e))); f1[e] = bf2f((unsigned short)hi[e]) * (fks * __builtin_amdgcn_exp2f(l2g * (float)(-4 - e))); }
                        const bf16x8 kf = pack8(f0, f1);
#pragma unroll
                        for (int et = 0; et < 4; ++et) sacc[dt][et] = MFMA16(kf, vf[et], sacc[dt][et]); }
                }
#pragma unroll
                for (int dt = 0; dt < 2; ++dt)
#pragma unroll
                    for (int et = 0; et < 4; ++et) *(LAS u32x2*)(lds + OFF_ST + ((et * 16 + fr) * STS + (2 * wid + dt) * 16 + fq * 4) * 2) = pack4(sacc[dt][et]);
            }
            __syncthreads();
        }
    }
}

__device__ __forceinline__ void phase_ret_gate(bf16_t* O, const bf16_t* G) {
    int tid = threadIdx.x; asm volatile("" : "+v"(tid));
    const int wid = __builtin_amdgcn_readfirstlane(tid >> 6), lane = tid & 63;
    for (int idx = blockIdx.x * 8 + wid; idx < MTOK * 4; idx += gridDim.x * 8) {
        const size_t base = (size_t)(idx >> 2) * 2048 + (idx & 3) * 512 + lane * 8;
        const u32x4 ov = *(const u32x4*)(O + base), gv = *(const u32x4*)(G + base);
        float o[8] = {bflo(ov.x), bfhi(ov.x), bflo(ov.y), bfhi(ov.y), bflo(ov.z), bfhi(ov.z), bflo(ov.w), bfhi(ov.w)};
        const float g[8] = {bflo(gv.x), bfhi(gv.x), bflo(gv.y), bfhi(gv.y), bflo(gv.z), bfhi(gv.z), bflo(gv.w), bfhi(gv.w)};
        float s = 0.f;
#pragma unroll
        for (int i = 0; i < 8; ++i) s += o[i];
        const float mu = wsum(s, lane) * (1.0f / 512.0f); float v = 0.f;
#pragma unroll
        for (int i = 0; i < 8; ++i) { const float d = o[i] - mu; v += d * d; }
        const float rstd = rsqrtf(wsum(v, lane) * (1.0f / 512.0f) + 1e-6f);
#pragma unroll
        for (int i = 0; i < 8; ++i) o[i] = (o[i] - mu) * rstd * silu_f(g[i]);
        u32x4 w; w.x = cvt_pk_bf16(o[0], o[1]); w.y = cvt_pk_bf16(o[2], o[3]); w.z = cvt_pk_bf16(o[4], o[5]); w.w = cvt_pk_bf16(o[6], o[7]);
        *(u32x4*)(O + base) = w;
    }
}

__device__ __forceinline__ void phase_nsa_mat(const bf16_t* PROJ, const float* pek, const float* pev, bf16_t* AK, bf16_t* AV) {
    const size_t per = (size_t)8128 * 256;
    int tid = threadIdx.x; asm volatile("" : "+v"(tid));
    for (size_t i = (size_t)blockIdx.x * NTHR + tid; i < 2 * per; i += (size_t)gridDim.x * NTHR) {
        const int kv = i >= per; const size_t rem = kv ? i - per : i; const int r = (int)(rem >> 8), pp = (int)(rem & 255), l = pp >> 3, d0 = (pp & 7) * 8;
        const int g = r & 3, bn = r >> 2, b = bn / 127, n = bn % 127;
        const u32x4 v = *(const u32x4*)(PROJ + ((size_t)b * SEQ + n * 16 + l) * 2816 + 1024 + kv * 256 + g * 64 + d0);
        const float* pe = (kv ? pev : pek) + l * 64 + d0; const f32x4 p0 = *(const f32x4*)pe, p1 = *(const f32x4*)(pe + 4);
        u32x4 w; w.x = cvt_pk_bf16(bflo(v.x) + p0[0], bfhi(v.x) + p0[1]); w.y = cvt_pk_bf16(bflo(v.y) + p0[2], bfhi(v.y) + p0[3]);
        w.z = cvt_pk_bf16(bflo(v.z) + p1[0], bfhi(v.z) + p1[1]); w.w = cvt_pk_bf16(bflo(v.w) + p1[2], bfhi(v.w) + p1[3]);
        *(u32x4*)((kv ? AV : AK) + (size_t)r * 2048 + l * 64 + d0) = w;
    }
}
__device__ __forceinline__ void phase_nsa_cmp2(const bf16_t* HK, const bf16_t* HV, const bf16_t* W2K, const bf16_t* W2V, bf16_t* KC, bf16_t* VC) {
    int tid = threadIdx.x; asm volatile("" : "+v"(tid));
    const int wid = __builtin_amdgcn_readfirstlane(tid >> 6), lane = tid & 63, fr = lane & 15, fq = lane >> 4;
    for (int tt = blockIdx.x * 8 + wid; tt < 508 * 2; tt += gridDim.x * 8) {
        const int kv = tt >= 508, rt = kv ? tt - 508 : tt; const bf16_t* Hd = kv ? HV : HK; const bf16_t* W = kv ? W2V : W2K; bf16_t* Od = kv ? VC : KC;
        f32x4 acc[4];
#pragma unroll
        for (int nt = 0; nt < 4; ++nt) acc[nt] = (f32x4){0.f, 0.f, 0.f, 0.f};
#pragma unroll
        for (int ks = 0; ks < 8; ++ks) { const bf16x8 hf = *(const bf16x8*)(Hd + (size_t)(rt * 16 + fr) * 256 + ks * 32 + fq * 8);
#pragma unroll
            for (int nt = 0; nt < 4; ++nt) acc[nt] = MFMA16(*(const bf16x8*)(W + (size_t)(nt * 16 + fr) * 256 + ks * 32 + fq * 8), hf, acc[nt]); }
#pragma unroll
        for (int nt = 0; nt < 4; ++nt) *(u32x2*)(Od + (size_t)(rt * 16 + fr) * 64 + nt * 16 + fq * 4) = pack4(acc[nt]);
    }
}

constexpr int A_KS = 72, A_VS = 72, A_KCS = 72, A_VCS = 72, A_KBYTES = 9216, A_VBYTES = 9216;
struct AttnCtx2 { int b, g, cur, head, hp; int t[2]; float slope; bf16x8 qf[2][2]; float gate[2][3]; unsigned selq[2]; unsigned anym; };
constexpr int B_OFF_K = 0, B_OFF_VT = 18432, B_OFF_KC = 36864, B_OFF_VCT = 55296, B_OFF_IMP = 73728, B_OFF_SEL = 107520, B_OFF_SELP = 107776;

template <int BR>
__device__ __forceinline__ void attn_branch64(const bf16_t* PROJ, LAS unsigned char* lds, const AttnCtx2& C, f32x4 (&otot)[2][4], int tid) {
    const int lane = tid & 63, fr = lane & 15, fq = lane >> 4;
    const float qs = 0.125f * 1.44269504089f, slope2 = C.slope * 1.44269504089f;
    f32x4 sl[4];
#pragma unroll
    for (int kt = 0; kt < 4; ++kt)
#pragma unroll
        for (int jj = 0; jj < 4; ++jj) sl[kt][jj] = slope2 * (float)(kt * 16 + jj);
    float m_[2] = {-1e30f, -1e30f}, l_[2] = {0.f, 0.f};
    f32x4 oa[2][4];
#pragma unroll
    for (int qi = 0; qi < 2; ++qi)
#pragma unroll
        for (int dt = 0; dt < 4; ++dt) oa[qi][dt] = (f32x4){0.f, 0.f, 0.f, 0.f};
    const int jlo = (BR == 1) ? 0 : (C.cur > 8 ? C.cur - 8 : 0);
    const int koff = (BR == 1 ? 1536 : 2048) + C.g * 64, voff = (BR == 1 ? 1792 : 2304) + C.g * 64;
    const int key = tid >> 3, d0 = (tid & 7) * 8;
    const bf16_t* srcb = PROJ + ((size_t)C.b * SEQ + key) * 2816 + d0;
    const int wofs = (key * A_KS + d0) * 2;
    int j = jlo;
    if (BR == 1) { while (j <= C.cur && !((C.anym >> j) & 1u)) ++j; }
    bf16x8 kreg = *(const bf16x8*)(srcb + (size_t)j * 64 * 2816 + koff), vreg = *(const bf16x8*)(srcb + (size_t)j * 64 * 2816 + voff);
    __syncthreads();
    int buf = 0;
    *(LAS bf16x8*)(lds + B_OFF_K + wofs) = kreg; *(LAS bf16x8*)(lds + B_OFF_VT + wofs) = vreg;
    __syncthreads();
    while (j <= C.cur) {
        int jn = j + 1;
        if (BR == 1) { while (jn <= C.cur && !((C.anym >> jn) & 1u)) ++jn; }
        const bool more = jn <= C.cur;
        if (more) { kreg = *(const bf16x8*)(srcb + (size_t)jn * 64 * 2816 + koff); vreg = *(const bf16x8*)(srcb + (size_t)jn * 64 * 2816 + voff); }
        const int kb = B_OFF_K + buf * A_KBYTES, vb = B_OFF_VT + buf * A_VBYTES;
        const bool partial = (j == C.cur) || (BR == 2 && j + 8 <= C.cur);
        bf16x8 pf[2][2];
#pragma unroll
        for (int qi = 0; qi < 2; ++qi) {
            f32x4 s4[4]; float alpha;
            const int dbase = C.t[qi] - j * 64 - fq * 4;
            if (partial) {
                float tmax = -1e30f;
#pragma unroll
                for (int kt = 0; kt < 4; ++kt) { f32x4 acc = (f32x4){0.f, 0.f, 0.f, 0.f};
#pragma unroll
                    for (int ks = 0; ks < 2; ++ks) acc = MFMA16(lds_rd16(lds, kb + ((kt * 16 + fr) * A_KS + ks * 32 + fq * 8) * 2), C.qf[qi][ks], acc);
#pragma unroll
                    for (int jj = 0; jj < 4; ++jj) { const int dist = dbase - (kt * 16 + jj);
                        const bool ok = (dist >= 0) && (BR == 1 ? (((C.selq[qi] >> j) & 1u) != 0u) : (dist < 512));
                        const float sv = ok ? acc[jj] * qs - slope2 * (float)dist : -1e30f; s4[kt][jj] = sv; tmax = fmaxf(tmax, sv); } }
                tmax = fmaxf(tmax, shx<16>(tmax, lane)); tmax = fmaxf(tmax, shx<32>(tmax, lane));
                const float mnew = fmaxf(m_[qi], tmax); alpha = __builtin_amdgcn_exp2f(m_[qi] - mnew); m_[qi] = mnew;
                float psum = 0.f;
#pragma unroll
                for (int kt = 0; kt < 4; ++kt)
#pragma unroll
                    for (int jj = 0; jj < 4; ++jj) { const float pp = (s4[kt][jj] > -1e29f) ? __builtin_amdgcn_exp2f(s4[kt][jj] - mnew) : 0.f; s4[kt][jj] = pp; psum += pp; }
                l_[qi] = l_[qi] * alpha + psum;
            } else {
                float c0 = -slope2 * (float)dbase;
                if (BR == 1 && !((C.selq[qi] >> j) & 1u)) c0 = -1e30f;
                float tmax = -1e30f;
#pragma unroll
                for (int kt = 0; kt < 4; ++kt) { f32x4 acc = (f32x4){0.f, 0.f, 0.f, 0.f};
#pragma unroll
                    for (int ks = 0; ks < 2; ++ks) acc = MFMA16(lds_rd16(lds, kb + ((kt * 16 + fr) * A_KS + ks * 32 + fq * 8) * 2), C.qf[qi][ks], acc);
#pragma unroll
                    for (int jj = 0; jj < 4; ++jj) { const float u = acc[jj] * qs + sl[kt][jj]; s4[kt][jj] = u; tmax = fmaxf(tmax, u); } }
                tmax += c0;
                tmax = fmaxf(tmax, shx<16>(tmax, lane)); tmax = fmaxf(tmax, shx<32>(tmax, lane));
                const float mnew = fmaxf(m_[qi], tmax); alpha = __builtin_amdgcn_exp2f(m_[qi] - mnew); m_[qi] = mnew;
                const float sh = mnew - c0; float psum = 0.f;
#pragma unroll
                for (int kt = 0; kt < 4; ++kt)
#pragma unroll
                    for (int jj = 0; jj < 4; ++jj) { const float pp = __builtin_amdgcn_exp2f(s4[kt][jj] - sh); s4[kt][jj] = pp; psum += pp; }
                l_[qi] = l_[qi] * alpha + psum;
            }
#pragma unroll
            for (int dt = 0; dt < 4; ++dt) oa[qi][dt] *= alpha;
            pf[qi][0] = pack8(s4[0], s4[1]); pf[qi][1] = pack8(s4[2], s4[3]);
        }
#pragma unroll
        for (int ks2 = 0; ks2 < 2; ++ks2)
#pragma unroll
            for (int dt = 0; dt < 4; ++dt) { const bf16x8 vf = lds_tr8x2(lds, vb + (ks2 * 32 + fq * 4 + ((lane & 15) >> 2)) * (A_VS * 2) + dt * 32 + 8 * (lane & 3), 16 * A_VS * 2);
                oa[0][dt] = MFMA16(vf, pf[0][ks2], oa[0][dt]); oa[1][dt] = MFMA16(vf, pf[1][ks2], oa[1][dt]); }
        if (more) { *(LAS bf16x8*)(lds + B_OFF_K + (buf ^ 1) * A_KBYTES + wofs) = kreg; *(LAS bf16x8*)(lds + B_OFF_VT + (buf ^ 1) * A_VBYTES + wofs) = vreg; }
        __syncthreads();
        buf ^= 1; j = jn;
    }
#pragma unroll
    for (int qi = 0; qi < 2; ++qi) { float lt = l_[qi]; lt += shx<16>(lt, lane); lt += shx<32>(lt, lane); const float inv = lt > 0.f ? C.gate[qi][BR] / lt : 0.f;
#pragma unroll
        for (int dt = 0; dt < 4; ++dt) otot[qi][dt] += oa[qi][dt] * inv; }
}

__device__ __forceinline__ void phase_nsa_attn64(const bf16_t* PROJ, const bf16_t* KCMP, const bf16_t* VCMP, bf16_t* OATT, LAS unsigned char* lds) {
    int tid0 = threadIdx.x; asm volatile("" : "+v"(tid0));
    const int wid = __builtin_amdgcn_readfirstlane(tid0 >> 6);
    LAS float* IMP = (LAS float*)(lds + B_OFF_IMP); LAS unsigned* SEL = (LAS unsigned*)(lds + B_OFF_SEL); LAS unsigned* SELP = (LAS unsigned*)(lds + B_OFF_SELP);
    for (int id = blockIdx.x; id < 2048; id += gridDim.x) {
        int tid = tid0; asm volatile("" : "+v"(tid));
        const int lane = tid & 63, fr = lane & 15, fq = lane >> 4;
        const int k8 = id & 255, ii = id >> 8, bg = k8 & 63, kk = k8 >> 6;
        AttnCtx2 C; C.cur = (ii & 1) ? 31 - (kk + 4 * (ii - 1)) : kk + 4 * ii; C.b = bg >> 2; C.g = bg & 3; C.hp = wid >> 1; C.head = C.g * 4 + C.hp; C.slope = exp2f(-0.5f * (float)(C.head + 1));
        int qq[2]; size_t trow[2];
#pragma unroll
        for (int qi = 0; qi < 2; ++qi) { qq[qi] = (wid & 1) * 32 + qi * 16 + fr; C.t[qi] = C.cur * 64 + qq[qi]; trow[qi] = (size_t)C.b * SEQ + C.t[qi];
            const bf16_t* pr = PROJ + trow[qi] * 2816;
#pragma unroll
            for (int ks = 0; ks < 2; ++ks) C.qf[qi][ks] = *(const bf16x8*)(pr + C.head * 64 + ks * 32 + fq * 8);
#pragma unroll
            for (int br = 0; br < 3; ++br) C.gate[qi][br] = 1.0f / (1.0f + __expf(-bf2f(pr[2560 + C.head * 3 + br]))); }
        f32x4 otot[2][4];
#pragma unroll
        for (int qi = 0; qi < 2; ++qi)
#pragma unroll
            for (int dt = 0; dt < 4; ++dt) otot[qi][dt] = (f32x4){0.f, 0.f, 0.f, 0.f};
        __syncthreads();
#pragma unroll
        for (int rep = 0; rep < 2; ++rep) { const int idx = tid + rep * NTHR, n = idx >> 3, d0 = (idx & 7) * 8, nc = n < 126 ? n : 126; const size_t src = ((size_t)(C.b * 127 + nc) * 4 + C.g) * 64 + d0;
            *(LAS bf16x8*)(lds + B_OFF_KC + (n * A_KCS + d0) * 2) = *(const bf16x8*)(KCMP + src);
            *(LAS bf16x8*)(lds + B_OFF_VCT + (n * A_VCS + d0) * 2) = *(const bf16x8*)(VCMP + src); }
        __syncthreads();
#pragma unroll
        for (int qi = 0; qi < 2; ++qi) {
            f32x4 sc[8]; float mx = -1e30f;
#pragma unroll
            for (int kt = 0; kt < 8; ++kt) { f32x4 acc = (f32x4){0.f, 0.f, 0.f, 0.f};
#pragma unroll
                for (int ks = 0; ks < 2; ++ks) acc = MFMA16(lds_rd16(lds, B_OFF_KC + ((kt * 16 + fr) * A_KCS + ks * 32 + fq * 8) * 2), C.qf[qi][ks], acc);
#pragma unroll
                for (int jj = 0; jj < 4; ++jj) { const int n = kt * 16 + fq * 4 + jj, ce = n * 16 + 31; const bool ok = (n <= 126) && (ce <= C.t[qi]);
                    const float sv = ok ? acc[jj] * 0.125f - C.slope * (float)(C.t[qi] - ce) : -1e30f; sc[kt][jj] = sv; mx = fmaxf(mx, sv); } }
            mx = fmaxf(mx, shx<16>(mx, lane)); mx = fmaxf(mx, shx<32>(mx, lane));
            float sum = 0.f;
#pragma unroll
            for (int kt = 0; kt < 8; ++kt)
#pragma unroll
                for (int jj = 0; jj < 4; ++jj) { const float pp = (sc[kt][jj] > -1e29f) ? __expf(sc[kt][jj] - mx) : 0.f; sc[kt][jj] = pp; sum += pp; }
            sum += shx<16>(sum, lane); sum += shx<32>(sum, lane);
            const float inv = sum > 0.f ? 1.0f / sum : 0.f;
#pragma unroll
            for (int kt = 0; kt < 8; ++kt) sc[kt] *= inv;
#pragma unroll
            for (int kt = 0; kt < 8; ++kt) { const float a = shi(sc[kt][3], (lane + 48) & 63); const float bp = kt > 0 ? shi(sc[kt > 0 ? kt - 1 : 0][3], (lane + 48) & 63) : 0.f;
                const float prev3 = fq > 0 ? a : bp;
                IMP[(C.hp * 64 + qq[qi]) * 33 + 4 * kt + fq] = sc[kt][0] + sc[kt][1] + sc[kt][2] + 0.5f * sc[kt][3] + 0.5f * prev3; }
            f32x4 oc[4];
#pragma unroll
            for (int dt = 0; dt < 4; ++dt) oc[dt] = (f32x4){0.f, 0.f, 0.f, 0.f};
#pragma unroll
            for (int ks2 = 0; ks2 < 4; ++ks2) { const bf16x8 pfc = pack8(sc[2 * ks2], sc[2 * ks2 + 1]);
#pragma unroll
                for (int dt = 0; dt < 4; ++dt) oc[dt] = MFMA16(lds_tr8x2(lds, B_OFF_VCT + (ks2 * 32 + fq * 4 + ((lane & 15) >> 2)) * (A_VCS * 2) + dt * 32 + 8 * (lane & 3), 16 * A_VCS * 2), pfc, oc[dt]); }
#pragma unroll
            for (int dt = 0; dt < 4; ++dt) otot[qi][dt] += oc[dt] * C.gate[qi][0];
        }
        __syncthreads();
        if (C.cur >= 16) {
            const int sq = tid & 63, jg = tid >> 6;
#pragma unroll
            for (int jj = 0; jj < 4; ++jj) { const int j = jg * 4 + jj; const float imp = IMP[(0 * 64 + sq) * 33 + j] + IMP[(1 * 64 + sq) * 33 + j] + IMP[(2 * 64 + sq) * 33 + j] + IMP[(3 * 64 + sq) * 33 + j];
                const bool valid = j <= C.cur, forced = (j == 0) || (j == C.cur) || (j == C.cur - 1);
                IMP[sq * 33 + j] = valid ? (forced ? 1e4f : imp) : -1.0f; }
            __syncthreads();
            unsigned bits = 0u;
#pragma unroll
            for (int jj = 0; jj < 4; ++jj) { const int j = jg * 4 + jj; const float sj = IMP[sq * 33 + j]; int cnt = 0;
                for (int j2 = 0; j2 < 32; ++j2) { const float s2 = IMP[sq * 33 + j2]; cnt += ((s2 > sj) || (s2 == sj && j2 < j)) ? 1 : 0; }
                if (cnt < 16) bits |= 1u << j; }
            SELP[jg * 64 + sq] = bits;
            __syncthreads();
            if (tid < 64) { unsigned m = 0u;
#pragma unroll
                for (int q = 0; q < 8; ++q) m |= SELP[q * 64 + tid];
                SEL[tid] = m; }
        } else { if (tid < 64) SEL[tid] = (2u << C.cur) - 1u; }
        __syncthreads();
        C.selq[0] = SEL[qq[0]]; C.selq[1] = SEL[qq[1]];
        { unsigned m = SEL[lane]; m |= shxu<32>(m, lane); m |= shxu<16>(m, lane); m |= shxu<8>(m, lane); m |= shxu<4>(m, lane); m |= shxu<2>(m, lane); m |= shxu<1>(m, lane); C.anym = (unsigned)__builtin_amdgcn_readfirstlane((int)m); }
        attn_branch64<1>(PROJ, lds, C, otot, tid);
        attn_branch64<2>(PROJ, lds, C, otot, tid);
#pragma unroll
        for (int qi = 0; qi < 2; ++qi)
#pragma unroll
            for (int dt = 0; dt < 4; ++dt) *(u32x2*)(OATT + trow[qi] * 1024 + C.head * 64 + dt * 16 + fq * 4) = pack4(otot[qi][dt]);
    }
}

#define XB_TMO      128
#define XB_XCNT(j)  (256  + 64 * (j))
#define XB_XSUB(j)  (1280 + 64 * (j))
#define XB_XGEN(j)  (2304 + 64 * (j))
#define XB_TOP      3328
#define XB_TOPGEN   3392
#define XCD_BAR_WORDS 3456
#define XB_SPIN_CAP (1u << 18)

__device__ __forceinline__ unsigned xb_ld(unsigned* p)              { return __hip_atomic_load(p, __ATOMIC_RELAXED, __HIP_MEMORY_SCOPE_AGENT); }
__device__ __forceinline__ unsigned xb_add(unsigned* p, unsigned v) { return __hip_atomic_fetch_add(p, v, __ATOMIC_RELAXED, __HIP_MEMORY_SCOPE_AGENT); }
__device__ __forceinline__ unsigned xb_xcc_id() { return (unsigned)__builtin_amdgcn_s_getreg((3 << 11) | 20) & 0xFu; }
#define XB_SPIN(cond, bar) do { unsigned _sp = 0; while (cond) { __builtin_amdgcn_s_sleep(1); \
    if ((++_sp & 255u) == 0u) { if (xb_ld(&(bar)[XB_TMO])) break; if (_sp > XB_SPIN_CAP) { atomicAdd(&(bar)[XB_TMO], 1u); break; } } } } while (0)

struct XcdBarrier {
    unsigned* bar; unsigned x;
    volatile LAS unsigned* st;
};

__device__ __forceinline__ XcdBarrier xcd_barrier_post(unsigned* bar, volatile LAS unsigned* st) {
    XcdBarrier b; b.bar = bar; b.x = xb_xcc_id(); b.st = st;
    if (threadIdx.x == 0) (void)xb_add(&bar[XB_XCNT(b.x)], 1u);
    return b;
}
__device__ __forceinline__ void xcd_barrier_complete(unsigned* bar, unsigned x, unsigned& nloc, unsigned& nx) {
    const unsigned G = gridDim.x * gridDim.y * gridDim.z;
    unsigned sum, cnt, mine, sp = 0u;
    for (;;) {
        sum = 0u; cnt = 0u; mine = 0u;
#pragma unroll
        for (unsigned j = 0; j < 16; ++j) { const unsigned c = xb_ld(&bar[XB_XCNT(j)]); sum += c; cnt += (c > 0u) ? 1u : 0u; mine = (j == x) ? c : mine; }
        if (sum == G) break;
        __builtin_amdgcn_s_sleep(1);
        if ((++sp & 255u) == 0u) { if (xb_ld(&bar[XB_TMO])) break; if (sp > XB_SPIN_CAP) { atomicAdd(&bar[XB_TMO], 1u); break; } }
    }
    nloc = mine > 0u ? mine : 1u; nx = cnt > 0u ? cnt : 1u;
}

__device__ __forceinline__ void xcd_barrier(const XcdBarrier& b) {
    asm volatile("s_waitcnt vmcnt(0)" ::: "memory");
    __syncthreads();
    if (threadIdx.x == 0) {
        unsigned* bar = b.bar;
        __builtin_amdgcn_s_waitcnt(0);
        unsigned nloc = b.st[0], nx = b.st[1];
        if (nloc == 0u) { xcd_barrier_complete(bar, b.x, nloc, nx); b.st[0] = nloc; b.st[1] = nx; }
        const unsigned old = xb_add(&bar[XB_XSUB(b.x)], 1u);
        const unsigned gen = old / nloc;
        if (old + 1u == (gen + 1u) * nloc) {
            __builtin_amdgcn_fence(__ATOMIC_RELEASE, "agent");
            asm volatile("s_waitcnt vmcnt(0)" ::: "memory");
            const unsigned og = xb_add(&bar[XB_TOP], 1u);
            const unsigned tg = og / nx;
            if (og + 1u == (tg + 1u) * nx) xb_add(&bar[XB_TOPGEN], 1u);
            else XB_SPIN(xb_ld(&bar[XB_TOPGEN]) == tg, bar);
            __builtin_amdgcn_fence(__ATOMIC_ACQUIRE, "agent");
            xb_add(&bar[XB_XGEN(b.x)], 1u);
            asm volatile("s_waitcnt vmcnt(0)" ::: "memory");
        } else {
            XB_SPIN(xb_ld(&bar[XB_XGEN(b.x)]) == gen, bar);
            __builtin_amdgcn_fence(__ATOMIC_ACQUIRE, "agent");
            asm volatile("s_waitcnt vmcnt(0)" ::: "memory");
        }
    }
    __syncthreads();
}


#ifndef R_CORE
#define R_CORE 1
#endif
#ifndef R_ATTN
#define R_ATTN 1
#endif
#ifndef R_GEMM
#define R_GEMM 1
#endif
#ifndef R_BAR
#define R_BAR 1
#endif
#ifndef R_PREP
#define R_PREP 1
#endif
#ifndef GEMM_ALIGN
#define GEMM_ALIGN true
#endif
#ifndef GEMM_SP2
#define GEMM_SP2 true
#endif
struct GemmDesc { const bf16_t* A; const bf16_t* Bt; bf16_t* O; int M, N, K, ldc, act, cshift; const float* stats; };
__device__ __forceinline__ void run_gemm(const GemmDesc& d, LAS unsigned char* lds) {
    pg8::Gemm g{d.A, d.Bt, d.M, d.N, d.K}; pg8::StaticOrder S; const int G = (int)gridDim.x; S.init(d.M, d.N, G, ((int)blockIdx.x + G - d.cshift % G) % G);
    if (d.act == 0) { pg8::Epi<0> E{d.O, d.ldc, nullptr}; pg8::gemm_phase<pg8::Epi<0>, pg8::StaticOrder, GEMM_ALIGN, GEMM_SP2>(lds, g, S, E); }
    else if (d.act == 1) { pg8::Epi<1> E{d.O, d.ldc, nullptr}; pg8::gemm_phase<pg8::Epi<1>, pg8::StaticOrder, GEMM_ALIGN, GEMM_SP2>(lds, g, S, E); }
    else if (d.act == 3) { pg8::Epi<3> E{d.O, d.ldc, d.stats}; pg8::gemm_phase<pg8::Epi<3>, pg8::StaticOrder, GEMM_ALIGN, GEMM_SP2>(lds, g, S, E); }
    else { pg8::Epi<2> E{d.O, d.ldc, nullptr}; pg8::gemm_phase<pg8::Epi<2>, pg8::StaticOrder, GEMM_ALIGN, GEMM_SP2>(lds, g, S, E); }
}

__global__ void __launch_bounds__(NTHR) fwd_megakernel(Params p) {
    extern __shared__ __attribute__((aligned(16))) unsigned char smem[];
    LAS unsigned char* lds = (LAS unsigned char*)smem;
    cg::grid_group grid = cg::this_grid();
    unsigned char* ws = p.ws; unsigned char* U = ws + OFF_U2;
    const float* mod = (const float*)(ws + OFF_MOD); bf16_t* H = (bf16_t*)(ws + OFF_H);
    if (threadIdx.x < 4) ((LAS unsigned*)(lds + XB_LDS_OFF))[threadIdx.x] = 0u;
    __syncthreads();
    XcdBarrier xbar = xcd_barrier_post((unsigned*)(ws + WS_END), (volatile LAS unsigned*)(lds + XB_LDS_OFF));
    grid.sync();

#if 0
    { const u32x4 pz = (u32x4){0xAAAAAAAAu, 0xAAAAAAAAu, 0xAAAAAAAAu, 0xAAAAAAAAu}; for (size_t i = (size_t)blockIdx.x * NTHR + threadIdx.x; i < WS_END / 16; i += (size_t)gridDim.x * NTHR) ((u32x4*)ws)[i] = pz; }
    xcd_barrier(xbar);
#endif
    for (int gs = 0; gs < 2 + DEPTH * 13; ++gs) {
        if (gs < 2) {
            if (gs == 0) { for (int rr = 0; rr < R_PREP; ++rr) phase_prep(p, lds); } else phase_init(p);
        } else {
        const int layer = (gs - 2) / 13, st = (gs - 2) % 13;
        const int jm = layer >> 1; const bool is_ret = (layer & 1) == 0;
        const float* modL = mod + (size_t)layer * 16 * MODW;
        {
            GemmDesc d[2]; int ng = 0;
            d[0].cshift = 0; d[1].cshift = 0;
            if (st == 0 || st == 10) {
                const int s = st == 0 ? 0 : 1;
                d[0] = GemmDesc{H, (const bf16_t*)(ws + OFF_FFN_IN + (size_t)(layer * 2 + s) * SZ_FFN_IN), (bf16_t*)(U + U_FFN_ACT), MTOK, 5632, 1024, DFF, 1, 0, nullptr}; ng = 1;
            } else if (st == 1 || st == 11) {
                const int s = st == 1 ? 0 : 1;
                d[0] = GemmDesc{(const bf16_t*)(U + U_FFN_ACT), (const bf16_t*)(ws + OFF_FFN_OUT + (size_t)(layer * 2 + s) * SZ_FFN_OUT), (bf16_t*)(U + U_FFN_Y), MTOK, 1024, DFF, 1024, 0, 0, nullptr}; ng = 1;
            } else if (st == 2 || st == 9 || st == 12) {
                const int sub = st == 2 ? 0 : (st == 9 ? 1 : 2);
                const bf16_t* y = (const bf16_t*)(U + (sub == 1 ? (is_ret ? U_RET_Y : U_NSA_Y) : U_FFN_Y));
                const float* modN = (sub == 2) ? (layer + 1 < DEPTH ? modL + (size_t)16 * MODW : modL) : modL;
                const int shc = (sub == 2) ? 0 : (sub + 1) * 3;
                phase_ln(p.out, p.out, y, modL + (sub * 3 + 2) * 1024, sub == 1 ? 1.0f : 0.5f, p.ln_g + (size_t)(layer * 3 + sub) * 1024, p.ln_b + (size_t)(layer * 3 + sub) * 1024,
                         modN + shc * 1024, modN + (shc + 1) * 1024, H);
            } else if (is_ret) {
                const bf16_t* Wi = (const bf16_t*)(ws + OFF_RET_IN + (size_t)jm * SZ_RET_IN);
                if (st == 3) { d[0] = GemmDesc{H, Wi, (bf16_t*)(U + U_RET_QKV), MTOK, 4096, 1024, 4096, 0, 0, nullptr}; ng = 1; }
                else if (st == 4) { for (int rr = 0; rr < R_CORE; ++rr) phase_ret_core((const bf16_t*)(U + U_RET_QKV), (bf16_t*)(U + U_RET_O), (float*)(ws + OFF_FFN_IN + (size_t)(layer * 2) * SZ_FFN_IN), lds); }
                else if (st == 5) { d[0] = GemmDesc{H, Wi + (size_t)4096 * 1024, (bf16_t*)(U + U_RET_O), MTOK, 2048, 1024, 2048, 3, 0, (const float*)(ws + OFF_FFN_IN + (size_t)(layer * 2) * SZ_FFN_IN)}; ng = 1; }
                else if (st == 6) continue;
                else if (st == 7) { d[0] = GemmDesc{(const bf16_t*)(U + U_RET_O), (const bf16_t*)(ws + OFF_RET_OUT + (size_t)jm * SZ_RET_OUT), (bf16_t*)(U + U_RET_Y), MTOK, 1024, 2048, 1024, 0, 0, nullptr}; ng = 1; }
                else continue;
            } else {
                if (st == 3) { d[0] = GemmDesc{H, (const bf16_t*)(ws + OFF_NSA_IN + (size_t)jm * SZ_NSA_IN), (bf16_t*)(U + U_NSA_PROJ), MTOK, 2816, 1024, 2816, 0, 0, nullptr}; ng = 1; }
                else if (st == 4) phase_nsa_mat((const bf16_t*)(U + U_NSA_PROJ), p.pe_k + (size_t)jm * 2048, p.pe_v + (size_t)jm * 2048, (bf16_t*)(U + U_NSA_ACMPK), (bf16_t*)(U + U_NSA_ACMPV));
                else if (st == 5) {
                    d[0] = GemmDesc{(const bf16_t*)(U + U_NSA_ACMPK), (const bf16_t*)(ws + OFF_W1 + (size_t)(0 * 2 + jm) * SZ_W1), (bf16_t*)(U + U_NSA_HK), 8192, 256, 2048, 256, 2, 0, nullptr};
                    d[1] = GemmDesc{(const bf16_t*)(U + U_NSA_ACMPV), (const bf16_t*)(ws + OFF_W1 + (size_t)(1 * 2 + jm) * SZ_W1), (bf16_t*)(U + U_NSA_HV), 8192, 256, 2048, 256, 2, 32, nullptr}; ng = 2;
                } else if (st == 6) phase_nsa_cmp2((const bf16_t*)(U + U_NSA_HK), (const bf16_t*)(U + U_NSA_HV), (const bf16_t*)(ws + OFF_W2 + (size_t)(0 * 2 + jm) * SZ_W2), (const bf16_t*)(ws + OFF_W2 + (size_t)(1 * 2 + jm) * SZ_W2),
                                               (bf16_t*)(U + U_NSA_KCMP), (bf16_t*)(U + U_NSA_VCMP));
                else if (st == 7) { for (int rr = 0; rr < R_ATTN; ++rr) phase_nsa_attn64((const bf16_t*)(U + U_NSA_PROJ), (const bf16_t*)(U + U_NSA_KCMP), (const bf16_t*)(U + U_NSA_VCMP), (bf16_t*)(U + U_NSA_OATT), lds); }
                else { d[0] = GemmDesc{(const bf16_t*)(U + U_NSA_OATT), (const bf16_t*)(ws + OFF_NSA_OUT + (size_t)jm * SZ_NSA_OUT), (bf16_t*)(U + U_NSA_Y), MTOK, 1024, 1024, 1024, 0, 0, nullptr}; ng = 1; }
            }
            for (int rr = 0; rr < R_GEMM; ++rr) for (int r = 0; r < ng; ++r) { GemmDesc dd = d[0]; if (r == 1) dd = d[1]; run_gemm(dd, lds); }
        }
        }
        xcd_barrier(xbar);
    }
}

extern "C" void kernel_launch(void* const* d_in, const int* in_sizes, int n_in, void* d_out, int out_size, void* d_ws, size_t ws_size, hipStream_t stream) {
    static int grid_blocks = 0;
    if (grid_blocks == 0) {
        int dev = 0, cus = 0, per_cu = 0;
        hipGetDevice(&dev); hipDeviceGetAttribute(&cus, hipDeviceAttributeMultiprocessorCount, dev);
        if (hipFuncSetAttribute((const void*)fwd_megakernel, hipFuncAttributeMaxDynamicSharedMemorySize, LDS_BYTES) != hipSuccess) fprintf(stderr, "hipFuncSetAttribute failed\n");
        if (hipOccupancyMaxActiveBlocksPerMultiprocessor(&per_cu, (const void*)fwd_megakernel, NTHR, LDS_BYTES) != hipSuccess || per_cu < 1) { fprintf(stderr, "occupancy query: %d\n", per_cu); per_cu = 1; }
        (void)hipGetLastError();
        grid_blocks = cus * 1;
        if (ws_size < WS_END + 16384) fprintf(stderr, "workspace too small: %zu < %zu\n", ws_size, (size_t)WS_END);
    }
    Params p{};
    p.x = (const float*)d_in[0]; p.c = (const float*)d_in[1]; p.ada_w = (const float*)d_in[2]; p.ada_b = (const float*)d_in[3]; p.ln_g = (const float*)d_in[4]; p.ln_b = (const float*)d_in[5];
    p.pe_k = (const float*)d_in[12]; p.pe_v = (const float*)d_in[13]; p.out = (float*)d_out; p.ws = (unsigned char*)d_ws;
    unsigned char* ws = (unsigned char*)d_ws; int nj = 0, te = 0;
    auto add = [&](const float* src, size_t dst_off, int K, int N, int Np, int mode) { p.jobs[nj] = WJob{src, (bf16_t*)(ws + dst_off), K, N, Np, mode}; te += (Np / 64) * (K / 64); p.tile_end[nj] = te; ++nj; };
    const float* ffn_in = (const float*)d_in[6]; const float* ffn_out = (const float*)d_in[7]; const float* ret_in = (const float*)d_in[8]; const float* ret_out = (const float*)d_in[9];
    const float* nsa_in = (const float*)d_in[10]; const float* nsa_out = (const float*)d_in[11];
    const float* ck1 = (const float*)d_in[14]; const float* ck2 = (const float*)d_in[15]; const float* cv1 = (const float*)d_in[16]; const float* cv2 = (const float*)d_in[17];
    for (int i = 0; i < 8; ++i) add(ffn_in + (size_t)i * 1024 * 5632, OFF_FFN_IN + i * SZ_FFN_IN, 1024, 5632, 5632, 1);
    for (int i = 0; i < 8; ++i) add(ffn_out + (size_t)i * 2816 * 1024, OFF_FFN_OUT + i * SZ_FFN_OUT, 2816, 1024, 1024, 0);
    for (int i = 0; i < 2; ++i) add(ret_in + (size_t)i * 1024 * 6144, OFF_RET_IN + i * SZ_RET_IN, 1024, 6144, 6144, 0);
    for (int i = 0; i < 2; ++i) add(ret_out + (size_t)i * 2048 * 1024, OFF_RET_OUT + i * SZ_RET_OUT, 2048, 1024, 1024, 0);
    for (int i = 0; i < 2; ++i) add(nsa_in + (size_t)i * 1024 * 2608, OFF_NSA_IN + i * SZ_NSA_IN, 1024, 2608, 2816, 0);
    for (int i = 0; i < 2; ++i) add(nsa_out + (size_t)i * 1024 * 1024, OFF_NSA_OUT + i * SZ_NSA_OUT, 1024, 1024, 1024, 0);
    for (int i = 0; i < 2; ++i) add(ck1 + (size_t)i * 2048 * 256, OFF_W1 + (0 * 2 + i) * SZ_W1, 2048, 256, 256, 0);
    for (int i = 0; i < 2; ++i) add(cv1 + (size_t)i * 2048 * 256, OFF_W1 + (1 * 2 + i) * SZ_W1, 2048, 256, 256, 0);
    for (int i = 0; i < 2; ++i) add(ck2 + (size_t)i * 256 * 64, OFF_W2 + (0 * 2 + i) * SZ_W2, 256, 64, 64, 0);
    for (int i = 0; i < 2; ++i) add(cv2 + (size_t)i * 256 * 64, OFF_W2 + (1 * 2 + i) * SZ_W2, 256, 64, 64, 0);
    p.njobs = nj;
    if (hipMemsetAsync(ws + WS_END, 0, 16384, stream) != hipSuccess) fprintf(stderr, "barrier memset failed\n");
    void* args[] = {&p};
    hipError_t e = hipLaunchCooperativeKernel((const void*)fwd_megakernel, dim3(grid_blocks), dim3(NTHR), args, LDS_BYTES, stream);
    if (e != hipSuccess) fprintf(stderr, "cooperative launch failed: %s (grid %d)\n", hipGetErrorString(e), grid_blocks);
}
```

```cpp
#include <hip/hip_runtime.h>
#include <hip/hip_cooperative_groups.h>
#include <cstdio>
namespace cg = cooperative_groups;

namespace pg8 {
#define PG8_LAS __attribute__((address_space(3)))
typedef unsigned short bf16_t;
typedef short bf16x8 __attribute__((ext_vector_type(8)));
typedef float f32x4 __attribute__((ext_vector_type(4)));
typedef unsigned u32x4 __attribute__((ext_vector_type(4)));
constexpr int BM = 256, BK = 64, HALF = 128, HTB = HALF * BK * 2  , STAGE_BYTES = 8 * HTB, NXCD = 8, WGM = 8;

__host__ __device__ __forceinline__ int lds_byte(int r, int c) { const int st = (r >> 4) * 2 + (c >> 5), rr = r & 15, cc = c & 31, ob = rr * 64 + cc * 2; return st * 1024 + (ob ^ (((ob >> 9) & 1) << 5)); }
__host__ __device__ __forceinline__ void stage_rc(int b, int& R, int& C) { const int st = b / 1024, sb = b % 1024, swz = sb ^ (((sb >> 9) & 1) << 5); R = (st >> 1) * 16 + swz / 64; C = (st & 1) * 32 + (swz % 64) / 2; }
__host__ __device__ __forceinline__ int perm32(int rho) { const int n = rho >> 4, i = rho & 15; return 8 * (i >> 2) + 4 * n + (i & 3); }

struct Unit { int pm, pn; };
struct Gemm { const bf16_t* A; const bf16_t* Bt; int M, N, K; };

struct StaticOrder {
    int nM, nN, nwg, G, c;
    __host__ __device__ void init(int M, int N, int G_, int c_) { nM = M / BM; nN = N / BM; nwg = nM * nN; G = G_; c = c_; }
    __host__ __device__ bool next(int i, Unit& u) const {
        const long L = (long)i * G + c; if (L >= nwg) return false;
        int wgid = (int)L; { const int q = nwg / NXCD, r = nwg % NXCD, xcd = wgid % NXCD, off = wgid / NXCD; wgid = (xcd < r ? xcd * (q + 1) : r * (q + 1) + (xcd - r) * q) + off; }
        const int nig = WGM * nN, gid = wgid / nig, fm = gid * WGM, gsz = (nM - fm) < WGM ? (nM - fm) : WGM;
        u.pm = fm + ((wgid % nig) % gsz); u.pn = (wgid % nig) / gsz; return true;
    }
    __device__ __forceinline__ void a_ready(const Unit&) const {}
    __device__ __forceinline__ void done(const Unit&) const {}
};

typedef float f32x2_t __attribute__((ext_vector_type(2)));
typedef __bf16 bf16x2_t __attribute__((ext_vector_type(2)));
__device__ __forceinline__ unsigned cvt_pk_bf16(float lo, float hi) { const f32x2_t v = {lo, hi}; return __builtin_bit_cast(unsigned, __builtin_convertvector(v, bf16x2_t)); }
__device__ __forceinline__ float silu_f(float a) { return a * __builtin_amdgcn_rcpf(1.0f + __builtin_amdgcn_exp2f(-1.44269504089f * a)); }
__device__ __forceinline__ float gelu_tanh_f(float x) { const float u = 0.7978845608028654f * (x + 0.044715f * x * x * x); const float t = 1.0f - 2.0f * __builtin_amdgcn_rcpf(1.0f + __builtin_amdgcn_exp2f(2.88539008178f * u)); return 0.5f * x * (1.0f + t); }

template <int ACT> struct Epi {
    static constexpr bool PERM = true, AFTER_DRAIN = false;
    bf16_t* O; int ldc; const float* stats;
    __device__ __forceinline__ void operator()(const f32x4 (&acc)[2][2][4][2], const Unit& u, int wr, int wc, int fr, int fq) const {
        const int row0 = u.pm * BM + wr * 64 + fr;
        if (ACT == 3) {
            const int hh = u.pn >> 1, col0 = u.pn * BM + wc * 32 + 8 * fq;
#pragma unroll
            for (int ai = 0; ai < 2; ++ai)
#pragma unroll
                for (int m = 0; m < 4; ++m) { const int r = row0 + ai * HALF + m * 16;
                    const f32x4* sp = (const f32x4*)(stats + ((size_t)r * 4 + hh) * 16);
                    const f32x4 s0 = sp[0], s1 = sp[1], s2 = sp[2], s3 = sp[3];
                    const float sm = ((s0[0] + s0[2]) + (s1[0] + s1[2])) + ((s2[0] + s2[2]) + (s3[0] + s3[2])), sq = ((s0[1] + s0[3]) + (s1[1] + s1[3])) + ((s2[1] + s2[3]) + (s3[1] + s3[3]));
                    const float mu = sm * (1.0f / 512.0f), rstd = rsqrtf(fmaxf(sq * (1.0f / 512.0f) - mu * mu, 0.f) + 1e-6f);
                    bf16_t* rowp = O + (size_t)r * ldc + col0;
#pragma unroll
                    for (int bj = 0; bj < 2; ++bj) { const u32x4 ov = *(const u32x4*)(rowp + bj * HALF); const f32x4 g0 = acc[ai][bj][m][0], g1 = acc[ai][bj][m][1];
                        u32x4 w;
                        w.x = cvt_pk_bf16((__uint_as_float(ov.x << 16) - mu) * rstd * silu_f(g0[0]), (__uint_as_float(ov.x & 0xffff0000u) - mu) * rstd * silu_f(g0[1]));
                        w.y = cvt_pk_bf16((__uint_as_float(ov.y << 16) - mu) * rstd * silu_f(g0[2]), (__uint_as_float(ov.y & 0xffff0000u) - mu) * rstd * silu_f(g0[3]));
                        w.z = cvt_pk_bf16((__uint_as_float(ov.z << 16) - mu) * rstd * silu_f(g1[0]), (__uint_as_float(ov.z & 0xffff0000u) - mu) * rstd * silu_f(g1[1]));
                        w.w = cvt_pk_bf16((__uint_as_float(ov.w << 16) - mu) * rstd * silu_f(g1[2]), (__uint_as_float(ov.w & 0xffff0000u) - mu) * rstd * silu_f(g1[3]));
                        *(u32x4*)(rowp + bj * HALF) = w; } }
            return;
        }
        if (ACT == 1) {
            const int col0 = u.pn * HALF + wc * 32 + 8 * fq;
#pragma unroll
            for (int ai = 0; ai < 2; ++ai)
#pragma unroll
                for (int m = 0; m < 4; ++m) { bf16_t* rowp = O + (size_t)(row0 + ai * HALF + m * 16) * ldc + col0;
                    const f32x4 a0 = acc[ai][0][m][0], a1 = acc[ai][0][m][1], u0 = acc[ai][1][m][0], u1 = acc[ai][1][m][1];
                    u32x4 w; w.x = cvt_pk_bf16(silu_f(a0[0]) * u0[0], silu_f(a0[1]) * u0[1]); w.y = cvt_pk_bf16(silu_f(a0[2]) * u0[2], silu_f(a0[3]) * u0[3]);
                    w.z = cvt_pk_bf16(silu_f(a1[0]) * u1[0], silu_f(a1[1]) * u1[1]); w.w = cvt_pk_bf16(silu_f(a1[2]) * u1[2], silu_f(a1[3]) * u1[3]);
                    *(u32x4*)rowp = w; }
        } else {
            const int col0 = u.pn * BM + wc * 32 + 8 * fq;
#pragma unroll
            for (int ai = 0; ai < 2; ++ai)
#pragma unroll
                for (int m = 0; m < 4; ++m) { bf16_t* rowp = O + (size_t)(row0 + ai * HALF + m * 16) * ldc + col0;
#pragma unroll
                    for (int bj = 0; bj < 2; ++bj) { f32x4 v0 = acc[ai][bj][m][0], v1 = acc[ai][bj][m][1];
                        if (ACT == 2) {
#pragma unroll
                            for (int j = 0; j < 4; ++j) { v0[j] = gelu_tanh_f(v0[j]); v1[j] = gelu_tanh_f(v1[j]); } }
                        u32x4 w; w.x = cvt_pk_bf16(v0[0], v0[1]); w.y = cvt_pk_bf16(v0[2], v0[3]); w.z = cvt_pk_bf16(v1[0], v1[1]); w.w = cvt_pk_bf16(v1[2], v1[3]);
                        *(u32x4*)(rowp + bj * HALF) = w; } }
        }
    }
};

template <class Epi, class Sched, bool ALIGN_EPI = false, bool SP2 = false>
__device__ __forceinline__ void gemm_phase(PG8_LAS unsigned char* lds, const Gemm g, const Sched& S, const Epi& E) {
    const int tid = threadIdx.x, wid = __builtin_amdgcn_readfirstlane(tid >> 6), lane = tid & 63, wr = wid >> 2, wc = wid & 3, fr = lane & 15, fq = lane >> 4;
    const int K = g.K, nt = K / BK;
    unsigned voffA[2], voffB[2];
#pragma unroll
    for (int i = 0; i < 2; ++i) { int R, C; stage_rc(tid * 16 + i * 8192, R, C); const int Rb = Epi::PERM ? ((R & ~31) + perm32(R & 31)) : R;
        voffA[i] = (unsigned)(R * K + C) * 2u; voffB[i] = (unsigned)(Rb * K + C) * 2u; }
    const size_t kstep = (size_t)(BK * 2);
    const size_t hstep = (size_t)HALF * K * 2;
    const size_t tstep = 2 * hstep;
    const unsigned ldsw = (unsigned)wid * 1024u;
    const int aoff = lds_byte(wr * 64 + fr, fq * 8), boff = lds_byte(wc * 32 + fr, fq * 8);
#define PG8_SA(b, h) (((b) * 2 + (h)) * HTB)
#define PG8_SB(b, h) ((4 + (b) * 2 + (h)) * HTB)
#define PG8_STAGE(bufoff, gbase, voff) do { _Pragma("unroll") for (int _i = 0; _i < 2; ++_i) \
        __builtin_amdgcn_global_load_lds((const unsigned*)((const char*)(gbase) + (voff)[_i]), (PG8_LAS unsigned*)(lds + (bufoff) + ldsw + _i * 8192), 16, 0, 0); } while (0)
#define PG8_LDA(dst, b, h) do { _Pragma("unroll") for (int m = 0; m < 4; ++m) _Pragma("unroll") for (int k = 0; k < 2; ++k) dst[m][k] = *(const PG8_LAS bf16x8*)(lds + PG8_SA(b, h) + aoff + m * 2048 + k * 1024); } while (0)
#define PG8_LDB(dst, b, h) do { _Pragma("unroll") for (int n = 0; n < 2; ++n) _Pragma("unroll") for (int k = 0; k < 2; ++k) dst[n][k] = *(const PG8_LAS bf16x8*)(lds + PG8_SB(b, h) + boff + n * 2048 + k * 1024); } while (0)
#define PG8_MMA(ai, bj, At, Bt) do { __builtin_amdgcn_s_setprio(1); _Pragma("unroll") for (int m = 0; m < 4; ++m) _Pragma("unroll") for (int n = 0; n < 2; ++n) _Pragma("unroll") for (int k = 0; k < 2; ++k) \
        acc[ai][bj][m][n] = __builtin_amdgcn_mfma_f32_16x16x32_bf16(Bt[n][k], At[m][k], acc[ai][bj][m][n], 0, 0, 0); __builtin_amdgcn_s_setprio(0); } while (0)
#define PG8_WAIT_V(n) asm volatile("s_waitcnt vmcnt(" #n ")" ::: "memory")
#define PG8_WAIT_L(n) asm volatile("s_waitcnt lgkmcnt(" #n ")" ::: "memory")
#define PG8_BAR __builtin_amdgcn_s_barrier()
#define PG8_SCHED __builtin_amdgcn_sched_barrier(0)
    Unit cur, nxt; int ui = 0;
    if (!S.next(0, cur)) return;
    f32x4 acc[2][2][4][2];
#pragma unroll
    for (int a = 0; a < 2; ++a)
#pragma unroll
        for (int b = 0; b < 2; ++b)
#pragma unroll
            for (int m = 0; m < 4; ++m)
#pragma unroll
                for (int n = 0; n < 2; ++n) acc[a][b][m][n] = (f32x4){0.f, 0.f, 0.f, 0.f};
    bf16x8 At[4][2], B0[2][2], B1[2][2];
    const char* cA = (const char*)g.A + (size_t)cur.pm * tstep; const char* cB = (const char*)g.Bt + (size_t)cur.pn * tstep;
    S.a_ready(cur);
    if constexpr (SP2) {
        PG8_STAGE(PG8_SB(0, 0), cB, voffB); PG8_STAGE(PG8_SB(0, 1), cB + hstep, voffB); PG8_STAGE(PG8_SA(0, 0), cA, voffA); PG8_STAGE(PG8_SA(0, 1), cA + hstep, voffA);
        if (wr == 1) PG8_BAR;
        PG8_WAIT_V(2); PG8_BAR;
        PG8_STAGE(PG8_SB(1, 0), cB + kstep, voffB); PG8_STAGE(PG8_SA(1, 0), cA + kstep, voffA); PG8_STAGE(PG8_SB(1, 1), cB + hstep + kstep, voffB);
        PG8_WAIT_V(6); PG8_BAR;
    } else {
        PG8_STAGE(PG8_SB(0, 0), cB, voffB); PG8_STAGE(PG8_SA(0, 0), cA, voffA); PG8_STAGE(PG8_SB(0, 1), cB + hstep, voffB); PG8_STAGE(PG8_SA(0, 1), cA + hstep, voffA);
        if (wr == 1) PG8_BAR;
        PG8_WAIT_V(4); PG8_BAR;
        PG8_STAGE(PG8_SB(1, 0), cB + kstep, voffB); PG8_STAGE(PG8_SA(1, 0), cA + kstep, voffA); PG8_STAGE(PG8_SB(1, 1), cB + hstep + kstep, voffB);
        PG8_WAIT_V(6); PG8_BAR;
    }
    for (;;) {
        const bool has_next = S.next(ui + 1, nxt);
        const char* nA = has_next ? (const char*)g.A + (size_t)nxt.pm * tstep : cA; const char* nB = has_next ? (const char*)g.Bt + (size_t)nxt.pn * tstep : cB;
        for (int t = 0; t < nt; t += 2) {
            const bool last = (t == nt - 2);
            const char* a1 = cA + (size_t)(t + 1) * kstep;
            const char* a2 = last ? nA : cA + (size_t)(t + 2) * kstep; const char* b2 = last ? nB : cB + (size_t)(t + 2) * kstep;
            const char* a3 = a2 + kstep; const char* b3 = b2 + kstep;
            if (last && has_next) S.a_ready(nxt);
            if constexpr (SP2) {
            PG8_LDB(B0, 0, 0); PG8_LDB(B1, 0, 1); PG8_SCHED; PG8_LDA(At, 0, 0); PG8_STAGE(PG8_SA(1, 1), a1 + hstep, voffA);
            PG8_WAIT_V(8); PG8_WAIT_L(0); PG8_BAR; PG8_MMA(0, 0, At, B0); PG8_MMA(0, 1, At, B1); PG8_BAR; PG8_SCHED;
            PG8_LDA(At, 0, 1); PG8_STAGE(PG8_SB(0, 0), b2, voffB); PG8_STAGE(PG8_SB(0, 1), b2 + hstep, voffB); PG8_STAGE(PG8_SA(0, 0), a2, voffA);
            PG8_WAIT_V(8); PG8_WAIT_L(0); PG8_BAR; PG8_MMA(1, 0, At, B0); PG8_MMA(1, 1, At, B1); PG8_BAR; PG8_SCHED;
            PG8_LDB(B0, 1, 0); PG8_LDB(B1, 1, 1); PG8_SCHED; PG8_LDA(At, 1, 0); PG8_STAGE(PG8_SA(0, 1), a2 + hstep, voffA);
            PG8_WAIT_V(8); PG8_WAIT_L(0); PG8_BAR; PG8_MMA(0, 0, At, B0); PG8_MMA(0, 1, At, B1); PG8_BAR; PG8_SCHED;
            PG8_LDA(At, 1, 1); PG8_STAGE(PG8_SB(1, 0), b3, voffB); PG8_STAGE(PG8_SB(1, 1), b3 + hstep, voffB); PG8_STAGE(PG8_SA(1, 0), a3, voffA);
            PG8_WAIT_V(8); PG8_WAIT_L(0); PG8_BAR; PG8_MMA(1, 0, At, B0); PG8_MMA(1, 1, At, B1); PG8_BAR; PG8_SCHED;
            } else {
            PG8_LDB(B0, 0, 0); PG8_SCHED; PG8_LDA(At, 0, 0); PG8_STAGE(PG8_SA(1, 1), a1 + hstep, voffA);
            PG8_WAIT_L(8); PG8_BAR; PG8_WAIT_L(0); PG8_MMA(0, 0, At, B0); PG8_BAR; PG8_SCHED;
            PG8_LDB(B1, 0, 1); PG8_STAGE(PG8_SB(0, 0), b2, voffB);
            PG8_BAR; PG8_WAIT_L(0); PG8_MMA(0, 1, At, B1); PG8_BAR;
            PG8_LDA(At, 0, 1); PG8_STAGE(PG8_SA(0, 0), a2, voffA);
            PG8_BAR; PG8_WAIT_L(0); PG8_MMA(1, 0, At, B0); PG8_BAR; PG8_SCHED;
            PG8_STAGE(PG8_SB(0, 1), b2 + hstep, voffB);
            PG8_WAIT_V(6); PG8_BAR; PG8_MMA(1, 1, At, B1); PG8_BAR;
            PG8_LDB(B0, 1, 0); PG8_SCHED; PG8_LDA(At, 1, 0); PG8_STAGE(PG8_SA(0, 1), a2 + hstep, voffA);
            PG8_WAIT_L(8); PG8_BAR; PG8_WAIT_L(0); PG8_MMA(0, 0, At, B0); PG8_BAR; PG8_SCHED;
            PG8_LDB(B1, 1, 1); PG8_STAGE(PG8_SB(1, 0), b3, voffB);
            PG8_BAR; PG8_WAIT_L(0); PG8_MMA(0, 1, At, B1); PG8_BAR;
            PG8_LDA(At, 1, 1); PG8_STAGE(PG8_SA(1, 0), a3, voffA);
            PG8_BAR; PG8_WAIT_L(0); PG8_MMA(1, 0, At, B0); PG8_BAR; PG8_SCHED;
            PG8_STAGE(PG8_SB(1, 1), b3 + hstep, voffB);
            PG8_WAIT_V(6); PG8_BAR; PG8_MMA(1, 1, At, B1); PG8_BAR;
            }
        }
        if constexpr (ALIGN_EPI) { if (wr == 0) PG8_BAR; }
        if constexpr (!Epi::AFTER_DRAIN) { E(acc, cur, wr, wc, fr, fq); S.done(cur); }
        if (!has_next) break;
#pragma unroll
        for (int a = 0; a < 2; ++a)
#pragma unroll
            for (int b = 0; b < 2; ++b)
#pragma unroll
                for (int m = 0; m < 4; ++m)
#pragma unroll
                    for (int n = 0; n < 2; ++n) acc[a][b][m][n] = (f32x4){0.f, 0.f, 0.f, 0.f};
        cur = nxt; cA = nA; cB = nB; ++ui;
        if constexpr (ALIGN_EPI) { if (wr == 1) PG8_BAR; }
    }
    PG8_WAIT_V(0);
    if constexpr (!ALIGN_EPI) { if (wr == 0) PG8_BAR; }
    PG8_BAR;
    if constexpr (Epi::AFTER_DRAIN) { E.fused(acc, cur, wr, wc, fr, fq, lds, wid, lane); S.done(cur); }
#undef PG8_SA
#undef PG8_SB
#undef PG8_STAGE
#undef PG8_LDA
#undef PG8_LDB
#undef PG8_MMA
#undef PG8_WAIT_V
#undef PG8_WAIT_L
#undef PG8_BAR
#undef PG8_SCHED
}
}

using pg8::bf16_t; using pg8::bf16x8; using pg8::f32x4; using pg8::u32x4; using pg8::cvt_pk_bf16; using pg8::silu_f;
#define LAS __attribute__((address_space(3)))
typedef unsigned u32x2 __attribute__((ext_vector_type(2)));
typedef short s16x4 __attribute__((ext_vector_type(4)));
#define MFMA16(a, b, c) __builtin_amdgcn_mfma_f32_16x16x32_bf16((a), (b), (c), 0, 0, 0)

constexpr int NTHR = 512;
constexpr int MTOK = 32768, DM = 1024, SEQ = 2048, DFF = 2816, DEPTH = 4, MODW = 9216;
constexpr float DN_ALPHA = 1.6817928305074290861f;
constexpr size_t MiB = (size_t)1 << 20;
constexpr size_t SZ_FFN_IN = (size_t)5632 * 1024 * 2, SZ_FFN_OUT = (size_t)1024 * 2816 * 2, SZ_RET_IN = (size_t)6144 * 1024 * 2, SZ_RET_OUT = (size_t)1024 * 2048 * 2,
                 SZ_NSA_IN = (size_t)2816 * 1024 * 2, SZ_NSA_OUT = (size_t)1024 * 1024 * 2, SZ_W1 = (size_t)256 * 2048 * 2, SZ_W2 = (size_t)64 * 256 * 2;
constexpr size_t OFF_FFN_IN = 0, OFF_FFN_OUT = OFF_FFN_IN + 8 * SZ_FFN_IN, OFF_RET_IN = OFF_FFN_OUT + 8 * SZ_FFN_OUT, OFF_RET_OUT = OFF_RET_IN + 2 * SZ_RET_IN,
                 OFF_NSA_IN = OFF_RET_OUT + 2 * SZ_RET_OUT, OFF_NSA_OUT = OFF_NSA_IN + 2 * SZ_NSA_IN, OFF_W1 = OFF_NSA_OUT + 2 * SZ_NSA_OUT, OFF_W2 = OFF_W1 + 4 * SZ_W1,
                 OFF_MOD = OFF_W2 + 4 * SZ_W2, OFF_H = OFF_MOD + (size_t)DEPTH * 16 * MODW * 4, OFF_U2 = OFF_H + (size_t)MTOK * DM * 2, WS_END = OFF_U2 + 384 * MiB;
constexpr size_t U_FFN_ACT = 0, U_FFN_Y = 192 * MiB;
constexpr size_t U_RET_QKV = 0, U_RET_G = 0, U_RET_O = 256 * MiB, U_RET_Y = 128 * MiB;
constexpr size_t U_NSA_PROJ = 0, U_NSA_Y = 192 * MiB, U_NSA_ACMPK = 256 * MiB, U_NSA_ACMPV = 288 * MiB, U_NSA_HK = 320 * MiB, U_NSA_HV = 324 * MiB, U_NSA_KCMP = 328 * MiB, U_NSA_VCMP = 329 * MiB, U_NSA_OATT = 256 * MiB;
constexpr int XB_LDS_OFF = 152 * 1024, LDS_BYTES = 152 * 1024 + 16;

struct WJob { const float* src; bf16_t* dst; int K, N, Np, mode; };
struct Params {
    const float* x; const float* c; const float* ada_w; const float* ada_b; const float* ln_g; const float* ln_b; const float* pe_k; const float* pe_v;
    float* out; unsigned char* ws;
    WJob jobs[32]; int tile_end[32]; int njobs; int pad;
};

__device__ __forceinline__ float bf2f(unsigned short b) { return __uint_as_float(((unsigned)b) << 16); }
__device__ __forceinline__ float bflo(unsigned w) { return __uint_as_float(w << 16); }
__device__ __forceinline__ float bfhi(unsigned w) { return __uint_as_float(w & 0xffff0000u); }
__device__ __forceinline__ unsigned short f2bf(float f) { return (unsigned short)(cvt_pk_bf16(f, 0.f) & 0xffffu); }
__device__ __forceinline__ bf16x8 pack8(const f32x4& a, const f32x4& b) { u32x4 w; w.x = cvt_pk_bf16(a[0], a[1]); w.y = cvt_pk_bf16(a[2], a[3]); w.z = cvt_pk_bf16(b[0], b[1]); w.w = cvt_pk_bf16(b[2], b[3]); return __builtin_bit_cast(bf16x8, w); }
__device__ __forceinline__ u32x2 pack4(const f32x4& a) { u32x2 w; w.x = cvt_pk_bf16(a[0], a[1]); w.y = cvt_pk_bf16(a[2], a[3]); return w; }
__device__ __forceinline__ bf16x8 lds_rd16(LAS unsigned char* lds, int off) { return *(const LAS bf16x8*)(lds + off); }
__device__ __forceinline__ bf16x8 lds_rd8x2(LAS unsigned char* lds, int off) { const s16x4 lo = *(const LAS s16x4*)(lds + off), hi = *(const LAS s16x4*)(lds + off + 32); return __builtin_shufflevector(lo, hi, 0, 1, 2, 3, 4, 5, 6, 7); }
template <int M> __device__ __forceinline__ float shx(float v, int lane) {
    if (M < 32) return __int_as_float(__builtin_amdgcn_ds_swizzle(__float_as_int(v), (M << 10) | 0x1f));
    return __int_as_float(__builtin_amdgcn_ds_bpermute((lane ^ M) << 2, __float_as_int(v)));
}
template <int M> __device__ __forceinline__ unsigned shxu(unsigned v, int lane) {
    if (M < 32) return (unsigned)__builtin_amdgcn_ds_swizzle((int)v, (M << 10) | 0x1f);
    return (unsigned)__builtin_amdgcn_ds_bpermute((lane ^ M) << 2, (int)v);
}
__device__ __forceinline__ float shi(float v, int src_lane) { return __int_as_float(__builtin_amdgcn_ds_bpermute(src_lane << 2, __float_as_int(v))); }
__device__ __forceinline__ float wsum(float v, int lane) { v += shx<32>(v, lane); v += shx<16>(v, lane); v += shx<8>(v, lane); v += shx<4>(v, lane); v += shx<2>(v, lane); v += shx<1>(v, lane); return v; }

struct WTile { const float* src; bf16_t* dst; int N, K, sbase, n0, k0; };
__device__ __forceinline__ WTile wt_lookup(const Params& p, int t) {
    int j = 0; while (j < p.njobs - 1 && t >= p.tile_end[j]) ++j;
    const int tl = t - (j ? p.tile_end[j - 1] : 0);
    const WJob& J = p.jobs[j];
    const int ntn = J.Np >> 6; const int tn = tl % ntn, tk = tl / ntn; const int n0 = tn * 64, k0 = tk * 64;
    int sbase = n0; if (J.mode == 1) { const int pn = n0 >> 8, r = n0 & 255; sbase = (r >> 7) * DFF + pn * 128 + (r & 127); }
    return WTile{J.src, J.dst, J.N, J.K, sbase, n0, k0};
}
__device__ __forceinline__ void wt_load(const WTile& W, int tid, f32x4& v0, f32x4& v1) {
    const int kk = tid >> 4, nn = (tid & 15) * 4;
    v0 = (f32x4){0.f, 0.f, 0.f, 0.f}; v1 = v0;
    if (W.sbase + nn < W.N) { v0 = __builtin_nontemporal_load((const f32x4*)(W.src + (size_t)(W.k0 + kk) * W.N + W.sbase + nn)); v1 = __builtin_nontemporal_load((const f32x4*)(W.src + (size_t)(W.k0 + kk + 32) * W.N + W.sbase + nn)); }
}

__device__ __forceinline__ void phase_prep(const Params& p, LAS unsigned char* lds) {
    int tid = threadIdx.x; asm volatile("" : "+v"(tid));
    LAS float* T = (LAS float*)lds;
    const int ntiles = p.tile_end[p.njobs - 1];
    {
        int t = blockIdx.x;
        WTile cur = wt_lookup(p, t < ntiles ? t : 0); f32x4 v0, v1;
        if (t < ntiles) wt_load(cur, tid, v0, v1);
        while (t < ntiles) {
            const int tn = t + (int)gridDim.x; const bool more = tn < ntiles;
            WTile nx = wt_lookup(p, more ? tn : 0); f32x4 n0 = (f32x4){0.f, 0.f, 0.f, 0.f}, n1 = n0;
            if (more) wt_load(nx, tid, n0, n1);
            const int kk = tid >> 4, nn = (tid & 15) * 4;
            T[kk * 65 + nn] = v0[0]; T[kk * 65 + nn + 1] = v0[1]; T[kk * 65 + nn + 2] = v0[2]; T[kk * 65 + nn + 3] = v0[3];
            T[(kk + 32) * 65 + nn] = v1[0]; T[(kk + 32) * 65 + nn + 1] = v1[1]; T[(kk + 32) * 65 + nn + 2] = v1[2]; T[(kk + 32) * 65 + nn + 3] = v1[3];
            __syncthreads();
            const int n = tid >> 3, k8 = (tid & 7) * 8;
            f32x4 a, b;
            a[0] = T[(k8 + 0) * 65 + n]; a[1] = T[(k8 + 1) * 65 + n]; a[2] = T[(k8 + 2) * 65 + n]; a[3] = T[(k8 + 3) * 65 + n];
            b[0] = T[(k8 + 4) * 65 + n]; b[1] = T[(k8 + 5) * 65 + n]; b[2] = T[(k8 + 6) * 65 + n]; b[3] = T[(k8 + 7) * 65 + n];
            *(bf16x8*)(cur.dst + (size_t)(cur.n0 + n) * cur.K + cur.k0 + k8) = pack8(a, b);
            __syncthreads();
            cur = nx; v0 = n0; v1 = n1; t = tn;
        }
    }
    if (blockIdx.x < 288) {
        LAS float* cs = (LAS float*)lds;
        LAS float* red = (LAS float*)(lds + 65536);
        float* mod = (float*)(p.ws + OFF_MOD);
        __syncthreads();
        for (int idx = tid; idx < 16 * 1024; idx += NTHR) { const int b = idx >> 10, k = idx & 1023; const float cv = p.c[idx]; cs[k * 16 + b] = cv / (1.0f + expf(-cv)); }
        __syncthreads();
        for (int unit = blockIdx.x; unit < 288; unit += gridDim.x) {
            const int i = unit / 72, n0 = (unit % 72) * 128, col = tid & 127, kq = tid >> 7;
            f32x4 a0 = (f32x4){0.f, 0.f, 0.f, 0.f}, a1 = a0, a2 = a0, a3 = a0;
            const float* wp = p.ada_w + ((size_t)i * 1024 + kq * 256) * MODW + n0 + col;
#pragma unroll 4
            for (int k = 0; k < 256; ++k) { const float w = __builtin_nontemporal_load(wp + (size_t)k * MODW); const LAS f32x4* cp = (const LAS f32x4*)(cs + (kq * 256 + k) * 16);
                a0 += cp[0] * w; a1 += cp[1] * w; a2 += cp[2] * w; a3 += cp[3] * w; }
#pragma unroll
            for (int b = 0; b < 4; ++b) { red[(kq * 16 + b) * 128 + col] = a0[b]; red[(kq * 16 + 4 + b) * 128 + col] = a1[b]; red[(kq * 16 + 8 + b) * 128 + col] = a2[b]; red[(kq * 16 + 12 + b) * 128 + col] = a3[b]; }
            __syncthreads();
#pragma unroll
            for (int r = 0; r < 4; ++r) { const int o = tid + r * NTHR, b = o >> 7, cc = o & 127;
                const float s = red[(0 * 16 + b) * 128 + cc] + red[(1 * 16 + b) * 128 + cc] + red[(2 * 16 + b) * 128 + cc] + red[(3 * 16 + b) * 128 + cc] + p.ada_b[i * MODW + n0 + cc];
                mod[((size_t)i * 16 + b) * MODW + n0 + cc] = s; }
            __syncthreads();
        }
    }
}

__device__ __forceinline__ void phase_init(const Params& p) {
    const float* mod = (const float*)(p.ws + OFF_MOD); bf16_t* H = (bf16_t*)(p.ws + OFF_H);
    int tid = threadIdx.x; asm volatile("" : "+v"(tid));
    for (size_t i = (size_t)blockIdx.x * NTHR + tid; i < (size_t)MTOK * 256; i += (size_t)gridDim.x * NTHR) {
        const int row = (int)(i >> 8), c4 = (int)(i & 255) * 4, b = row >> 11;
        const f32x4 xv = __builtin_nontemporal_load((const f32x4*)(p.x + i * 4)); *(f32x4*)(p.out + i * 4) = xv;
        const float* m = mod + (size_t)b * MODW; const f32x4 sh = *(const f32x4*)(m + c4), sc = *(const f32x4*)(m + 1024 + c4);
        const f32x4 h = xv * (sc + 1.0f) + sh; *(u32x2*)(H + i * 4) = pack4(h);
    }
}

__device__ __forceinline__ void phase_ln(float* xio, float* xout, const bf16_t* y, const float* modG, float rw, const float* lng, const float* lnb, const float* modSh, const float* modSc, bf16_t* H) {
    int tid = threadIdx.x; asm volatile("" : "+v"(tid));
    const int wid = __builtin_amdgcn_readfirstlane(tid >> 6), lane = tid & 63;
    for (int row = blockIdx.x * 8 + wid; row < MTOK; row += gridDim.x * 8) {
        const int b = row >> 11; const size_t rb = (size_t)row * DM;
        f32x4 z[4]; float s = 0.f;
#pragma unroll
        for (int q = 0; q < 4; ++q) { const int c = q * 256 + lane * 4; const f32x4 xv = __builtin_nontemporal_load((const f32x4*)(xio + rb + c)); const u32x2 yv = __builtin_nontemporal_load((const u32x2*)(y + rb + c));
            const f32x4 gt = *(const f32x4*)(modG + (size_t)b * MODW + c); const f32x4 yf = (f32x4){bflo(yv.x), bfhi(yv.x), bflo(yv.y), bfhi(yv.y)};
            z[q] = xv * DN_ALPHA + (gt + 1.0f) * yf * rw; s += (z[q][0] + z[q][1]) + (z[q][2] + z[q][3]); }
        const float mu = wsum(s, lane) * (1.0f / 1024.0f); float v = 0.f;
#pragma unroll
        for (int q = 0; q < 4; ++q) { const f32x4 d = z[q] - mu; v += (d[0] * d[0] + d[1] * d[1]) + (d[2] * d[2] + d[3] * d[3]); }
        const float rstd = rsqrtf(wsum(v, lane) * (1.0f / 1024.0f) + 1e-5f);
#pragma unroll
        for (int q = 0; q < 4; ++q) { const int c = q * 256 + lane * 4; const f32x4 g4 = *(const f32x4*)(lng + c), b4 = *(const f32x4*)(lnb + c);
            const f32x4 xn = (z[q] - mu) * rstd * g4 + b4; __builtin_nontemporal_store(xn, (f32x4*)(xout + rb + c));
            const f32x4 sh = *(const f32x4*)(modSh + (size_t)b * MODW + c), sc = *(const f32x4*)(modSc + (size_t)b * MODW + c);
            *(u32x2*)(H + rb + c) = pack4(xn * (sc + 1.0f) + sh); }
    }
}

typedef short v4i16_t __attribute__((ext_vector_type(4)));
__device__ __forceinline__ s16x4 lds_tr8(LAS unsigned char* lds, int off) { return __builtin_bit_cast(s16x4, __builtin_amdgcn_ds_read_tr16_b64_v4i16((LAS v4i16_t*)(lds + off))); }

__device__ __forceinline__ bf16x8 lds_tr8x2(LAS unsigned char* lds, int off, int hi_off) { const s16x4 lo = lds_tr8(lds, off), hi = lds_tr8(lds, off + hi_off); return __builtin_shufflevector(lo, hi, 0, 1, 2, 3, 4, 5, 6, 7); }

__device__ __forceinline__ void phase_ret_core(const bf16_t* QKV, bf16_t* O, float* stats, LAS unsigned char* lds) {
    constexpr int KSB = 528, PS = 136, STS = 264, OFF_K = 0, OFF_P = 67584, OFF_VT = 102400, OFF_ST = 119808;
    int tid = threadIdx.x; asm volatile("" : "+v"(tid));
    const int wid = __builtin_amdgcn_readfirstlane(tid >> 6), lane = tid & 63, fr = lane & 15, fq = lane >> 4;
    if (wid >= 4) __builtin_amdgcn_s_setprio(1);
    for (int item = blockIdx.x; item < 512; item += gridDim.x) {
        const int es = item & 7, bh = item >> 3, hh = bh & 3, b = bh >> 2, e0 = es * 64;
        const float log_g = logf(1.0f - exp2f(-5.0f - (float)hh));
        const float gN = expf(log_g * 128.0f);
        const float l2g = log_g * 1.44269504089f;
        __syncthreads();
        for (int i = tid; i < 64 * STS / 2; i += NTHR) ((LAS unsigned*)(lds + OFF_ST))[i] = 0u;
        f32x4 sacc[2][4];
#pragma unroll
        for (int dt = 0; dt < 2; ++dt)
#pragma unroll
            for (int et = 0; et < 4; ++et) sacc[dt][et] = (f32x4){0.f, 0.f, 0.f, 0.f};
        bf16x8 kst[8], vst[2];
        {   const bf16_t* kp = QKV + ((size_t)b * SEQ + (tid >> 5)) * 4096 + 1024 + hh * 256 + (tid & 31) * 8;
#pragma unroll
            for (int it = 0; it < 8; ++it) kst[it] = *(const bf16x8*)(kp + (size_t)it * 16 * 4096);
            const bf16_t* vrow = QKV + ((size_t)b * SEQ + 2 * (tid & 63)) * 4096 + 2048 + hh * 512 + e0 + (tid >> 6) * 8;
            vst[0] = *(const bf16x8*)(vrow); vst[1] = *(const bf16x8*)(vrow + 4096); }
        bf16x8 qf[8];
        { const bf16_t* qrow = QKV + ((size_t)b * SEQ + wid * 16 + fr) * 4096 + hh * 256 + fq * 8;
#pragma unroll
          for (int ks = 0; ks < 8; ++ks) qf[ks] = *(const bf16x8*)(qrow + ks * 32); }
        for (int n = 0; n < 16; ++n) {
            const size_t tok0 = (size_t)b * SEQ + n * 128;
            int t2 = tid; asm volatile("" : "+v"(t2));
            const int lane = t2 & 63, fr = lane & 15, fq = lane >> 4;
            {
#pragma unroll
                for (int it = 0; it < 8; ++it) *(LAS bf16x8*)(lds + OFF_K + ((t2 >> 5) + 16 * it) * KSB + (t2 & 31) * 16) = kst[it];
                const int cp_ = t2 & 63, q_ = t2 >> 6;
#pragma unroll
                for (int i = 0; i < 8; ++i) *(LAS unsigned*)(lds + OFF_VT + ((q_ * 8 + i) * PS + 2 * cp_) * 2) = (unsigned)(unsigned short)vst[0][i] | ((unsigned)(unsigned short)vst[1][i] << 16);
            }
            if (n < 15) {
                const bf16_t* kp = QKV + (tok0 + 128 + (t2 >> 5)) * 4096 + 1024 + hh * 256 + (t2 & 31) * 8;
#pragma unroll
                for (int it = 0; it < 8; ++it) kst[it] = *(const bf16x8*)(kp + (size_t)it * 16 * 4096);
                const bf16_t* vrow = QKV + (tok0 + 128 + 2 * (t2 & 63)) * 4096 + 2048 + hh * 512 + e0 + (t2 >> 6) * 8;
                vst[0] = *(const bf16x8*)(vrow); vst[1] = *(const bf16x8*)(vrow + 4096); }
            __syncthreads();
            const int cc = wid * 16 + fr;
            const int npair = (wid >> 1) + 1;
            f32x4 a1[4], a2[4];
#pragma unroll
            for (int et = 0; et < 4; ++et) { a1[et] = (f32x4){0.f, 0.f, 0.f, 0.f}; a2[et] = a1[et]; }
            for (int cp2 = 0; cp2 < npair; ++cp2) {
                const int kb0 = OFF_K + (cp2 * 32 + fr) * KSB + fq * 16;
                f32x4 acc0 = (f32x4){0.f, 0.f, 0.f, 0.f}, acc1 = acc0;
#pragma unroll
                for (int ks = 0; ks < 8; ++ks) { acc0 = MFMA16(lds_rd16(lds, kb0 + ks * 64), qf[ks], acc0); acc1 = MFMA16(lds_rd16(lds, kb0 + 16 * KSB + ks * 64), qf[ks], acc1); }
                f32x4 pv0, pv1;
#pragma unroll
                for (int j = 0; j < 4; ++j) { const int cp = cp2 * 32 + fq * 4 + j;
                    pv0[j] = (cc >= cp) ? acc0[j] * 0.0625f * __builtin_amdgcn_exp2f(l2g * (float)(cc - cp)) : 0.f;
                    pv1[j] = (cc >= cp + 16) ? acc1[j] * 0.0625f * __builtin_amdgcn_exp2f(l2g * (float)(cc - cp - 16)) : 0.f; }
                const bf16x8 pf = pack8(pv0, pv1);
#pragma unroll
                for (int et = 0; et < 4; ++et) a1[et] = MFMA16(lds_rd8x2(lds, OFF_VT + ((et * 16 + fr) * PS + cp2 * 32 + fq * 4) * 2), pf, a1[et]);
            }
            {
#pragma unroll
                for (int ks = 0; ks < 8; ++ks)
#pragma unroll
                    for (int et = 0; et < 4; ++et) a2[et] = MFMA16(lds_rd16(lds, OFF_ST + ((et * 16 + fr) * STS + ks * 32 + fq * 8) * 2), qf[ks], a2[et]);
                const float dq = __builtin_amdgcn_exp2f(l2g * (float)(cc + 1));
                bf16_t* orow = O + (tok0 + cc) * 2048 + hh * 512 + e0 + fq * 4;
                float ssum = 0.f, ssq = 0.f;
#pragma unroll
                for (int et = 0; et < 4; ++et) { const f32x4 ov = a1[et] + a2[et] * dq; *(u32x2*)(orow + et * 16) = pack4(ov);
                    ssum += (ov[0] + ov[1]) + (ov[2] + ov[3]); ssq += (ov[0] * ov[0] + ov[1] * ov[1]) + (ov[2] * ov[2] + ov[3] * ov[3]); }
                ssum += shx<16>(ssum, lane); ssum += shx<32>(ssum, lane); ssq += shx<16>(ssq, lane); ssq += shx<32>(ssq, lane);
                if (fq == 0) { float* sp = stats + (((tok0 + cc) * 4 + hh) * 8 + es) * 2; sp[0] = ssum; sp[1] = ssq; }
            }
            if (n < 15) {
                const bf16_t* qrow = QKV + (tok0 + 128 + cc) * 4096 + hh * 256 + fq * 8;
#pragma unroll
                for (int ks = 0; ks < 8; ++ks) qf[ks] = *(const bf16x8*)(qrow + ks * 32); }
            __syncthreads();
            if (n < 15) {
#pragma unroll
                for (int dt = 0; dt < 2; ++dt)
#pragma unroll
                    for (int et = 0; et < 4; ++et) sacc[dt][et] *= gN;
                const int q4 = (lane & 15) >> 2, p4 = lane & 3;
                const float fbase = 0.0625f * __builtin_amdgcn_exp2f(l2g * (float)(127 - 8 * fq));
#pragma unroll
                for (int ks = 0; ks < 4; ++ks) {
                    bf16x8 vf[4];
#pragma unroll
                    for (int et = 0; et < 4; ++et) vf[et] = lds_rd16(lds, OFF_VT + ((et * 16 + fr) * PS + ks * 32 + fq * 8) * 2);
                    const float fks = fbase * __builtin_amdgcn_exp2f(l2g * (float)(-32 * ks));
#pragma unroll
                    for (int dt = 0; dt < 2; ++dt) {
                        const int tb = OFF_K + (32 * ks + 8 * fq + q4) * KSB + (2 * wid + dt) * 32 + 8 * p4;
                        const s16x4 lo = lds_tr8(lds, tb), hi = lds_tr8(lds, tb + 4 * KSB);
                        f32x4 f0, f1;
#pragma unroll
                        for (int e = 0; e < 4; ++e) { f0[e] = bf2f((unsigned short)lo[e]) * (fks * __builtin_amdgcn_exp2f(l2g * (float)(-e))); f1[e] = bf2f((unsigned short)hi[e]) * (fks * __builtin_amdgcn_exp2f(l2g * (float)(-4 - e))); }
                        const bf16x8 kf = pack8(f0, f1);
#pragma unroll
                        for (int et = 0; et < 4; ++et) sacc[dt][et] = MFMA16(kf, vf[et], sacc[dt][et]); }
                }
#pragma unroll
                for (int dt = 0; dt < 2; ++dt)
#pragma unroll
                    for (int et = 0; et < 4; ++et) *(LAS u32x2*)(lds + OFF_ST + ((et * 16 + fr) * STS + (2 * wid + dt) * 16 + fq * 4) * 2) = pack4(sacc[dt][et]);
            }
            __syncthreads();
        }
    }
    __builtin_amdgcn_s_setprio(0);
}

__device__ __forceinline__ void phase_ret_gate(bf16_t* O, const bf16_t* G) {
    int tid = threadIdx.x; asm volatile("" : "+v"(tid));
    const int wid = __builtin_amdgcn_readfirstlane(tid >> 6), lane = tid & 63;
    for (int idx = blockIdx.x * 8 + wid; idx < MTOK * 4; idx += gridDim.x * 8) {
        const size_t base = (size_t)(idx >> 2) * 2048 + (idx & 3) * 512 + lane * 8;
        const u32x4 ov = *(const u32x4*)(O + base), gv = *(const u32x4*)(G + base);
        float o[8] = {bflo(ov.x), bfhi(ov.x), bflo(ov.y), bfhi(ov.y), bflo(ov.z), bfhi(ov.z), bflo(ov.w), bfhi(ov.w)};
        const float g[8] = {bflo(gv.x), bfhi(gv.x), bflo(gv.y), bfhi(gv.y), bflo(gv.z), bfhi(gv.z), bflo(gv.w), bfhi(gv.w)};
        float s = 0.f;
#pragma unroll
        for (int i = 0; i < 8; ++i) s += o[i];
        const float mu = wsum(s, lane) * (1.0f / 512.0f); float v = 0.f;
#pragma unroll
        for (int i = 0; i < 8; ++i) { const float d = o[i] - mu; v += d * d; }
        const float rstd = rsqrtf(wsum(v, lane) * (1.0f / 512.0f) + 1e-6f);
#pragma unroll
        for (int i = 0; i < 8; ++i) o[i] = (o[i] - mu) * rstd * silu_f(g[i]);
        u32x4 w; w.x = cvt_pk_bf16(o[0], o[1]); w.y = cvt_pk_bf16(o[2], o[3]); w.z = cvt_pk_bf16(o[4], o[5]); w.w = cvt_pk_bf16(o[6], o[7]);
        *(u32x4*)(O + base) = w;
    }
}

__device__ __forceinline__ void phase_nsa_mat(const bf16_t* PROJ, const float* pek, const float* pev, bf16_t* AK, bf16_t* AV) {
    const size_t per = (size_t)8128 * 256;
    int tid = threadIdx.x; asm volatile("" : "+v"(tid));
    for (size_t i = (size_t)blockIdx.x * NTHR + tid; i < 2 * per; i += (size_t)gridDim.x * NTHR) {
        const int kv = i >= per; const size_t rem = kv ? i - per : i; const int r = (int)(rem >> 8), pp = (int)(rem & 255), l = pp >> 3, d0 = (pp & 7) * 8;
        const int g = r & 3, bn = r >> 2, b = bn / 127, n = bn % 127;
        const u32x4 v = *(const u32x4*)(PROJ + ((size_t)b * SEQ + n * 16 + l) * 2816 + 1024 + kv * 256 + g * 64 + d0);
        const float* pe = (kv ? pev : pek) + l * 64 + d0; const f32x4 p0 = *(const f32x4*)pe, p1 = *(const f32x4*)(pe + 4);
        u32x4 w; w.x = cvt_pk_bf16(bflo(v.x) + p0[0], bfhi(v.x) + p0[1]); w.y = cvt_pk_bf16(bflo(v.y) + p0[2], bfhi(v.y) + p0[3]);
        w.z = cvt_pk_bf16(bflo(v.z) + p1[0], bfhi(v.z) + p1[1]); w.w = cvt_pk_bf16(bflo(v.w) + p1[2], bfhi(v.w) + p1[3]);
        *(u32x4*)((kv ? AV : AK) + (size_t)r * 2048 + l * 64 + d0) = w;
    }
}
__device__ __forceinline__ void phase_nsa_cmp2(const bf16_t* HK, const bf16_t* HV, const bf16_t* W2K, const bf16_t* W2V, bf16_t* KC, bf16_t* VC) {
    int tid = threadIdx.x; asm volatile("" : "+v"(tid));
    const int wid = __builtin_amdgcn_readfirstlane(tid >> 6), lane = tid & 63, fr = lane & 15, fq = lane >> 4;
    for (int tt = blockIdx.x * 8 + wid; tt < 508 * 2; tt += gridDim.x * 8) {
        const int kv = tt >= 508, rt = kv ? tt - 508 : tt; const bf16_t* Hd = kv ? HV : HK; const bf16_t* W = kv ? W2V : W2K; bf16_t* Od = kv ? VC : KC;
        f32x4 acc[4];
#pragma unroll
        for (int nt = 0; nt < 4; ++nt) acc[nt] = (f32x4){0.f, 0.f, 0.f, 0.f};
#pragma unroll
        for (int ks = 0; ks < 8; ++ks) { const bf16x8 hf = *(const bf16x8*)(Hd + (size_t)(rt * 16 + fr) * 256 + ks * 32 + fq * 8);
#pragma unroll
            for (int nt = 0; nt < 4; ++nt) acc[nt] = MFMA16(*(const bf16x8*)(W + (size_t)(nt * 16 + fr) * 256 + ks * 32 + fq * 8), hf, acc[nt]); }
#pragma unroll
        for (int nt = 0; nt < 4; ++nt) *(u32x2*)(Od + (size_t)(rt * 16 + fr) * 64 + nt * 16 + fq * 4) = pack4(acc[nt]);
    }
}

constexpr int A_KS = 72, A_VS = 72, A_KCS = 72, A_VCS = 72, A_KBYTES = 9216, A_VBYTES = 9216;
struct AttnCtx2 { int b, g, cur, head, hp; int t[2]; float slope; bf16x8 qf[2][2]; float gate[2][3]; unsigned selq[2]; unsigned anym; };
constexpr int B_OFF_K = 0, B_OFF_VT = 18432, B_OFF_KC = 36864, B_OFF_VCT = 55296, B_OFF_IMP = 73728, B_OFF_SEL = 107520, B_OFF_SELP = 107776;

template <int BR>
__device__ __forceinline__ void attn_branch64(const bf16_t* PROJ, LAS unsigned char* lds, const AttnCtx2& C, f32x4 (&otot)[2][4], int tid) {
    const int lane = tid & 63, fr = lane & 15, fq = lane >> 4;
    const float qs = 0.125f * 1.44269504089f, slope2 = C.slope * 1.44269504089f;
    f32x4 sl[4];
#pragma unroll
    for (int kt = 0; kt < 4; ++kt)
#pragma unroll
        for (int jj = 0; jj < 4; ++jj) sl[kt][jj] = slope2 * (float)(kt * 16 + jj);
    float m_[2] = {-1e30f, -1e30f}, l_[2] = {0.f, 0.f};
    f32x4 oa[2][4];
#pragma unroll
    for (int qi = 0; qi < 2; ++qi)
#pragma unroll
        for (int dt = 0; dt < 4; ++dt) oa[qi][dt] = (f32x4){0.f, 0.f, 0.f, 0.f};
    const int jlo = (BR == 1) ? 0 : (C.cur > 8 ? C.cur - 8 : 0);
    const int koff = (BR == 1 ? 1536 : 2048) + C.g * 64, voff = (BR == 1 ? 1792 : 2304) + C.g * 64;
    const int key = tid >> 3, d0 = (tid & 7) * 8;
    const bf16_t* srcb = PROJ + ((size_t)C.b * SEQ + key) * 2816 + d0;
    const int wofs = (key * A_KS + d0) * 2;
    int j = jlo;
    if (BR == 1) { while (j <= C.cur && !((C.anym >> j) & 1u)) ++j; }
    bf16x8 kreg = *(const bf16x8*)(srcb + (size_t)j * 64 * 2816 + koff), vreg = *(const bf16x8*)(srcb + (size_t)j * 64 * 2816 + voff);
    __syncthreads();
    int buf = 0;
    *(LAS bf16x8*)(lds + B_OFF_K + wofs) = kreg; *(LAS bf16x8*)(lds + B_OFF_VT + wofs) = vreg;
    __syncthreads();
    while (j <= C.cur) {
        int jn = j + 1;
        if (BR == 1) { while (jn <= C.cur && !((C.anym >> jn) & 1u)) ++jn; }
        const bool more = jn <= C.cur;
        if (more) { kreg = *(const bf16x8*)(srcb + (size_t)jn * 64 * 2816 + koff); vreg = *(const bf16x8*)(srcb + (size_t)jn * 64 * 2816 + voff); }
        const int kb = B_OFF_K + buf * A_KBYTES, vb = B_OFF_VT + buf * A_VBYTES;
        const bool partial = (j == C.cur) || (BR == 2 && j + 8 <= C.cur);
        bf16x8 pf[2][2];
#pragma unroll
        for (int qi = 0; qi < 2; ++qi) {
            f32x4 s4[4]; float alpha;
            const int dbase = C.t[qi] - j * 64 - fq * 4;
            if (partial) {
                float tmax = -1e30f;
#pragma unroll
                for (int kt = 0; kt < 4; ++kt) { f32x4 acc = (f32x4){0.f, 0.f, 0.f, 0.f};
#pragma unroll
                    for (int ks = 0; ks < 2; ++ks) acc = MFMA16(lds_rd16(lds, kb + ((kt * 16 + fr) * A_KS + ks * 32 + fq * 8) * 2), C.qf[qi][ks], acc);
#pragma unroll
                    for (int jj = 0; jj < 4; ++jj) { const int dist = dbase - (kt * 16 + jj);
                        const bool ok = (dist >= 0) && (BR == 1 ? (((C.selq[qi] >> j) & 1u) != 0u) : (dist < 512));
                        const float sv = ok ? acc[jj] * qs - slope2 * (float)dist : -1e30f; s4[kt][jj] = sv; tmax = fmaxf(tmax, sv); } }
                tmax = fmaxf(tmax, shx<16>(tmax, lane)); tmax = fmaxf(tmax, shx<32>(tmax, lane));
                const float mnew = fmaxf(m_[qi], tmax); alpha = __builtin_amdgcn_exp2f(m_[qi] - mnew); m_[qi] = mnew;
                float psum = 0.f;
#pragma unroll
                for (int kt = 0; kt < 4; ++kt)
#pragma unroll
                    for (int jj = 0; jj < 4; ++jj) { const float pp = (s4[kt][jj] > -1e29f) ? __builtin_amdgcn_exp2f(s4[kt][jj] - mnew) : 0.f; s4[kt][jj] = pp; psum += pp; }
                l_[qi] = l_[qi] * alpha + psum;
            } else {
                float c0 = -slope2 * (float)dbase;
                if (BR == 1 && !((C.selq[qi] >> j) & 1u)) c0 = -1e30f;
                float tmax = -1e30f;
#pragma unroll
                for (int kt = 0; kt < 4; ++kt) { f32x4 acc = (f32x4){0.f, 0.f, 0.f, 0.f};
#pragma unroll
                    for (int ks = 0; ks < 2; ++ks) acc = MFMA16(lds_rd16(lds, kb + ((kt * 16 + fr) * A_KS + ks * 32 + fq * 8) * 2), C.qf[qi][ks], acc);
#pragma unroll
                    for (int jj = 0; jj < 4; ++jj) { const float u = acc[jj] * qs + sl[kt][jj]; s4[kt][jj] = u; tmax = fmaxf(tmax, u); } }
                tmax += c0;
                tmax = fmaxf(tmax, shx<16>(tmax, lane)); tmax = fmaxf(tmax, shx<32>(tmax, lane));
                const float mnew = fmaxf(m_[qi], tmax); alpha = __builtin_amdgcn_exp2f(m_[qi] - mnew); m_[qi] = mnew;
                const float sh = mnew - c0; float psum = 0.f;
#pragma unroll
                for (int kt = 0; kt < 4; ++kt)
#pragma unroll
                    for (int jj = 0; jj < 4; ++jj) { const float pp = __builtin_amdgcn_exp2f(s4[kt][jj] - sh); s4[kt][jj] = pp; psum += pp; }
                l_[qi] = l_[qi] * alpha + psum;
            }
#pragma unroll
            for (int dt = 0; dt < 4; ++dt) oa[qi][dt] *= alpha;
            pf[qi][0] = pack8(s4[0], s4[1]); pf[qi][1] = pack8(s4[2], s4[3]);
        }
#pragma unroll
        for (int ks2 = 0; ks2 < 2; ++ks2)
#pragma unroll
            for (int dt = 0; dt < 4; ++dt) { const bf16x8 vf = lds_tr8x2(lds, vb + (ks2 * 32 + fq * 4 + ((lane & 15) >> 2)) * (A_VS * 2) + dt * 32 + 8 * (lane & 3), 16 * A_VS * 2);
                oa[0][dt] = MFMA16(vf, pf[0][ks2], oa[0][dt]); oa[1][dt] = MFMA16(vf, pf[1][ks2], oa[1][dt]); }
        if (more) { *(LAS bf16x8*)(lds + B_OFF_K + (buf ^ 1) * A_KBYTES + wofs) = kreg; *(LAS bf16x8*)(lds + B_OFF_VT + (buf ^ 1) * A_VBYTES + wofs) = vreg; }
        __syncthreads();
        buf ^= 1; j = jn;
    }
#pragma unroll
    for (int qi = 0; qi < 2; ++qi) { float lt = l_[qi]; lt += shx<16>(lt, lane); lt += shx<32>(lt, lane); const float inv = lt > 0.f ? C.gate[qi][BR] / lt : 0.f;
#pragma unroll
        for (int dt = 0; dt < 4; ++dt) otot[qi][dt] += oa[qi][dt] * inv; }
}

__device__ __forceinline__ void phase_nsa_attn64(const bf16_t* PROJ, const bf16_t* KCMP, const bf16_t* VCMP, bf16_t* OATT, LAS unsigned char* lds) {
    int tid0 = threadIdx.x; asm volatile("" : "+v"(tid0));
    const int wid = __builtin_amdgcn_readfirstlane(tid0 >> 6);
    if (wid >= 4) __builtin_amdgcn_s_setprio(1);
    LAS float* IMP = (LAS float*)(lds + B_OFF_IMP); LAS unsigned* SEL = (LAS unsigned*)(lds + B_OFF_SEL); LAS unsigned* SELP = (LAS unsigned*)(lds + B_OFF_SELP);
    for (int id = blockIdx.x; id < 2048; id += gridDim.x) {
        int tid = tid0; asm volatile("" : "+v"(tid));
        const int lane = tid & 63, fr = lane & 15, fq = lane >> 4;
        const int k8 = id & 255, ii = id >> 8, bg = k8 & 63, kk = k8 >> 6;
        AttnCtx2 C; C.cur = (ii & 1) ? 31 - (kk + 4 * (ii - 1)) : kk + 4 * ii; C.b = bg >> 2; C.g = bg & 3; C.hp = wid >> 1; C.head = C.g * 4 + C.hp; C.slope = exp2f(-0.5f * (float)(C.head + 1));
        int qq[2]; size_t trow[2];
#pragma unroll
        for (int qi = 0; qi < 2; ++qi) { qq[qi] = (wid & 1) * 32 + qi * 16 + fr; C.t[qi] = C.cur * 64 + qq[qi]; trow[qi] = (size_t)C.b * SEQ + C.t[qi];
            const bf16_t* pr = PROJ + trow[qi] * 2816;
#pragma unroll
            for (int ks = 0; ks < 2; ++ks) C.qf[qi][ks] = *(const bf16x8*)(pr + C.head * 64 + ks * 32 + fq * 8);
#pragma unroll
            for (int br = 0; br < 3; ++br) C.gate[qi][br] = 1.0f / (1.0f + __expf(-bf2f(pr[2560 + C.head * 3 + br]))); }
        f32x4 otot[2][4];
#pragma unroll
        for (int qi = 0; qi < 2; ++qi)
#pragma unroll
            for (int dt = 0; dt < 4; ++dt) otot[qi][dt] = (f32x4){0.f, 0.f, 0.f, 0.f};
        __syncthreads();
#pragma unroll
        for (int rep = 0; rep < 2; ++rep) { const int idx = tid + rep * NTHR, n = idx >> 3, d0 = (idx & 7) * 8, nc = n < 126 ? n : 126; const size_t src = ((size_t)(C.b * 127 + nc) * 4 + C.g) * 64 + d0;
            *(LAS bf16x8*)(lds + B_OFF_KC + (n * A_KCS + d0) * 2) = *(const bf16x8*)(KCMP + src);
            *(LAS bf16x8*)(lds + B_OFF_VCT + (n * A_VCS + d0) * 2) = *(const bf16x8*)(VCMP + src); }
        __syncthreads();
#pragma unroll
        for (int qi = 0; qi < 2; ++qi) {
            f32x4 sc[8]; float mx = -1e30f;
#pragma unroll
            for (int kt = 0; kt < 8; ++kt) { f32x4 acc = (f32x4){0.f, 0.f, 0.f, 0.f};
#pragma unroll
                for (int ks = 0; ks < 2; ++ks) acc = MFMA16(lds_rd16(lds, B_OFF_KC + ((kt * 16 + fr) * A_KCS + ks * 32 + fq * 8) * 2), C.qf[qi][ks], acc);
#pragma unroll
                for (int jj = 0; jj < 4; ++jj) { const int n = kt * 16 + fq * 4 + jj, ce = n * 16 + 31; const bool ok = (n <= 126) && (ce <= C.t[qi]);
                    const float sv = ok ? acc[jj] * 0.125f - C.slope * (float)(C.t[qi] - ce) : -1e30f; sc[kt][jj] = sv; mx = fmaxf(mx, sv); } }
            mx = fmaxf(mx, shx<16>(mx, lane)); mx = fmaxf(mx, shx<32>(mx, lane));
            float sum = 0.f;
#pragma unroll
            for (int kt = 0; kt < 8; ++kt)
#pragma unroll
                for (int jj = 0; jj < 4; ++jj) { const float pp = (sc[kt][jj] > -1e29f) ? __expf(sc[kt][jj] - mx) : 0.f; sc[kt][jj] = pp; sum += pp; }
            sum += shx<16>(sum, lane); sum += shx<32>(sum, lane);
            const float inv = sum > 0.f ? 1.0f / sum : 0.f;
#pragma unroll
            for (int kt = 0; kt < 8; ++kt) sc[kt] *= inv;
#pragma unroll
            for (int kt = 0; kt < 8; ++kt) { const float a = shi(sc[kt][3], (lane + 48) & 63); const float bp = kt > 0 ? shi(sc[kt > 0 ? kt - 1 : 0][3], (lane + 48) & 63) : 0.f;
                const float prev3 = fq > 0 ? a : bp;
                IMP[(C.hp * 64 + qq[qi]) * 33 + 4 * kt + fq] = sc[kt][0] + sc[kt][1] + sc[kt][2] + 0.5f * sc[kt][3] + 0.5f * prev3; }
            f32x4 oc[4];
#pragma unroll
            for (int dt = 0; dt < 4; ++dt) oc[dt] = (f32x4){0.f, 0.f, 0.f, 0.f};
#pragma unroll
            for (int ks2 = 0; ks2 < 4; ++ks2) { const bf16x8 pfc = pack8(sc[2 * ks2], sc[2 * ks2 + 1]);
#pragma unroll
                for (int dt = 0; dt < 4; ++dt) oc[dt] = MFMA16(lds_tr8x2(lds, B_OFF_VCT + (ks2 * 32 + fq * 4 + ((lane & 15) >> 2)) * (A_VCS * 2) + dt * 32 + 8 * (lane & 3), 16 * A_VCS * 2), pfc, oc[dt]); }
#pragma unroll
            for (int dt = 0; dt < 4; ++dt) otot[qi][dt] += oc[dt] * C.gate[qi][0];
        }
        __syncthreads();
        if (C.cur >= 16) {
            const int sq = tid & 63, jg = tid >> 6;
#pragma unroll
            for (int jj = 0; jj < 4; ++jj) { const int j = jg * 4 + jj; const float imp = IMP[(0 * 64 + sq) * 33 + j] + IMP[(1 * 64 + sq) * 33 + j] + IMP[(2 * 64 + sq) * 33 + j] + IMP[(3 * 64 + sq) * 33 + j];
                const bool valid = j <= C.cur, forced = (j == 0) || (j == C.cur) || (j == C.cur - 1);
                IMP[sq * 33 + j] = valid ? (forced ? 1e4f : imp) : -1.0f; }
            __syncthreads();
            unsigned bits = 0u;
#pragma unroll
            for (int jj = 0; jj < 4; ++jj) { const int j = jg * 4 + jj; const float sj = IMP[sq * 33 + j]; int cnt = 0;
                for (int j2 = 0; j2 < 32; ++j2) { const float s2 = IMP[sq * 33 + j2]; cnt += ((s2 > sj) || (s2 == sj && j2 < j)) ? 1 : 0; }
                if (cnt < 16) bits |= 1u << j; }
            SELP[jg * 64 + sq] = bits;
            __syncthreads();
            if (tid < 64) { unsigned m = 0u;
#pragma unroll
                for (int q = 0; q < 8; ++q) m |= SELP[q * 64 + tid];
                SEL[tid] = m; }
        } else { if (tid < 64) SEL[tid] = (2u << C.cur) - 1u; }
        __syncthreads();
        C.selq[0] = SEL[qq[0]]; C.selq[1] = SEL[qq[1]];
        { unsigned m = SEL[lane]; m |= shxu<32>(m, lane); m |= shxu<16>(m, lane); m |= shxu<8>(m, lane); m |= shxu<4>(m, lane); m |= shxu<2>(m, lane); m |= shxu<1>(m, lane); C.anym = (unsigned)__builtin_amdgcn_readfirstlane((int)m); }
        attn_branch64<1>(PROJ, lds, C, otot, tid);
        attn_branch64<2>(PROJ, lds, C, otot, tid);
#pragma unroll
        for (int qi = 0; qi < 2; ++qi)
#pragma unroll
            for (int dt = 0; dt < 4; ++dt) *(u32x2*)(OATT + trow[qi] * 1024 + C.head * 64 + dt * 16 + fq * 4) = pack4(otot[qi][dt]);
    }
    __builtin_amdgcn_s_setprio(0);
}

#define XB_TMO      128
#define XB_XCNT(j)  (256  + 64 * (j))
#define XB_XSUB(j)  (1280 + 64 * (j))
#define XB_XGEN(j)  (2304 + 64 * (j))
#define XB_TOP      3328
#define XB_TOPGEN   3392
#define XCD_BAR_WORDS 3456
#define XB_SPIN_CAP (1u << 18)

__device__ __forceinline__ unsigned xb_ld(unsigned* p)              { return __hip_atomic_load(p, __ATOMIC_RELAXED, __HIP_MEMORY_SCOPE_AGENT); }
__device__ __forceinline__ unsigned xb_add(unsigned* p, unsigned v) { return __hip_atomic_fetch_add(p, v, __ATOMIC_RELAXED, __HIP_MEMORY_SCOPE_AGENT); }
__device__ __forceinline__ unsigned xb_xcc_id() { return (unsigned)__builtin_amdgcn_s_getreg((3 << 11) | 20) & 0xFu; }
#define XB_SPIN(cond, bar) do { unsigned _sp = 0; while (cond) { __builtin_amdgcn_s_sleep(1); \
    if ((++_sp & 255u) == 0u) { if (xb_ld(&(bar)[XB_TMO])) break; if (_sp > XB_SPIN_CAP) { atomicAdd(&(bar)[XB_TMO], 1u); break; } } } } while (0)

struct XcdBarrier {
    unsigned* bar; unsigned x;
    volatile LAS unsigned* st;
};

__device__ __forceinline__ XcdBarrier xcd_barrier_post(unsigned* bar, volatile LAS unsigned* st) {
    XcdBarrier b; b.bar = bar; b.x = xb_xcc_id(); b.st = st;
    if (threadIdx.x == 0) (void)xb_add(&bar[XB_XCNT(b.x)], 1u);
    return b;
}
__device__ __forceinline__ void xcd_barrier_complete(unsigned* bar, unsigned x, unsigned& nloc, unsigned& nx) {
    const unsigned G = gridDim.x * gridDim.y * gridDim.z;
    unsigned sum, cnt, mine, sp = 0u;
    for (;;) {
        sum = 0u; cnt = 0u; mine = 0u;
#pragma unroll
        for (unsigned j = 0; j < 16; ++j) { const unsigned c = xb_ld(&bar[XB_XCNT(j)]); sum += c; cnt += (c > 0u) ? 1u : 0u; mine = (j == x) ? c : mine; }
        if (sum == G) break;
        __builtin_amdgcn_s_sleep(1);
        if ((++sp & 255u) == 0u) { if (xb_ld(&bar[XB_TMO])) break; if (sp > XB_SPIN_CAP) { atomicAdd(&bar[XB_TMO], 1u); break; } }
    }
    nloc = mine > 0u ? mine : 1u; nx = cnt > 0u ? cnt : 1u;
}

__device__ __forceinline__ void xcd_barrier(const XcdBarrier& b) {
    asm volatile("s_waitcnt vmcnt(0)" ::: "memory");
    __syncthreads();
    if (threadIdx.x == 0) {
        unsigned* bar = b.bar;
        __builtin_amdgcn_s_waitcnt(0);
        unsigned nloc = b.st[0], nx = b.st[1];
        if (nloc == 0u) { xcd_barrier_complete(bar, b.x, nloc, nx); b.st[0] = nloc; b.st[1] = nx; }
        const unsigned old = xb_add(&bar[XB_XSUB(b.x)], 1u);
        const unsigned gen = old / nloc;
        if (old + 1u == (gen + 1u) * nloc) {
            __builtin_amdgcn_fence(__ATOMIC_RELEASE, "agent");
            asm volatile("s_waitcnt vmcnt(0)" ::: "memory");
            const unsigned og = xb_add(&bar[XB_TOP], 1u);
            const unsigned tg = og / nx;
            if (og + 1u == (tg + 1u) * nx) xb_add(&bar[XB_TOPGEN], 1u);
            else XB_SPIN(xb_ld(&bar[XB_TOPGEN]) == tg, bar);
            __builtin_amdgcn_fence(__ATOMIC_ACQUIRE, "agent");
            xb_add(&bar[XB_XGEN(b.x)], 1u);
            asm volatile("s_waitcnt vmcnt(0)" ::: "memory");
        } else {
            XB_SPIN(xb_ld(&bar[XB_XGEN(b.x)]) == gen, bar);
            __builtin_amdgcn_fence(__ATOMIC_ACQUIRE, "agent");
            asm volatile("s_waitcnt vmcnt(0)" ::: "memory");
        }
    }
    __syncthreads();
}


#ifndef R_CORE
#define R_CORE 1
#endif
#ifndef R_ATTN
#define R_ATTN 1
#endif
#ifndef R_GEMM
#define R_GEMM 1
#endif
#ifndef R_BAR
#define R_BAR 1
#endif
#ifndef R_PREP
#define R_PREP 1
#endif
#ifndef GEMM_ALIGN
#define GEMM_ALIGN true
#endif
#ifndef GEMM_SP2
#define GEMM_SP2 true
#endif
struct GemmDesc { const bf16_t* A; const bf16_t* Bt; bf16_t* O; int M, N, K, ldc, act, cshift; const float* stats; };
__device__ __forceinline__ void run_gemm(const GemmDesc& d, LAS unsigned char* lds) {
    pg8::Gemm g{d.A, d.Bt, d.M, d.N, d.K}; pg8::StaticOrder S; const int G = (int)gridDim.x; S.init(d.M, d.N, G, ((int)blockIdx.x + G - d.cshift % G) % G);
    if (d.act == 0) { pg8::Epi<0> E{d.O, d.ldc, nullptr}; pg8::gemm_phase<pg8::Epi<0>, pg8::StaticOrder, GEMM_ALIGN, GEMM_SP2>(lds, g, S, E); }
    else if (d.act == 1) { pg8::Epi<1> E{d.O, d.ldc, nullptr}; pg8::gemm_phase<pg8::Epi<1>, pg8::StaticOrder, GEMM_ALIGN, GEMM_SP2>(lds, g, S, E); }
    else if (d.act == 3) { pg8::Epi<3> E{d.O, d.ldc, d.stats}; pg8::gemm_phase<pg8::Epi<3>, pg8::StaticOrder, GEMM_ALIGN, GEMM_SP2>(lds, g, S, E); }
    else { pg8::Epi<2> E{d.O, d.ldc, nullptr}; pg8::gemm_phase<pg8::Epi<2>, pg8::StaticOrder, GEMM_ALIGN, GEMM_SP2>(lds, g, S, E); }
}

__global__ void __launch_bounds__(NTHR) fwd_megakernel(Params p) {
    extern __shared__ __attribute__((aligned(16))) unsigned char smem[];
    LAS unsigned char* lds = (LAS unsigned char*)smem;
    cg::grid_group grid = cg::this_grid();
    unsigned char* ws = p.ws; unsigned char* U = ws + OFF_U2;
    const float* mod = (const float*)(ws + OFF_MOD); bf16_t* H = (bf16_t*)(ws + OFF_H);
    if (threadIdx.x < 4) ((LAS unsigned*)(lds + XB_LDS_OFF))[threadIdx.x] = 0u;
    __syncthreads();
    XcdBarrier xbar = xcd_barrier_post((unsigned*)(ws + WS_END), (volatile LAS unsigned*)(lds + XB_LDS_OFF));
    grid.sync();

#if 0
    { const u32x4 pz = (u32x4){0xAAAAAAAAu, 0xAAAAAAAAu, 0xAAAAAAAAu, 0xAAAAAAAAu}; for (size_t i = (size_t)blockIdx.x * NTHR + threadIdx.x; i < WS_END / 16; i += (size_t)gridDim.x * NTHR) ((u32x4*)ws)[i] = pz; }
    xcd_barrier(xbar);
#endif
    for (int gs = 0; gs < 2 + DEPTH * 13; ++gs) {
        if (gs < 2) {
            if (gs == 0) { for (int rr = 0; rr < R_PREP; ++rr) phase_prep(p, lds); } else phase_init(p);
        } else {
        const int layer = (gs - 2) / 13, st = (gs - 2) % 13;
        const int jm = layer >> 1; const bool is_ret = (layer & 1) == 0;
        const float* modL = mod + (size_t)layer * 16 * MODW;
        {
            GemmDesc d[2]; int ng = 0;
            d[0].cshift = 0; d[1].cshift = 0;
            if (st == 0 || st == 10) {
                const int s = st == 0 ? 0 : 1;
                d[0] = GemmDesc{H, (const bf16_t*)(ws + OFF_FFN_IN + (size_t)(layer * 2 + s) * SZ_FFN_IN), (bf16_t*)(U + U_FFN_ACT), MTOK, 5632, 1024, DFF, 1, 0, nullptr}; ng = 1;
            } else if (st == 1 || st == 11) {
                const int s = st == 1 ? 0 : 1;
                d[0] = GemmDesc{(const bf16_t*)(U + U_FFN_ACT), (const bf16_t*)(ws + OFF_FFN_OUT + (size_t)(layer * 2 + s) * SZ_FFN_OUT), (bf16_t*)(U + U_FFN_Y), MTOK, 1024, DFF, 1024, 0, 0, nullptr}; ng = 1;
            } else if (st == 2 || st == 9 || st == 12) {
                const int sub = st == 2 ? 0 : (st == 9 ? 1 : 2);
                const bf16_t* y = (const bf16_t*)(U + (sub == 1 ? (is_ret ? U_RET_Y : U_NSA_Y) : U_FFN_Y));
                const float* modN = (sub == 2) ? (layer + 1 < DEPTH ? modL + (size_t)16 * MODW : modL) : modL;
                const int shc = (sub == 2) ? 0 : (sub + 1) * 3;
                phase_ln(p.out, p.out, y, modL + (sub * 3 + 2) * 1024, sub == 1 ? 1.0f : 0.5f, p.ln_g + (size_t)(layer * 3 + sub) * 1024, p.ln_b + (size_t)(layer * 3 + sub) * 1024,
                         modN + shc * 1024, modN + (shc + 1) * 1024, H);
            } else if (is_ret) {
                const bf16_t* Wi = (const bf16_t*)(ws + OFF_RET_IN + (size_t)jm * SZ_RET_IN);
                if (st == 3) { d[0] = GemmDesc{H, Wi, (bf16_t*)(U + U_RET_QKV), MTOK, 4096, 1024, 4096, 0, 0, nullptr}; ng = 1; }
                else if (st == 4) { for (int rr = 0; rr < R_CORE; ++rr) phase_ret_core((const bf16_t*)(U + U_RET_QKV), (bf16_t*)(U + U_RET_O), (float*)(ws + OFF_FFN_IN + (size_t)(layer * 2) * SZ_FFN_IN), lds); }
                else if (st == 5) { d[0] = GemmDesc{H, Wi + (size_t)4096 * 1024, (bf16_t*)(U + U_RET_O), MTOK, 2048, 1024, 2048, 3, 0, (const float*)(ws + OFF_FFN_IN + (size_t)(layer * 2) * SZ_FFN_IN)}; ng = 1; }
                else if (st == 6) continue;
                else if (st == 7) { d[0] = GemmDesc{(const bf16_t*)(U + U_RET_O), (const bf16_t*)(ws + OFF_RET_OUT + (size_t)jm * SZ_RET_OUT), (bf16_t*)(U + U_RET_Y), MTOK, 1024, 2048, 1024, 0, 0, nullptr}; ng = 1; }
                else continue;
            } else {
                if (st == 3) { d[0] = GemmDesc{H, (const bf16_t*)(ws + OFF_NSA_IN + (size_t)jm * SZ_NSA_IN), (bf16_t*)(U + U_NSA_PROJ), MTOK, 2816, 1024, 2816, 0, 0, nullptr}; ng = 1; }
                else if (st == 4) phase_nsa_mat((const bf16_t*)(U + U_NSA_PROJ), p.pe_k + (size_t)jm * 2048, p.pe_v + (size_t)jm * 2048, (bf16_t*)(U + U_NSA_ACMPK), (bf16_t*)(U + U_NSA_ACMPV));
                else if (st == 5) {
                    d[0] = GemmDesc{(const bf16_t*)(U + U_NSA_ACMPK), (const bf16_t*)(ws + OFF_W1 + (size_t)(0 * 2 + jm) * SZ_W1), (bf16_t*)(U + U_NSA_HK), 8192, 256, 2048, 256, 2, 0, nullptr};
                    d[1] = GemmDesc{(const bf16_t*)(U + U_NSA_ACMPV), (const bf16_t*)(ws + OFF_W1 + (size_t)(1 * 2 + jm) * SZ_W1), (bf16_t*)(U + U_NSA_HV), 8192, 256, 2048, 256, 2, 32, nullptr}; ng = 2;
                } else if (st == 6) phase_nsa_cmp2((const bf16_t*)(U + U_NSA_HK), (const bf16_t*)(U + U_NSA_HV), (const bf16_t*)(ws + OFF_W2 + (size_t)(0 * 2 + jm) * SZ_W2), (const bf16_t*)(ws + OFF_W2 + (size_t)(1 * 2 + jm) * SZ_W2),
                                               (bf16_t*)(U + U_NSA_KCMP), (bf16_t*)(U + U_NSA_VCMP));
                else if (st == 7) { for (int rr = 0; rr < R_ATTN; ++rr) phase_nsa_attn64((const bf16_t*)(U + U_NSA_PROJ), (const bf16_t*)(U + U_NSA_KCMP), (const bf16_t*)(U + U_NSA_VCMP), (bf16_t*)(U + U_NSA_OATT), lds); }
                else { d[0] = GemmDesc{(const bf16_t*)(U + U_NSA_OATT), (const bf16_t*)(ws + OFF_NSA_OUT + (size_t)jm * SZ_NSA_OUT), (bf16_t*)(U + U_NSA_Y), MTOK, 1024, 1024, 1024, 0, 0, nullptr}; ng = 1; }
            }
            for (int rr = 0; rr < R_GEMM; ++rr) for (int r = 0; r < ng; ++r) { GemmDesc dd = d[0]; if (r == 1) dd = d[1]; run_gemm(dd, lds); }
        }
        }
        xcd_barrier(xbar);
    }
}

extern "C" void kernel_launch(void* const* d_in, const int* in_sizes, int n_in, void* d_out, int out_size, void* d_ws, size_t ws_size, hipStream_t stream) {
    static int grid_blocks = 0;
    if (grid_blocks == 0) {
        int dev = 0, cus = 0, per_cu = 0;
        hipGetDevice(&dev); hipDeviceGetAttribute(&cus, hipDeviceAttributeMultiprocessorCount, dev);
        if (hipFuncSetAttribute((const void*)fwd_megakernel, hipFuncAttributeMaxDynamicSharedMemorySize, LDS_BYTES) != hipSuccess) fprintf(stderr, "hipFuncSetAttribute failed\n");
        if (hipOccupancyMaxActiveBlocksPerMultiprocessor(&per_cu, (const void*)fwd_megakernel, NTHR, LDS_BYTES) != hipSuccess || per_cu < 1) { fprintf(stderr, "occupancy query: %d\n", per_cu); per_cu = 1; }
        (void)hipGetLastError();
        grid_blocks = cus * 1;
        if (ws_size < WS_END + 16384) fprintf(stderr, "workspace too small: %zu < %zu\n", ws_size, (size_t)WS_END);
    }
    Params p{};
    p.x = (const float*)d_in[0]; p.c = (const float*)d_in[1]; p.ada_w = (const float*)d_in[2]; p.ada_b = (const float*)d_in[3]; p.ln_g = (const float*)d_in[4]; p.ln_b = (const float*)d_in[5];
    p.pe_k = (const float*)d_in[12]; p.pe_v = (const float*)d_in[13]; p.out = (float*)d_out; p.ws = (unsigned char*)d_ws;
    unsigned char* ws = (unsigned char*)d_ws; int nj = 0, te = 0;
    auto add = [&](const float* src, size_t dst_off, int K, int N, int Np, int mode) { p.jobs[nj] = WJob{src, (bf16_t*)(ws + dst_off), K, N, Np, mode}; te += (Np / 64) * (K / 64); p.tile_end[nj] = te; ++nj; };
    const float* ffn_in = (const float*)d_in[6]; const float* ffn_out = (const float*)d_in[7]; const float* ret_in = (const float*)d_in[8]; const float* ret_out = (const float*)d_in[9];
    const float* nsa_in = (const float*)d_in[10]; const float* nsa_out = (const float*)d_in[11];
    const float* ck1 = (const float*)d_in[14]; const float* ck2 = (const float*)d_in[15]; const float* cv1 = (const float*)d_in[16]; const float* cv2 = (const float*)d_in[17];
    for (int i = 0; i < 8; ++i) add(ffn_in + (size_t)i * 1024 * 5632, OFF_FFN_IN + i * SZ_FFN_IN, 1024, 5632, 5632, 1);
    for (int i = 0; i < 8; ++i) add(ffn_out + (size_t)i * 2816 * 1024, OFF_FFN_OUT + i * SZ_FFN_OUT, 2816, 1024, 1024, 0);
    for (int i = 0; i < 2; ++i) add(ret_in + (size_t)i * 1024 * 6144, OFF_RET_IN + i * SZ_RET_IN, 1024, 6144, 6144, 0);
    for (int i = 0; i < 2; ++i) add(ret_out + (size_t)i * 2048 * 1024, OFF_RET_OUT + i * SZ_RET_OUT, 2048, 1024, 1024, 0);
    for (int i = 0; i < 2; ++i) add(nsa_in + (size_t)i * 1024 * 2608, OFF_NSA_IN + i * SZ_NSA_IN, 1024, 2608, 2816, 0);
    for (int i = 0; i < 2; ++i) add(nsa_out + (size_t)i * 1024 * 1024, OFF_NSA_OUT + i * SZ_NSA_OUT, 1024, 1024, 1024, 0);
    for (int i = 0; i < 2; ++i) add(ck1 + (size_t)i * 2048 * 256, OFF_W1 + (0 * 2 + i) * SZ_W1, 2048, 256, 256, 0);
    for (int i = 0; i < 2; ++i) add(cv1 + (size_t)i * 2048 * 256, OFF_W1 + (1 * 2 + i) * SZ_W1, 2048, 256, 256, 0);
    for (int i = 0; i < 2; ++i) add(ck2 + (size_t)i * 256 * 64, OFF_W2 + (0 * 2 + i) * SZ_W2, 256, 64, 64, 0);
    for (int i = 0; i < 2; ++i) add(cv2 + (size_t)i * 256 * 64, OFF_W2 + (1 * 2 + i) * SZ_W2, 256, 64, 64, 0);
    p.njobs = nj;
    if (hipMemsetAsync(ws + WS_END, 0, 16384, stream) != hipSuccess) fprintf(stderr, "barrier memset failed\n");
    void* args[] = {&p};
    hipError_t e = hipLaunchCooperativeKernel((const void*)fwd_megakernel, dim3(grid_blocks), dim3(NTHR), args, LDS_BYTES, stream);
    if (e != hipSuccess) fprintf(stderr, "cooperative launch failed: %s (grid %d)\n", hipGetErrorString(e), grid_blocks);
}
```
